# Optimizing an MI355X kernel written in HIP

```python
import jax, jax.numpy as jnp
from jax import lax
import numpy as np

D_MODEL = 2048
BATCH = 2
SEQ = 8192
DEPTH = 2

GRID_W = 64
CTX_LEN = 256
N_MIXERS = 2
N_HGRN_LAYERS = (DEPTH + N_MIXERS - 1) // N_MIXERS
N_ATTN_LAYERS = DEPTH // N_MIXERS
HGRN_HEADS = 16
HGRN_HEAD_K = D_MODEL // HGRN_HEADS
HGRN_HEAD_V = D_MODEL // HGRN_HEADS
HGRN_CHUNK = 64
ATTN_HEADS = 16
ATTN_KV_HEADS = 4
ATTN_GROUP = ATTN_HEADS // ATTN_KV_HEADS
HEAD_DIM = D_MODEL // ATTN_HEADS
AXIS_DIM = HEAD_DIM // 2
ROPE_THETA = 10000.0
Q_BLOCK = 128
D_FF = ((8 * D_MODEL // 3 + 255) // 256) * 256
CONV_W = 3
N_MOD = 6
EPS = 1e-6

kernel_name = 'hybrid_hgrn2_gqa_convffn_dit'


def rms_norm(x, gain):
    x32 = x.astype(jnp.float32)
    y = x32 * lax.rsqrt(jnp.mean(x32 * x32, axis=-1, keepdims=True) + EPS)
    return (y * gain.astype(jnp.float32)).astype(x.dtype)


def modulate(x, shift, scale):
    return x * (1 + scale) + shift


def dwconv_centred(h, w, b):
    T = h.shape[1]
    hp = jnp.pad(h, ((0, 0), (CONV_W // 2, CONV_W // 2), (0, 0)))
    return sum(hp[:, d:d + T] * w[d] for d in range(CONV_W)) + b


def conv_ffn(h, w_in, conv_w, conv_b, w_out):
    gate, up = jnp.split(h @ w_in, 2, axis=-1)
    return (jax.nn.silu(dwconv_centred(gate, conv_w, conv_b)) * up) @ w_out


def gla_chunk_scan(q, k, v, log_f, s0):
    B, H, T, _ = q.shape
    n_chunks = T // HGRN_CHUNK

    def chunks(a):
        return jnp.moveaxis(a.reshape(B, H, n_chunks, HGRN_CHUNK, a.shape[-1]), 2, 0)

    within = jnp.tril(jnp.ones((HGRN_CHUNK, HGRN_CHUNK), dtype=bool))[:, :, None]

    def step(S, inp):
        qc, kc, vc, lfc = inp
        b = jnp.cumsum(lfc, axis=2)
        rel = b[:, :, :, None, :] - b[:, :, None, :, :]
        decay = jnp.exp(jnp.where(within, rel, -jnp.inf))
        scores = jnp.einsum('bhtk,bhsk,bhtsk->bhts', qc, kc, decay)
        o = (jnp.einsum('bhts,bhsv->bhtv', scores, vc)
             + jnp.einsum('bhtk,bhkv->bhtv', qc * jnp.exp(b), S))
        b_end = b[:, :, -1:, :]
        S = (jnp.exp(b_end[:, :, 0, :, None]) * S
             + jnp.einsum('bhsk,bhsv->bhkv', kc * jnp.exp(b_end - b), vc))
        return S, o

    S, o = lax.scan(step, s0, (chunks(q), chunks(k), chunks(v), chunks(log_f)))
    return jnp.moveaxis(o, 0, 2).reshape(B, H, T, v.shape[-1]), S


def hgrn2_mixer(h_lat, h_ctx, w_in, lower_bound, o_gain, w_out, need_ctx):
    def project(h):
        B, T, _ = h.shape
        q, f_fw, f_bw, v, g = jnp.split(h @ w_in, 5, axis=-1)

        def heads(a):
            return a.reshape(B, T, HGRN_HEADS, -1).transpose(0, 2, 1, 3).astype(jnp.float32)

        dirs = []
        for f_raw, lb in ((f_fw, lower_bound[0]), (f_bw, lower_bound[1])):
            f = lb + (1 - lb) * jax.nn.sigmoid(f_raw.astype(jnp.float32))
            dirs.append((heads(1 - f), heads(jnp.log(f))))
        return heads(jax.nn.silu(q)) * HGRN_HEAD_K ** -0.5, dirs, heads(v), g

    def flip(a):
        return a[:, :, ::-1]

    def readout(o, g):
        B, H, T, V = o.shape
        o = rms_norm(o, o_gain).transpose(0, 2, 1, 3).reshape(B, T, H * V).astype(g.dtype)
        return (o * jax.nn.silu(g)) @ w_out

    q_c, ((k_cf, lf_cf), (k_cb, lf_cb)), v_c, g_c = project(h_ctx)
    q_l, ((k_lf, lf_lf), (k_lb, lf_lb)), v_l, g_l = project(h_lat)
    s0 = jnp.zeros((h_lat.shape[0], HGRN_HEADS, HGRN_HEAD_K, HGRN_HEAD_V), jnp.float32)
    o_cf, s_fw = gla_chunk_scan(q_c, k_cf, v_c, lf_cf, s0)
    o_cb, s_bw = gla_chunk_scan(flip(q_c), flip(k_cb), flip(v_c), flip(lf_cb), s0)
    o_lf, _ = gla_chunk_scan(q_l, k_lf, v_l, lf_lf, s_fw)
    o_lb, _ = gla_chunk_scan(flip(q_l), flip(k_lb), flip(v_l), flip(lf_lb), s_bw)
    y_lat = readout(o_lf + flip(o_lb), g_l)
    y_ctx = readout(o_cf + flip(o_cb), g_c) if need_ctx else None
    return y_lat, y_ctx


def axial_rope_tables(rows, cols):
    inv_freq = ROPE_THETA ** (-jnp.arange(0, AXIS_DIM, 2, dtype=jnp.float32) / AXIS_DIM)
    ang = jnp.concatenate([rows[:, None] * inv_freq, cols[:, None] * inv_freq], axis=-1)
    return jnp.cos(ang), jnp.sin(ang)


def apply_axial_rope(x, cos, sin):
    x32 = x.astype(jnp.float32)
    x1, x2 = x32[..., 0::2], x32[..., 1::2]
    c, s = cos[:, None, :], sin[:, None, :]
    return jnp.stack([x1 * c - x2 * s, x1 * s + x2 * c], axis=-1).reshape(x.shape).astype(x.dtype)


def gqa_mixer(h_lat, h_ctx, w_qkv, q_gain, k_gain, w_out, cos, sin, need_ctx):
    def project(h):
        B, T, _ = h.shape
        p = (h @ w_qkv).reshape(B, T, ATTN_HEADS + 2 * ATTN_KV_HEADS, HEAD_DIM)
        k = rms_norm(p[:, :, ATTN_HEADS:ATTN_HEADS + ATTN_KV_HEADS], k_gain)
        return p[:, :, :ATTN_HEADS], k, p[:, :, ATTN_HEADS + ATTN_KV_HEADS:]

    def attend(q, k, v):
        s = jnp.einsum('bqkgd,bskd->bkgqs', q, k, preferred_element_type=jnp.float32) * HEAD_DIM ** -0.5
        p = jax.nn.softmax(s, axis=-1).astype(v.dtype)
        return jnp.einsum('bkgqs,bskd->bqkgd', p, v)

    B, T, D = h_lat.shape
    q_l, k_l, v_l = project(h_lat)
    q_c, k_c, v_c = project(h_ctx)
    q_l = apply_axial_rope(rms_norm(q_l, q_gain), cos, sin)
    q_blocks = jnp.moveaxis(
        q_l.reshape(B, T // Q_BLOCK, Q_BLOCK, ATTN_KV_HEADS, ATTN_GROUP, HEAD_DIM), 1, 0)
    k_all = jnp.concatenate([k_c, apply_axial_rope(k_l, cos, sin)], axis=1)
    v_all = jnp.concatenate([v_c, v_l], axis=1)
    o_l = lax.map(lambda qb: attend(qb, k_all, v_all), q_blocks)
    y_lat = jnp.moveaxis(o_l, 0, 1).reshape(B, T, D) @ w_out
    if need_ctx:
        Tc = h_ctx.shape[1]
        q_c = rms_norm(q_c, q_gain).reshape(B, Tc, ATTN_KV_HEADS, ATTN_GROUP, HEAD_DIM)
        y_ctx = attend(q_c, k_c, v_c).reshape(B, Tc, D) @ w_out
    else:
        y_ctx = None
    return y_lat, y_ctx


def setup_inputs(seed: int = 0) -> dict:
    key = jax.random.key(seed)
    ks = iter(jax.random.split(key, 24))

    def normal(shape, scale):
        return jax.random.normal(next(ks), shape, jnp.float32) * scale

    def gain(shape):
        return 1.0 + normal(shape, 0.05)

    D = D_MODEL
    return {
        'x': normal((BATCH, SEQ, D), 1.0),
        'c': normal((BATCH, D), 1.0),
        'ctx': normal((BATCH, CTX_LEN, D), 1.0),
        'c_ctx': normal((D,), 1.0),
        'ada_w': normal((DEPTH, D, N_MOD * D), D ** -0.5),
        'ada_b': normal((DEPTH, N_MOD * D), 0.02),
        'norm_mix_pre': gain((DEPTH, D)),
        'norm_mix_post': gain((DEPTH, D)),
        'norm_ffn_pre': gain((DEPTH, D)),
        'norm_ffn_post': gain((DEPTH, D)),
        'hgrn_w_in': normal((N_HGRN_LAYERS, D, 5 * D), D ** -0.5),
        'hgrn_lb_logits': normal((2, N_HGRN_LAYERS + 1, HGRN_HEADS * HGRN_HEAD_K), 0.1),
        'hgrn_o_norm': gain((N_HGRN_LAYERS, HGRN_HEAD_V)),
        'hgrn_w_out': normal((N_HGRN_LAYERS, HGRN_HEADS * HGRN_HEAD_V, D), D ** -0.5),
        'attn_w_qkv': normal((N_ATTN_LAYERS, D, (ATTN_HEADS + 2 * ATTN_KV_HEADS) * HEAD_DIM), D ** -0.5),
        'attn_q_norm': gain((N_ATTN_LAYERS, HEAD_DIM)),
        'attn_k_norm': gain((N_ATTN_LAYERS, HEAD_DIM)),
        'attn_w_out': normal((N_ATTN_LAYERS, ATTN_HEADS * HEAD_DIM, D), D ** -0.5),
        'ffn_w_in': normal((DEPTH, D, 2 * D_FF), D ** -0.5),
        'ffn_conv_w': normal((DEPTH, CONV_W, D_FF), CONV_W ** -0.5),
        'ffn_conv_b': normal((DEPTH, D_FF), 0.02),
        'ffn_w_out': normal((DEPTH, D_FF, D), D_FF ** -0.5),
    }


def reference(x, c, ctx, c_ctx, ada_w, ada_b, norm_mix_pre, norm_mix_post, norm_ffn_pre, norm_ffn_post,
              hgrn_w_in, hgrn_lb_logits, hgrn_o_norm, hgrn_w_out,
              attn_w_qkv, attn_q_norm, attn_k_norm, attn_w_out,
              ffn_w_in, ffn_conv_w, ffn_conv_b, ffn_w_out):
    T = x.shape[1]
    ROWS = T // GRID_W
    rows = jnp.repeat(jnp.arange(ROWS, dtype=jnp.float32), GRID_W)
    cols = jnp.tile(jnp.arange(GRID_W, dtype=jnp.float32), ROWS)
    cos, sin = axial_rope_tables(rows, cols)
    lower_bounds = jnp.cumsum(jax.nn.softmax(hgrn_lb_logits.astype(jnp.float32), axis=1), axis=1)
    silu_c = jax.nn.silu(c)
    silu_cc = jax.nn.silu(c_ctx)
    x_lat, x_ctx = x, ctx
    for i in range(DEPTH):
        j = i // N_MIXERS
        last = i == DEPTH - 1
        sh_ml, sc_ml, gt_ml, sh_fl, sc_fl, gt_fl = jnp.split(
            (silu_c @ ada_w[i] + ada_b[i])[:, None, :], N_MOD, axis=-1)
        sh_mc, sc_mc, gt_mc, sh_fc, sc_fc, gt_fc = jnp.split(
            silu_cc @ ada_w[i] + ada_b[i], N_MOD, axis=-1)
        h_l = modulate(rms_norm(x_lat, norm_mix_pre[i]), sh_ml, sc_ml)
        h_c = modulate(rms_norm(x_ctx, norm_mix_pre[i]), sh_mc, sc_mc)
        if i % N_MIXERS == 0:
            y_l, y_c = hgrn2_mixer(h_l, h_c, hgrn_w_in[j], lower_bounds[:, j], hgrn_o_norm[j],
                                   hgrn_w_out[j], not last)
        else:
            y_l, y_c = gqa_mixer(h_l, h_c, attn_w_qkv[j], attn_q_norm[j], attn_k_norm[j],
                                 attn_w_out[j], cos, sin, not last)
        x_lat = x_lat + gt_ml * rms_norm(y_l, norm_mix_post[i])
        h_l = modulate(rms_norm(x_lat, norm_ffn_pre[i]), sh_fl, sc_fl)
        f_l = conv_ffn(h_l, ffn_w_in[i], ffn_conv_w[i], ffn_conv_b[i], ffn_w_out[i])
        x_lat = x_lat + gt_fl * rms_norm(f_l, norm_ffn_post[i])
        if not last:
            x_ctx = x_ctx + gt_mc * rms_norm(y_c, norm_mix_post[i])
            h_c = modulate(rms_norm(x_ctx, norm_ffn_pre[i]), sh_fc, sc_fc)
            f_c = conv_ffn(h_c, ffn_w_in[i], ffn_conv_w[i], ffn_conv_b[i], ffn_w_out[i])
            x_ctx = x_ctx + gt_fc * rms_norm(f_c, norm_ffn_post[i])
    return x_lat
```

```cpp
#include <hip/hip_runtime.h>
#include <hip/hip_cooperative_groups.h>
#include <cstdio>
#include <cstdint>
namespace cg = cooperative_groups;

#define LAS __attribute__((address_space(3)))
typedef unsigned short bf16_t;
typedef short bf16x8 __attribute__((ext_vector_type(8)));
typedef float f32x4 __attribute__((ext_vector_type(4)));
typedef float f32x2 __attribute__((ext_vector_type(2)));
typedef float f32x16 __attribute__((ext_vector_type(16)));
typedef unsigned u32x4 __attribute__((ext_vector_type(4)));
typedef unsigned u32x2 __attribute__((ext_vector_type(2)));
typedef short s16x4 __attribute__((ext_vector_type(4)));

constexpr int DM = 2048, NB = 2, SEQ = 8192, CTX = 256, SB = SEQ + CTX, MR = NB * SB;
constexpr int NH = 16, HD = 128, NKV = 4, DFF = 5632, NQKV = 3072, NHG = 5 * DM;
constexpr float EPS = 1e-6f;

constexpr size_t MiB = 1u << 20;
constexpr size_t WS_MOD = 64 * 1024;
constexpr size_t WS_XCTX = 2 * MiB;
constexpr size_t WS_W = 6 * MiB;
constexpr size_t W_HIN = WS_W, W_HOUT = WS_W + 40 * MiB, W_FIN = WS_W + 48 * MiB, W_FOUT = WS_W + 92 * MiB;
constexpr size_t W_QKV = WS_W, W_AOUT = WS_W + 12 * MiB;
constexpr size_t WS_H = 120 * MiB;
constexpr size_t WS_BIG = 186 * MiB;
constexpr size_t WS_ACT = 549 * MiB;
constexpr size_t WS_END = WS_ACT + (size_t)MR * DFF * 2;
static_assert(WS_END <= 768 * MiB, "ws");

constexpr int LDS_BYTES = 147456;

typedef __bf16 bf16x2_t __attribute__((ext_vector_type(2)));
__device__ __forceinline__ unsigned cvt_pk_bf16(float lo, float hi) { f32x2 v = {lo, hi}; bf16x2_t b = __builtin_convertvector(v, bf16x2_t); return __builtin_bit_cast(unsigned, b); }
__device__ __forceinline__ unsigned f2bf(float f) { unsigned u = __builtin_bit_cast(unsigned, f); return (u + 0x7fffu + ((u >> 16) & 1u)) >> 16; }
__device__ __forceinline__ unsigned pk2(float lo, float hi) { return f2bf(lo) | (f2bf(hi) << 16); }
__device__ __forceinline__ float bflo(unsigned u) { return __builtin_bit_cast(float, u << 16); }
__device__ __forceinline__ float bfhi(unsigned u) { return __builtin_bit_cast(float, u & 0xffff0000u); }
__device__ __forceinline__ float wave_sum(float v) {
#pragma unroll
    for (int o = 1; o < 64; o <<= 1) v += __shfl_xor(v, o);
    return v;
}
__device__ __forceinline__ float siluf(float v) { return v / (1.f + __expf(-v)); }
#define LBAR() do { asm volatile("s_waitcnt lgkmcnt(0)" ::: "memory"); __builtin_amdgcn_s_barrier(); asm volatile("" ::: "memory"); } while (0)

namespace pg8 {
constexpr int BM = 256, BK = 64, HALF = 128, HTB = HALF * BK * 2, STAGE_BYTES = 8 * HTB, NXCD = 8, WGM = 8;
__host__ __device__ __forceinline__ int lds_byte(int r, int c) { const int st = (r >> 4) * 2 + (c >> 5), rr = r & 15, cc = c & 31, ob = rr * 64 + cc * 2; return st * 1024 + (ob ^ (((ob >> 9) & 1) << 5)); }
__host__ __device__ __forceinline__ void stage_rc(int b, int& R, int& C) { const int st = b / 1024, sb = b % 1024, swz = sb ^ (((sb >> 9) & 1) << 5); R = (st >> 1) * 16 + swz / 64; C = (st & 1) * 32 + (swz % 64) / 2; }
__host__ __device__ __forceinline__ int perm32(int rho) { const int n = rho >> 4, i = rho & 15; return 8 * (i >> 2) + 4 * n + (i & 3); }

struct Unit { int pm, pn, kn; };
struct Gemm { const bf16_t* A; const bf16_t* Bt; int M, N, K; };

struct Order {
    int nM, nN, nwg, G, c, skip, ntf, nsplit;
    __device__ void init(int nM_, int N, int K, int G_, int c_, int skip_, int nsplit_) { nM = nM_; nN = N / BM; nwg = nM * nN; G = G_; c = c_; skip = skip_; ntf = K / BK; nsplit = nsplit_; }
    __device__ bool next(int i, Unit& u) const {
        const long L = (long)i * G + c;
        if (L >= nwg) {
            const int j = (int)(L - nwg); if (j >= 2 * nN * nsplit) return false;
            const int sidx = j % nsplit, cu = j / nsplit, cr = cu / nN;
            const int ntu = ntf / nsplit; u.pm = cr ? 33 : 0; u.pn = cu % nN; u.kn = (sidx * ntu) | (ntu << 16); return true;
        }
        int wgid = (int)L; { const int q = nwg / NXCD, r = nwg % NXCD, xcd = wgid % NXCD, off = wgid / NXCD; wgid = (xcd < r ? xcd * (q + 1) : r * (q + 1) + (xcd - r) * q) + off; }
        const int nig = WGM * nN, gid = wgid / nig, fm = gid * WGM, gsz = (nM - fm) < WGM ? (nM - fm) : WGM;
        int pm = fm + ((wgid % nig) % gsz); u.pn = (wgid % nig) / gsz;
        if (skip) pm = pm + 1 + (pm >= 32 ? 1 : 0);
        u.pm = pm; u.kn = ntf << 16; return true;
    }
    __device__ __forceinline__ void a_ready(const Unit&) const {}
    __device__ __forceinline__ void done(const Unit&) const {}
};

struct EpiBf16 {
    static constexpr bool PERM = true, AFTER_DRAIN = false;
    bf16_t* O; int ldc;
    __device__ __forceinline__ void operator()(const f32x4 (&acc)[2][2][4][2], const Unit& u, int wr, int wc, int fr, int fq) const {
        const int row0 = u.pm * BM + wr * 64 + fr; const int col0 = u.pn * BM + wc * 32 + 8 * fq;
#pragma unroll
        for (int ai = 0; ai < 2; ++ai)
#pragma unroll
            for (int m = 0; m < 4; ++m) { bf16_t* rowp = O + (size_t)(row0 + ai * HALF + m * 16) * ldc + col0;
#pragma unroll
                for (int bj = 0; bj < 2; ++bj) { const f32x4 v0 = acc[ai][bj][m][0], v1 = acc[ai][bj][m][1];
                    u32x4 w; w.x = cvt_pk_bf16(v0[0], v0[1]); w.y = cvt_pk_bf16(v0[2], v0[3]); w.z = cvt_pk_bf16(v1[0], v1[1]); w.w = cvt_pk_bf16(v1[2], v1[3]);
                    *(u32x4*)(rowp + bj * HALF) = w; } }
    }
};
struct EpiF32 {
    static constexpr bool PERM = true, AFTER_DRAIN = false;
    bf16_t* O; int ldc; float* SL; int ntf;
    __device__ __forceinline__ void operator()(const f32x4 (&acc)[2][2][4][2], const Unit& u, int wr, int wc, int fr, int fq) const {
        const int ntu = u.kn >> 16, kt0 = u.kn & 0xffff;
        const int row0 = wr * 64 + fr; const int col0 = u.pn * BM + wc * 32 + 8 * fq;
        if (ntu < ntf) {
            float* basep = SL + ((size_t)(kt0 / ntu) * 512 + (u.pm == 33 ? 256 : 0)) * ldc;
#pragma unroll
            for (int ai = 0; ai < 2; ++ai)
#pragma unroll
                for (int m = 0; m < 4; ++m) { float* rowp = basep + (size_t)(row0 + ai * HALF + m * 16) * ldc + col0;
#pragma unroll
                    for (int bj = 0; bj < 2; ++bj) { *(f32x4*)(rowp + bj * HALF) = acc[ai][bj][m][0]; *(f32x4*)(rowp + bj * HALF + 4) = acc[ai][bj][m][1]; } }
        } else {
            bf16_t* basep = O + (size_t)u.pm * BM * ldc;
#pragma unroll
            for (int ai = 0; ai < 2; ++ai)
#pragma unroll
                for (int m = 0; m < 4; ++m) { bf16_t* rowp = basep + (size_t)(row0 + ai * HALF + m * 16) * ldc + col0;
#pragma unroll
                    for (int bj = 0; bj < 2; ++bj) { const f32x4 v0 = acc[ai][bj][m][0], v1 = acc[ai][bj][m][1];
                        u32x4 w; w.x = cvt_pk_bf16(v0[0], v0[1]); w.y = cvt_pk_bf16(v0[2], v0[3]); w.z = cvt_pk_bf16(v1[0], v1[1]); w.w = cvt_pk_bf16(v1[2], v1[3]);
                        *(u32x4*)(rowp + bj * HALF) = w; } }
        }
    }
};

template <int CTRL> __device__ __forceinline__ float dpp_upd(float oldv, float src) {
    return __builtin_bit_cast(float, __builtin_amdgcn_update_dpp(__builtin_bit_cast(int, oldv), __builtin_bit_cast(int, src), CTRL, 0xf, 0xf, false)); }
template <int M> __device__ __forceinline__ float conv_elem(float gp, float gc, float gn, float up, float hp, float hn, float w0, float w1, float w2, float cb) {
    const float X = (M == 0) ? hp : dpp_upd<0x121>(0.f, gp);
    const float prev = dpp_upd<0x111>(X, gc);
    const float Yv = (M == 3) ? hn : dpp_upd<0x12F>(0.f, gn);
    const float next = dpp_upd<0x101>(Yv, gc);
    const float y = w0 * prev + w1 * gc + w2 * next + cb;
    return y * __builtin_amdgcn_rcpf(1.f + __builtin_amdgcn_exp2f(y * -1.4426950408889634f)) * up;
}
template <int M> __device__ __forceinline__ f32x4 conv_group(const f32x4 GP, const f32x4 GC, const f32x4 GN, const f32x4 up, const f32x4 hp, const f32x4 hn, const f32x4 w0, const f32x4 w1, const f32x4 w2, const f32x4 cb) {
    f32x4 r;
    r.x = conv_elem<M>(GP.x, GC.x, GN.x, up.x, hp.x, hn.x, w0.x, w1.x, w2.x, cb.x);
    r.y = conv_elem<M>(GP.y, GC.y, GN.y, up.y, hp.y, hn.y, w0.y, w1.y, w2.y, cb.y);
    r.z = conv_elem<M>(GP.z, GC.z, GN.z, up.z, hp.z, hn.z, w0.z, w1.z, w2.z, cb.z);
    r.w = conv_elem<M>(GP.w, GC.w, GN.w, up.w, hp.w, hn.w, w0.w, w1.w, w2.w, cb.w);
    return r;
}
struct EpiConv {
    static constexpr bool PERM = true, AFTER_DRAIN = false;
    bf16_t* ACT; const float* cw; const float* cbias; float* BND; LAS float* xch;
    __device__ __forceinline__ void operator()(const f32x4 (&acc)[2][2][4][2], const Unit& u, int wr_, int wc_, int fr_, int fq_) const {
        int wr = wr_, wc = wc_, fr = fr_, fq = fq_;
        asm volatile("" : "+v"(fr), "+v"(fq), "+s"(wr), "+s"(wc));
        const int cl = wc * 32 + 8 * fq, f0 = u.pn * 128 + cl;
#pragma unroll
        for (int ai = 0; ai < 2; ++ai) { const int blk = 2 * ai + wr;
            if (fr == 0) { *(LAS f32x4*)(xch + (blk * 2 + 0) * 128 + cl) = acc[ai][0][0][0]; *(LAS f32x4*)(xch + (blk * 2 + 0) * 128 + cl + 4) = acc[ai][0][0][1]; }
            if (fr == 15) { *(LAS f32x4*)(xch + (blk * 2 + 1) * 128 + cl) = acc[ai][0][3][0]; *(LAS f32x4*)(xch + (blk * 2 + 1) * 128 + cl + 4) = acc[ai][0][3][1]; } }
        { float* bnd = BND + (size_t)u.pm * 6 * DFF + f0;
          if (wr == 0 && fr < 2) { *(f32x4*)(bnd + fr * DFF) = acc[0][0][0][0]; *(f32x4*)(bnd + fr * DFF + 4) = acc[0][0][0][1]; }
          asm volatile("" ::: "memory");
          if (wr == 0 && fr == 0) { *(f32x4*)(bnd + 4 * DFF) = acc[0][1][0][0]; *(f32x4*)(bnd + 4 * DFF + 4) = acc[0][1][0][1]; }
          asm volatile("" ::: "memory");
          if (wr == 1 && fr >= 14) { *(f32x4*)(bnd + (fr - 12) * DFF) = acc[1][0][3][0]; *(f32x4*)(bnd + (fr - 12) * DFF + 4) = acc[1][0][3][1]; }
          asm volatile("" ::: "memory");
          if (wr == 1 && fr == 15) { *(f32x4*)(bnd + 5 * DFF) = acc[1][1][3][0]; *(f32x4*)(bnd + 5 * DFF + 4) = acc[1][1][3][1]; }
        }
        LBAR(); __builtin_amdgcn_sched_barrier(0);
        const f32x4 w00 = *(const f32x4*)(cw + f0), w01 = *(const f32x4*)(cw + f0 + 4), w10 = *(const f32x4*)(cw + DFF + f0), w11 = *(const f32x4*)(cw + DFF + f0 + 4);
        const f32x4 w20 = *(const f32x4*)(cw + 2 * DFF + f0), w21 = *(const f32x4*)(cw + 2 * DFF + f0 + 4), cb0 = *(const f32x4*)(cbias + f0), cb1 = *(const f32x4*)(cbias + f0 + 4);
#pragma unroll
        for (int ai = 0; ai < 2; ++ai) { const int blk = 2 * ai + wr;
            f32x4 hp0 = {0.f, 0.f, 0.f, 0.f}, hp1 = hp0, hn0 = hp0, hn1 = hp0;
            if (blk > 0) { hp0 = *(const LAS f32x4*)(xch + ((blk - 1) * 2 + 1) * 128 + cl); hp1 = *(const LAS f32x4*)(xch + ((blk - 1) * 2 + 1) * 128 + cl + 4); }
            if (blk < 3) { hn0 = *(const LAS f32x4*)(xch + ((blk + 1) * 2 + 0) * 128 + cl); hn1 = *(const LAS f32x4*)(xch + ((blk + 1) * 2 + 0) * 128 + cl + 4); }
#define CONV_ROW(M, MP, MN) do { __builtin_amdgcn_sched_barrier(0); \
            const f32x4 v0 = conv_group<M>(acc[ai][0][MP][0], acc[ai][0][M][0], acc[ai][0][MN][0], acc[ai][1][M][0], hp0, hn0, w00, w10, w20, cb0); \
            const f32x4 v1 = conv_group<M>(acc[ai][0][MP][1], acc[ai][0][M][1], acc[ai][0][MN][1], acc[ai][1][M][1], hp1, hn1, w01, w11, w21, cb1); \
            const int rl = ai * HALF + wr * 64 + M * 16 + fr; \
            if (rl != 0 && rl != 255) { u32x4 w; w.x = cvt_pk_bf16(v0[0], v0[1]); w.y = cvt_pk_bf16(v0[2], v0[3]); w.z = cvt_pk_bf16(v1[0], v1[1]); w.w = cvt_pk_bf16(v1[2], v1[3]); \
                *(u32x4*)(ACT + (size_t)(u.pm * BM + rl) * DFF + f0) = w; } } while (0)
            CONV_ROW(0, 0, 1); CONV_ROW(1, 0, 2); CONV_ROW(2, 1, 3); CONV_ROW(3, 2, 3);
#undef CONV_ROW
            __builtin_amdgcn_sched_barrier(0);
        }
    }
};

template <class Epi, class Sched, bool ALIGN_EPI = false, bool SP2 = false>
__device__ __forceinline__ void gemm_phase(LAS unsigned char* lds, const Gemm g, const Sched& S, const Epi& E) {
    const int tid = threadIdx.x, wid = __builtin_amdgcn_readfirstlane(tid >> 6), lane = tid & 63, wr = wid >> 2, wc = wid & 3, fr = lane & 15, fq = lane >> 4;
    const int K = g.K;
    unsigned voffA[2], voffB[2];
#pragma unroll
    for (int i = 0; i < 2; ++i) { int R, C; stage_rc(tid * 16 + i * 8192, R, C); const int Rb = Epi::PERM ? ((R & ~31) + perm32(R & 31)) : R;
        voffA[i] = (unsigned)(R * K + C) * 2u; voffB[i] = (unsigned)(Rb * K + C) * 2u; }
    const size_t kstep = (size_t)(BK * 2);
    const size_t hstep = (size_t)HALF * K * 2;
    const size_t tstep = 2 * hstep;
    const unsigned ldsw = (unsigned)wid * 1024u;
    const int aoff = lds_byte(wr * 64 + fr, fq * 8), boff = lds_byte(wc * 32 + fr, fq * 8);
#define PG8_SA(b, h) (((b) * 2 + (h)) * HTB)
#define PG8_SB(b, h) ((4 + (b) * 2 + (h)) * HTB)
#define PG8_STAGE(bufoff, gbase, voff) do { _Pragma("unroll") for (int _i = 0; _i < 2; ++_i) \
        __builtin_amdgcn_global_load_lds((const unsigned*)((const char*)(gbase) + (voff)[_i]), (LAS unsigned*)(lds + (bufoff) + ldsw + _i * 8192), 16, 0, 0); } while (0)
#define PG8_LDA(dst, b, h) do { _Pragma("unroll") for (int m = 0; m < 4; ++m) _Pragma("unroll") for (int k = 0; k < 2; ++k) dst[m][k] = *(const LAS bf16x8*)(lds + PG8_SA(b, h) + aoff + m * 2048 + k * 1024); } while (0)
#define PG8_LDB(dst, b, h) do { _Pragma("unroll") for (int n = 0; n < 2; ++n) _Pragma("unroll") for (int k = 0; k < 2; ++k) dst[n][k] = *(const LAS bf16x8*)(lds + PG8_SB(b, h) + boff + n * 2048 + k * 1024); } while (0)
#define PG8_MMA(ai, bj, At, Bt) do { __builtin_amdgcn_s_setprio(1); _Pragma("unroll") for (int m = 0; m < 4; ++m) _Pragma("unroll") for (int n = 0; n < 2; ++n) _Pragma("unroll") for (int k = 0; k < 2; ++k) \
        acc[ai][bj][m][n] = __builtin_amdgcn_mfma_f32_16x16x32_bf16(Bt[n][k], At[m][k], acc[ai][bj][m][n], 0, 0, 0); __builtin_amdgcn_s_setprio(0); } while (0)
#define PG8_WAIT_V(n) asm volatile("s_waitcnt vmcnt(" #n ")" ::: "memory")
#define PG8_WAIT_L(n) asm volatile("s_waitcnt lgkmcnt(" #n ")" ::: "memory")
#define PG8_BAR __builtin_amdgcn_s_barrier()
#define PG8_SCHED __builtin_amdgcn_sched_barrier(0)
    Unit cur, nxt; int ui = 0;
    if (!S.next(0, cur)) return;
    f32x4 acc[2][2][4][2];
#pragma unroll
    for (int a = 0; a < 2; ++a)
#pragma unroll
        for (int b = 0; b < 2; ++b)
#pragma unroll
            for (int m = 0; m < 4; ++m)
#pragma unroll
                for (int n = 0; n < 2; ++n) acc[a][b][m][n] = (f32x4){0.f, 0.f, 0.f, 0.f};
    bf16x8 At[4][2], B0[2][2], B1[2][2];
    const char* cA = (const char*)g.A + (size_t)cur.pm * tstep + (size_t)(cur.kn & 0xffff) * kstep; const char* cB = (const char*)g.Bt + (size_t)cur.pn * tstep + (size_t)(cur.kn & 0xffff) * kstep;
    S.a_ready(cur);
    if constexpr (SP2) {
        PG8_STAGE(PG8_SB(0, 0), cB, voffB); PG8_STAGE(PG8_SB(0, 1), cB + hstep, voffB); PG8_STAGE(PG8_SA(0, 0), cA, voffA); PG8_STAGE(PG8_SA(0, 1), cA + hstep, voffA);
        if (wr == 1) PG8_BAR;
        PG8_WAIT_V(2); PG8_BAR;
        PG8_STAGE(PG8_SB(1, 0), cB + kstep, voffB); PG8_STAGE(PG8_SA(1, 0), cA + kstep, voffA); PG8_STAGE(PG8_SB(1, 1), cB + hstep + kstep, voffB);
        PG8_WAIT_V(6); PG8_BAR;
    } else {
        PG8_STAGE(PG8_SB(0, 0), cB, voffB); PG8_STAGE(PG8_SA(0, 0), cA, voffA); PG8_STAGE(PG8_SB(0, 1), cB + hstep, voffB); PG8_STAGE(PG8_SA(0, 1), cA + hstep, voffA);
        if (wr == 1) PG8_BAR;
        PG8_WAIT_V(4); PG8_BAR;
        PG8_STAGE(PG8_SB(1, 0), cB + kstep, voffB); PG8_STAGE(PG8_SA(1, 0), cA + kstep, voffA); PG8_STAGE(PG8_SB(1, 1), cB + hstep + kstep, voffB);
        PG8_WAIT_V(6); PG8_BAR;
    }
    for (;;) {
        const bool has_next = S.next(ui + 1, nxt);
        const char* nA = has_next ? (const char*)g.A + (size_t)nxt.pm * tstep + (size_t)(nxt.kn & 0xffff) * kstep : cA; const char* nB = has_next ? (const char*)g.Bt + (size_t)nxt.pn * tstep + (size_t)(nxt.kn & 0xffff) * kstep : cB;
        const int nt = cur.kn >> 16;
        for (int t = 0; t < nt; t += 2) {
            const bool last = (t == nt - 2);
            const char* a1 = cA + (size_t)(t + 1) * kstep;
            const char* a2 = last ? nA : cA + (size_t)(t + 2) * kstep; const char* b2 = last ? nB : cB + (size_t)(t + 2) * kstep;
            const char* a3 = a2 + kstep; const char* b3 = b2 + kstep;
            if (last && has_next) S.a_ready(nxt);
            if constexpr (SP2) {
            PG8_LDB(B0, 0, 0); PG8_LDB(B1, 0, 1); PG8_SCHED; PG8_LDA(At, 0, 0); PG8_STAGE(PG8_SA(1, 1), a1 + hstep, voffA);
            PG8_WAIT_V(8); PG8_WAIT_L(0); PG8_BAR; PG8_MMA(0, 0, At, B0); PG8_MMA(0, 1, At, B1); PG8_BAR; PG8_SCHED;
            PG8_LDA(At, 0, 1); PG8_STAGE(PG8_SB(0, 0), b2, voffB); PG8_STAGE(PG8_SB(0, 1), b2 + hstep, voffB); PG8_STAGE(PG8_SA(0, 0), a2, voffA);
            PG8_WAIT_V(8); PG8_WAIT_L(0); PG8_BAR; PG8_MMA(1, 0, At, B0); PG8_MMA(1, 1, At, B1); PG8_BAR; PG8_SCHED;
            PG8_LDB(B0, 1, 0); PG8_LDB(B1, 1, 1); PG8_SCHED; PG8_LDA(At, 1, 0); PG8_STAGE(PG8_SA(0, 1), a2 + hstep, voffA);
            PG8_WAIT_V(8); PG8_WAIT_L(0); PG8_BAR; PG8_MMA(0, 0, At, B0); PG8_MMA(0, 1, At, B1); PG8_BAR; PG8_SCHED;
            PG8_LDA(At, 1, 1); PG8_STAGE(PG8_SB(1, 0), b3, voffB); PG8_STAGE(PG8_SB(1, 1), b3 + hstep, voffB); PG8_STAGE(PG8_SA(1, 0), a3, voffA);
            PG8_WAIT_V(8); PG8_WAIT_L(0); PG8_BAR; PG8_MMA(1, 0, At, B0); PG8_MMA(1, 1, At, B1); PG8_BAR; PG8_SCHED;
            } else {
            PG8_LDB(B0, 0, 0); PG8_SCHED; PG8_LDA(At, 0, 0); PG8_STAGE(PG8_SA(1, 1), a1 + hstep, voffA);
            PG8_WAIT_L(8); PG8_BAR; PG8_WAIT_L(0); PG8_MMA(0, 0, At, B0); PG8_BAR; PG8_SCHED;
            PG8_LDB(B1, 0, 1); PG8_STAGE(PG8_SB(0, 0), b2, voffB);
            PG8_BAR; PG8_WAIT_L(0); PG8_MMA(0, 1, At, B1); PG8_BAR;
            PG8_LDA(At, 0, 1); PG8_STAGE(PG8_SA(0, 0), a2, voffA);
            PG8_BAR; PG8_WAIT_L(0); PG8_MMA(1, 0, At, B0); PG8_BAR; PG8_SCHED;
            PG8_STAGE(PG8_SB(0, 1), b2 + hstep, voffB);
            PG8_WAIT_V(6); PG8_BAR; PG8_MMA(1, 1, At, B1); PG8_BAR;
            PG8_LDB(B0, 1, 0); PG8_SCHED; PG8_LDA(At, 1, 0); PG8_STAGE(PG8_SA(0, 1), a2 + hstep, voffA);
            PG8_WAIT_L(8); PG8_BAR; PG8_WAIT_L(0); PG8_MMA(0, 0, At, B0); PG8_BAR; PG8_SCHED;
            PG8_LDB(B1, 1, 1); PG8_STAGE(PG8_SB(1, 0), b3, voffB);
            PG8_BAR; PG8_WAIT_L(0); PG8_MMA(0, 1, At, B1); PG8_BAR;
            PG8_LDA(At, 1, 1); PG8_STAGE(PG8_SA(1, 0), a3, voffA);
            PG8_BAR; PG8_WAIT_L(0); PG8_MMA(1, 0, At, B0); PG8_BAR; PG8_SCHED;
            PG8_STAGE(PG8_SB(1, 1), b3 + hstep, voffB);
            PG8_WAIT_V(6); PG8_BAR; PG8_MMA(1, 1, At, B1); PG8_BAR;
            }
        }
        if constexpr (ALIGN_EPI) { if (wr == 0) PG8_BAR; }
        if constexpr (!Epi::AFTER_DRAIN) { E(acc, cur, wr, wc, fr, fq); S.done(cur); }
        if (!has_next) break;
#pragma unroll
        for (int a = 0; a < 2; ++a)
#pragma unroll
            for (int b = 0; b < 2; ++b)
#pragma unroll
                for (int m = 0; m < 4; ++m)
#pragma unroll
                    for (int n = 0; n < 2; ++n) acc[a][b][m][n] = (f32x4){0.f, 0.f, 0.f, 0.f};
        cur = nxt; cA = nA; cB = nB; ++ui;
        if constexpr (ALIGN_EPI) { if (wr == 1) PG8_BAR; }
    }
    PG8_WAIT_V(0);
    if constexpr (!ALIGN_EPI) { if (wr == 0) PG8_BAR; }
    PG8_BAR;
#undef PG8_SA
#undef PG8_SB
#undef PG8_STAGE
#undef PG8_LDA
#undef PG8_LDB
#undef PG8_MMA
#undef PG8_WAIT_V
#undef PG8_WAIT_L
#undef PG8_BAR
#undef PG8_SCHED
}
}

namespace att {
constexpr int D = 128, NW = 8, QBLK = 32, KVBLK = 64;
constexpr float SCALE = 0.088388347648318440f;
constexpr float THR = 8.f;
constexpr int LDQ = NQKV, LDK = NQKV, LDO = DM;
constexpr size_t SHM_V = KVBLK * D * 2, SHM_K = KVBLK * D * 2, SHM_ATTN = 2 * SHM_V + 2 * SHM_K + NW * 64 * 4;
#define KSWZ(row, colB) ((row) * 256 + ((colB) ^ (((row) & 7) << 4)))
#define SBAR() __builtin_amdgcn_sched_barrier(0)
__device__ __forceinline__ int crow(int r, int hi) { return (r & 3) + 8 * (r >> 2) + 4 * hi; }
__device__ __forceinline__ unsigned cvtpk(float lo, float hi) { unsigned r; asm volatile("v_cvt_pk_bf16_f32 %0, %1, %2" : "=v"(r) : "v"(lo), "v"(hi)); return r; }
__device__ __forceinline__ bf16x8 ld8(const bf16_t* p) { return *reinterpret_cast<const bf16x8*>(p); }

__device__ __forceinline__ void partialSM(f32x16& p0, f32x16& p1, float& m_reg, float& mn, float& alpha) {
  constexpr float C = SCALE * 1.4426950408889634f;
  float pmax = p0[0];
#pragma unroll
  for (int r = 1; r < 16; ++r) pmax = fmaxf(pmax, p0[r]);
#pragma unroll
  for (int r = 0; r < 16; ++r) pmax = fmaxf(pmax, p1[r]);
  { auto rr = __builtin_amdgcn_permlane32_swap(__float_as_uint(pmax), __float_as_uint(pmax), false, false);
    pmax = fmaxf(__uint_as_float(rr[0]), __uint_as_float(rr[1])); }
  if (__builtin_expect(__all(pmax - m_reg <= THR / SCALE), 1)) { mn = m_reg; alpha = 1.f; }
  else { mn = fmaxf(m_reg, pmax); alpha = __builtin_amdgcn_exp2f((m_reg - mn) * C); m_reg = mn; }
  float mnC = -mn * C;
#pragma unroll
  for (int r = 0; r < 16; ++r) p0[r] = fmaf(p0[r], C, mnC);
#pragma unroll
  for (int r = 0; r < 16; ++r) p1[r] = fmaf(p1[r], C, mnC);
#pragma unroll
  for (int r = 0; r < 16; ++r) p0[r] = __builtin_amdgcn_exp2f(p0[r]);
}
__device__ __forceinline__ void finishSM(f32x16& p0, f32x16& p1, float alpha, float& l_reg, bf16x8& pa0, bf16x8& pa1, bf16x8& pa2, bf16x8& pa3) {
#pragma unroll
  for (int r = 0; r < 16; ++r) p1[r] = __builtin_amdgcn_exp2f(p1[r]);
  float ps = 0;
#pragma unroll
  for (int r = 0; r < 16; ++r) ps += p0[r];
#pragma unroll
  for (int r = 0; r < 16; ++r) ps += p1[r];
  { auto rr = __builtin_amdgcn_permlane32_swap(__float_as_uint(ps), __float_as_uint(ps), false, false);
    ps = __uint_as_float(rr[0]) + __uint_as_float(rr[1]); }
  l_reg = l_reg * alpha + ps;
#define PK4(P, BASE, OUT) do { unsigned a0 = cvtpk(P[BASE + 0], P[BASE + 1]), a1 = cvtpk(P[BASE + 2], P[BASE + 3]);   \
    unsigned b0 = cvtpk(P[BASE + 4], P[BASE + 5]), b1 = cvtpk(P[BASE + 6], P[BASE + 7]);                              \
    auto r0 = __builtin_amdgcn_permlane32_swap(a0, b0, false, false); auto r1 = __builtin_amdgcn_permlane32_swap(a1, b1, false, false); \
    u32x4 w = {r0[0], r1[0], r0[1], r1[1]}; OUT = *reinterpret_cast<bf16x8*>(&w); } while (0)
  PK4(p0, 0, pa0); PK4(p0, 8, pa1); PK4(p1, 0, pa2); PK4(p1, 8, pa3);
#undef PK4
}
__device__ __forceinline__ void qkt(f32x16& p0, f32x16& p1, const bf16_t* Ks, const bf16x8* qr, int r32, int hi) {
  p0 = f32x16{}; p1 = f32x16{};
#pragma unroll
  for (int d0 = 0; d0 < 8; ++d0) { int cb = (d0 * 16 + hi * 8) * 2;
    bf16x8 b0 = *reinterpret_cast<const bf16x8*>((const char*)Ks + KSWZ(r32, cb));
    bf16x8 b1 = *reinterpret_cast<const bf16x8*>((const char*)Ks + KSWZ(32 + r32, cb));
    p0 = __builtin_amdgcn_mfma_f32_32x32x16_bf16(b0, qr[d0], p0, 0, 0, 0);
    p1 = __builtin_amdgcn_mfma_f32_32x32x16_bf16(b1, qr[d0], p1, 0, 0, 0); }
}
__device__ __forceinline__ int v_st(int k, int c) { const int kk = (k & ~0xC) | ((k & 4) << 1) | ((k & 8) >> 1); return ((kk >> 3) * 4 + (c >> 5)) * 512 + ((kk & 7) * 32 + (c & 31)) * 2; }
__device__ __forceinline__ int v_rd_base(int lane) { return ((lane & 3) << 3) | (((lane >> 2) & 3) << 6) | (((lane >> 4) & 1) << 5) | (((lane >> 5) & 1) << 8); }
constexpr int v_rd_off(int d0, int ks, int half) { return d0 * 512 + ks * 4096 + half * 2048; }
template <int OFF> __device__ __forceinline__ s16x4 tr_read(int vb) {
  s16x4 r; asm volatile("ds_read_b64_tr_b16 %0, %1 offset:%2" : "=&v"(r) : "v"(vb), "i"(OFF) : "memory"); return r;
}
template <int D0> __device__ __forceinline__ void pv_one(f32x16& od, int vb, bf16x8 pa0, bf16x8 pa1, bf16x8 pa2, bf16x8 pa3) {
  const s16x4 l0 = tr_read<v_rd_off(D0, 0, 0)>(vb), h0 = tr_read<v_rd_off(D0, 0, 1)>(vb), l1 = tr_read<v_rd_off(D0, 1, 0)>(vb), h1 = tr_read<v_rd_off(D0, 1, 1)>(vb);
  const s16x4 l2 = tr_read<v_rd_off(D0, 2, 0)>(vb), h2 = tr_read<v_rd_off(D0, 2, 1)>(vb), l3 = tr_read<v_rd_off(D0, 3, 0)>(vb), h3 = tr_read<v_rd_off(D0, 3, 1)>(vb);
  asm volatile("s_waitcnt lgkmcnt(0)" ::: "memory"); SBAR();
#define PK(L, H) (bf16x8){L[0], L[1], L[2], L[3], H[0], H[1], H[2], H[3]}
  od = __builtin_amdgcn_mfma_f32_32x32x16_bf16(pa0, PK(l0, h0), od, 0, 0, 0);
  od = __builtin_amdgcn_mfma_f32_32x32x16_bf16(pa1, PK(l1, h1), od, 0, 0, 0);
  od = __builtin_amdgcn_mfma_f32_32x32x16_bf16(pa2, PK(l2, h2), od, 0, 0, 0);
  od = __builtin_amdgcn_mfma_f32_32x32x16_bf16(pa3, PK(l3, h3), od, 0, 0, 0);
#undef PK
}
__device__ __forceinline__ void pv_d0(f32x16* o, int vb, bf16x8 pa0, bf16x8 pa1, bf16x8 pa2, bf16x8 pa3) {
  pv_one<0>(o[0], vb, pa0, pa1, pa2, pa3); pv_one<1>(o[1], vb, pa0, pa1, pa2, pa3); pv_one<2>(o[2], vb, pa0, pa1, pa2, pa3); pv_one<3>(o[3], vb, pa0, pa1, pa2, pa3);
}

__device__ __forceinline__ void attn_dense_body(const bf16_t* __restrict__ Qb, const bf16_t* __restrict__ Kh, const bf16_t* __restrict__ Vh,
                                                bf16_t* __restrict__ Ob, int seq, char* lds) {
  const int tid = threadIdx.x, wid = tid >> 6, lane = tid & 63, r32 = lane & 31, hi = lane >> 5;
  bf16_t* V_lds = (bf16_t*)lds; bf16_t* K_lds = (bf16_t*)(lds + 2 * SHM_V);
  float* ws = (float*)(lds + 2 * SHM_V + 2 * SHM_K) + wid * 64; float* li_l = ws; float* al_l = ws + 32;
  float m_reg = -1e30f, l_reg = 0; f32x16 o[4] = {}; bf16x8 qr[8];
  const bf16_t* Qw = Qb + (long)(wid * QBLK + r32) * LDQ + hi * 8;
#pragma unroll
  for (int d0 = 0; d0 < 8; ++d0) qr[d0] = ld8(Qw + d0 * 16);
  const int sr = tid >> 4, sc = (tid & 15) * 8, vst0 = v_st(sr, sc), vst1 = v_st(32 + sr, sc);
  const int vb0 = (int)(uintptr_t)V_lds + v_rd_base(lane);
  struct { bf16x8 vs0, vs1, ks0, ks1; } sr_[2];
#define SLOAD(i, k0) do { sr_[i].vs0 = ld8(&Vh[(long)((k0) + sr) * LDK + sc]); sr_[i].vs1 = ld8(&Vh[(long)((k0) + 32 + sr) * LDK + sc]); \
    sr_[i].ks0 = ld8(&Kh[(long)((k0) + sr) * LDK + sc]); sr_[i].ks1 = ld8(&Kh[(long)((k0) + 32 + sr) * LDK + sc]); } while (0)
#define SWRITE(b, i) do { *(bf16x8*)((char*)V_lds + (b) * SHM_V + vst0) = sr_[i].vs0;          \
    *(bf16x8*)((char*)V_lds + (b) * SHM_V + vst1) = sr_[i].vs1; int kc = sc * 2;               \
    *(bf16x8*)((char*)K_lds + (b) * SHM_K + KSWZ(sr, kc)) = sr_[i].ks0;                       \
    *(bf16x8*)((char*)K_lds + (b) * SHM_K + KSWZ(32 + sr, kc)) = sr_[i].ks1; } while (0)
#define SWAIT() do { asm volatile("s_waitcnt vmcnt(4)" ::: "memory"); } while (0)
#define RESC(a) do { if (__any((a) < 1.f)) { if (hi == 0) al_l[r32] = (a); asm volatile("s_waitcnt lgkmcnt(0)" ::: "memory"); \
    _Pragma("unroll") for (int d = 0; d < 4; ++d) _Pragma("unroll") for (int r = 0; r < 16; ++r) o[d][r] *= al_l[crow(r, hi)]; } } while (0)
  f32x16 pA0, pA1, pB0, pB1; float mnA, mnB, alA, alB; bf16x8 pa0, pa1, pa2, pa3; const int NT = seq / KVBLK;
  constexpr int SE = 0, SO = 1;
  SLOAD(SE, 0); asm volatile("s_waitcnt vmcnt(0)" ::: "memory"); SWRITE(0, SE); __syncthreads();
  qkt(pA0, pA1, K_lds, qr, r32, hi); partialSM(pA0, pA1, m_reg, mnA, alA);
  SLOAD(SO, KVBLK); if (2 < NT) SLOAD(SE, 2 * KVBLK);
  SWAIT(); SWRITE(1, SO); __syncthreads();
  for (int j = 1; j + 1 < NT; j += 2) {
    SBAR(); qkt(pB0, pB1, (bf16_t*)((char*)K_lds + SHM_K), qr, r32, hi);
    finishSM(pA0, pA1, alA, l_reg, pa0, pa1, pa2, pa3); SBAR();
    SLOAD(SO, (j + 2) * KVBLK); SBAR();
    pv_d0(o, vb0, pa0, pa1, pa2, pa3); partialSM(pB0, pB1, m_reg, mnB, alB);
    __syncthreads(); SWAIT(); SWRITE(0, SE);
    RESC(alB); __syncthreads();
    SBAR(); qkt(pA0, pA1, K_lds, qr, r32, hi);
    finishSM(pB0, pB1, alB, l_reg, pa0, pa1, pa2, pa3); SBAR();
    if (j + 3 < NT) SLOAD(SE, (j + 3) * KVBLK); SBAR();
    pv_d0(o, vb0 + (int)SHM_V, pa0, pa1, pa2, pa3); partialSM(pA0, pA1, m_reg, mnA, alA);
    __syncthreads(); SWAIT(); SWRITE(1, SO);
    RESC(alA); __syncthreads();
  }
  SBAR(); qkt(pB0, pB1, (bf16_t*)((char*)K_lds + SHM_K), qr, r32, hi);
  finishSM(pA0, pA1, alA, l_reg, pa0, pa1, pa2, pa3); SBAR();
  pv_d0(o, vb0, pa0, pa1, pa2, pa3); partialSM(pB0, pB1, m_reg, mnB, alB);
  __syncthreads(); RESC(alB);
  finishSM(pB0, pB1, alB, l_reg, pa0, pa1, pa2, pa3); SBAR();
  pv_d0(o, vb0 + (int)SHM_V, pa0, pa1, pa2, pa3);
  if (hi == 0) li_l[r32] = l_reg; asm volatile("s_waitcnt lgkmcnt(0)" ::: "memory");
  float rli[16];
#pragma unroll
  for (int r = 0; r < 16; ++r) rli[r] = __builtin_amdgcn_rcpf(li_l[crow(r, hi)]);
  bf16_t* Ow = Ob + (long)(wid * QBLK) * LDO;
#pragma unroll
  for (int r = 0; r < 16; ++r) { int orow = crow(r, hi);
#pragma unroll
    for (int d0 = 0; d0 < 4; ++d0) Ow[(long)orow * LDO + d0 * 32 + r32] = (bf16_t)f2bf(o[d0][r] * rli[r]); }
  __syncthreads();
#undef SLOAD
#undef SWRITE
#undef SWAIT
#undef RESC
}
}

__device__ __forceinline__ void transpose_item(const float* W, int K, int N, bf16_t* WT, LAS float* scr, int item, int lane, bool ffn_remap = false) {
    const int nblk = N / 32, kb = item / nblk, nb = item % nblk, k0 = 64 * kb, n0 = 32 * nb;
    int n0o = n0; if (ffn_remap) { const int half = n0 >= DFF ? 1 : 0, f = n0 - half * DFF; n0o = (f >> 7) * 256 + half * 128 + (f & 127); }
#pragma unroll 8
    for (int i = 0; i < 32; ++i) { const int kk = 2 * i + (lane >> 5); scr[kk * 33 + (lane & 31)] = W[(size_t)(k0 + kk) * N + n0 + (lane & 31)]; }
    asm volatile("s_waitcnt lgkmcnt(0)" ::: "memory");
    const int c = lane & 7;
#pragma unroll
    for (int j = 0; j < 4; ++j) { const int n = (lane >> 3) + 8 * j; const LAS float* s = scr + (8 * c) * 33 + n;
        u32x4 o; o.x = pk2(s[0 * 33], s[1 * 33]); o.y = pk2(s[2 * 33], s[3 * 33]); o.z = pk2(s[4 * 33], s[5 * 33]); o.w = pk2(s[6 * 33], s[7 * 33]);
        *(u32x4*)(WT + (size_t)(n0o + n) * K + k0 + 8 * c) = o; }
    asm volatile("s_waitcnt lgkmcnt(0)" ::: "memory");
}

__device__ __forceinline__ void ada_phase(const float* c, const float* c_ctx, const float* ada_w, const float* ada_b, float* mod, LAS unsigned char* lds, int wg, int G, int tid) {
    LAS float* sv = (LAS float*)lds;
    LAS float* part = sv + 3 * 2048;
    for (int i = tid; i < 3 * 2048; i += 512) { const int s = i >> 11, k = i & 2047; const float v = (s == 0) ? c_ctx[k] : c[(s - 1) * 2048 + k]; sv[i] = siluf(v); }
    __syncthreads();
    const int wave = tid >> 6, lane = tid & 63;
    for (int item = wg; item < 192; item += G) {
        const int L = item / 96, n0 = (item % 96) * 128;
        const float* W = ada_w + (size_t)L * 2048 * 12288 + n0 + lane * 2;
        float a0x = 0, a0y = 0, a1x = 0, a1y = 0, a2x = 0, a2y = 0;
        const int k0 = wave * 256;
#pragma unroll 8
        for (int k = 0; k < 256; ++k) {
            const f32x2 w = *(const f32x2*)(W + (size_t)(k0 + k) * 12288);
            const float s0 = sv[k0 + k], s1 = sv[2048 + k0 + k], s2 = sv[4096 + k0 + k];
            a0x += s0 * w.x; a0y += s0 * w.y; a1x += s1 * w.x; a1y += s1 * w.y; a2x += s2 * w.x; a2y += s2 * w.y;
        }
        part[(wave * 3 + 0) * 128 + lane * 2] = a0x; part[(wave * 3 + 0) * 128 + lane * 2 + 1] = a0y;
        part[(wave * 3 + 1) * 128 + lane * 2] = a1x; part[(wave * 3 + 1) * 128 + lane * 2 + 1] = a1y;
        part[(wave * 3 + 2) * 128 + lane * 2] = a2x; part[(wave * 3 + 2) * 128 + lane * 2 + 1] = a2y;
        __syncthreads();
        if (tid < 384) { const int s = tid >> 7, n = tid & 127; float acc = ada_b[L * 12288 + n0 + n];
#pragma unroll
            for (int w = 0; w < 8; ++w) acc += part[(w * 3 + s) * 128 + n];
            mod[(size_t)(L * 3 + s) * 12288 + n0 + n] = acc; }
        __syncthreads();
    }
}

template <bool XIN_BF, bool XOUT_BF>
__device__ __forceinline__ void row_phase(const float* xin_lat, const float* xin_ctx, float* xout_lat, float* xout_ctx, bf16_t* XR,
                                          const bf16_t* Y, const float* g_post, const float* g_pre, const float* modL, int jgate, int jshift, int jscale,
                                          bf16_t* H, bool has_y, bool make_h, bool lat_only, int gw, int NGW, int lane, const float* YS = nullptr, int nsplit = 0) {
    for (int r = gw; r < MR; r += NGW) {
        const int b = r / SB, p = r - b * SB; int s; const float* xi; float* xo; const bool ctxrow = p < CTX;
        size_t xrow;
        if (ctxrow) { if (lat_only) continue; s = 0; xrow = (size_t)(b * CTX + p) * DM; xi = xin_ctx + xrow; xo = xout_ctx + xrow; }
        else { s = 1 + b; xrow = (size_t)(b * SEQ + p - CTX) * DM; xi = xin_lat + xrow; xo = xout_lat + xrow; }
        const float* ms = modL + (size_t)s * 12288;
        f32x4 x[8];
#pragma unroll
        for (int j = 0; j < 8; ++j) {
            if (XIN_BF && !ctxrow) { const u32x2 xb = *(const u32x2*)(XR + xrow + (j * 64 + lane) * 4); x[j] = (f32x4){bflo(xb.x), bfhi(xb.x), bflo(xb.y), bfhi(xb.y)}; }
            else x[j] = *(const f32x4*)(xi + (j * 64 + lane) * 4);
        }
        if (has_y) {
            f32x4 y[8]; float ss = 0.f;
#pragma unroll
            for (int j = 0; j < 8; ++j) {
                if (ctxrow && nsplit > 0) { f32x4 t = {0.f, 0.f, 0.f, 0.f};
                    for (int sp = 0; sp < nsplit; ++sp) t += *(const f32x4*)(YS + ((size_t)sp * 512 + b * CTX + p) * DM + (j * 64 + lane) * 4);
                    y[j] = t; }
                else { const u32x2 yb = *(const u32x2*)(Y + (size_t)r * DM + (j * 64 + lane) * 4); y[j] = (f32x4){bflo(yb.x), bfhi(yb.x), bflo(yb.y), bfhi(yb.y)}; }
                ss += (y[j].x * y[j].x + y[j].y * y[j].y) + (y[j].z * y[j].z + y[j].w * y[j].w); }
            const float rs = rsqrtf(wave_sum(ss) * (1.f / DM) + EPS);
#pragma unroll
            for (int j = 0; j < 8; ++j) { const f32x4 gp = *(const f32x4*)(g_post + (j * 64 + lane) * 4); const f32x4 gt = *(const f32x4*)(ms + jgate * 2048 + (j * 64 + lane) * 4);
                x[j] = x[j] + gt * (y[j] * rs * gp);
                if (XOUT_BF && !ctxrow) { u32x2 w; w.x = cvt_pk_bf16(x[j].x, x[j].y); w.y = cvt_pk_bf16(x[j].z, x[j].w); *(u32x2*)(XR + xrow + (j * 64 + lane) * 4) = w;
                    x[j] = (f32x4){bflo(w.x), bfhi(w.x), bflo(w.y), bfhi(w.y)}; }
                else *(f32x4*)(xo + (j * 64 + lane) * 4) = x[j]; }
        }
        if (make_h) {
            float ss = 0.f;
#pragma unroll
            for (int j = 0; j < 8; ++j) ss += (x[j].x * x[j].x + x[j].y * x[j].y) + (x[j].z * x[j].z + x[j].w * x[j].w);
            const float rs = rsqrtf(wave_sum(ss) * (1.f / DM) + EPS);
#pragma unroll
            for (int j = 0; j < 8; ++j) { const f32x4 gp = *(const f32x4*)(g_pre + (j * 64 + lane) * 4); const f32x4 sh = *(const f32x4*)(ms + jshift * 2048 + (j * 64 + lane) * 4);
                const f32x4 sc = *(const f32x4*)(ms + jscale * 2048 + (j * 64 + lane) * 4);
                const f32x4 hv = (x[j] * rs * gp) * (sc + 1.f) + sh;
                u32x2 w; w.x = cvt_pk_bf16(hv.x, hv.y); w.y = cvt_pk_bf16(hv.z, hv.w);
                *(u32x2*)(H + (size_t)r * DM + (j * 64 + lane) * 4) = w; }
        }
    }
}

__device__ __forceinline__ void gla_prep_phase(bf16_t* P, bf16_t* QB, float* EB, const float* __restrict__ lbl, LAS unsigned char* lds, int wg, int G, int tid) {
    const int lane = tid & 63, w = __builtin_amdgcn_readfirstlane(tid >> 6);
    constexpr float L2E = 1.4426950408889634f;
    int par = 0;
    for (int item = wg; item < NB * NH * 132; item += G, par ^= 1) {
        LAS float* TOT = (LAS float*)lds + par * 2048;
        const int rb = item % 132, bh = item / 132, h = bh & 15, b = bh >> 4;
        float lb[2][2], oml[2][2];
#pragma unroll
        for (int d = 0; d < 2; ++d)
#pragma unroll
            for (int e = 0; e < 2; ++e) { const int ch = h * 128 + 2 * lane + e; const float l0 = lbl[(d * 2 + 0) * 2048 + ch], l1 = lbl[(d * 2 + 1) * 2048 + ch];
                lb[d][e] = __builtin_amdgcn_rcpf(1.f + __builtin_amdgcn_exp2f((l1 - l0) * L2E)); oml[d][e] = 1.f - lb[d][e]; }
        const size_t row0 = (size_t)b * SB + rb * 64 + 8 * w;
        const int col = h * 128 + 2 * lane;
        unsigned q2[8], ff[8], fb[8];
#pragma unroll
        for (int i = 0; i < 8; ++i) { const size_t ro = (row0 + i) * NHG + col; q2[i] = *(const unsigned*)(P + ro); ff[i] = *(const unsigned*)(P + ro + 2048); fb[i] = *(const unsigned*)(P + ro + 4096); }
        float blf[8][2], blb[8][2], kkf[8][2], kkb[8][2];
        { float r0 = 0.f, r1 = 0.f;
#pragma unroll
          for (int i = 0; i < 8; ++i) {
              { const float sg = __builtin_amdgcn_rcpf(1.f + __builtin_amdgcn_exp2f(bflo(ff[i]) * -L2E)); r0 += __builtin_amdgcn_logf(lb[0][0] + oml[0][0] * sg); blf[i][0] = r0; kkf[i][0] = oml[0][0] - oml[0][0] * sg; }
              { const float sg = __builtin_amdgcn_rcpf(1.f + __builtin_amdgcn_exp2f(bfhi(ff[i]) * -L2E)); r1 += __builtin_amdgcn_logf(lb[0][1] + oml[0][1] * sg); blf[i][1] = r1; kkf[i][1] = oml[0][1] - oml[0][1] * sg; }
          }
          *(LAS f32x2*)(TOT + w * 128 + 2 * lane) = (f32x2){r0, r1}; }
        { float r0 = 0.f, r1 = 0.f;
#pragma unroll
          for (int i = 7; i >= 0; --i) {
              { const float sg = __builtin_amdgcn_rcpf(1.f + __builtin_amdgcn_exp2f(bflo(fb[i]) * -L2E)); r0 += __builtin_amdgcn_logf(lb[1][0] + oml[1][0] * sg); blb[i][0] = r0; kkb[i][0] = oml[1][0] - oml[1][0] * sg; }
              { const float sg = __builtin_amdgcn_rcpf(1.f + __builtin_amdgcn_exp2f(bfhi(fb[i]) * -L2E)); r1 += __builtin_amdgcn_logf(lb[1][1] + oml[1][1] * sg); blb[i][1] = r1; kkb[i][1] = oml[1][1] - oml[1][1] * sg; }
          }
          *(LAS f32x2*)(TOT + 1024 + w * 128 + 2 * lane) = (f32x2){r0, r1}; }
        LBAR();
        float pf0 = 0.f, pf1 = 0.f, tf0 = 0.f, tf1 = 0.f, pb0 = 0.f, pb1 = 0.f, tb0 = 0.f, tb1 = 0.f;
#pragma unroll
        for (int g = 0; g < 8; ++g) { const f32x2 x = *(const LAS f32x2*)(TOT + g * 128 + 2 * lane), y = *(const LAS f32x2*)(TOT + 1024 + g * 128 + 2 * lane);
            tf0 += x.x; tf1 += x.y; tb0 += y.x; tb1 += y.y; if (g < w) { pf0 += x.x; pf1 += x.y; } if (g > w) { pb0 += y.x; pb1 += y.y; } }
#pragma unroll
        for (int i = 0; i < 8; ++i) {
            const float qs0 = bflo(q2[i]), qs1 = bfhi(q2[i]);
            const float s0 = qs0 * 0.08838834764831845f * __builtin_amdgcn_rcpf(1.f + __builtin_amdgcn_exp2f(qs0 * -L2E));
            const float s1 = qs1 * 0.08838834764831845f * __builtin_amdgcn_rcpf(1.f + __builtin_amdgcn_exp2f(qs1 * -L2E));
            const float df0 = pf0 + blf[i][0] - tf0, df1 = pf1 + blf[i][1] - tf1, db0 = pb0 + blb[i][0] - tb0, db1 = pb1 + blb[i][1] - tb1;
            const size_t ro = (row0 + i) * NHG + col;
            *(unsigned*)(P + ro) = cvt_pk_bf16(s0 * __builtin_amdgcn_exp2f(df0), s1 * __builtin_amdgcn_exp2f(df1));
            *(unsigned*)(P + ro + 2048) = cvt_pk_bf16(kkf[i][0] * __builtin_amdgcn_exp2f(-df0), kkf[i][1] * __builtin_amdgcn_exp2f(-df1));
            *(unsigned*)(P + ro + 4096) = cvt_pk_bf16(kkb[i][0] * __builtin_amdgcn_exp2f(-db0), kkb[i][1] * __builtin_amdgcn_exp2f(-db1));
            *(unsigned*)(QB + (row0 + i) * DM + col) = cvt_pk_bf16(s0 * __builtin_amdgcn_exp2f(db0), s1 * __builtin_amdgcn_exp2f(db1));
        }
        if (w == 0) {
            const int cb = rb < 4 ? 3 - rb : 135 - rb;
            *(f32x2*)(EB + ((size_t)((b * 16 + h) * 2 + 0) * 132 + rb) * 128 + 2 * lane) = (f32x2){__builtin_amdgcn_exp2f(tf0), __builtin_amdgcn_exp2f(tf1)};
            *(f32x2*)(EB + ((size_t)((b * 16 + h) * 2 + 1) * 132 + cb) * 128 + 2 * lane) = (f32x2){__builtin_amdgcn_exp2f(tb0), __builtin_amdgcn_exp2f(tb1)};
        }
    }
    __syncthreads();
}

__device__ __forceinline__ void gla_item(const bf16_t* __restrict__ P, const bf16_t* __restrict__ QS, int ldq, const float* __restrict__ EB, bf16_t* __restrict__ Od, LAS unsigned char* lds, int b, int h, int dir, int vs, int tid) {
    const int lane = tid & 63, w = __builtin_amdgcn_readfirstlane(tid >> 6), fr = lane & 15, fq = lane >> 4;
    constexpr int SETB = 66560;
    LAS unsigned char* PS = lds + 2 * SETB;
    for (int i = tid; i < 9216 / 4; i += 512) ((LAS unsigned*)PS)[i] = 0u;
    f32x4 S0 = {0.f, 0.f, 0.f, 0.f}, S1 = {0.f, 0.f, 0.f, 0.f};
    const int colq = h * 128 + 2 * lane, colf = 2048 * (1 + dir) + h * 128 + 2 * lane, colv = 3 * 2048 + h * 128 + vs * 32 + (tid & 7) * 4;
    const int tv = tid >> 3, base = b * SB, rofs = dir ? 63 : 0, rsign = dir ? -1 : 1;
    const float* ebp = EB + (size_t)((b * 16 + h) * 2 + dir) * 132 * 128 + 16 * w + 4 * fq;
    unsigned q2[4][8], f2[4][8]; u32x2 vv[4]; f32x4 eb[4];
#define GLA_R0(c) (dir ? ((c) < 4 ? base + 192 - 64 * (c) : base + 8640 - 64 * (c)) : base + 64 * (c))
#define GLA_LOAD(u, c) do { const int R0n = GLA_R0(c); \
        _Pragma("unroll") for (int i = 0; i < 8; ++i) { const size_t rr = (size_t)(R0n + rofs + rsign * (8 * w + i)); \
            q2[u][i] = *(const unsigned*)(QS + rr * ldq + colq); f2[u][i] = *(const unsigned*)(P + rr * NHG + colf); } \
        vv[u] = *(const u32x2*)(P + (size_t)(R0n + rofs + rsign * tv) * NHG + colv); eb[u] = *(const f32x4*)(ebp + (size_t)(c) * 128); } while (0)
    GLA_LOAD(0, 0); GLA_LOAD(1, 1); GLA_LOAD(2, 2); GLA_LOAD(3, 3);
    LBAR();
    for (int c0 = 0; c0 < 132; c0 += 4) {
#pragma unroll
      for (int u = 0; u < 4; ++u) {
        const int c = c0 + u;
        const int R0 = GLA_R0(c);
        LAS unsigned char* QD = lds + (u & 1) * SETB; LAS unsigned char* KD = QD + 17408; LAS unsigned char* KDT = QD + 34816; LAS unsigned char* VT = QD + 53248; LAS unsigned char* SDT = QD + 57856;
#pragma unroll
        for (int i = 0; i < 8; ++i) { *(LAS unsigned*)(QD + (8 * w + i) * 272 + lane * 4) = q2[u][i]; *(LAS unsigned*)(KD + (8 * w + i) * 272 + lane * 4) = f2[u][i]; }
        { u32x4 t0, t1;
          t0.x = (f2[u][0] & 0xffffu) | (f2[u][1] << 16); t0.y = (f2[u][2] & 0xffffu) | (f2[u][3] << 16); t0.z = (f2[u][4] & 0xffffu) | (f2[u][5] << 16); t0.w = (f2[u][6] & 0xffffu) | (f2[u][7] << 16);
          t1.x = (f2[u][0] >> 16) | (f2[u][1] & 0xffff0000u); t1.y = (f2[u][2] >> 16) | (f2[u][3] & 0xffff0000u); t1.z = (f2[u][4] >> 16) | (f2[u][5] & 0xffff0000u); t1.w = (f2[u][6] >> 16) | (f2[u][7] & 0xffff0000u);
          *(LAS u32x4*)(KDT + (2 * lane) * 144 + w * 16) = t0; *(LAS u32x4*)(KDT + (2 * lane + 1) * 144 + w * 16) = t1; }
        { LAS bf16_t* vt = (LAS bf16_t*)VT; const int v4 = (tid & 7) * 4;
          vt[(v4 + 0) * 72 + tv] = (bf16_t)(vv[u].x & 0xffffu); vt[(v4 + 1) * 72 + tv] = (bf16_t)(vv[u].x >> 16);
          vt[(v4 + 2) * 72 + tv] = (bf16_t)(vv[u].y & 0xffffu); vt[(v4 + 3) * 72 + tv] = (bf16_t)(vv[u].y >> 16); }
        S0 *= eb[u]; S1 *= eb[u];
        *(LAS u32x2*)(SDT + fr * 272 + (16 * w + 4 * fq) * 2) = (u32x2){cvt_pk_bf16(S0.x, S0.y), cvt_pk_bf16(S0.z, S0.w)};
        *(LAS u32x2*)(SDT + (16 + fr) * 272 + (16 * w + 4 * fq) * 2) = (u32x2){cvt_pk_bf16(S1.x, S1.y), cvt_pk_bf16(S1.z, S1.w)};
        if (c + 4 < 132) GLA_LOAD(u, c + 4);
        LBAR();
        for (int q = w; q < 10; q += 8) {
            const int ti = (q >= 1) + (q >= 3) + (q >= 6), si = q - ti * (ti + 1) / 2;
            f32x4 acc = {0.f, 0.f, 0.f, 0.f};
#pragma unroll
            for (int ks = 0; ks < 4; ++ks) { const bf16x8 a = *(const LAS bf16x8*)(KD + (16 * si + fr) * 272 + (ks * 32 + fq * 8) * 2);
                const bf16x8 bq = *(const LAS bf16x8*)(QD + (16 * ti + fr) * 272 + (ks * 32 + fq * 8) * 2);
                acc = __builtin_amdgcn_mfma_f32_16x16x32_bf16(a, bq, acc, 0, 0, 0); }
            if (si == ti) {
#pragma unroll
                for (int j = 0; j < 4; ++j) if (4 * fq + j > fr) acc[j] = 0.f;
            }
            *(LAS u32x2*)(PS + (16 * ti + fr) * 144 + (16 * si + 4 * fq) * 2) = (u32x2){cvt_pk_bf16(acc.x, acc.y), cvt_pk_bf16(acc.z, acc.w)};
        }
        LBAR();
        { const int ti = w >> 1, vi = w & 1; f32x4 o = {0.f, 0.f, 0.f, 0.f};
#pragma unroll
          for (int ks = 0; ks < 2; ++ks) { const bf16x8 a = *(const LAS bf16x8*)(VT + (16 * vi + fr) * 144 + (ks * 32 + fq * 8) * 2);
              const bf16x8 bp = *(const LAS bf16x8*)(PS + (16 * ti + fr) * 144 + (ks * 32 + fq * 8) * 2);
              o = __builtin_amdgcn_mfma_f32_16x16x32_bf16(a, bp, o, 0, 0, 0); }
#pragma unroll
          for (int ks = 0; ks < 4; ++ks) { const bf16x8 a = *(const LAS bf16x8*)(SDT + (16 * vi + fr) * 272 + (ks * 32 + fq * 8) * 2);
              const bf16x8 bq = *(const LAS bf16x8*)(QD + (16 * ti + fr) * 272 + (ks * 32 + fq * 8) * 2);
              o = __builtin_amdgcn_mfma_f32_16x16x32_bf16(a, bq, o, 0, 0, 0); }
          const size_t ro = (size_t)(R0 + rofs + rsign * (16 * ti + fr)) * DM;
          *(u32x2*)(Od + ro + h * 128 + vs * 32 + 16 * vi + 4 * fq) = (u32x2){cvt_pk_bf16(o.x, o.y), cvt_pk_bf16(o.z, o.w)}; }
#pragma unroll
        for (int ks = 0; ks < 2; ++ks) { const bf16x8 a = *(const LAS bf16x8*)(KDT + (16 * w + fr) * 144 + (ks * 32 + fq * 8) * 2);
            const bf16x8 b0 = *(const LAS bf16x8*)(VT + fr * 144 + (ks * 32 + fq * 8) * 2);
            const bf16x8 b1 = *(const LAS bf16x8*)(VT + (16 + fr) * 144 + (ks * 32 + fq * 8) * 2);
            S0 = __builtin_amdgcn_mfma_f32_16x16x32_bf16(a, b0, S0, 0, 0, 0);
            S1 = __builtin_amdgcn_mfma_f32_16x16x32_bf16(a, b1, S1, 0, 0, 0); }
      }
    }
#undef GLA_LOAD
#undef GLA_R0
    __syncthreads();
}

__device__ __forceinline__ void readout_phase(const bf16_t* Ofw, const bf16_t* Obw, const bf16_t* P, const float* o_gain, bf16_t* R, int gw, int NGW, int lane) {
    const int cl = (8 * lane) & 127;
    f32x4 g0 = *(const f32x4*)(o_gain + cl), g1 = *(const f32x4*)(o_gain + cl + 4);
    for (int it = gw; it < MR * 4; it += NGW) {
        const int r = it >> 2, c0 = (it & 3) * 512 + 8 * lane;
        const u32x4 a = *(const u32x4*)(Ofw + (size_t)r * DM + c0), bq = *(const u32x4*)(Obw + (size_t)r * DM + c0), g = *(const u32x4*)(P + (size_t)r * NHG + 4 * DM + c0);
        float o[8];
        o[0] = bflo(a.x) + bflo(bq.x); o[1] = bfhi(a.x) + bfhi(bq.x); o[2] = bflo(a.y) + bflo(bq.y); o[3] = bfhi(a.y) + bfhi(bq.y);
        o[4] = bflo(a.z) + bflo(bq.z); o[5] = bfhi(a.z) + bfhi(bq.z); o[6] = bflo(a.w) + bflo(bq.w); o[7] = bfhi(a.w) + bfhi(bq.w);
        float ss = 0.f;
#pragma unroll
        for (int e = 0; e < 8; ++e) ss += o[e] * o[e];
        ss += __shfl_xor(ss, 1); ss += __shfl_xor(ss, 2); ss += __shfl_xor(ss, 4); ss += __shfl_xor(ss, 8);
        const float rs = rsqrtf(ss * (1.f / 128.f) + EPS);
        const float gv[8] = {bflo(g.x), bfhi(g.x), bflo(g.y), bfhi(g.y), bflo(g.z), bfhi(g.z), bflo(g.w), bfhi(g.w)};
        const float gn[8] = {g0.x, g0.y, g0.z, g0.w, g1.x, g1.y, g1.z, g1.w};
        float v[8];
#pragma unroll
        for (int e = 0; e < 8; ++e) v[e] = o[e] * rs * gn[e] * siluf(gv[e]);
        u32x4 wv; wv.x = cvt_pk_bf16(v[0], v[1]); wv.y = cvt_pk_bf16(v[2], v[3]); wv.z = cvt_pk_bf16(v[4], v[5]); wv.w = cvt_pk_bf16(v[6], v[7]);
        *(u32x4*)(R + (size_t)r * DM + c0) = wv;
    }
}

__device__ __forceinline__ void conv_fix_phase(const float* BND, const float* cw, const float* cbias, bf16_t* ACT, bool lat_only, int gw, int NGW, int lane) {
    constexpr float L2E = 1.4426950408889634f;
    for (int it = gw; it < 66 * 2 * 11; it += NGW) {
        const int cbk = it % 11, rest = it / 11, which = rest & 1, pm = rest >> 1;
        if (lat_only && (pm == 0 || pm == 33)) continue;
        const int c0 = cbk * 512 + 8 * lane;
        const float* bn = BND + (size_t)pm * 6 * DFF + c0;
        f32x4 pv[2], cv[2], nv[2], uv[2]; size_t row;
        if (which == 0) {
            const bool seq_start = (pm == 0 || pm == 1 || pm == 33 || pm == 34);
#pragma unroll
            for (int hh = 0; hh < 2; ++hh) { pv[hh] = seq_start ? (f32x4){0.f, 0.f, 0.f, 0.f} : *(const f32x4*)(bn - 6 * DFF + 3 * DFF + 4 * hh);
                cv[hh] = *(const f32x4*)(bn + 4 * hh); nv[hh] = *(const f32x4*)(bn + DFF + 4 * hh); uv[hh] = *(const f32x4*)(bn + 4 * DFF + 4 * hh); }
            row = (size_t)pm * 256;
        } else {
            const bool seq_end = (pm == 0 || pm == 32 || pm == 33 || pm == 65);
#pragma unroll
            for (int hh = 0; hh < 2; ++hh) { pv[hh] = *(const f32x4*)(bn + 2 * DFF + 4 * hh); cv[hh] = *(const f32x4*)(bn + 3 * DFF + 4 * hh);
                nv[hh] = seq_end ? (f32x4){0.f, 0.f, 0.f, 0.f} : *(const f32x4*)(bn + 6 * DFF + 4 * hh); uv[hh] = *(const f32x4*)(bn + 5 * DFF + 4 * hh); }
            row = (size_t)pm * 256 + 255;
        }
        float v[8];
#pragma unroll
        for (int hh = 0; hh < 2; ++hh) {
            const f32x4 w0 = *(const f32x4*)(cw + c0 + 4 * hh), w1 = *(const f32x4*)(cw + DFF + c0 + 4 * hh), w2 = *(const f32x4*)(cw + 2 * DFF + c0 + 4 * hh), cb = *(const f32x4*)(cbias + c0 + 4 * hh);
#pragma unroll
            for (int j = 0; j < 4; ++j) { const float y = w0[j] * pv[hh][j] + w1[j] * cv[hh][j] + w2[j] * nv[hh][j] + cb[j];
                v[4 * hh + j] = y * __builtin_amdgcn_rcpf(1.f + __builtin_amdgcn_exp2f(y * -L2E)) * uv[hh][j]; }
        }
        u32x4 wv; wv.x = cvt_pk_bf16(v[0], v[1]); wv.y = cvt_pk_bf16(v[2], v[3]); wv.z = cvt_pk_bf16(v[4], v[5]); wv.w = cvt_pk_bf16(v[6], v[7]);
        *(u32x4*)(ACT + row * DFF + c0) = wv;
    }
}

__device__ __forceinline__ void qknorm_phase(bf16_t* QKV, const float* q_gain, const float* k_gain, int gw, int NGW, int lane) {
    const int cl = (8 * lane) & 127;
    for (int it = gw; it < MR * 5; it += NGW) {
        const int r = it / 5, grp = it - r * 5, p = r % SB;
        const bool lat = p >= CTX;
        if (!lat && grp < 4) continue;
        bf16_t* ptr = QKV + (size_t)r * NQKV + grp * 512 + 8 * lane;
        const float* gn = (grp < 4) ? q_gain : k_gain;
        const u32x4 a = *(const u32x4*)ptr;
        float x[8] = {bflo(a.x), bfhi(a.x), bflo(a.y), bfhi(a.y), bflo(a.z), bfhi(a.z), bflo(a.w), bfhi(a.w)};
        float ss = 0.f;
#pragma unroll
        for (int e = 0; e < 8; ++e) ss += x[e] * x[e];
        ss += __shfl_xor(ss, 1); ss += __shfl_xor(ss, 2); ss += __shfl_xor(ss, 4); ss += __shfl_xor(ss, 8);
        const float rs = rsqrtf(ss * (1.f / 128.f) + EPS);
#pragma unroll
        for (int e = 0; e < 8; ++e) x[e] = x[e] * rs * gn[cl + e];
        if (lat) {
            const int t = p - CTX; const float prow = (float)(t >> 6), pcol = (float)(t & 63);
#pragma unroll
            for (int e2 = 0; e2 < 4; ++e2) {
                const int i = (cl >> 1) + e2; const int fi = i & 31;
                const float invf = exp2f(-(float)fi * (13.287712379549449f / 32.f));
                const float ang = ((i >= 32) ? pcol : prow) * invf;
                float sn, cs; sincosf(ang, &sn, &cs);
                const float x1 = x[2 * e2], x2 = x[2 * e2 + 1];
                x[2 * e2] = x1 * cs - x2 * sn; x[2 * e2 + 1] = x1 * sn + x2 * cs;
            }
        }
        u32x4 wv; wv.x = cvt_pk_bf16(x[0], x[1]); wv.y = cvt_pk_bf16(x[2], x[3]); wv.z = cvt_pk_bf16(x[4], x[5]); wv.w = cvt_pk_bf16(x[6], x[7]);
        *(u32x4*)ptr = wv;
    }
}


#define XB_TMO      128
#define XB_XCNT(j)  (256  + 64 * (j))
#define XB_XSUB(j)  (1280 + 64 * (j))
#define XB_XGEN(j)  (2304 + 64 * (j))
#define XB_TOP      3328
#define XB_TOPGEN   3392
#define XCD_BAR_WORDS 3456
#define XB_SPIN_CAP (1u << 20)
__device__ __forceinline__ unsigned xb_ld(unsigned* p)              { return __hip_atomic_load(p, __ATOMIC_RELAXED, __HIP_MEMORY_SCOPE_AGENT); }
__device__ __forceinline__ unsigned xb_add(unsigned* p, unsigned v) { return __hip_atomic_fetch_add(p, v, __ATOMIC_RELAXED, __HIP_MEMORY_SCOPE_AGENT); }
__device__ __forceinline__ unsigned xb_xcc_id() { return (unsigned)__builtin_amdgcn_s_getreg((3 << 11) | 20) & 0xFu; }
#define XB_SPIN(cond, bar) do { unsigned _sp = 0; while (cond) { __builtin_amdgcn_s_sleep(1); \
    if ((++_sp & 255u) == 0u) { if (xb_ld(&(bar)[XB_TMO])) break; if (_sp > XB_SPIN_CAP) { atomicAdd(&(bar)[XB_TMO], 1u); break; } } } } while (0)
struct XcdBarrier { unsigned* bar; unsigned x; volatile LAS unsigned* st; };
__device__ __forceinline__ XcdBarrier xcd_barrier_post(unsigned* bar, volatile LAS unsigned* st) {
    XcdBarrier b; b.bar = bar; b.x = xb_xcc_id(); b.st = st;
    if (threadIdx.x == 0) (void)xb_add(&bar[XB_XCNT(b.x)], 1u);
    return b;
}
__device__ __forceinline__ void xcd_barrier_complete(unsigned* bar, unsigned x, unsigned& nloc, unsigned& nx) {
    const unsigned G = gridDim.x * gridDim.y * gridDim.z;
    unsigned sum, cnt, mine, sp = 0u;
    for (;;) {
        sum = 0u; cnt = 0u; mine = 0u;
#pragma unroll
        for (unsigned j = 0; j < 16; ++j) { const unsigned c = xb_ld(&bar[XB_XCNT(j)]); sum += c; cnt += (c > 0u) ? 1u : 0u; mine = (j == x) ? c : mine; }
        if (sum == G) break;
        __builtin_amdgcn_s_sleep(1);
        if ((++sp & 255u) == 0u) { if (xb_ld(&bar[XB_TMO])) break; if (sp > XB_SPIN_CAP) { atomicAdd(&bar[XB_TMO], 1u); break; } }
    }
    nloc = mine > 0u ? mine : 1u; nx = cnt > 0u ? cnt : 1u;
}
__device__ __forceinline__ void xcd_barrier(const XcdBarrier& b) {
    asm volatile("s_waitcnt vmcnt(0)" ::: "memory");
    __syncthreads();
    if (threadIdx.x == 0) {
        unsigned* bar = b.bar;
        __builtin_amdgcn_s_waitcnt(0);
        unsigned nloc = b.st[0], nx = b.st[1];
        if (nloc == 0u) { xcd_barrier_complete(bar, b.x, nloc, nx); b.st[0] = nloc; b.st[1] = nx; }
        const unsigned old = xb_add(&bar[XB_XSUB(b.x)], 1u);
        const unsigned gen = old / nloc;
        if (old + 1u == (gen + 1u) * nloc) {
            __builtin_amdgcn_fence(__ATOMIC_RELEASE, "agent");
            asm volatile("s_waitcnt vmcnt(0)" ::: "memory");
            const unsigned og = xb_add(&bar[XB_TOP], 1u);
            const unsigned tg = og / nx;
            if (og + 1u == (tg + 1u) * nx) xb_add(&bar[XB_TOPGEN], 1u);
            else XB_SPIN(xb_ld(&bar[XB_TOPGEN]) == tg, bar);
            __builtin_amdgcn_fence(__ATOMIC_ACQUIRE, "agent");
            xb_add(&bar[XB_XGEN(b.x)], 1u);
            asm volatile("s_waitcnt vmcnt(0)" ::: "memory");
        } else {
            XB_SPIN(xb_ld(&bar[XB_XGEN(b.x)]) == gen, bar);
            __builtin_amdgcn_fence(__ATOMIC_ACQUIRE, "agent");
            asm volatile("s_waitcnt vmcnt(0)" ::: "memory");
        }
    }
    __syncthreads();
}

struct KArgs { const float* in[22]; float* out; unsigned char* ws; int ph_lo, ph_hi; };
enum { I_X = 0, I_C, I_CTX, I_CCTX, I_ADAW, I_ADAB, I_NMPRE, I_NMPOST, I_NFPRE, I_NFPOST, I_HWIN, I_HLB, I_HONORM, I_HWOUT, I_AQKV, I_AQN, I_AKN, I_AWOUT, I_FWIN, I_FCW, I_FCB, I_FWOUT };
constexpr int N_PHASES = 20;

__global__ void __launch_bounds__(512, 2) mega_fwd(KArgs a) {
    extern __shared__ __attribute__((aligned(16))) unsigned char lds_raw[];
    LAS unsigned char* lds = (LAS unsigned char*)lds_raw;
    cg::grid_group grid = cg::this_grid();
    const int tid = threadIdx.x, lane = tid & 63, wave = __builtin_amdgcn_readfirstlane(tid >> 6);
    const int G = gridDim.x, wg = blockIdx.x;
    const int gw = wg * 8 + wave, NGW = G * 8;
    unsigned char* ws = a.ws;
    float* mod = (float*)(ws + WS_MOD);
    float* xctx = (float*)(ws + WS_XCTX);
    bf16_t* H = (bf16_t*)(ws + WS_H);
    bf16_t* BIG = (bf16_t*)(ws + WS_BIG);
    bf16_t* Y = (bf16_t*)(ws + WS_BIG);
    bf16_t* XR = (bf16_t*)(ws + WS_BIG + 256 * MiB);
    float* BND = (float*)(ws + WS_BIG + 200 * MiB);
    float* YS = (float*)(ws + WS_BIG + 132 * MiB);
    bf16_t* ACT = (bf16_t*)(ws + WS_ACT);
    bf16_t* OFW = ACT; bf16_t* OBW = ACT + (size_t)MR * DM;
    const int lo = a.ph_lo, hi = a.ph_hi;
#ifndef MK_REPMASK
#define MK_REPMASK 0u
#endif
#define PH(k) if (lo <= (k) && (k) < hi) for (int rep_ = 0; rep_ <= (int)((MK_REPMASK >> (k)) & 1u); ++rep_)
#define SEAM(k) do { if ((k) + 1 < hi) { if ((k) == 0) { asm volatile("s_waitcnt vmcnt(0) lgkmcnt(0)" ::: "memory"); grid.sync(); } else xcd_barrier(bar); } } while (0)
    LAS float* scr = (LAS float*)(lds + wave * 16384);
    volatile LAS unsigned* MISC = (volatile LAS unsigned*)(lds + LDS_BYTES - 256);
    if (tid < 16) MISC[tid] = 0u;
    __syncthreads();
    XcdBarrier bar = xcd_barrier_post((unsigned*)ws, MISC);

    PH(0) {
        ada_phase(a.in[I_C], a.in[I_CCTX], a.in[I_ADAW], a.in[I_ADAB], mod, lds, wg, G, tid);
        constexpr int I0 = 32 * (NHG / 32), I1 = 32 * (DM / 32), I2 = 32 * (2 * DFF / 32), I3 = (DFF / 64) * (DM / 32);
        for (int it = gw; it < I0 + I1 + I2 + I3; it += NGW) {
            int r = it;
            if (r < I0) { transpose_item(a.in[I_HWIN], DM, NHG, (bf16_t*)(ws + W_HIN), scr, r, lane); continue; } r -= I0;
            if (r < I1) { transpose_item(a.in[I_HWOUT], DM, DM, (bf16_t*)(ws + W_HOUT), scr, r, lane); continue; } r -= I1;
            if (r < I2) { transpose_item(a.in[I_FWIN], DM, 2 * DFF, (bf16_t*)(ws + W_FIN), scr, r, lane, true); continue; } r -= I2;
            transpose_item(a.in[I_FWOUT], DFF, DM, (bf16_t*)(ws + W_FOUT), scr, r, lane);
        }
        SEAM(0);
    }
    PH(1) {
        row_phase<false, false>(a.in[I_X], a.in[I_CTX], nullptr, nullptr, XR, nullptr, nullptr, a.in[I_NMPRE], mod, 0, 0, 1, H, false, true, false, gw, NGW, lane);
        SEAM(1);
    }
    PH(2) {
        pg8::Gemm g{H, (const bf16_t*)(ws + W_HIN), MR, NHG, DM}; pg8::Order S; S.init(MR / 256, NHG, DM, G, wg, 0, 0);
        pg8::EpiBf16 E{BIG, NHG};
        pg8::gemm_phase<pg8::EpiBf16, pg8::Order, true, true>(lds, g, S, E);
        SEAM(2);
    }
    PH(3) {
        float* EB = (float*)(ACT + (size_t)2 * MR * DM);
        if (rep_ == 0) gla_prep_phase(BIG, H, EB, a.in[I_HLB], lds, wg, G, tid);
        xcd_barrier(bar);
        for (int item = wg; item < 256; item += G) {
            const int xq = item & 7, yq = item >> 3, vs = yq & 3, sq = xq + 8 * (yq >> 2);
            const int dir = sq & 1, h = (sq >> 1) & 15, b = sq >> 5;
            gla_item(BIG, dir ? H : BIG, dir ? DM : NHG, EB, dir ? OBW : OFW, lds, b, h, dir, vs, tid);
        }
        SEAM(3);
    }
    PH(4) {
        readout_phase(OFW, OBW, BIG, a.in[I_HONORM], H, gw, NGW, lane);
        SEAM(4);
    }
    PH(5) {
        pg8::Gemm g{H, (const bf16_t*)(ws + W_HOUT), MR, DM, DM}; pg8::Order S; S.init(64, DM, DM, G, wg, 1, 16);
        pg8::EpiF32 E{Y, DM, YS, DM / 64};
        pg8::gemm_phase<pg8::EpiF32, pg8::Order, true, true>(lds, g, S, E);
        SEAM(5);
    }
    PH(6) {
        row_phase<false, true>(a.in[I_X], a.in[I_CTX], a.out, xctx, XR, Y, a.in[I_NMPOST], a.in[I_NFPRE], mod, 2, 3, 4, H, true, true, false, gw, NGW, lane, YS, 16);
        SEAM(6);
    }
    PH(7) {
        pg8::Gemm g{H, (const bf16_t*)(ws + W_FIN), MR, 2 * DFF, DM}; pg8::Order S; S.init(MR / 256, 2 * DFF, DM, G, wg, 0, 0);
        pg8::EpiConv E{ACT, a.in[I_FCW], a.in[I_FCB], BND, (LAS float*)(lds + 131072)};
        pg8::gemm_phase<pg8::EpiConv, pg8::Order, true, true>(lds, g, S, E);
        SEAM(7);
    }
    PH(8) {
        conv_fix_phase(BND, a.in[I_FCW], a.in[I_FCB], ACT, false, gw, NGW, lane);
        SEAM(8);
    }
    PH(9) {
        pg8::Gemm g{ACT, (const bf16_t*)(ws + W_FOUT), MR, DM, DFF}; pg8::Order S; S.init(64, DM, DFF, G, wg, 1, 11);
        pg8::EpiF32 E{Y, DM, YS, DFF / 64};
        pg8::gemm_phase<pg8::EpiF32, pg8::Order, true, true>(lds, g, S, E);
        SEAM(9);
    }
    PH(10) {
        row_phase<true, true>(a.out, xctx, a.out, xctx, XR, Y, a.in[I_NFPOST], a.in[I_NMPRE] + DM, mod, 5, 6 * 3 + 0, 6 * 3 + 1, H, true, true, false, gw, NGW, lane, YS, 11);
        __syncthreads();
        constexpr int I0 = 32 * (NQKV / 32), I1 = 32 * (DM / 32), I2 = 32 * (2 * DFF / 32), I3 = (DFF / 64) * (DM / 32);
        for (int it = gw; it < I0 + I1 + I2 + I3; it += NGW) {
            int r = it;
            if (r < I0) { transpose_item(a.in[I_AQKV], DM, NQKV, (bf16_t*)(ws + W_QKV), scr, r, lane); continue; } r -= I0;
            if (r < I1) { transpose_item(a.in[I_AWOUT], DM, DM, (bf16_t*)(ws + W_AOUT), scr, r, lane); continue; } r -= I1;
            if (r < I2) { transpose_item(a.in[I_FWIN] + (size_t)DM * 2 * DFF, DM, 2 * DFF, (bf16_t*)(ws + W_FIN), scr, r, lane, true); continue; } r -= I2;
            transpose_item(a.in[I_FWOUT] + (size_t)DFF * DM, DFF, DM, (bf16_t*)(ws + W_FOUT), scr, r, lane);
        }
        SEAM(10);
    }
    PH(11) {
        pg8::Gemm g{H, (const bf16_t*)(ws + W_QKV), MR, NQKV, DM}; pg8::Order S; S.init(MR / 256, NQKV, DM, G, wg, 0, 0);
        pg8::EpiBf16 E{BIG, NQKV};
        pg8::gemm_phase<pg8::EpiBf16, pg8::Order, true, true>(lds, g, S, E);
        SEAM(11);
    }
    PH(12) {
        qknorm_phase(BIG, a.in[I_AQN], a.in[I_AKN], gw, NGW, lane);
        SEAM(12);
    }
    PH(13) {
        for (int u = wg; u < 1024; u += G) {
            const int x = u & 7, rest = u >> 3, j = rest & 31, i = rest >> 5;
            const int b = x >> 2, kvh = x & 3, h = kvh * 4 + i;
            const size_t qrow = (size_t)b * SB + CTX + (size_t)j * 256;
            att::attn_dense_body(BIG + qrow * NQKV + h * 128, BIG + (size_t)b * SB * NQKV + 2048 + kvh * 128, BIG + (size_t)b * SB * NQKV + 2560 + kvh * 128,
                                 ACT + qrow * DM + h * 128, SB, (char*)lds_raw);
        }
        SEAM(13);
    }
    PH(14) {
        pg8::Gemm g{ACT, (const bf16_t*)(ws + W_AOUT), MR, DM, DM}; pg8::Order S; S.init(64, DM, DM, G, wg, 1, 0);
        pg8::EpiF32 E{Y, DM, nullptr, 0};
        pg8::gemm_phase<pg8::EpiF32, pg8::Order, true, true>(lds, g, S, E);
        SEAM(14);
    }
    PH(15) {
        row_phase<true, true>(a.out, xctx, a.out, xctx, XR, Y, a.in[I_NMPOST] + DM, a.in[I_NFPRE] + DM, mod + 3 * 12288, 2, 3, 4, H, true, true, true, gw, NGW, lane);
        SEAM(15);
    }
    PH(16) {
        pg8::Gemm g{H, (const bf16_t*)(ws + W_FIN), MR, 2 * DFF, DM}; pg8::Order S; S.init(64, 2 * DFF, DM, G, wg, 1, 0);
        pg8::EpiConv E{ACT, a.in[I_FCW] + 3 * DFF, a.in[I_FCB] + DFF, BND, (LAS float*)(lds + 131072)};
        pg8::gemm_phase<pg8::EpiConv, pg8::Order, true, true>(lds, g, S, E);
        SEAM(16);
    }
    PH(17) {
        conv_fix_phase(BND, a.in[I_FCW] + 3 * DFF, a.in[I_FCB] + DFF, ACT, true, gw, NGW, lane);
        SEAM(17);
    }
    PH(18) {
        pg8::Gemm g{ACT, (const bf16_t*)(ws + W_FOUT), MR, DM, DFF}; pg8::Order S; S.init(64, DM, DFF, G, wg, 1, 0);
        pg8::EpiF32 E{Y, DM, nullptr, 0};
        pg8::gemm_phase<pg8::EpiF32, pg8::Order, true, true>(lds, g, S, E);
        SEAM(18);
    }
    PH(19) {
        row_phase<true, false>(a.out, xctx, a.out, xctx, XR, Y, a.in[I_NFPOST] + DM, nullptr, mod + 3 * 12288, 5, 0, 0, H, true, false, true, gw, NGW, lane);
    }
#undef PH
#undef SEAM
}


extern "C" void kernel_launch(void* const* d_in, const int* in_sizes, int n_in, void* d_out, int out_size, void* d_ws, size_t ws_size, hipStream_t stream) {
    static int grid = 0;
    if (grid == 0) {
        if (n_in != 22 || ws_size < WS_END || out_size != NB * SEQ * DM) { fprintf(stderr, "kernel_launch: unexpected shapes n_in %d ws %zu out %d\n", n_in, ws_size, out_size); grid = -1; return; }
        int dev = 0, cus = 0, per_cu = 0;
        if (hipGetDevice(&dev) != hipSuccess || hipDeviceGetAttribute(&cus, hipDeviceAttributeMultiprocessorCount, dev) != hipSuccess) { grid = -1; return; }
        if (hipFuncSetAttribute((const void*)mega_fwd, hipFuncAttributeMaxDynamicSharedMemorySize, LDS_BYTES) != hipSuccess) { fprintf(stderr, "kernel_launch: hipFuncSetAttribute failed\n"); grid = -1; return; }
        if (hipOccupancyMaxActiveBlocksPerMultiprocessor(&per_cu, (const void*)mega_fwd, 512, LDS_BYTES) != hipSuccess || per_cu < 1) { fprintf(stderr, "kernel_launch: occupancy query says %d\n", per_cu); per_cu = 1; }
        (void)hipGetLastError();
        grid = cus * 1;
    }
    if (grid < 0) return;
    KArgs a{};
    for (int i = 0; i < 22; ++i) a.in[i] = (const float*)d_in[i];
    a.out = (float*)d_out; a.ws = (unsigned char*)d_ws;
    a.ph_lo = 0; a.ph_hi = N_PHASES;
    if (hipMemsetAsync(d_ws, 0, 16384, stream) != hipSuccess) { fprintf(stderr, "kernel_launch: memset failed\n"); return; }
    void* args[] = {&a};
    hipError_t e = hipLaunchCooperativeKernel((const void*)mega_fwd, dim3(grid), dim3(512), args, LDS_BYTES, stream);
    if (e != hipSuccess) fprintf(stderr, "cooperative launch failed: %s (grid %d)\n", hipGetErrorString(e), grid);
}
```

```cpp
#include <hip/hip_runtime.h>
#include <hip/hip_cooperative_groups.h>
#include <cstdio>
#include <cstdint>
namespace cg = cooperative_groups;

#define LAS __attribute__((address_space(3)))
typedef unsigned short bf16_t;
typedef short bf16x8 __attribute__((ext_vector_type(8)));
typedef float f32x4 __attribute__((ext_vector_type(4)));
typedef float f32x2 __attribute__((ext_vector_type(2)));
typedef float f32x16 __attribute__((ext_vector_type(16)));
typedef unsigned u32x4 __attribute__((ext_vector_type(4)));
typedef unsigned u32x2 __attribute__((ext_vector_type(2)));
typedef short s16x4 __attribute__((ext_vector_type(4)));

constexpr int DM = 2048, NB = 2, SEQ = 8192, CTX = 256, SB = SEQ + CTX, MR = NB * SB;
constexpr int NH = 16, HD = 128, NKV = 4, DFF = 5632, NQKV = 3072, NHG = 5 * DM;
constexpr float EPS = 1e-6f;

constexpr size_t MiB = 1u << 20;
constexpr size_t WS_MOD = 64 * 1024;
constexpr size_t WS_XCTX = 2 * MiB;
constexpr size_t WS_W = 6 * MiB;
constexpr size_t W_HIN = WS_W, W_HOUT = WS_W + 40 * MiB, W_FIN = WS_W + 48 * MiB, W_FOUT = WS_W + 92 * MiB;
constexpr size_t W_QKV = WS_W, W_AOUT = WS_W + 12 * MiB;
constexpr size_t WS_H = 120 * MiB;
constexpr size_t WS_BIG = 186 * MiB;
constexpr size_t WS_ACT = 549 * MiB;
constexpr size_t WS_END = WS_ACT + (size_t)MR * DFF * 2;
static_assert(WS_END <= 768 * MiB, "ws");

constexpr int LDS_BYTES = 147456;

typedef __bf16 bf16x2_t __attribute__((ext_vector_type(2)));
__device__ __forceinline__ unsigned cvt_pk_bf16(float lo, float hi) { f32x2 v = {lo, hi}; bf16x2_t b = __builtin_convertvector(v, bf16x2_t); return __builtin_bit_cast(unsigned, b); }
__device__ __forceinline__ unsigned f2bf(float f) { unsigned u = __builtin_bit_cast(unsigned, f); return (u + 0x7fffu + ((u >> 16) & 1u)) >> 16; }
__device__ __forceinline__ unsigned pk2(float lo, float hi) { return f2bf(lo) | (f2bf(hi) << 16); }
__device__ __forceinline__ float bflo(unsigned u) { return __builtin_bit_cast(float, u << 16); }
__device__ __forceinline__ float bfhi(unsigned u) { return __builtin_bit_cast(float, u & 0xffff0000u); }
__device__ __forceinline__ float wave_sum(float v) {
#pragma unroll
    for (int o = 1; o < 64; o <<= 1) v += __shfl_xor(v, o);
    return v;
}
__device__ __forceinline__ float siluf(float v) { return v / (1.f + __expf(-v)); }
#define LBAR() do { asm volatile("s_waitcnt lgkmcnt(0)" ::: "memory"); __builtin_amdgcn_s_barrier(); asm volatile("" ::: "memory"); } while (0)

namespace pg8 {
constexpr int BM = 256, BK = 64, HALF = 128, HTB = HALF * BK * 2, STAGE_BYTES = 8 * HTB, NXCD = 8, WGM = 4;
__host__ __device__ __forceinline__ int lds_byte(int r, int c) { const int st = (r >> 4) * 2 + (c >> 5), rr = r & 15, cc = c & 31, ob = rr * 64 + cc * 2; return st * 1024 + (ob ^ (((ob >> 9) & 1) << 5)); }
__host__ __device__ __forceinline__ void stage_rc(int b, int& R, int& C) { const int st = b / 1024, sb = b % 1024, swz = sb ^ (((sb >> 9) & 1) << 5); R = (st >> 1) * 16 + swz / 64; C = (st & 1) * 32 + (swz % 64) / 2; }
__host__ __device__ __forceinline__ int perm32(int rho) { const int n = rho >> 4, i = rho & 15; return 8 * (i >> 2) + 4 * n + (i & 3); }

struct Unit { int pm, pn, kn; };
struct Gemm { const bf16_t* A; const bf16_t* Bt; int M, N, K; };

struct Order {
    int nM, nN, nwg, G, c, skip, ntf, nsplit;
    __device__ void init(int nM_, int N, int K, int G_, int c_, int skip_, int nsplit_) { nM = nM_; nN = N / BM; nwg = nM * nN; G = G_; c = c_; skip = skip_; ntf = K / BK; nsplit = nsplit_; }
    __device__ bool next(int i, Unit& u) const {
        const long L = (long)i * G + c;
        if (L >= nwg) {
            const int j = (int)(L - nwg); if (j >= 2 * nN * nsplit) return false;
            const int sidx = j % nsplit, cu = j / nsplit, cr = cu / nN;
            const int ntu = ntf / nsplit; u.pm = cr ? 33 : 0; u.pn = cu % nN; u.kn = (sidx * ntu) | (ntu << 16); return true;
        }
        int wgid = (int)L; { const int q = nwg / NXCD, r = nwg % NXCD, xcd = wgid % NXCD, off = wgid / NXCD; wgid = (xcd < r ? xcd * (q + 1) : r * (q + 1) + (xcd - r) * q) + off; }
        const int nig = WGM * nN, gid = wgid / nig, fm = gid * WGM, gsz = (nM - fm) < WGM ? (nM - fm) : WGM;
        int pm = fm + ((wgid % nig) % gsz); u.pn = (wgid % nig) / gsz;
        if (skip) pm = pm + 1 + (pm >= 32 ? 1 : 0);
        u.pm = pm; u.kn = ntf << 16; return true;
    }
    __device__ __forceinline__ void a_ready(const Unit&) const {}
    __device__ __forceinline__ void done(const Unit&) const {}
};

struct EpiBf16 {
    static constexpr bool PERM = true, AFTER_DRAIN = false;
    bf16_t* O; int ldc;
    __device__ __forceinline__ void operator()(const f32x4 (&acc)[2][2][4][2], const Unit& u, int wr, int wc, int fr, int fq) const {
        const int row0 = u.pm * BM + wr * 64 + fr; const int col0 = u.pn * BM + wc * 32 + 8 * fq;
#pragma unroll
        for (int ai = 0; ai < 2; ++ai)
#pragma unroll
            for (int m = 0; m < 4; ++m) { bf16_t* rowp = O + (size_t)(row0 + ai * HALF + m * 16) * ldc + col0;
#pragma unroll
                for (int bj = 0; bj < 2; ++bj) { const f32x4 v0 = acc[ai][bj][m][0], v1 = acc[ai][bj][m][1];
                    u32x4 w; w.x = cvt_pk_bf16(v0[0], v0[1]); w.y = cvt_pk_bf16(v0[2], v0[3]); w.z = cvt_pk_bf16(v1[0], v1[1]); w.w = cvt_pk_bf16(v1[2], v1[3]);
                    *(u32x4*)(rowp + bj * HALF) = w; } }
    }
};
struct EpiF32 {
    static constexpr bool PERM = true, AFTER_DRAIN = false;
    bf16_t* O; int ldc; float* SL; int ntf;
    __device__ __forceinline__ void operator()(const f32x4 (&acc)[2][2][4][2], const Unit& u, int wr, int wc, int fr, int fq) const {
        const int ntu = u.kn >> 16, kt0 = u.kn & 0xffff;
        const int row0 = wr * 64 + fr; const int col0 = u.pn * BM + wc * 32 + 8 * fq;
        if (ntu < ntf) {
            float* basep = SL + ((size_t)(kt0 / ntu) * 512 + (u.pm == 33 ? 256 : 0)) * ldc;
#pragma unroll
            for (int ai = 0; ai < 2; ++ai)
#pragma unroll
                for (int m = 0; m < 4; ++m) { float* rowp = basep + (size_t)(row0 + ai * HALF + m * 16) * ldc + col0;
#pragma unroll
                    for (int bj = 0; bj < 2; ++bj) { *(f32x4*)(rowp + bj * HALF) = acc[ai][bj][m][0]; *(f32x4*)(rowp + bj * HALF + 4) = acc[ai][bj][m][1]; } }
        } else {
            bf16_t* basep = O + (size_t)u.pm * BM * ldc;
#pragma unroll
            for (int ai = 0; ai < 2; ++ai)
#pragma unroll
                for (int m = 0; m < 4; ++m) { bf16_t* rowp = basep + (size_t)(row0 + ai * HALF + m * 16) * ldc + col0;
#pragma unroll
                    for (int bj = 0; bj < 2; ++bj) { const f32x4 v0 = acc[ai][bj][m][0], v1 = acc[ai][bj][m][1];
                        u32x4 w; w.x = cvt_pk_bf16(v0[0], v0[1]); w.y = cvt_pk_bf16(v0[2], v0[3]); w.z = cvt_pk_bf16(v1[0], v1[1]); w.w = cvt_pk_bf16(v1[2], v1[3]);
                        *(u32x4*)(rowp + bj * HALF) = w; } }
        }
    }
};

template <int CTRL> __device__ __forceinline__ float dpp_upd(float oldv, float src) {
    return __builtin_bit_cast(float, __builtin_amdgcn_update_dpp(__builtin_bit_cast(int, oldv), __builtin_bit_cast(int, src), CTRL, 0xf, 0xf, false)); }
template <int M> __device__ __forceinline__ float conv_elem(float gp, float gc, float gn, float up, float hp, float hn, float w0, float w1, float w2, float cb) {
    const float X = (M == 0) ? hp : dpp_upd<0x121>(0.f, gp);
    const float prev = dpp_upd<0x111>(X, gc);
    const float Yv = (M == 3) ? hn : dpp_upd<0x12F>(0.f, gn);
    const float next = dpp_upd<0x101>(Yv, gc);
    const float y = w0 * prev + w1 * gc + w2 * next + cb;
    return y * __builtin_amdgcn_rcpf(1.f + __builtin_amdgcn_exp2f(y * -1.4426950408889634f)) * up;
}
template <int M> __device__ __forceinline__ f32x4 conv_group(const f32x4 GP, const f32x4 GC, const f32x4 GN, const f32x4 up, const f32x4 hp, const f32x4 hn, const f32x4 w0, const f32x4 w1, const f32x4 w2, const f32x4 cb) {
    f32x4 r;
    r.x = conv_elem<M>(GP.x, GC.x, GN.x, up.x, hp.x, hn.x, w0.x, w1.x, w2.x, cb.x);
    r.y = conv_elem<M>(GP.y, GC.y, GN.y, up.y, hp.y, hn.y, w0.y, w1.y, w2.y, cb.y);
    r.z = conv_elem<M>(GP.z, GC.z, GN.z, up.z, hp.z, hn.z, w0.z, w1.z, w2.z, cb.z);
    r.w = conv_elem<M>(GP.w, GC.w, GN.w, up.w, hp.w, hn.w, w0.w, w1.w, w2.w, cb.w);
    return r;
}
struct EpiConv {
    static constexpr bool PERM = true, AFTER_DRAIN = false;
    bf16_t* ACT; const float* cw; const float* cbias; float* BND; LAS float* xch;
    __device__ __forceinline__ void operator()(const f32x4 (&acc)[2][2][4][2], const Unit& u, int wr_, int wc_, int fr_, int fq_) const {
        int wr = wr_, wc = wc_, fr = fr_, fq = fq_;
        asm volatile("" : "+v"(fr), "+v"(fq), "+s"(wr), "+s"(wc));
        const int cl = wc * 32 + 8 * fq, f0 = u.pn * 128 + cl;
#pragma unroll
        for (int ai = 0; ai < 2; ++ai) { const int blk = 2 * ai + wr;
            if (fr == 0) { *(LAS f32x4*)(xch + (blk * 2 + 0) * 128 + cl) = acc[ai][0][0][0]; *(LAS f32x4*)(xch + (blk * 2 + 0) * 128 + cl + 4) = acc[ai][0][0][1]; }
            if (fr == 15) { *(LAS f32x4*)(xch + (blk * 2 + 1) * 128 + cl) = acc[ai][0][3][0]; *(LAS f32x4*)(xch + (blk * 2 + 1) * 128 + cl + 4) = acc[ai][0][3][1]; } }
        { float* bnd = BND + (size_t)u.pm * 6 * DFF + f0;
          if (wr == 0 && fr < 2) { *(f32x4*)(bnd + fr * DFF) = acc[0][0][0][0]; *(f32x4*)(bnd + fr * DFF + 4) = acc[0][0][0][1]; }
          asm volatile("" ::: "memory");
          if (wr == 0 && fr == 0) { *(f32x4*)(bnd + 4 * DFF) = acc[0][1][0][0]; *(f32x4*)(bnd + 4 * DFF + 4) = acc[0][1][0][1]; }
          asm volatile("" ::: "memory");
          if (wr == 1 && fr >= 14) { *(f32x4*)(bnd + (fr - 12) * DFF) = acc[1][0][3][0]; *(f32x4*)(bnd + (fr - 12) * DFF + 4) = acc[1][0][3][1]; }
          asm volatile("" ::: "memory");
          if (wr == 1 && fr == 15) { *(f32x4*)(bnd + 5 * DFF) = acc[1][1][3][0]; *(f32x4*)(bnd + 5 * DFF + 4) = acc[1][1][3][1]; }
        }
        LBAR(); __builtin_amdgcn_sched_barrier(0);
        const f32x4 w00 = *(const f32x4*)(cw + f0), w01 = *(const f32x4*)(cw + f0 + 4), w10 = *(const f32x4*)(cw + DFF + f0), w11 = *(const f32x4*)(cw + DFF + f0 + 4);
        const f32x4 w20 = *(const f32x4*)(cw + 2 * DFF + f0), w21 = *(const f32x4*)(cw + 2 * DFF + f0 + 4), cb0 = *(const f32x4*)(cbias + f0), cb1 = *(const f32x4*)(cbias + f0 + 4);
#pragma unroll
        for (int ai = 0; ai < 2; ++ai) { const int blk = 2 * ai + wr;
            f32x4 hp0 = {0.f, 0.f, 0.f, 0.f}, hp1 = hp0, hn0 = hp0, hn1 = hp0;
            if (blk > 0) { hp0 = *(const LAS f32x4*)(xch + ((blk - 1) * 2 + 1) * 128 + cl); hp1 = *(const LAS f32x4*)(xch + ((blk - 1) * 2 + 1) * 128 + cl + 4); }
            if (blk < 3) { hn0 = *(const LAS f32x4*)(xch + ((blk + 1) * 2 + 0) * 128 + cl); hn1 = *(const LAS f32x4*)(xch + ((blk + 1) * 2 + 0) * 128 + cl + 4); }
#define CONV_ROW(M, MP, MN) do { __builtin_amdgcn_sched_barrier(0); \
            const f32x4 v0 = conv_group<M>(acc[ai][0][MP][0], acc[ai][0][M][0], acc[ai][0][MN][0], acc[ai][1][M][0], hp0, hn0, w00, w10, w20, cb0); \
            const f32x4 v1 = conv_group<M>(acc[ai][0][MP][1], acc[ai][0][M][1], acc[ai][0][MN][1], acc[ai][1][M][1], hp1, hn1, w01, w11, w21, cb1); \
            const int rl = ai * HALF + wr * 64 + M * 16 + fr; \
            if (rl != 0 && rl != 255) { u32x4 w; w.x = cvt_pk_bf16(v0[0], v0[1]); w.y = cvt_pk_bf16(v0[2], v0[3]); w.z = cvt_pk_bf16(v1[0], v1[1]); w.w = cvt_pk_bf16(v1[2], v1[3]); \
                *(u32x4*)(ACT + (size_t)(u.pm * BM + rl) * DFF + f0) = w; } } while (0)
            CONV_ROW(0, 0, 1); CONV_ROW(1, 0, 2); CONV_ROW(2, 1, 3); CONV_ROW(3, 2, 3);
#undef CONV_ROW
            __builtin_amdgcn_sched_barrier(0);
        }
    }
};

template <class Epi, class Sched, bool ALIGN_EPI = false, bool SP2 = false>
__device__ __forceinline__ void gemm_phase(LAS unsigned char* lds, const Gemm g, const Sched& S, const Epi& E) {
    const int tid = threadIdx.x, wid = __builtin_amdgcn_readfirstlane(tid >> 6), lane = tid & 63, wr = wid >> 2, wc = wid & 3, fr = lane & 15, fq = lane >> 4;
    const int K = g.K;
    unsigned voffA[2], voffB[2];
#pragma unroll
    for (int i = 0; i < 2; ++i) { int R, C; stage_rc(tid * 16 + i * 8192, R, C); const int Rb = Epi::PERM ? ((R & ~31) + perm32(R & 31)) : R;
        voffA[i] = (unsigned)(R * K + C) * 2u; voffB[i] = (unsigned)(Rb * K + C) * 2u; }
    const size_t kstep = (size_t)(BK * 2);
    const size_t hstep = (size_t)HALF * K * 2;
    const size_t tstep = 2 * hstep;
    const unsigned ldsw = (unsigned)wid * 1024u;
    const int aoff = lds_byte(wr * 64 + fr, fq * 8), boff = lds_byte(wc * 32 + fr, fq * 8);
#define PG8_SA(b, h) (((b) * 2 + (h)) * HTB)
#define PG8_SB(b, h) ((4 + (b) * 2 + (h)) * HTB)
#define PG8_STAGE(bufoff, gbase, voff) do { _Pragma("unroll") for (int _i = 0; _i < 2; ++_i) \
        __builtin_amdgcn_global_load_lds((const unsigned*)((const char*)(gbase) + (voff)[_i]), (LAS unsigned*)(lds + (bufoff) + ldsw + _i * 8192), 16, 0, 0); } while (0)
#define PG8_LDA(dst, b, h) do { _Pragma("unroll") for (int m = 0; m < 4; ++m) _Pragma("unroll") for (int k = 0; k < 2; ++k) dst[m][k] = *(const LAS bf16x8*)(lds + PG8_SA(b, h) + aoff + m * 2048 + k * 1024); } while (0)
#define PG8_LDB(dst, b, h) do { _Pragma("unroll") for (int n = 0; n < 2; ++n) _Pragma("unroll") for (int k = 0; k < 2; ++k) dst[n][k] = *(const LAS bf16x8*)(lds + PG8_SB(b, h) + boff + n * 2048 + k * 1024); } while (0)
#define PG8_MMA(ai, bj, At, Bt) do { __builtin_amdgcn_s_setprio(1); _Pragma("unroll") for (int m = 0; m < 4; ++m) _Pragma("unroll") for (int n = 0; n < 2; ++n) _Pragma("unroll") for (int k = 0; k < 2; ++k) \
        acc[ai][bj][m][n] = __builtin_amdgcn_mfma_f32_16x16x32_bf16(Bt[n][k], At[m][k], acc[ai][bj][m][n], 0, 0, 0); __builtin_amdgcn_s_setprio(0); } while (0)
#define PG8_WAIT_V(n) asm volatile("s_waitcnt vmcnt(" #n ")" ::: "memory")
#define PG8_WAIT_L(n) asm volatile("s_waitcnt lgkmcnt(" #n ")" ::: "memory")
#define PG8_BAR __builtin_amdgcn_s_barrier()
#define PG8_SCHED __builtin_amdgcn_sched_barrier(0)
    Unit cur, nxt; int ui = 0;
    if (!S.next(0, cur)) return;
    f32x4 acc[2][2][4][2];
#pragma unroll
    for (int a = 0; a < 2; ++a)
#pragma unroll
        for (int b = 0; b < 2; ++b)
#pragma unroll
            for (int m = 0; m < 4; ++m)
#pragma unroll
                for (int n = 0; n < 2; ++n) acc[a][b][m][n] = (f32x4){0.f, 0.f, 0.f, 0.f};
    bf16x8 At[4][2], B0[2][2], B1[2][2];
    const char* cA = (const char*)g.A + (size_t)cur.pm * tstep + (size_t)(cur.kn & 0xffff) * kstep; const char* cB = (const char*)g.Bt + (size_t)cur.pn * tstep + (size_t)(cur.kn & 0xffff) * kstep;
    S.a_ready(cur);
    if constexpr (SP2) {
        PG8_STAGE(PG8_SB(0, 0), cB, voffB); PG8_STAGE(PG8_SB(0, 1), cB + hstep, voffB); PG8_STAGE(PG8_SA(0, 0), cA, voffA); PG8_STAGE(PG8_SA(0, 1), cA + hstep, voffA);
        if (wr == 1) PG8_BAR;
        PG8_WAIT_V(2); PG8_BAR;
        PG8_STAGE(PG8_SB(1, 0), cB + kstep, voffB); PG8_STAGE(PG8_SA(1, 0), cA + kstep, voffA); PG8_STAGE(PG8_SB(1, 1), cB + hstep + kstep, voffB);
        PG8_WAIT_V(6); PG8_BAR;
    } else {
        PG8_STAGE(PG8_SB(0, 0), cB, voffB); PG8_STAGE(PG8_SA(0, 0), cA, voffA); PG8_STAGE(PG8_SB(0, 1), cB + hstep, voffB); PG8_STAGE(PG8_SA(0, 1), cA + hstep, voffA);
        if (wr == 1) PG8_BAR;
        PG8_WAIT_V(4); PG8_BAR;
        PG8_STAGE(PG8_SB(1, 0), cB + kstep, voffB); PG8_STAGE(PG8_SA(1, 0), cA + kstep, voffA); PG8_STAGE(PG8_SB(1, 1), cB + hstep + kstep, voffB);
        PG8_WAIT_V(6); PG8_BAR;
    }
    for (;;) {
        const bool has_next = S.next(ui + 1, nxt);
        const char* nA = has_next ? (const char*)g.A + (size_t)nxt.pm * tstep + (size_t)(nxt.kn & 0xffff) * kstep : cA; const char* nB = has_next ? (const char*)g.Bt + (size_t)nxt.pn * tstep + (size_t)(nxt.kn & 0xffff) * kstep : cB;
        const int nt = cur.kn >> 16;
        for (int t = 0; t < nt; t += 2) {
            const bool last = (t == nt - 2);
            const char* a1 = cA + (size_t)(t + 1) * kstep;
            const char* a2 = last ? nA : cA + (size_t)(t + 2) * kstep; const char* b2 = last ? nB : cB + (size_t)(t + 2) * kstep;
            const char* a3 = a2 + kstep; const char* b3 = b2 + kstep;
            if (last && has_next) S.a_ready(nxt);
            if constexpr (SP2) {
            PG8_LDB(B0, 0, 0); PG8_LDB(B1, 0, 1); PG8_SCHED; PG8_LDA(At, 0, 0); PG8_STAGE(PG8_SA(1, 1), a1 + hstep, voffA);
            PG8_WAIT_V(8); PG8_WAIT_L(0); PG8_BAR; PG8_MMA(0, 0, At, B0); PG8_MMA(0, 1, At, B1); PG8_BAR; PG8_SCHED;
            PG8_LDA(At, 0, 1); PG8_STAGE(PG8_SB(0, 0), b2, voffB); PG8_STAGE(PG8_SB(0, 1), b2 + hstep, voffB); PG8_STAGE(PG8_SA(0, 0), a2, voffA);
            PG8_WAIT_V(8); PG8_WAIT_L(0); PG8_BAR; PG8_MMA(1, 0, At, B0); PG8_MMA(1, 1, At, B1); PG8_BAR; PG8_SCHED;
            PG8_LDB(B0, 1, 0); PG8_LDB(B1, 1, 1); PG8_SCHED; PG8_LDA(At, 1, 0); PG8_STAGE(PG8_SA(0, 1), a2 + hstep, voffA);
            PG8_WAIT_V(8); PG8_WAIT_L(0); PG8_BAR; PG8_MMA(0, 0, At, B0); PG8_MMA(0, 1, At, B1); PG8_BAR; PG8_SCHED;
            PG8_LDA(At, 1, 1); PG8_STAGE(PG8_SB(1, 0), b3, voffB); PG8_STAGE(PG8_SB(1, 1), b3 + hstep, voffB); PG8_STAGE(PG8_SA(1, 0), a3, voffA);
            PG8_WAIT_V(8); PG8_WAIT_L(0); PG8_BAR; PG8_MMA(1, 0, At, B0); PG8_MMA(1, 1, At, B1); PG8_BAR; PG8_SCHED;
            } else {
            PG8_LDB(B0, 0, 0); PG8_SCHED; PG8_LDA(At, 0, 0); PG8_STAGE(PG8_SA(1, 1), a1 + hstep, voffA);
            PG8_WAIT_L(8); PG8_BAR; PG8_WAIT_L(0); PG8_MMA(0, 0, At, B0); PG8_BAR; PG8_SCHED;
            PG8_LDB(B1, 0, 1); PG8_STAGE(PG8_SB(0, 0), b2, voffB);
            PG8_BAR; PG8_WAIT_L(0); PG8_MMA(0, 1, At, B1); PG8_BAR;
            PG8_LDA(At, 0, 1); PG8_STAGE(PG8_SA(0, 0), a2, voffA);
            PG8_BAR; PG8_WAIT_L(0); PG8_MMA(1, 0, At, B0); PG8_BAR; PG8_SCHED;
            PG8_STAGE(PG8_SB(0, 1), b2 + hstep, voffB);
            PG8_WAIT_V(6); PG8_BAR; PG8_MMA(1, 1, At, B1); PG8_BAR;
            PG8_LDB(B0, 1, 0); PG8_SCHED; PG8_LDA(At, 1, 0); PG8_STAGE(PG8_SA(0, 1), a2 + hstep, voffA);
            PG8_WAIT_L(8); PG8_BAR; PG8_WAIT_L(0); PG8_MMA(0, 0, At, B0); PG8_BAR; PG8_SCHED;
            PG8_LDB(B1, 1, 1); PG8_STAGE(PG8_SB(1, 0), b3, voffB);
            PG8_BAR; PG8_WAIT_L(0); PG8_MMA(0, 1, At, B1); PG8_BAR;
            PG8_LDA(At, 1, 1); PG8_STAGE(PG8_SA(1, 0), a3, voffA);
            PG8_BAR; PG8_WAIT_L(0); PG8_MMA(1, 0, At, B0); PG8_BAR; PG8_SCHED;
            PG8_STAGE(PG8_SB(1, 1), b3 + hstep, voffB);
            PG8_WAIT_V(6); PG8_BAR; PG8_MMA(1, 1, At, B1); PG8_BAR;
            }
        }
        if constexpr (ALIGN_EPI) { if (wr == 0) PG8_BAR; }
        if constexpr (!Epi::AFTER_DRAIN) { E(acc, cur, wr, wc, fr, fq); S.done(cur); }
        if (!has_next) break;
#pragma unroll
        for (int a = 0; a < 2; ++a)
#pragma unroll
            for (int b = 0; b < 2; ++b)
#pragma unroll
                for (int m = 0; m < 4; ++m)
#pragma unroll
                    for (int n = 0; n < 2; ++n) acc[a][b][m][n] = (f32x4){0.f, 0.f, 0.f, 0.f};
        cur = nxt; cA = nA; cB = nB; ++ui;
        if constexpr (ALIGN_EPI) { if (wr == 1) PG8_BAR; }
    }
    PG8_WAIT_V(0);
    if constexpr (!ALIGN_EPI) { if (wr == 0) PG8_BAR; }
    PG8_BAR;
#undef PG8_SA
#undef PG8_SB
#undef PG8_STAGE
#undef PG8_LDA
#undef PG8_LDB
#undef PG8_MMA
#undef PG8_WAIT_V
#undef PG8_WAIT_L
#undef PG8_BAR
#undef PG8_SCHED
}
}

namespace att {
constexpr int D = 128, NW = 8, QBLK = 32, KVBLK = 64;
constexpr float SCALE = 0.088388347648318440f;
constexpr float THR = 8.f;
constexpr int LDQ = NQKV, LDK = NQKV, LDO = DM;
constexpr size_t SHM_V = KVBLK * D * 2, SHM_K = KVBLK * D * 2, SHM_ATTN = 2 * SHM_V + 2 * SHM_K + NW * 64 * 4;
#define KSWZ(row, colB) ((row) * 256 + ((colB) ^ (((row) & 7) << 4)))
#define SBAR() __builtin_amdgcn_sched_barrier(0)
__device__ __forceinline__ int crow(int r, int hi) { return (r & 3) + 8 * (r >> 2) + 4 * hi; }
__device__ __forceinline__ unsigned cvtpk(float lo, float hi) { unsigned r; asm volatile("v_cvt_pk_bf16_f32 %0, %1, %2" : "=v"(r) : "v"(lo), "v"(hi)); return r; }
__device__ __forceinline__ bf16x8 ld8(const bf16_t* p) { return *reinterpret_cast<const bf16x8*>(p); }

__device__ __forceinline__ void partialSM(f32x16& p0, f32x16& p1, float& m_reg, float& mn, float& alpha) {
  constexpr float C = SCALE * 1.4426950408889634f;
  float pmax = p0[0];
#pragma unroll
  for (int r = 1; r < 16; ++r) pmax = fmaxf(pmax, p0[r]);
#pragma unroll
  for (int r = 0; r < 16; ++r) pmax = fmaxf(pmax, p1[r]);
  { auto rr = __builtin_amdgcn_permlane32_swap(__float_as_uint(pmax), __float_as_uint(pmax), false, false);
    pmax = fmaxf(__uint_as_float(rr[0]), __uint_as_float(rr[1])); }
  if (__builtin_expect(__all(pmax - m_reg <= THR / SCALE), 1)) { mn = m_reg; alpha = 1.f; }
  else { mn = fmaxf(m_reg, pmax); alpha = __builtin_amdgcn_exp2f((m_reg - mn) * C); m_reg = mn; }
  float mnC = -mn * C;
#pragma unroll
  for (int r = 0; r < 16; ++r) p0[r] = fmaf(p0[r], C, mnC);
#pragma unroll
  for (int r = 0; r < 16; ++r) p1[r] = fmaf(p1[r], C, mnC);
#pragma unroll
  for (int r = 0; r < 16; ++r) p0[r] = __builtin_amdgcn_exp2f(p0[r]);
}
__device__ __forceinline__ void finishSM(f32x16& p0, f32x16& p1, float alpha, float& l_reg, bf16x8& pa0, bf16x8& pa1, bf16x8& pa2, bf16x8& pa3) {
#pragma unroll
  for (int r = 0; r < 16; ++r) p1[r] = __builtin_amdgcn_exp2f(p1[r]);
  float ps = 0;
#pragma unroll
  for (int r = 0; r < 16; ++r) ps += p0[r];
#pragma unroll
  for (int r = 0; r < 16; ++r) ps += p1[r];
  { auto rr = __builtin_amdgcn_permlane32_swap(__float_as_uint(ps), __float_as_uint(ps), false, false);
    ps = __uint_as_float(rr[0]) + __uint_as_float(rr[1]); }
  l_reg = l_reg * alpha + ps;
#define PK4(P, BASE, OUT) do { unsigned a0 = cvtpk(P[BASE + 0], P[BASE + 1]), a1 = cvtpk(P[BASE + 2], P[BASE + 3]);   \
    unsigned b0 = cvtpk(P[BASE + 4], P[BASE + 5]), b1 = cvtpk(P[BASE + 6], P[BASE + 7]);                              \
    auto r0 = __builtin_amdgcn_permlane32_swap(a0, b0, false, false); auto r1 = __builtin_amdgcn_permlane32_swap(a1, b1, false, false); \
    u32x4 w = {r0[0], r1[0], r0[1], r1[1]}; OUT = *reinterpret_cast<bf16x8*>(&w); } while (0)
  PK4(p0, 0, pa0); PK4(p0, 8, pa1); PK4(p1, 0, pa2); PK4(p1, 8, pa3);
#undef PK4
}
__device__ __forceinline__ void qkt(f32x16& p0, f32x16& p1, const bf16_t* Ks, const bf16x8* qr, int r32, int hi) {
  p0 = f32x16{}; p1 = f32x16{};
#pragma unroll
  for (int d0 = 0; d0 < 8; ++d0) { int cb = (d0 * 16 + hi * 8) * 2;
    bf16x8 b0 = *reinterpret_cast<const bf16x8*>((const char*)Ks + KSWZ(r32, cb));
    bf16x8 b1 = *reinterpret_cast<const bf16x8*>((const char*)Ks + KSWZ(32 + r32, cb));
    p0 = __builtin_amdgcn_mfma_f32_32x32x16_bf16(b0, qr[d0], p0, 0, 0, 0);
    p1 = __builtin_amdgcn_mfma_f32_32x32x16_bf16(b1, qr[d0], p1, 0, 0, 0); }
}
__device__ __forceinline__ int v_st(int k, int c) { const int kk = (k & ~0xC) | ((k & 4) << 1) | ((k & 8) >> 1); return ((kk >> 3) * 4 + (c >> 5)) * 512 + ((kk & 7) * 32 + (c & 31)) * 2; }
__device__ __forceinline__ int v_rd_base(int lane) { return ((lane & 3) << 3) | (((lane >> 2) & 3) << 6) | (((lane >> 4) & 1) << 5) | (((lane >> 5) & 1) << 8); }
constexpr int v_rd_off(int d0, int ks, int half) { return d0 * 512 + ks * 4096 + half * 2048; }
template <int OFF> __device__ __forceinline__ s16x4 tr_read(int vb) {
  s16x4 r; asm volatile("ds_read_b64_tr_b16 %0, %1 offset:%2" : "=&v"(r) : "v"(vb), "i"(OFF) : "memory"); return r;
}
template <int D0> __device__ __forceinline__ void pv_one(f32x16& od, int vb, bf16x8 pa0, bf16x8 pa1, bf16x8 pa2, bf16x8 pa3) {
  const s16x4 l0 = tr_read<v_rd_off(D0, 0, 0)>(vb), h0 = tr_read<v_rd_off(D0, 0, 1)>(vb), l1 = tr_read<v_rd_off(D0, 1, 0)>(vb), h1 = tr_read<v_rd_off(D0, 1, 1)>(vb);
  const s16x4 l2 = tr_read<v_rd_off(D0, 2, 0)>(vb), h2 = tr_read<v_rd_off(D0, 2, 1)>(vb), l3 = tr_read<v_rd_off(D0, 3, 0)>(vb), h3 = tr_read<v_rd_off(D0, 3, 1)>(vb);
  asm volatile("s_waitcnt lgkmcnt(0)" ::: "memory"); SBAR();
#define PK(L, H) (bf16x8){L[0], L[1], L[2], L[3], H[0], H[1], H[2], H[3]}
  od = __builtin_amdgcn_mfma_f32_32x32x16_bf16(pa0, PK(l0, h0), od, 0, 0, 0);
  od = __builtin_amdgcn_mfma_f32_32x32x16_bf16(pa1, PK(l1, h1), od, 0, 0, 0);
  od = __builtin_amdgcn_mfma_f32_32x32x16_bf16(pa2, PK(l2, h2), od, 0, 0, 0);
  od = __builtin_amdgcn_mfma_f32_32x32x16_bf16(pa3, PK(l3, h3), od, 0, 0, 0);
#undef PK
}
__device__ __forceinline__ void pv_d0(f32x16* o, int vb, bf16x8 pa0, bf16x8 pa1, bf16x8 pa2, bf16x8 pa3) {
  pv_one<0>(o[0], vb, pa0, pa1, pa2, pa3); pv_one<1>(o[1], vb, pa0, pa1, pa2, pa3); pv_one<2>(o[2], vb, pa0, pa1, pa2, pa3); pv_one<3>(o[3], vb, pa0, pa1, pa2, pa3);
}

__device__ __forceinline__ void attn_dense_body(const bf16_t* __restrict__ Qb, const bf16_t* __restrict__ Kh, const bf16_t* __restrict__ Vh,
                                                bf16_t* __restrict__ Ob, int seq, char* lds) {
  const int tid = threadIdx.x, wid = tid >> 6, lane = tid & 63, r32 = lane & 31, hi = lane >> 5;
  bf16_t* V_lds = (bf16_t*)lds; bf16_t* K_lds = (bf16_t*)(lds + 2 * SHM_V);
  float* ws = (float*)(lds + 2 * SHM_V + 2 * SHM_K) + wid * 64; float* li_l = ws; float* al_l = ws + 32;
  float m_reg = -1e30f, l_reg = 0; f32x16 o[4] = {}; bf16x8 qr[8];
  const bf16_t* Qw = Qb + (long)(wid * QBLK + r32) * LDQ + hi * 8;
#pragma unroll
  for (int d0 = 0; d0 < 8; ++d0) qr[d0] = ld8(Qw + d0 * 16);
  const int sr = tid >> 4, sc = (tid & 15) * 8, vst0 = v_st(sr, sc), vst1 = v_st(32 + sr, sc);
  const int vb0 = (int)(uintptr_t)V_lds + v_rd_base(lane);
  struct { bf16x8 vs0, vs1, ks0, ks1; } sr_[2];
#define SLOAD(i, k0) do { sr_[i].vs0 = ld8(&Vh[(long)((k0) + sr) * LDK + sc]); sr_[i].vs1 = ld8(&Vh[(long)((k0) + 32 + sr) * LDK + sc]); \
    sr_[i].ks0 = ld8(&Kh[(long)((k0) + sr) * LDK + sc]); sr_[i].ks1 = ld8(&Kh[(long)((k0) + 32 + sr) * LDK + sc]); } while (0)
#define SWRITE(b, i) do { *(bf16x8*)((char*)V_lds + (b) * SHM_V + vst0) = sr_[i].vs0;          \
    *(bf16x8*)((char*)V_lds + (b) * SHM_V + vst1) = sr_[i].vs1; int kc = sc * 2;               \
    *(bf16x8*)((char*)K_lds + (b) * SHM_K + KSWZ(sr, kc)) = sr_[i].ks0;                       \
    *(bf16x8*)((char*)K_lds + (b) * SHM_K + KSWZ(32 + sr, kc)) = sr_[i].ks1; } while (0)
#define SWAIT() do { asm volatile("s_waitcnt vmcnt(4)" ::: "memory"); } while (0)
#define RESC(a) do { if (__any((a) < 1.f)) { if (hi == 0) al_l[r32] = (a); asm volatile("s_waitcnt lgkmcnt(0)" ::: "memory"); \
    _Pragma("unroll") for (int d = 0; d < 4; ++d) _Pragma("unroll") for (int r = 0; r < 16; ++r) o[d][r] *= al_l[crow(r, hi)]; } } while (0)
  f32x16 pA0, pA1, pB0, pB1; float mnA, mnB, alA, alB; bf16x8 pa0, pa1, pa2, pa3; const int NT = seq / KVBLK;
  constexpr int SE = 0, SO = 1;
  SLOAD(SE, 0); asm volatile("s_waitcnt vmcnt(0)" ::: "memory"); SWRITE(0, SE); __syncthreads();
  qkt(pA0, pA1, K_lds, qr, r32, hi); partialSM(pA0, pA1, m_reg, mnA, alA);
  SLOAD(SO, KVBLK); if (2 < NT) SLOAD(SE, 2 * KVBLK);
  SWAIT(); SWRITE(1, SO); __syncthreads();
  for (int j = 1; j + 1 < NT; j += 2) {
    SBAR(); qkt(pB0, pB1, (bf16_t*)((char*)K_lds + SHM_K), qr, r32, hi);
    finishSM(pA0, pA1, alA, l_reg, pa0, pa1, pa2, pa3); SBAR();
    SLOAD(SO, (j + 2) * KVBLK); SBAR();
    pv_d0(o, vb0, pa0, pa1, pa2, pa3); partialSM(pB0, pB1, m_reg, mnB, alB);
    __syncthreads(); SWAIT(); SWRITE(0, SE);
    RESC(alB); __syncthreads();
    SBAR(); qkt(pA0, pA1, K_lds, qr, r32, hi);
    finishSM(pB0, pB1, alB, l_reg, pa0, pa1, pa2, pa3); SBAR();
    if (j + 3 < NT) SLOAD(SE, (j + 3) * KVBLK); SBAR();
    pv_d0(o, vb0 + (int)SHM_V, pa0, pa1, pa2, pa3); partialSM(pA0, pA1, m_reg, mnA, alA);
    __syncthreads(); SWAIT(); SWRITE(1, SO);
    RESC(alA); __syncthreads();
  }
  SBAR(); qkt(pB0, pB1, (bf16_t*)((char*)K_lds + SHM_K), qr, r32, hi);
  finishSM(pA0, pA1, alA, l_reg, pa0, pa1, pa2, pa3); SBAR();
  pv_d0(o, vb0, pa0, pa1, pa2, pa3); partialSM(pB0, pB1, m_reg, mnB, alB);
  __syncthreads(); RESC(alB);
  finishSM(pB0, pB1, alB, l_reg, pa0, pa1, pa2, pa3); SBAR();
  pv_d0(o, vb0 + (int)SHM_V, pa0, pa1, pa2, pa3);
  if (hi == 0) li_l[r32] = l_reg; asm volatile("s_waitcnt lgkmcnt(0)" ::: "memory");
  float rli[16];
#pragma unroll
  for (int r = 0; r < 16; ++r) rli[r] = __builtin_amdgcn_rcpf(li_l[crow(r, hi)]);
  bf16_t* Ow = Ob + (long)(wid * QBLK) * LDO;
#pragma unroll
  for (int r = 0; r < 16; ++r) { int orow = crow(r, hi);
#pragma unroll
    for (int d0 = 0; d0 < 4; ++d0) Ow[(long)orow * LDO + d0 * 32 + r32] = (bf16_t)f2bf(o[d0][r] * rli[r]); }
  __syncthreads();
#undef SLOAD
#undef SWRITE
#undef SWAIT
#undef RESC
}
}

__device__ __forceinline__ void transpose_item(const float* W, int K, int N, bf16_t* WT, LAS float* scr, int item, int lane, bool ffn_remap = false) {
    const int nblk = N / 32, kb = item / nblk, nb = item % nblk, k0 = 64 * kb, n0 = 32 * nb;
    int n0o = n0; if (ffn_remap) { const int half = n0 >= DFF ? 1 : 0, f = n0 - half * DFF; n0o = (f >> 7) * 256 + half * 128 + (f & 127); }
#pragma unroll 8
    for (int i = 0; i < 32; ++i) { const int kk = 2 * i + (lane >> 5); scr[kk * 33 + (lane & 31)] = W[(size_t)(k0 + kk) * N + n0 + (lane & 31)]; }
    asm volatile("s_waitcnt lgkmcnt(0)" ::: "memory");
    const int c = lane & 7;
#pragma unroll
    for (int j = 0; j < 4; ++j) { const int n = (lane >> 3) + 8 * j; const LAS float* s = scr + (8 * c) * 33 + n;
        u32x4 o; o.x = pk2(s[0 * 33], s[1 * 33]); o.y = pk2(s[2 * 33], s[3 * 33]); o.z = pk2(s[4 * 33], s[5 * 33]); o.w = pk2(s[6 * 33], s[7 * 33]);
        *(u32x4*)(WT + (size_t)(n0o + n) * K + k0 + 8 * c) = o; }
    asm volatile("s_waitcnt lgkmcnt(0)" ::: "memory");
}

__device__ __forceinline__ void ada_phase(const float* c, const float* c_ctx, const float* ada_w, const float* ada_b, float* mod, LAS unsigned char* lds, int wg, int G, int tid) {
    LAS float* sv = (LAS float*)lds;
    LAS float* part = sv + 3 * 2048;
    for (int i = tid; i < 3 * 2048; i += 512) { const int s = i >> 11, k = i & 2047; const float v = (s == 0) ? c_ctx[k] : c[(s - 1) * 2048 + k]; sv[i] = siluf(v); }
    __syncthreads();
    const int wave = tid >> 6, lane = tid & 63;
    for (int item = wg; item < 192; item += G) {
        const int L = item / 96, n0 = (item % 96) * 128;
        const float* W = ada_w + (size_t)L * 2048 * 12288 + n0 + lane * 2;
        float a0x = 0, a0y = 0, a1x = 0, a1y = 0, a2x = 0, a2y = 0;
        const int k0 = wave * 256;
#pragma unroll 8
        for (int k = 0; k < 256; ++k) {
            const f32x2 w = *(const f32x2*)(W + (size_t)(k0 + k) * 12288);
            const float s0 = sv[k0 + k], s1 = sv[2048 + k0 + k], s2 = sv[4096 + k0 + k];
            a0x += s0 * w.x; a0y += s0 * w.y; a1x += s1 * w.x; a1y += s1 * w.y; a2x += s2 * w.x; a2y += s2 * w.y;
        }
        part[(wave * 3 + 0) * 128 + lane * 2] = a0x; part[(wave * 3 + 0) * 128 + lane * 2 + 1] = a0y;
        part[(wave * 3 + 1) * 128 + lane * 2] = a1x; part[(wave * 3 + 1) * 128 + lane * 2 + 1] = a1y;
        part[(wave * 3 + 2) * 128 + lane * 2] = a2x; part[(wave * 3 + 2) * 128 + lane * 2 + 1] = a2y;
        __syncthreads();
        if (tid < 384) { const int s = tid >> 7, n = tid & 127; float acc = ada_b[L * 12288 + n0 + n];
#pragma unroll
            for (int w = 0; w < 8; ++w) acc += part[(w * 3 + s) * 128 + n];
            mod[(size_t)(L * 3 + s) * 12288 + n0 + n] = acc; }
        __syncthreads();
    }
}

template <bool XIN_BF, bool XOUT_BF>
__device__ __forceinline__ void row_phase(const float* xin_lat, const float* xin_ctx, float* xout_lat, float* xout_ctx, bf16_t* XR,
                                          const bf16_t* Y, const float* g_post, const float* g_pre, const float* modL, int jgate, int jshift, int jscale,
                                          bf16_t* H, bool has_y, bool make_h, bool lat_only, int gw, int NGW, int lane, const float* YS = nullptr, int nsplit = 0) {
    for (int r = gw; r < MR; r += NGW) {
        const int b = r / SB, p = r - b * SB; int s; const float* xi; float* xo; const bool ctxrow = p < CTX;
        size_t xrow;
        if (ctxrow) { if (lat_only) continue; s = 0; xrow = (size_t)(b * CTX + p) * DM; xi = xin_ctx + xrow; xo = xout_ctx + xrow; }
        else { s = 1 + b; xrow = (size_t)(b * SEQ + p - CTX) * DM; xi = xin_lat + xrow; xo = xout_lat + xrow; }
        const float* ms = modL + (size_t)s * 12288;
        f32x4 x[8];
#pragma unroll
        for (int j = 0; j < 8; ++j) {
            if (XIN_BF && !ctxrow) { const u32x2 xb = *(const u32x2*)(XR + xrow + (j * 64 + lane) * 4); x[j] = (f32x4){bflo(xb.x), bfhi(xb.x), bflo(xb.y), bfhi(xb.y)}; }
            else x[j] = *(const f32x4*)(xi + (j * 64 + lane) * 4);
        }
        if (has_y) {
            f32x4 y[8]; float ss = 0.f;
#pragma unroll
            for (int j = 0; j < 8; ++j) {
                if (ctxrow && nsplit > 0) { f32x4 t = {0.f, 0.f, 0.f, 0.f};
                    for (int sp = 0; sp < nsplit; ++sp) t += *(const f32x4*)(YS + ((size_t)sp * 512 + b * CTX + p) * DM + (j * 64 + lane) * 4);
                    y[j] = t; }
                else { const u32x2 yb = *(const u32x2*)(Y + (size_t)r * DM + (j * 64 + lane) * 4); y[j] = (f32x4){bflo(yb.x), bfhi(yb.x), bflo(yb.y), bfhi(yb.y)}; }
                ss += (y[j].x * y[j].x + y[j].y * y[j].y) + (y[j].z * y[j].z + y[j].w * y[j].w); }
            const float rs = rsqrtf(wave_sum(ss) * (1.f / DM) + EPS);
#pragma unroll
            for (int j = 0; j < 8; ++j) { const f32x4 gp = *(const f32x4*)(g_post + (j * 64 + lane) * 4); const f32x4 gt = *(const f32x4*)(ms + jgate * 2048 + (j * 64 + lane) * 4);
                x[j] = x[j] + gt * (y[j] * rs * gp);
                if (XOUT_BF && !ctxrow) { u32x2 w; w.x = cvt_pk_bf16(x[j].x, x[j].y); w.y = cvt_pk_bf16(x[j].z, x[j].w); *(u32x2*)(XR + xrow + (j * 64 + lane) * 4) = w;
                    x[j] = (f32x4){bflo(w.x), bfhi(w.x), bflo(w.y), bfhi(w.y)}; }
                else *(f32x4*)(xo + (j * 64 + lane) * 4) = x[j]; }
        }
        if (make_h) {
            float ss = 0.f;
#pragma unroll
            for (int j = 0; j < 8; ++j) ss += (x[j].x * x[j].x + x[j].y * x[j].y) + (x[j].z * x[j].z + x[j].w * x[j].w);
            const float rs = rsqrtf(wave_sum(ss) * (1.f / DM) + EPS);
#pragma unroll
            for (int j = 0; j < 8; ++j) { const f32x4 gp = *(const f32x4*)(g_pre + (j * 64 + lane) * 4); const f32x4 sh = *(const f32x4*)(ms + jshift * 2048 + (j * 64 + lane) * 4);
                const f32x4 sc = *(const f32x4*)(ms + jscale * 2048 + (j * 64 + lane) * 4);
                const f32x4 hv = (x[j] * rs * gp) * (sc + 1.f) + sh;
                u32x2 w; w.x = cvt_pk_bf16(hv.x, hv.y); w.y = cvt_pk_bf16(hv.z, hv.w);
                *(u32x2*)(H + (size_t)r * DM + (j * 64 + lane) * 4) = w; }
        }
    }
}

__device__ __forceinline__ void gla_prep_phase(bf16_t* P, bf16_t* QB, float* EB, const float* __restrict__ lbl, LAS unsigned char* lds, int wg, int G, int tid) {
    const int lane = tid & 63, w = __builtin_amdgcn_readfirstlane(tid >> 6);
    constexpr float L2E = 1.4426950408889634f;
    int par = 0;
    for (int item = wg; item < NB * NH * 132; item += G, par ^= 1) {
        LAS float* TOT = (LAS float*)lds + par * 2048;
        const int rb = item % 132, bh = item / 132, h = bh & 15, b = bh >> 4;
        float lb[2][2], oml[2][2];
#pragma unroll
        for (int d = 0; d < 2; ++d)
#pragma unroll
            for (int e = 0; e < 2; ++e) { const int ch = h * 128 + 2 * lane + e; const float l0 = lbl[(d * 2 + 0) * 2048 + ch], l1 = lbl[(d * 2 + 1) * 2048 + ch];
                lb[d][e] = __builtin_amdgcn_rcpf(1.f + __builtin_amdgcn_exp2f((l1 - l0) * L2E)); oml[d][e] = 1.f - lb[d][e]; }
        const size_t row0 = (size_t)b * SB + rb * 64 + 8 * w;
        const int col = h * 128 + 2 * lane;
        unsigned q2[8], ff[8], fb[8];
#pragma unroll
        for (int i = 0; i < 8; ++i) { const size_t ro = (row0 + i) * NHG + col; q2[i] = *(const unsigned*)(P + ro); ff[i] = *(const unsigned*)(P + ro + 2048); fb[i] = *(const unsigned*)(P + ro + 4096); }
        float blf[8][2], blb[8][2], kkf[8][2], kkb[8][2];
        { float r0 = 0.f, r1 = 0.f;
#pragma unroll
          for (int i = 0; i < 8; ++i) {
              { const float sg = __builtin_amdgcn_rcpf(1.f + __builtin_amdgcn_exp2f(bflo(ff[i]) * -L2E)); r0 += __builtin_amdgcn_logf(lb[0][0] + oml[0][0] * sg); blf[i][0] = r0; kkf[i][0] = oml[0][0] - oml[0][0] * sg; }
              { const float sg = __builtin_amdgcn_rcpf(1.f + __builtin_amdgcn_exp2f(bfhi(ff[i]) * -L2E)); r1 += __builtin_amdgcn_logf(lb[0][1] + oml[0][1] * sg); blf[i][1] = r1; kkf[i][1] = oml[0][1] - oml[0][1] * sg; }
          }
          *(LAS f32x2*)(TOT + w * 128 + 2 * lane) = (f32x2){r0, r1}; }
        { float r0 = 0.f, r1 = 0.f;
#pragma unroll
          for (int i = 7; i >= 0; --i) {
              { const float sg = __builtin_amdgcn_rcpf(1.f + __builtin_amdgcn_exp2f(bflo(fb[i]) * -L2E)); r0 += __builtin_amdgcn_logf(lb[1][0] + oml[1][0] * sg); blb[i][0] = r0; kkb[i][0] = oml[1][0] - oml[1][0] * sg; }
              { const float sg = __builtin_amdgcn_rcpf(1.f + __builtin_amdgcn_exp2f(bfhi(fb[i]) * -L2E)); r1 += __builtin_amdgcn_logf(lb[1][1] + oml[1][1] * sg); blb[i][1] = r1; kkb[i][1] = oml[1][1] - oml[1][1] * sg; }
          }
          *(LAS f32x2*)(TOT + 1024 + w * 128 + 2 * lane) = (f32x2){r0, r1}; }
        LBAR();
        float pf0 = 0.f, pf1 = 0.f, tf0 = 0.f, tf1 = 0.f, pb0 = 0.f, pb1 = 0.f, tb0 = 0.f, tb1 = 0.f;
#pragma unroll
        for (int g = 0; g < 8; ++g) { const f32x2 x = *(const LAS f32x2*)(TOT + g * 128 + 2 * lane), y = *(const LAS f32x2*)(TOT + 1024 + g * 128 + 2 * lane);
            tf0 += x.x; tf1 += x.y; tb0 += y.x; tb1 += y.y; if (g < w) { pf0 += x.x; pf1 += x.y; } if (g > w) { pb0 += y.x; pb1 += y.y; } }
#pragma unroll
        for (int i = 0; i < 8; ++i) {
            const float qs0 = bflo(q2[i]), qs1 = bfhi(q2[i]);
            const float s0 = qs0 * 0.08838834764831845f * __builtin_amdgcn_rcpf(1.f + __builtin_amdgcn_exp2f(qs0 * -L2E));
            const float s1 = qs1 * 0.08838834764831845f * __builtin_amdgcn_rcpf(1.f + __builtin_amdgcn_exp2f(qs1 * -L2E));
            const float df0 = pf0 + blf[i][0] - tf0, df1 = pf1 + blf[i][1] - tf1, db0 = pb0 + blb[i][0] - tb0, db1 = pb1 + blb[i][1] - tb1;
            const size_t ro = (row0 + i) * NHG + col;
            *(unsigned*)(P + ro) = cvt_pk_bf16(s0 * __builtin_amdgcn_exp2f(df0), s1 * __builtin_amdgcn_exp2f(df1));
            *(unsigned*)(P + ro + 2048) = cvt_pk_bf16(kkf[i][0] * __builtin_amdgcn_exp2f(-df0), kkf[i][1] * __builtin_amdgcn_exp2f(-df1));
            *(unsigned*)(P + ro + 4096) = cvt_pk_bf16(kkb[i][0] * __builtin_amdgcn_exp2f(-db0), kkb[i][1] * __builtin_amdgcn_exp2f(-db1));
            *(unsigned*)(QB + (row0 + i) * DM + col) = cvt_pk_bf16(s0 * __builtin_amdgcn_exp2f(db0), s1 * __builtin_amdgcn_exp2f(db1));
        }
        if (w == 0) {
            const int cb = rb < 4 ? 3 - rb : 135 - rb;
            *(f32x2*)(EB + ((size_t)((b * 16 + h) * 2 + 0) * 132 + rb) * 128 + 2 * lane) = (f32x2){__builtin_amdgcn_exp2f(tf0), __builtin_amdgcn_exp2f(tf1)};
            *(f32x2*)(EB + ((size_t)((b * 16 + h) * 2 + 1) * 132 + cb) * 128 + 2 * lane) = (f32x2){__builtin_amdgcn_exp2f(tb0), __builtin_amdgcn_exp2f(tb1)};
        }
    }
    __syncthreads();
}

__device__ __forceinline__ void gla_item(const bf16_t* __restrict__ P, const bf16_t* __restrict__ QS, int ldq, const float* __restrict__ EB, bf16_t* __restrict__ Od, LAS unsigned char* lds, int b, int h, int dir, int vs, int tid) {
    const int lane = tid & 63, w = __builtin_amdgcn_readfirstlane(tid >> 6), fr = lane & 15, fq = lane >> 4;
    constexpr int SETB = 66560;
    LAS unsigned char* PS = lds + 2 * SETB;
    for (int i = tid; i < 9216 / 4; i += 512) ((LAS unsigned*)PS)[i] = 0u;
    f32x4 S0 = {0.f, 0.f, 0.f, 0.f}, S1 = {0.f, 0.f, 0.f, 0.f};
    const int colq = h * 128 + 2 * lane, colf = 2048 * (1 + dir) + h * 128 + 2 * lane, colv = 3 * 2048 + h * 128 + vs * 32 + (tid & 7) * 4;
    const int tv = tid >> 3, base = b * SB, rofs = dir ? 63 : 0, rsign = dir ? -1 : 1;
    const float* ebp = EB + (size_t)((b * 16 + h) * 2 + dir) * 132 * 128 + 16 * w + 4 * fq;
    unsigned q2[4][8], f2[4][8]; u32x2 vv[4]; f32x4 eb[4];
#define GLA_R0(c) (dir ? ((c) < 4 ? base + 192 - 64 * (c) : base + 8640 - 64 * (c)) : base + 64 * (c))
#define GLA_LOAD(u, c) do { const int R0n = GLA_R0(c); \
        _Pragma("unroll") for (int i = 0; i < 8; ++i) { const size_t rr = (size_t)(R0n + rofs + rsign * (8 * w + i)); \
            q2[u][i] = *(const unsigned*)(QS + rr * ldq + colq); f2[u][i] = *(const unsigned*)(P + rr * NHG + colf); } \
        vv[u] = *(const u32x2*)(P + (size_t)(R0n + rofs + rsign * tv) * NHG + colv); eb[u] = *(const f32x4*)(ebp + (size_t)(c) * 128); } while (0)
    GLA_LOAD(0, 0); GLA_LOAD(1, 1); GLA_LOAD(2, 2); GLA_LOAD(3, 3);
    LBAR();
    for (int c0 = 0; c0 < 132; c0 += 4) {
#pragma unroll
      for (int u = 0; u < 4; ++u) {
        const int c = c0 + u;
        const int R0 = GLA_R0(c);
        LAS unsigned char* QD = lds + (u & 1) * SETB; LAS unsigned char* KD = QD + 17408; LAS unsigned char* KDT = QD + 34816; LAS unsigned char* VT = QD + 53248; LAS unsigned char* SDT = QD + 57856;
#pragma unroll
        for (int i = 0; i < 8; ++i) { *(LAS unsigned*)(QD + (8 * w + i) * 272 + lane * 4) = q2[u][i]; *(LAS unsigned*)(KD + (8 * w + i) * 272 + lane * 4) = f2[u][i]; }
        { u32x4 t0, t1;
          t0.x = (f2[u][0] & 0xffffu) | (f2[u][1] << 16); t0.y = (f2[u][2] & 0xffffu) | (f2[u][3] << 16); t0.z = (f2[u][4] & 0xffffu) | (f2[u][5] << 16); t0.w = (f2[u][6] & 0xffffu) | (f2[u][7] << 16);
          t1.x = (f2[u][0] >> 16) | (f2[u][1] & 0xffff0000u); t1.y = (f2[u][2] >> 16) | (f2[u][3] & 0xffff0000u); t1.z = (f2[u][4] >> 16) | (f2[u][5] & 0xffff0000u); t1.w = (f2[u][6] >> 16) | (f2[u][7] & 0xffff0000u);
          *(LAS u32x4*)(KDT + (2 * lane) * 144 + w * 16) = t0; *(LAS u32x4*)(KDT + (2 * lane + 1) * 144 + w * 16) = t1; }
        { LAS bf16_t* vt = (LAS bf16_t*)VT; const int v4 = (tid & 7) * 4;
          vt[(v4 + 0) * 72 + tv] = (bf16_t)(vv[u].x & 0xffffu); vt[(v4 + 1) * 72 + tv] = (bf16_t)(vv[u].x >> 16);
          vt[(v4 + 2) * 72 + tv] = (bf16_t)(vv[u].y & 0xffffu); vt[(v4 + 3) * 72 + tv] = (bf16_t)(vv[u].y >> 16); }
        S0 *= eb[u]; S1 *= eb[u];
        *(LAS u32x2*)(SDT + fr * 272 + (16 * w + 4 * fq) * 2) = (u32x2){cvt_pk_bf16(S0.x, S0.y), cvt_pk_bf16(S0.z, S0.w)};
        *(LAS u32x2*)(SDT + (16 + fr) * 272 + (16 * w + 4 * fq) * 2) = (u32x2){cvt_pk_bf16(S1.x, S1.y), cvt_pk_bf16(S1.z, S1.w)};
        if (c + 4 < 132) GLA_LOAD(u, c + 4);
        LBAR();
        for (int q = w; q < 10; q += 8) {
            const int ti = (q >= 1) + (q >= 3) + (q >= 6), si = q - ti * (ti + 1) / 2;
            f32x4 acc = {0.f, 0.f, 0.f, 0.f};
#pragma unroll
            for (int ks = 0; ks < 4; ++ks) { const bf16x8 a = *(const LAS bf16x8*)(KD + (16 * si + fr) * 272 + (ks * 32 + fq * 8) * 2);
                const bf16x8 bq = *(const LAS bf16x8*)(QD + (16 * ti + fr) * 272 + (ks * 32 + fq * 8) * 2);
                acc = __builtin_amdgcn_mfma_f32_16x16x32_bf16(a, bq, acc, 0, 0, 0); }
            if (si == ti) {
#pragma unroll
                for (int j = 0; j < 4; ++j) if (4 * fq + j > fr) acc[j] = 0.f;
            }
            *(LAS u32x2*)(PS + (16 * ti + fr) * 144 + (16 * si + 4 * fq) * 2) = (u32x2){cvt_pk_bf16(acc.x, acc.y), cvt_pk_bf16(acc.z, acc.w)};
        }
        LBAR();
        { const int ti = w >> 1, vi = w & 1; f32x4 o = {0.f, 0.f, 0.f, 0.f};
#pragma unroll
          for (int ks = 0; ks < 2; ++ks) { const bf16x8 a = *(const LAS bf16x8*)(VT + (16 * vi + fr) * 144 + (ks * 32 + fq * 8) * 2);
              const bf16x8 bp = *(const LAS bf16x8*)(PS + (16 * ti + fr) * 144 + (ks * 32 + fq * 8) * 2);
              o = __builtin_amdgcn_mfma_f32_16x16x32_bf16(a, bp, o, 0, 0, 0); }
#pragma unroll
          for (int ks = 0; ks < 4; ++ks) { const bf16x8 a = *(const LAS bf16x8*)(SDT + (16 * vi + fr) * 272 + (ks * 32 + fq * 8) * 2);
              const bf16x8 bq = *(const LAS bf16x8*)(QD + (16 * ti + fr) * 272 + (ks * 32 + fq * 8) * 2);
              o = __builtin_amdgcn_mfma_f32_16x16x32_bf16(a, bq, o, 0, 0, 0); }
          const size_t ro = (size_t)(R0 + rofs + rsign * (16 * ti + fr)) * DM;
          *(u32x2*)(Od + ro + h * 128 + vs * 32 + 16 * vi + 4 * fq) = (u32x2){cvt_pk_bf16(o.x, o.y), cvt_pk_bf16(o.z, o.w)}; }
#pragma unroll
        for (int ks = 0; ks < 2; ++ks) { const bf16x8 a = *(const LAS bf16x8*)(KDT + (16 * w + fr) * 144 + (ks * 32 + fq * 8) * 2);
            const bf16x8 b0 = *(const LAS bf16x8*)(VT + fr * 144 + (ks * 32 + fq * 8) * 2);
            const bf16x8 b1 = *(const LAS bf16x8*)(VT + (16 + fr) * 144 + (ks * 32 + fq * 8) * 2);
            S0 = __builtin_amdgcn_mfma_f32_16x16x32_bf16(a, b0, S0, 0, 0, 0);
            S1 = __builtin_amdgcn_mfma_f32_16x16x32_bf16(a, b1, S1, 0, 0, 0); }
      }
    }
#undef GLA_LOAD
#undef GLA_R0
    __syncthreads();
}

__device__ __forceinline__ void readout_phase(const bf16_t* Ofw, const bf16_t* Obw, const bf16_t* P, const float* o_gain, bf16_t* R, int gw, int NGW, int lane) {
    const int cl = (8 * lane) & 127;
    f32x4 g0 = *(const f32x4*)(o_gain + cl), g1 = *(const f32x4*)(o_gain + cl + 4);
    for (int it = gw; it < MR * 4; it += NGW) {
        const int r = it >> 2, c0 = (it & 3) * 512 + 8 * lane;
        const u32x4 a = *(const u32x4*)(Ofw + (size_t)r * DM + c0), bq = *(const u32x4*)(Obw + (size_t)r * DM + c0), g = *(const u32x4*)(P + (size_t)r * NHG + 4 * DM + c0);
        float o[8];
        o[0] = bflo(a.x) + bflo(bq.x); o[1] = bfhi(a.x) + bfhi(bq.x); o[2] = bflo(a.y) + bflo(bq.y); o[3] = bfhi(a.y) + bfhi(bq.y);
        o[4] = bflo(a.z) + bflo(bq.z); o[5] = bfhi(a.z) + bfhi(bq.z); o[6] = bflo(a.w) + bflo(bq.w); o[7] = bfhi(a.w) + bfhi(bq.w);
        float ss = 0.f;
#pragma unroll
        for (int e = 0; e < 8; ++e) ss += o[e] * o[e];
        ss += __shfl_xor(ss, 1); ss += __shfl_xor(ss, 2); ss += __shfl_xor(ss, 4); ss += __shfl_xor(ss, 8);
        const float rs = rsqrtf(ss * (1.f / 128.f) + EPS);
        const float gv[8] = {bflo(g.x), bfhi(g.x), bflo(g.y), bfhi(g.y), bflo(g.z), bfhi(g.z), bflo(g.w), bfhi(g.w)};
        const float gn[8] = {g0.x, g0.y, g0.z, g0.w, g1.x, g1.y, g1.z, g1.w};
        float v[8];
#pragma unroll
        for (int e = 0; e < 8; ++e) v[e] = o[e] * rs * gn[e] * siluf(gv[e]);
        u32x4 wv; wv.x = cvt_pk_bf16(v[0], v[1]); wv.y = cvt_pk_bf16(v[2], v[3]); wv.z = cvt_pk_bf16(v[4], v[5]); wv.w = cvt_pk_bf16(v[6], v[7]);
        *(u32x4*)(R + (size_t)r * DM + c0) = wv;
    }
}

__device__ __forceinline__ void conv_fix_phase(const float* BND, const float* cw, const float* cbias, bf16_t* ACT, bool lat_only, int gw, int NGW, int lane) {
    constexpr float L2E = 1.4426950408889634f;
    for (int it = gw; it < 66 * 2 * 11; it += NGW) {
        const int cbk = it % 11, rest = it / 11, which = rest & 1, pm = rest >> 1;
        if (lat_only && (pm == 0 || pm == 33)) continue;
        const int c0 = cbk * 512 + 8 * lane;
        const float* bn = BND + (size_t)pm * 6 * DFF + c0;
        f32x4 pv[2], cv[2], nv[2], uv[2]; size_t row;
        if (which == 0) {
            const bool seq_start = (pm == 0 || pm == 1 || pm == 33 || pm == 34);
#pragma unroll
            for (int hh = 0; hh < 2; ++hh) { pv[hh] = seq_start ? (f32x4){0.f, 0.f, 0.f, 0.f} : *(const f32x4*)(bn - 6 * DFF + 3 * DFF + 4 * hh);
                cv[hh] = *(const f32x4*)(bn + 4 * hh); nv[hh] = *(const f32x4*)(bn + DFF + 4 * hh); uv[hh] = *(const f32x4*)(bn + 4 * DFF + 4 * hh); }
            row = (size_t)pm * 256;
        } else {
            const bool seq_end = (pm == 0 || pm == 32 || pm == 33 || pm == 65);
#pragma unroll
            for (int hh = 0; hh < 2; ++hh) { pv[hh] = *(const f32x4*)(bn + 2 * DFF + 4 * hh); cv[hh] = *(const f32x4*)(bn + 3 * DFF + 4 * hh);
                nv[hh] = seq_end ? (f32x4){0.f, 0.f, 0.f, 0.f} : *(const f32x4*)(bn + 6 * DFF + 4 * hh); uv[hh] = *(const f32x4*)(bn + 5 * DFF + 4 * hh); }
            row = (size_t)pm * 256 + 255;
        }
        float v[8];
#pragma unroll
        for (int hh = 0; hh < 2; ++hh) {
            const f32x4 w0 = *(const f32x4*)(cw + c0 + 4 * hh), w1 = *(const f32x4*)(cw + DFF + c0 + 4 * hh), w2 = *(const f32x4*)(cw + 2 * DFF + c0 + 4 * hh), cb = *(const f32x4*)(cbias + c0 + 4 * hh);
#pragma unroll
            for (int j = 0; j < 4; ++j) { const float y = w0[j] * pv[hh][j] + w1[j] * cv[hh][j] + w2[j] * nv[hh][j] + cb[j];
                v[4 * hh + j] = y * __builtin_amdgcn_rcpf(1.f + __builtin_amdgcn_exp2f(y * -L2E)) * uv[hh][j]; }
        }
        u32x4 wv; wv.x = cvt_pk_bf16(v[0], v[1]); wv.y = cvt_pk_bf16(v[2], v[3]); wv.z = cvt_pk_bf16(v[4], v[5]); wv.w = cvt_pk_bf16(v[6], v[7]);
        *(u32x4*)(ACT + row * DFF + c0) = wv;
    }
}

__device__ __forceinline__ void qknorm_phase(bf16_t* QKV, const float* q_gain, const float* k_gain, int gw, int NGW, int lane) {
    const int cl = (8 * lane) & 127;
    for (int it = gw; it < MR * 5; it += NGW) {
        const int r = it / 5, grp = it - r * 5, p = r % SB;
        const bool lat = p >= CTX;
        if (!lat && grp < 4) continue;
        bf16_t* ptr = QKV + (size_t)r * NQKV + grp * 512 + 8 * lane;
        const float* gn = (grp < 4) ? q_gain : k_gain;
        const u32x4 a = *(const u32x4*)ptr;
        float x[8] = {bflo(a.x), bfhi(a.x), bflo(a.y), bfhi(a.y), bflo(a.z), bfhi(a.z), bflo(a.w), bfhi(a.w)};
        float ss = 0.f;
#pragma unroll
        for (int e = 0; e < 8; ++e) ss += x[e] * x[e];
        ss += __shfl_xor(ss, 1); ss += __shfl_xor(ss, 2); ss += __shfl_xor(ss, 4); ss += __shfl_xor(ss, 8);
        const float rs = rsqrtf(ss * (1.f / 128.f) + EPS);
#pragma unroll
        for (int e = 0; e < 8; ++e) x[e] = x[e] * rs * gn[cl + e];
        if (lat) {
            const int t = p - CTX; const float prow = (float)(t >> 6), pcol = (float)(t & 63);
#pragma unroll
            for (int e2 = 0; e2 < 4; ++e2) {
                const int i = (cl >> 1) + e2; const int fi = i & 31;
                const float invf = exp2f(-(float)fi * (13.287712379549449f / 32.f));
                const float ang = ((i >= 32) ? pcol : prow) * invf;
                float sn, cs; sincosf(ang, &sn, &cs);
                const float x1 = x[2 * e2], x2 = x[2 * e2 + 1];
                x[2 * e2] = x1 * cs - x2 * sn; x[2 * e2 + 1] = x1 * sn + x2 * cs;
            }
        }
        u32x4 wv; wv.x = cvt_pk_bf16(x[0], x[1]); wv.y = cvt_pk_bf16(x[2], x[3]); wv.z = cvt_pk_bf16(x[4], x[5]); wv.w = cvt_pk_bf16(x[6], x[7]);
        *(u32x4*)ptr = wv;
    }
}


#define XB_TMO      128
#define XB_XCNT(j)  (256  + 64 * (j))
#define XB_XSUB(j)  (1280 + 64 * (j))
#define XB_XGEN(j)  (2304 + 64 * (j))
#define XB_TOP      3328
#define XB_TOPGEN   3392
#define XCD_BAR_WORDS 3456
#define XB_SPIN_CAP (1u << 20)
__device__ __forceinline__ unsigned xb_ld(unsigned* p)              { return __hip_atomic_load(p, __ATOMIC_RELAXED, __HIP_MEMORY_SCOPE_AGENT); }
__device__ __forceinline__ unsigned xb_add(unsigned* p, unsigned v) { return __hip_atomic_fetch_add(p, v, __ATOMIC_RELAXED, __HIP_MEMORY_SCOPE_AGENT); }
__device__ __forceinline__ unsigned xb_xcc_id() { return (unsigned)__builtin_amdgcn_s_getreg((3 << 11) | 20) & 0xFu; }
#define XB_SPIN(cond, bar) do { unsigned _sp = 0; while (cond) { __builtin_amdgcn_s_sleep(1); \
    if ((++_sp & 255u) == 0u) { if (xb_ld(&(bar)[XB_TMO])) break; if (_sp > XB_SPIN_CAP) { atomicAdd(&(bar)[XB_TMO], 1u); break; } } } } while (0)
struct XcdBarrier { unsigned* bar; unsigned x; volatile LAS unsigned* st; };
__device__ __forceinline__ XcdBarrier xcd_barrier_post(unsigned* bar, volatile LAS unsigned* st) {
    XcdBarrier b; b.bar = bar; b.x = xb_xcc_id(); b.st = st;
    if (threadIdx.x == 0) (void)xb_add(&bar[XB_XCNT(b.x)], 1u);
    return b;
}
__device__ __forceinline__ void xcd_barrier_complete(unsigned* bar, unsigned x, unsigned& nloc, unsigned& nx) {
    const unsigned G = gridDim.x * gridDim.y * gridDim.z;
    unsigned sum, cnt, mine, sp = 0u;
    for (;;) {
        sum = 0u; cnt = 0u; mine = 0u;
#pragma unroll
        for (unsigned j = 0; j < 16; ++j) { const unsigned c = xb_ld(&bar[XB_XCNT(j)]); sum += c; cnt += (c > 0u) ? 1u : 0u; mine = (j == x) ? c : mine; }
        if (sum == G) break;
        __builtin_amdgcn_s_sleep(1);
        if ((++sp & 255u) == 0u) { if (xb_ld(&bar[XB_TMO])) break; if (sp > XB_SPIN_CAP) { atomicAdd(&bar[XB_TMO], 1u); break; } }
    }
    nloc = mine > 0u ? mine : 1u; nx = cnt > 0u ? cnt : 1u;
}
__device__ __forceinline__ void xcd_barrier(const XcdBarrier& b) {
    asm volatile("s_waitcnt vmcnt(0)" ::: "memory");
    __syncthreads();
    if (threadIdx.x == 0) {
        unsigned* bar = b.bar;
        __builtin_amdgcn_s_waitcnt(0);
        unsigned nloc = b.st[0], nx = b.st[1];
        if (nloc == 0u) { xcd_barrier_complete(bar, b.x, nloc, nx); b.st[0] = nloc; b.st[1] = nx; }
        const unsigned old = xb_add(&bar[XB_XSUB(b.x)], 1u);
        const unsigned gen = old / nloc;
        if (old + 1u == (gen + 1u) * nloc) {
            __builtin_amdgcn_fence(__ATOMIC_RELEASE, "agent");
            asm volatile("s_waitcnt vmcnt(0)" ::: "memory");
            const unsigned og = xb_add(&bar[XB_TOP], 1u);
            const unsigned tg = og / nx;
            if (og + 1u == (tg + 1u) * nx) xb_add(&bar[XB_TOPGEN], 1u);
            else XB_SPIN(xb_ld(&bar[XB_TOPGEN]) == tg, bar);
            __builtin_amdgcn_fence(__ATOMIC_ACQUIRE, "agent");
            xb_add(&bar[XB_XGEN(b.x)], 1u);
            asm volatile("s_waitcnt vmcnt(0)" ::: "memory");
        } else {
            XB_SPIN(xb_ld(&bar[XB_XGEN(b.x)]) == gen, bar);
            __builtin_amdgcn_fence(__ATOMIC_ACQUIRE, "agent");
            asm volatile("s_waitcnt vmcnt(0)" ::: "memory");
        }
    }
    __syncthreads();
}

struct KArgs { const float* in[22]; float* out; unsigned char* ws; int ph_lo, ph_hi; };
enum { I_X = 0, I_C, I_CTX, I_CCTX, I_ADAW, I_ADAB, I_NMPRE, I_NMPOST, I_NFPRE, I_NFPOST, I_HWIN, I_HLB, I_HONORM, I_HWOUT, I_AQKV, I_AQN, I_AKN, I_AWOUT, I_FWIN, I_FCW, I_FCB, I_FWOUT };
constexpr int N_PHASES = 20;

__global__ void __launch_bounds__(512, 2) mega_fwd(KArgs a) {
    extern __shared__ __attribute__((aligned(16))) unsigned char lds_raw[];
    LAS unsigned char* lds = (LAS unsigned char*)lds_raw;
    cg::grid_group grid = cg::this_grid();
    const int tid = threadIdx.x, lane = tid & 63, wave = __builtin_amdgcn_readfirstlane(tid >> 6);
    const int G = gridDim.x, wg = blockIdx.x;
    const int gw = wg * 8 + wave, NGW = G * 8;
    unsigned char* ws = a.ws;
    float* mod = (float*)(ws + WS_MOD);
    float* xctx = (float*)(ws + WS_XCTX);
    bf16_t* H = (bf16_t*)(ws + WS_H);
    bf16_t* BIG = (bf16_t*)(ws + WS_BIG);
    bf16_t* Y = (bf16_t*)(ws + WS_BIG);
    bf16_t* XR = (bf16_t*)(ws + WS_BIG + 256 * MiB);
    float* BND = (float*)(ws + WS_BIG + 200 * MiB);
    float* YS = (float*)(ws + WS_BIG + 132 * MiB);
    bf16_t* ACT = (bf16_t*)(ws + WS_ACT);
    bf16_t* OFW = ACT; bf16_t* OBW = ACT + (size_t)MR * DM;
    const int lo = a.ph_lo, hi = a.ph_hi;
#ifndef MK_REPMASK
#define MK_REPMASK 0u
#endif
#define PH(k) if (lo <= (k) && (k) < hi) for (int rep_ = 0; rep_ <= (int)((MK_REPMASK >> (k)) & 1u); ++rep_)
#define SEAM(k) do { if ((k) + 1 < hi) { if ((k) == 0) { asm volatile("s_waitcnt vmcnt(0) lgkmcnt(0)" ::: "memory"); grid.sync(); } else xcd_barrier(bar); } } while (0)
    LAS float* scr = (LAS float*)(lds + wave * 16384);
    volatile LAS unsigned* MISC = (volatile LAS unsigned*)(lds + LDS_BYTES - 256);
    if (tid < 16) MISC[tid] = 0u;
    __syncthreads();
    XcdBarrier bar = xcd_barrier_post((unsigned*)ws, MISC);

    PH(0) {
        ada_phase(a.in[I_C], a.in[I_CCTX], a.in[I_ADAW], a.in[I_ADAB], mod, lds, wg, G, tid);
        constexpr int I0 = 32 * (NHG / 32), I1 = 32 * (DM / 32), I2 = 32 * (2 * DFF / 32), I3 = (DFF / 64) * (DM / 32);
        for (int it = gw; it < I0 + I1 + I2 + I3; it += NGW) {
            int r = it;
            if (r < I0) { transpose_item(a.in[I_HWIN], DM, NHG, (bf16_t*)(ws + W_HIN), scr, r, lane); continue; } r -= I0;
            if (r < I1) { transpose_item(a.in[I_HWOUT], DM, DM, (bf16_t*)(ws + W_HOUT), scr, r, lane); continue; } r -= I1;
            if (r < I2) { transpose_item(a.in[I_FWIN], DM, 2 * DFF, (bf16_t*)(ws + W_FIN), scr, r, lane, true); continue; } r -= I2;
            transpose_item(a.in[I_FWOUT], DFF, DM, (bf16_t*)(ws + W_FOUT), scr, r, lane);
        }
        SEAM(0);
    }
    PH(1) {
        row_phase<false, false>(a.in[I_X], a.in[I_CTX], nullptr, nullptr, XR, nullptr, nullptr, a.in[I_NMPRE], mod, 0, 0, 1, H, false, true, false, gw, NGW, lane);
        SEAM(1);
    }
    PH(2) {
        pg8::Gemm g{H, (const bf16_t*)(ws + W_HIN), MR, NHG, DM}; pg8::Order S; S.init(MR / 256, NHG, DM, G, wg, 0, 0);
        pg8::EpiBf16 E{BIG, NHG};
        pg8::gemm_phase<pg8::EpiBf16, pg8::Order, true, true>(lds, g, S, E);
        SEAM(2);
    }
    PH(3) {
        float* EB = (float*)(ACT + (size_t)2 * MR * DM);
        if (rep_ == 0) gla_prep_phase(BIG, H, EB, a.in[I_HLB], lds, wg, G, tid);
        xcd_barrier(bar);
        for (int item = wg; item < 256; item += G) {
            const int xq = item & 7, yq = item >> 3, vs = yq & 3, sq = xq + 8 * (yq >> 2);
            const int dir = sq & 1, h = (sq >> 1) & 15, b = sq >> 5;
            gla_item(BIG, dir ? H : BIG, dir ? DM : NHG, EB, dir ? OBW : OFW, lds, b, h, dir, vs, tid);
        }
        SEAM(3);
    }
    PH(4) {
        readout_phase(OFW, OBW, BIG, a.in[I_HONORM], H, gw, NGW, lane);
        SEAM(4);
    }
    PH(5) {
        pg8::Gemm g{H, (const bf16_t*)(ws + W_HOUT), MR, DM, DM}; pg8::Order S; S.init(64, DM, DM, G, wg, 1, 16);
        pg8::EpiF32 E{Y, DM, YS, DM / 64};
        pg8::gemm_phase<pg8::EpiF32, pg8::Order, true, true>(lds, g, S, E);
        SEAM(5);
    }
    PH(6) {
        row_phase<false, true>(a.in[I_X], a.in[I_CTX], a.out, xctx, XR, Y, a.in[I_NMPOST], a.in[I_NFPRE], mod, 2, 3, 4, H, true, true, false, gw, NGW, lane, YS, 16);
        SEAM(6);
    }
    PH(7) {
        pg8::Gemm g{H, (const bf16_t*)(ws + W_FIN), MR, 2 * DFF, DM}; pg8::Order S; S.init(MR / 256, 2 * DFF, DM, G, wg, 0, 0);
        pg8::EpiConv E{ACT, a.in[I_FCW], a.in[I_FCB], BND, (LAS float*)(lds + 131072)};
        pg8::gemm_phase<pg8::EpiConv, pg8::Order, true, true>(lds, g, S, E);
        SEAM(7);
    }
    PH(8) {
        conv_fix_phase(BND, a.in[I_FCW], a.in[I_FCB], ACT, false, gw, NGW, lane);
        SEAM(8);
    }
    PH(9) {
        pg8::Gemm g{ACT, (const bf16_t*)(ws + W_FOUT), MR, DM, DFF}; pg8::Order S; S.init(64, DM, DFF, G, wg, 1, 11);
        pg8::EpiF32 E{Y, DM, YS, DFF / 64};
        pg8::gemm_phase<pg8::EpiF32, pg8::Order, true, true>(lds, g, S, E);
        SEAM(9);
    }
    PH(10) {
        row_phase<true, true>(a.out, xctx, a.out, xctx, XR, Y, a.in[I_NFPOST], a.in[I_NMPRE] + DM, mod, 5, 6 * 3 + 0, 6 * 3 + 1, H, true, true, false, gw, NGW, lane, YS, 11);
        __syncthreads();
        constexpr int I0 = 32 * (NQKV / 32), I1 = 32 * (DM / 32), I2 = 32 * (2 * DFF / 32), I3 = (DFF / 64) * (DM / 32);
        for (int it = gw; it < I0 + I1 + I2 + I3; it += NGW) {
            int r = it;
            if (r < I0) { transpose_item(a.in[I_AQKV], DM, NQKV, (bf16_t*)(ws + W_QKV), scr, r, lane); continue; } r -= I0;
            if (r < I1) { transpose_item(a.in[I_AWOUT], DM, DM, (bf16_t*)(ws + W_AOUT), scr, r, lane); continue; } r -= I1;
            if (r < I2) { transpose_item(a.in[I_FWIN] + (size_t)DM * 2 * DFF, DM, 2 * DFF, (bf16_t*)(ws + W_FIN), scr, r, lane, true); continue; } r -= I2;
            transpose_item(a.in[I_FWOUT] + (size_t)DFF * DM, DFF, DM, (bf16_t*)(ws + W_FOUT), scr, r, lane);
        }
        SEAM(10);
    }
    PH(11) {
        pg8::Gemm g{H, (const bf16_t*)(ws + W_QKV), MR, NQKV, DM}; pg8::Order S; S.init(MR / 256, NQKV, DM, G, wg, 0, 0);
        pg8::EpiBf16 E{BIG, NQKV};
        pg8::gemm_phase<pg8::EpiBf16, pg8::Order, true, true>(lds, g, S, E);
        SEAM(11);
    }
    PH(12) {
        qknorm_phase(BIG, a.in[I_AQN], a.in[I_AKN], gw, NGW, lane);
        SEAM(12);
    }
    PH(13) {
        for (int u = wg; u < 1024; u += G) {
            const int x = u & 7, rest = u >> 3, j = rest & 31, i = rest >> 5;
            const int b = x >> 2, kvh = x & 3, h = kvh * 4 + i;
            const size_t qrow = (size_t)b * SB + CTX + (size_t)j * 256;
            att::attn_dense_body(BIG + qrow * NQKV + h * 128, BIG + (size_t)b * SB * NQKV + 2048 + kvh * 128, BIG + (size_t)b * SB * NQKV + 2560 + kvh * 128,
                                 ACT + qrow * DM + h * 128, SB, (char*)lds_raw);
        }
        SEAM(13);
    }
    PH(14) {
        pg8::Gemm g{ACT, (const bf16_t*)(ws + W_AOUT), MR, DM, DM}; pg8::Order S; S.init(64, DM, DM, G, wg, 1, 0);
        pg8::EpiF32 E{Y, DM, nullptr, 0};
        pg8::gemm_phase<pg8::EpiF32, pg8::Order, true, true>(lds, g, S, E);
        SEAM(14);
    }
    PH(15) {
        row_phase<true, true>(a.out, xctx, a.out, xctx, XR, Y, a.in[I_NMPOST] + DM, a.in[I_NFPRE] + DM, mod + 3 * 12288, 2, 3, 4, H, true, true, true, gw, NGW, lane);
        SEAM(15);
    }
    PH(16) {
        pg8::Gemm g{H, (const bf16_t*)(ws + W_FIN), MR, 2 * DFF, DM}; pg8::Order S; S.init(64, 2 * DFF, DM, G, wg, 1, 0);
        pg8::EpiConv E{ACT, a.in[I_FCW] + 3 * DFF, a.in[I_FCB] + DFF, BND, (LAS float*)(lds + 131072)};
        pg8::gemm_phase<pg8::EpiConv, pg8::Order, true, true>(lds, g, S, E);
        SEAM(16);
    }
    PH(17) {
        conv_fix_phase(BND, a.in[I_FCW] + 3 * DFF, a.in[I_FCB] + DFF, ACT, true, gw, NGW, lane);
        SEAM(17);
    }
    PH(18) {
        pg8::Gemm g{ACT, (const bf16_t*)(ws + W_FOUT), MR, DM, DFF}; pg8::Order S; S.init(64, DM, DFF, G, wg, 1, 0);
        pg8::EpiF32 E{Y, DM, nullptr, 0};
        pg8::gemm_phase<pg8::EpiF32, pg8::Order, true, true>(lds, g, S, E);
        SEAM(18);
    }
    PH(19) {
        row_phase<true, false>(a.out, xctx, a.out, xctx, XR, Y, a.in[I_NFPOST] + DM, nullptr, mod + 3 * 12288, 5, 0, 0, H, true, false, true, gw, NGW, lane);
    }
#undef PH
#undef SEAM
}


extern "C" void kernel_launch(void* const* d_in, const int* in_sizes, int n_in, void* d_out, int out_size, void* d_ws, size_t ws_size, hipStream_t stream) {
    static int grid = 0;
    if (grid == 0) {
        if (n_in != 22 || ws_size < WS_END || out_size != NB * SEQ * DM) { fprintf(stderr, "kernel_launch: unexpected shapes n_in %d ws %zu out %d\n", n_in, ws_size, out_size); grid = -1; return; }
        int dev = 0, cus = 0, per_cu = 0;
        if (hipGetDevice(&dev) != hipSuccess || hipDeviceGetAttribute(&cus, hipDeviceAttributeMultiprocessorCount, dev) != hipSuccess) { grid = -1; return; }
        if (hipFuncSetAttribute((const void*)mega_fwd, hipFuncAttributeMaxDynamicSharedMemorySize, LDS_BYTES) != hipSuccess) { fprintf(stderr, "kernel_launch: hipFuncSetAttribute failed\n"); grid = -1; return; }
        if (hipOccupancyMaxActiveBlocksPerMultiprocessor(&per_cu, (const void*)mega_fwd, 512, LDS_BYTES) != hipSuccess || per_cu < 1) { fprintf(stderr, "kernel_launch: occupancy query says %d\n", per_cu); per_cu = 1; }
        (void)hipGetLastError();
        grid = cus * 1;
    }
    if (grid < 0) return;
    KArgs a{};
    for (int i = 0; i < 22; ++i) a.in[i] = (const float*)d_in[i];
    a.out = (float*)d_out; a.ws = (unsigned char*)d_ws;
    a.ph_lo = 0; a.ph_hi = N_PHASES;
    if (hipMemsetAsync(d_ws, 0, 16384, stream) != hipSuccess) { fprintf(stderr, "kernel_launch: memset failed\n"); return; }
    void* args[] = {&a};
    hipError_t e = hipLaunchCooperativeKernel((const void*)mega_fwd, dim3(grid), dim3(512), args, LDS_BYTES, stream);
    if (e != hipSuccess) fprintf(stderr, "cooperative launch failed: %s (grid %d)\n", hipGetErrorString(e), grid);
}
```

```cpp
#include <hip/hip_runtime.h>
#include <hip/hip_cooperative_groups.h>
#include <cstdio>
#include <cstdint>
namespace cg = cooperative_groups;

#define LAS __attribute__((address_space(3)))
typedef unsigned short bf16_t;
typedef short bf16x8 __attribute__((ext_vector_type(8)));
typedef float f32x4 __attribute__((ext_vector_type(4)));
typedef float f32x2 __attribute__((ext_vector_type(2)));
typedef float f32x16 __attribute__((ext_vector_type(16)));
typedef unsigned u32x4 __attribute__((ext_vector_type(4)));
typedef unsigned u32x2 __attribute__((ext_vector_type(2)));
typedef short s16x4 __attribute__((ext_vector_type(4)));

constexpr int DM = 2048, NB = 2, SEQ = 8192, CTX = 256, SB = SEQ + CTX, MR = NB * SB;
constexpr int NH = 16, HD = 128, NKV = 4, DFF = 5632, NQKV = 3072, NHG = 5 * DM;
constexpr float EPS = 1e-6f;

constexpr size_t MiB = 1u << 20;
constexpr size_t WS_MOD = 64 * 1024;
constexpr size_t WS_XCTX = 2 * MiB;
constexpr size_t WS_W = 6 * MiB;
constexpr size_t W_HIN = WS_W, W_HOUT = WS_W + 40 * MiB, W_FIN = WS_W + 48 * MiB, W_FOUT = WS_W + 92 * MiB;
constexpr size_t W_QKV = WS_W, W_AOUT = WS_W + 12 * MiB;
constexpr size_t WS_H = 120 * MiB;
constexpr size_t WS_BIG = 186 * MiB;
constexpr size_t WS_ACT = 549 * MiB;
constexpr size_t WS_END = WS_ACT + (size_t)MR * DFF * 2;
static_assert(WS_END <= 768 * MiB, "ws");

constexpr int LDS_BYTES = 147456;

typedef __bf16 bf16x2_t __attribute__((ext_vector_type(2)));
__device__ __forceinline__ unsigned cvt_pk_bf16(float lo, float hi) { f32x2 v = {lo, hi}; bf16x2_t b = __builtin_convertvector(v, bf16x2_t); return __builtin_bit_cast(unsigned, b); }
__device__ __forceinline__ unsigned f2bf(float f) { unsigned u = __builtin_bit_cast(unsigned, f); return (u + 0x7fffu + ((u >> 16) & 1u)) >> 16; }
__device__ __forceinline__ unsigned pk2(float lo, float hi) { return f2bf(lo) | (f2bf(hi) << 16); }
__device__ __forceinline__ float bflo(unsigned u) { return __builtin_bit_cast(float, u << 16); }
__device__ __forceinline__ float bfhi(unsigned u) { return __builtin_bit_cast(float, u & 0xffff0000u); }
__device__ __forceinline__ float wave_sum(float v) {
#pragma unroll
    for (int o = 1; o < 64; o <<= 1) v += __shfl_xor(v, o);
    return v;
}
__device__ __forceinline__ float siluf(float v) { return v / (1.f + __expf(-v)); }
#define LBAR() do { asm volatile("s_waitcnt lgkmcnt(0)" ::: "memory"); __builtin_amdgcn_s_barrier(); asm volatile("" ::: "memory"); } while (0)

namespace pg8 {
constexpr int BM = 256, BK = 64, HALF = 128, HTB = HALF * BK * 2, STAGE_BYTES = 8 * HTB, NXCD = 8, WGM = 4;
__host__ __device__ __forceinline__ int lds_byte(int r, int c) { const int st = (r >> 4) * 2 + (c >> 5), rr = r & 15, cc = c & 31, ob = rr * 64 + cc * 2; return st * 1024 + (ob ^ (((ob >> 9) & 1) << 5)); }
__host__ __device__ __forceinline__ void stage_rc(int b, int& R, int& C) { const int st = b / 1024, sb = b % 1024, swz = sb ^ (((sb >> 9) & 1) << 5); R = (st >> 1) * 16 + swz / 64; C = (st & 1) * 32 + (swz % 64) / 2; }
__host__ __device__ __forceinline__ int perm32(int rho) { const int n = rho >> 4, i = rho & 15; return 8 * (i >> 2) + 4 * n + (i & 3); }

struct Unit { int pm, pn, kn; };
struct Gemm { const bf16_t* A; const bf16_t* Bt; int M, N, K; };

struct Order {
    int nM, nN, nwg, G, c, skip, ntf, nsplit;
    __device__ void init(int nM_, int N, int K, int G_, int c_, int skip_, int nsplit_) { nM = nM_; nN = N / BM; nwg = nM * nN; G = G_; c = c_; skip = skip_; ntf = K / BK; nsplit = nsplit_; }
    __device__ bool next(int i, Unit& u) const {
        const long L = (long)i * G + c;
        if (L >= nwg) {
            const int j = (int)(L - nwg); if (j >= 2 * nN * nsplit) return false;
            const int sidx = j % nsplit, cu = j / nsplit, cr = cu / nN;
            const int ntu = ntf / nsplit; u.pm = cr ? 33 : 0; u.pn = cu % nN; u.kn = (sidx * ntu) | (ntu << 16); return true;
        }
        int wgid = (int)L; { const int q = nwg / NXCD, r = nwg % NXCD, xcd = wgid % NXCD, off = wgid / NXCD; wgid = (xcd < r ? xcd * (q + 1) : r * (q + 1) + (xcd - r) * q) + off; }
        const int nig = WGM * nN, gid = wgid / nig, fm = gid * WGM, gsz = (nM - fm) < WGM ? (nM - fm) : WGM;
        int pm = fm + ((wgid % nig) % gsz); u.pn = (wgid % nig) / gsz;
        if (skip) pm = pm + 1 + (pm >= 32 ? 1 : 0);
        u.pm = pm; u.kn = ntf << 16; return true;
    }
    __device__ __forceinline__ void a_ready(const Unit&) const {}
    __device__ __forceinline__ void done(const Unit&) const {}
};

struct EpiBf16 {
    static constexpr bool PERM = true, AFTER_DRAIN = false;
    bf16_t* O; int ldc;
    __device__ __forceinline__ void operator()(const f32x4 (&acc)[2][2][4][2], const Unit& u, int wr, int wc, int fr, int fq) const {
        const int row0 = u.pm * BM + wr * 64 + fr; const int col0 = u.pn * BM + wc * 32 + 8 * fq;
#pragma unroll
        for (int ai = 0; ai < 2; ++ai)
#pragma unroll
            for (int m = 0; m < 4; ++m) { bf16_t* rowp = O + (size_t)(row0 + ai * HALF + m * 16) * ldc + col0;
#pragma unroll
                for (int bj = 0; bj < 2; ++bj) { const f32x4 v0 = acc[ai][bj][m][0], v1 = acc[ai][bj][m][1];
                    u32x4 w; w.x = cvt_pk_bf16(v0[0], v0[1]); w.y = cvt_pk_bf16(v0[2], v0[3]); w.z = cvt_pk_bf16(v1[0], v1[1]); w.w = cvt_pk_bf16(v1[2], v1[3]);
                    *(u32x4*)(rowp + bj * HALF) = w; } }
    }
};
struct EpiF32 {
    static constexpr bool PERM = true, AFTER_DRAIN = false;
    bf16_t* O; int ldc; float* SL; int ntf;
    __device__ __forceinline__ void operator()(const f32x4 (&acc)[2][2][4][2], const Unit& u, int wr, int wc, int fr, int fq) const {
        const int ntu = u.kn >> 16, kt0 = u.kn & 0xffff;
        const int row0 = wr * 64 + fr; const int col0 = u.pn * BM + wc * 32 + 8 * fq;
        if (ntu < ntf) {
            float* basep = SL + ((size_t)(kt0 / ntu) * 512 + (u.pm == 33 ? 256 : 0)) * ldc;
#pragma unroll
            for (int ai = 0; ai < 2; ++ai)
#pragma unroll
                for (int m = 0; m < 4; ++m) { float* rowp = basep + (size_t)(row0 + ai * HALF + m * 16) * ldc + col0;
#pragma unroll
                    for (int bj = 0; bj < 2; ++bj) { *(f32x4*)(rowp + bj * HALF) = acc[ai][bj][m][0]; *(f32x4*)(rowp + bj * HALF + 4) = acc[ai][bj][m][1]; } }
        } else {
            bf16_t* basep = O + (size_t)u.pm * BM * ldc;
#pragma unroll
            for (int ai = 0; ai < 2; ++ai)
#pragma unroll
                for (int m = 0; m < 4; ++m) { bf16_t* rowp = basep + (size_t)(row0 + ai * HALF + m * 16) * ldc + col0;
#pragma unroll
                    for (int bj = 0; bj < 2; ++bj) { const f32x4 v0 = acc[ai][bj][m][0], v1 = acc[ai][bj][m][1];
                        u32x4 w; w.x = cvt_pk_bf16(v0[0], v0[1]); w.y = cvt_pk_bf16(v0[2], v0[3]); w.z = cvt_pk_bf16(v1[0], v1[1]); w.w = cvt_pk_bf16(v1[2], v1[3]);
                        *(u32x4*)(rowp + bj * HALF) = w; } }
        }
    }
};

template <int CTRL> __device__ __forceinline__ float dpp_upd(float oldv, float src) {
    return __builtin_bit_cast(float, __builtin_amdgcn_update_dpp(__builtin_bit_cast(int, oldv), __builtin_bit_cast(int, src), CTRL, 0xf, 0xf, false)); }
template <int M> __device__ __forceinline__ float conv_elem(float gp, float gc, float gn, float up, float hp, float hn, float w0, float w1, float w2, float cb) {
    const float X = (M == 0) ? hp : dpp_upd<0x121>(0.f, gp);
    const float prev = dpp_upd<0x111>(X, gc);
    const float Yv = (M == 3) ? hn : dpp_upd<0x12F>(0.f, gn);
    const float next = dpp_upd<0x101>(Yv, gc);
    const float y = w0 * prev + w1 * gc + w2 * next + cb;
    return y * __builtin_amdgcn_rcpf(1.f + __builtin_amdgcn_exp2f(y * -1.4426950408889634f)) * up;
}
template <int M> __device__ __forceinline__ f32x4 conv_group(const f32x4 GP, const f32x4 GC, const f32x4 GN, const f32x4 up, const f32x4 hp, const f32x4 hn, const f32x4 w0, const f32x4 w1, const f32x4 w2, const f32x4 cb) {
    f32x4 r;
    r.x = conv_elem<M>(GP.x, GC.x, GN.x, up.x, hp.x, hn.x, w0.x, w1.x, w2.x, cb.x);
    r.y = conv_elem<M>(GP.y, GC.y, GN.y, up.y, hp.y, hn.y, w0.y, w1.y, w2.y, cb.y);
    r.z = conv_elem<M>(GP.z, GC.z, GN.z, up.z, hp.z, hn.z, w0.z, w1.z, w2.z, cb.z);
    r.w = conv_elem<M>(GP.w, GC.w, GN.w, up.w, hp.w, hn.w, w0.w, w1.w, w2.w, cb.w);
    return r;
}
struct EpiConv {
    static constexpr bool PERM = true, AFTER_DRAIN = false;
    bf16_t* ACT; const float* cw; const float* cbias; float* BND; LAS float* xch;
    __device__ __forceinline__ void operator()(const f32x4 (&acc)[2][2][4][2], const Unit& u, int wr_, int wc_, int fr_, int fq_) const {
        int wr = wr_, wc = wc_, fr = fr_, fq = fq_;
        asm volatile("" : "+v"(fr), "+v"(fq), "+s"(wr), "+s"(wc));
        const int cl = wc * 32 + 8 * fq, f0 = u.pn * 128 + cl;
#pragma unroll
        for (int ai = 0; ai < 2; ++ai) { const int blk = 2 * ai + wr;
            if (fr == 0) { *(LAS f32x4*)(xch + (blk * 2 + 0) * 128 + cl) = acc[ai][0][0][0]; *(LAS f32x4*)(xch + (blk * 2 + 0) * 128 + cl + 4) = acc[ai][0][0][1]; }
            if (fr == 15) { *(LAS f32x4*)(xch + (blk * 2 + 1) * 128 + cl) = acc[ai][0][3][0]; *(LAS f32x4*)(xch + (blk * 2 + 1) * 128 + cl + 4) = acc[ai][0][3][1]; } }
        { float* bnd = BND + (size_t)u.pm * 6 * DFF + f0;
          if (wr == 0 && fr < 2) { *(f32x4*)(bnd + fr * DFF) = acc[0][0][0][0]; *(f32x4*)(bnd + fr * DFF + 4) = acc[0][0][0][1]; }
          asm volatile("" ::: "memory");
          if (wr == 0 && fr == 0) { *(f32x4*)(bnd + 4 * DFF) = acc[0][1][0][0]; *(f32x4*)(bnd + 4 * DFF + 4) = acc[0][1][0][1]; }
          asm volatile("" ::: "memory");
          if (wr == 1 && fr >= 14) { *(f32x4*)(bnd + (fr - 12) * DFF) = acc[1][0][3][0]; *(f32x4*)(bnd + (fr - 12) * DFF + 4) = acc[1][0][3][1]; }
          asm volatile("" ::: "memory");
          if (wr == 1 && fr == 15) { *(f32x4*)(bnd + 5 * DFF) = acc[1][1][3][0]; *(f32x4*)(bnd + 5 * DFF + 4) = acc[1][1][3][1]; }
        }
        LBAR(); __builtin_amdgcn_sched_barrier(0);
        const f32x4 w00 = *(const f32x4*)(cw + f0), w01 = *(const f32x4*)(cw + f0 + 4), w10 = *(const f32x4*)(cw + DFF + f0), w11 = *(const f32x4*)(cw + DFF + f0 + 4);
        const f32x4 w20 = *(const f32x4*)(cw + 2 * DFF + f0), w21 = *(const f32x4*)(cw + 2 * DFF + f0 + 4), cb0 = *(const f32x4*)(cbias + f0), cb1 = *(const f32x4*)(cbias + f0 + 4);
#pragma unroll
        for (int ai = 0; ai < 2; ++ai) { const int blk = 2 * ai + wr;
            f32x4 hp0 = {0.f, 0.f, 0.f, 0.f}, hp1 = hp0, hn0 = hp0, hn1 = hp0;
            if (blk > 0) { hp0 = *(const LAS f32x4*)(xch + ((blk - 1) * 2 + 1) * 128 + cl); hp1 = *(const LAS f32x4*)(xch + ((blk - 1) * 2 + 1) * 128 + cl + 4); }
            if (blk < 3) { hn0 = *(const LAS f32x4*)(xch + ((blk + 1) * 2 + 0) * 128 + cl); hn1 = *(const LAS f32x4*)(xch + ((blk + 1) * 2 + 0) * 128 + cl + 4); }
#define CONV_ROW(M, MP, MN) do { __builtin_amdgcn_sched_barrier(0); \
            const f32x4 v0 = conv_group<M>(acc[ai][0][MP][0], acc[ai][0][M][0], acc[ai][0][MN][0], acc[ai][1][M][0], hp0, hn0, w00, w10, w20, cb0); \
            const f32x4 v1 = conv_group<M>(acc[ai][0][MP][1], acc[ai][0][M][1], acc[ai][0][MN][1], acc[ai][1][M][1], hp1, hn1, w01, w11, w21, cb1); \
            const int rl = ai * HALF + wr * 64 + M * 16 + fr; \
            if (rl != 0 && rl != 255) { u32x4 w; w.x = cvt_pk_bf16(v0[0], v0[1]); w.y = cvt_pk_bf16(v0[2], v0[3]); w.z = cvt_pk_bf16(v1[0], v1[1]); w.w = cvt_pk_bf16(v1[2], v1[3]); \
                *(u32x4*)(ACT + (size_t)(u.pm * BM + rl) * DFF + f0) = w; } } while (0)
            CONV_ROW(0, 0, 1); CONV_ROW(1, 0, 2); CONV_ROW(2, 1, 3); CONV_ROW(3, 2, 3);
#undef CONV_ROW
            __builtin_amdgcn_sched_barrier(0);
        }
    }
};

template <class Epi, class Sched, bool ALIGN_EPI = false, bool SP2 = false>
__device__ __forceinline__ void gemm_phase(LAS unsigned char* lds, const Gemm g, const Sched& S, const Epi& E) {
    const int tid = threadIdx.x, wid = __builtin_amdgcn_readfirstlane(tid >> 6), lane = tid & 63, wr = wid >> 2, wc = wid & 3, fr = lane & 15, fq = lane >> 4;
    const int K = g.K;
    unsigned voffA[2], voffB[2];
#pragma unroll
    for (int i = 0; i < 2; ++i) { int R, C; stage_rc(tid * 16 + i * 8192, R, C); const int Rb = Epi::PERM ? ((R & ~31) + perm32(R & 31)) : R;
        voffA[i] = (unsigned)(R * K + C) * 2u; voffB[i] = (unsigned)(Rb * K + C) * 2u; }
    const size_t kstep = (size_t)(BK * 2);
    const size_t hstep = (size_t)HALF * K * 2;
    const size_t tstep = 2 * hstep;
    const unsigned ldsw = (unsigned)wid * 1024u;
    const int aoff = lds_byte(wr * 64 + fr, fq * 8), boff = lds_byte(wc * 32 + fr, fq * 8);
#define PG8_SA(b, h) (((b) * 2 + (h)) * HTB)
#define PG8_SB(b, h) ((4 + (b) * 2 + (h)) * HTB)
#define PG8_STAGE(bufoff, gbase, voff) do { _Pragma("unroll") for (int _i = 0; _i < 2; ++_i) \
        __builtin_amdgcn_global_load_lds((const unsigned*)((const char*)(gbase) + (voff)[_i]), (LAS unsigned*)(lds + (bufoff) + ldsw + _i * 8192), 16, 0, 0); } while (0)
#define PG8_LDA(dst, b, h) do { _Pragma("unroll") for (int m = 0; m < 4; ++m) _Pragma("unroll") for (int k = 0; k < 2; ++k) dst[m][k] = *(const LAS bf16x8*)(lds + PG8_SA(b, h) + aoff + m * 2048 + k * 1024); } while (0)
#define PG8_LDB(dst, b, h) do { _Pragma("unroll") for (int n = 0; n < 2; ++n) _Pragma("unroll") for (int k = 0; k < 2; ++k) dst[n][k] = *(const LAS bf16x8*)(lds + PG8_SB(b, h) + boff + n * 2048 + k * 1024); } while (0)
#define PG8_MMA(ai, bj, At, Bt) do { __builtin_amdgcn_s_setprio(1); _Pragma("unroll") for (int m = 0; m < 4; ++m) _Pragma("unroll") for (int n = 0; n < 2; ++n) _Pragma("unroll") for (int k = 0; k < 2; ++k) \
        acc[ai][bj][m][n] = __builtin_amdgcn_mfma_f32_16x16x32_bf16(Bt[n][k], At[m][k], acc[ai][bj][m][n], 0, 0, 0); __builtin_amdgcn_s_setprio(0); } while (0)
#define PG8_WAIT_V(n) asm volatile("s_waitcnt vmcnt(" #n ")" ::: "memory")
#define PG8_WAIT_L(n) asm volatile("s_waitcnt lgkmcnt(" #n ")" ::: "memory")
#define PG8_BAR __builtin_amdgcn_s_barrier()
#define PG8_SCHED __builtin_amdgcn_sched_barrier(0)
    Unit cur, nxt; int ui = 0;
    if (!S.next(0, cur)) return;
    f32x4 acc[2][2][4][2];
#pragma unroll
    for (int a = 0; a < 2; ++a)
#pragma unroll
        for (int b = 0; b < 2; ++b)
#pragma unroll
            for (int m = 0; m < 4; ++m)
#pragma unroll
                for (int n = 0; n < 2; ++n) acc[a][b][m][n] = (f32x4){0.f, 0.f, 0.f, 0.f};
    bf16x8 At[4][2], B0[2][2], B1[2][2];
    const char* cA = (const char*)g.A + (size_t)cur.pm * tstep + (size_t)(cur.kn & 0xffff) * kstep; const char* cB = (const char*)g.Bt + (size_t)cur.pn * tstep + (size_t)(cur.kn & 0xffff) * kstep;
    S.a_ready(cur);
    if constexpr (SP2) {
        PG8_STAGE(PG8_SB(0, 0), cB, voffB); PG8_STAGE(PG8_SB(0, 1), cB + hstep, voffB); PG8_STAGE(PG8_SA(0, 0), cA, voffA); PG8_STAGE(PG8_SA(0, 1), cA + hstep, voffA);
        if (wr == 1) PG8_BAR;
        PG8_WAIT_V(2); PG8_BAR;
        PG8_STAGE(PG8_SB(1, 0), cB + kstep, voffB); PG8_STAGE(PG8_SA(1, 0), cA + kstep, voffA); PG8_STAGE(PG8_SB(1, 1), cB + hstep + kstep, voffB);
        PG8_WAIT_V(6); PG8_BAR;
    } else {
        PG8_STAGE(PG8_SB(0, 0), cB, voffB); PG8_STAGE(PG8_SA(0, 0), cA, voffA); PG8_STAGE(PG8_SB(0, 1), cB + hstep, voffB); PG8_STAGE(PG8_SA(0, 1), cA + hstep, voffA);
        if (wr == 1) PG8_BAR;
        PG8_WAIT_V(4); PG8_BAR;
        PG8_STAGE(PG8_SB(1, 0), cB + kstep, voffB); PG8_STAGE(PG8_SA(1, 0), cA + kstep, voffA); PG8_STAGE(PG8_SB(1, 1), cB + hstep + kstep, voffB);
        PG8_WAIT_V(6); PG8_BAR;
    }
    for (;;) {
        const bool has_next = S.next(ui + 1, nxt);
        const char* nA = has_next ? (const char*)g.A + (size_t)nxt.pm * tstep + (size_t)(nxt.kn & 0xffff) * kstep : cA; const char* nB = has_next ? (const char*)g.Bt + (size_t)nxt.pn * tstep + (size_t)(nxt.kn & 0xffff) * kstep : cB;
        const int nt = cur.kn >> 16;
        for (int t = 0; t < nt; t += 2) {
            const bool last = (t == nt - 2);
            const char* a1 = cA + (size_t)(t + 1) * kstep;
            const char* a2 = last ? nA : cA + (size_t)(t + 2) * kstep; const char* b2 = last ? nB : cB + (size_t)(t + 2) * kstep;
            const char* a3 = a2 + kstep; const char* b3 = b2 + kstep;
            if (last && has_next) S.a_ready(nxt);
            if constexpr (SP2) {
            PG8_LDB(B0, 0, 0); PG8_LDB(B1, 0, 1); PG8_SCHED; PG8_LDA(At, 0, 0); PG8_STAGE(PG8_SA(1, 1), a1 + hstep, voffA);
            PG8_WAIT_V(8); PG8_WAIT_L(0); PG8_BAR; PG8_MMA(0, 0, At, B0); PG8_MMA(0, 1, At, B1); PG8_BAR; PG8_SCHED;
            PG8_LDA(At, 0, 1); PG8_STAGE(PG8_SB(0, 0), b2, voffB); PG8_STAGE(PG8_SB(0, 1), b2 + hstep, voffB); PG8_STAGE(PG8_SA(0, 0), a2, voffA);
            PG8_WAIT_V(8); PG8_WAIT_L(0); PG8_BAR; PG8_MMA(1, 0, At, B0); PG8_MMA(1, 1, At, B1); PG8_BAR; PG8_SCHED;
            PG8_LDB(B0, 1, 0); PG8_LDB(B1, 1, 1); PG8_SCHED; PG8_LDA(At, 1, 0); PG8_STAGE(PG8_SA(0, 1), a2 + hstep, voffA);
            PG8_WAIT_V(8); PG8_WAIT_L(0); PG8_BAR; PG8_MMA(0, 0, At, B0); PG8_MMA(0, 1, At, B1); PG8_BAR; PG8_SCHED;
            PG8_LDA(At, 1, 1); PG8_STAGE(PG8_SB(1, 0), b3, voffB); PG8_STAGE(PG8_SB(1, 1), b3 + hstep, voffB); PG8_STAGE(PG8_SA(1, 0), a3, voffA);
            PG8_WAIT_V(8); PG8_WAIT_L(0); PG8_BAR; PG8_MMA(1, 0, At, B0); PG8_MMA(1, 1, At, B1); PG8_BAR; PG8_SCHED;
            } else {
            PG8_LDB(B0, 0, 0); PG8_SCHED; PG8_LDA(At, 0, 0); PG8_STAGE(PG8_SA(1, 1), a1 + hstep, voffA);
            PG8_WAIT_L(8); PG8_BAR; PG8_WAIT_L(0); PG8_MMA(0, 0, At, B0); PG8_BAR; PG8_SCHED;
            PG8_LDB(B1, 0, 1); PG8_STAGE(PG8_SB(0, 0), b2, voffB);
            PG8_BAR; PG8_WAIT_L(0); PG8_MMA(0, 1, At, B1); PG8_BAR;
            PG8_LDA(At, 0, 1); PG8_STAGE(PG8_SA(0, 0), a2, voffA);
            PG8_BAR; PG8_WAIT_L(0); PG8_MMA(1, 0, At, B0); PG8_BAR; PG8_SCHED;
            PG8_STAGE(PG8_SB(0, 1), b2 + hstep, voffB);
            PG8_WAIT_V(6); PG8_BAR; PG8_MMA(1, 1, At, B1); PG8_BAR;
            PG8_LDB(B0, 1, 0); PG8_SCHED; PG8_LDA(At, 1, 0); PG8_STAGE(PG8_SA(0, 1), a2 + hstep, voffA);
            PG8_WAIT_L(8); PG8_BAR; PG8_WAIT_L(0); PG8_MMA(0, 0, At, B0); PG8_BAR; PG8_SCHED;
            PG8_LDB(B1, 1, 1); PG8_STAGE(PG8_SB(1, 0), b3, voffB);
            PG8_BAR; PG8_WAIT_L(0); PG8_MMA(0, 1, At, B1); PG8_BAR;
            PG8_LDA(At, 1, 1); PG8_STAGE(PG8_SA(1, 0), a3, voffA);
            PG8_BAR; PG8_WAIT_L(0); PG8_MMA(1, 0, At, B0); PG8_BAR; PG8_SCHED;
            PG8_STAGE(PG8_SB(1, 1), b3 + hstep, voffB);
            PG8_WAIT_V(6); PG8_BAR; PG8_MMA(1, 1, At, B1); PG8_BAR;
            }
        }
        if constexpr (ALIGN_EPI) { if (wr == 0) PG8_BAR; }
        if constexpr (!Epi::AFTER_DRAIN) { E(acc, cur, wr, wc, fr, fq); S.done(cur); }
        if (!has_next) break;
#pragma unroll
        for (int a = 0; a < 2; ++a)
#pragma unroll
            for (int b = 0; b < 2; ++b)
#pragma unroll
                for (int m = 0; m < 4; ++m)
#pragma unroll
                    for (int n = 0; n < 2; ++n) acc[a][b][m][n] = (f32x4){0.f, 0.f, 0.f, 0.f};
        cur = nxt; cA = nA; cB = nB; ++ui;
        if constexpr (ALIGN_EPI) { if (wr == 1) PG8_BAR; }
    }
    PG8_WAIT_V(0);
    if constexpr (!ALIGN_EPI) { if (wr == 0) PG8_BAR; }
    PG8_BAR;
#undef PG8_SA
#undef PG8_SB
#undef PG8_STAGE
#undef PG8_LDA
#undef PG8_LDB
#undef PG8_MMA
#undef PG8_WAIT_V
#undef PG8_WAIT_L
#undef PG8_BAR
#undef PG8_SCHED
}
}

namespace att {
constexpr int D = 128, NW = 8, QBLK = 32, KVBLK = 64;
constexpr float SCALE = 0.088388347648318440f;
constexpr float THR = 8.f;
constexpr int LDQ = NQKV, LDK = NQKV, LDO = DM;
constexpr size_t SHM_V = KVBLK * D * 2, SHM_K = KVBLK * D * 2, SHM_ATTN = 2 * SHM_V + 2 * SHM_K + NW * 64 * 4;
#define KSWZ(row, colB) ((row) * 256 + ((colB) ^ (((row) & 7) << 4)))
#define SBAR() __builtin_amdgcn_sched_barrier(0)
__device__ __forceinline__ int crow(int r, int hi) { return (r & 3) + 8 * (r >> 2) + 4 * hi; }
__device__ __forceinline__ unsigned cvtpk(float lo, float hi) { unsigned r; asm volatile("v_cvt_pk_bf16_f32 %0, %1, %2" : "=v"(r) : "v"(lo), "v"(hi)); return r; }
__device__ __forceinline__ bf16x8 ld8(const bf16_t* p) { return *reinterpret_cast<const bf16x8*>(p); }

__device__ __forceinline__ void partialSM(f32x16& p0, f32x16& p1, float& m_reg, float& mn, float& alpha) {
  constexpr float C = SCALE * 1.4426950408889634f;
  float pmax = p0[0];
#pragma unroll
  for (int r = 1; r < 16; ++r) pmax = fmaxf(pmax, p0[r]);
#pragma unroll
  for (int r = 0; r < 16; ++r) pmax = fmaxf(pmax, p1[r]);
  { auto rr = __builtin_amdgcn_permlane32_swap(__float_as_uint(pmax), __float_as_uint(pmax), false, false);
    pmax = fmaxf(__uint_as_float(rr[0]), __uint_as_float(rr[1])); }
  if (__builtin_expect(__all(pmax - m_reg <= THR / SCALE), 1)) { mn = m_reg; alpha = 1.f; }
  else { mn = fmaxf(m_reg, pmax); alpha = __builtin_amdgcn_exp2f((m_reg - mn) * C); m_reg = mn; }
  float mnC = -mn * C;
#pragma unroll
  for (int r = 0; r < 16; ++r) p0[r] = fmaf(p0[r], C, mnC);
#pragma unroll
  for (int r = 0; r < 16; ++r) p1[r] = fmaf(p1[r], C, mnC);
#pragma unroll
  for (int r = 0; r < 16; ++r) p0[r] = __builtin_amdgcn_exp2f(p0[r]);
}
__device__ __forceinline__ void finishSM(f32x16& p0, f32x16& p1, float alpha, float& l_reg, bf16x8& pa0, bf16x8& pa1, bf16x8& pa2, bf16x8& pa3) {
#pragma unroll
  for (int r = 0; r < 16; ++r) p1[r] = __builtin_amdgcn_exp2f(p1[r]);
  float ps = 0;
#pragma unroll
  for (int r = 0; r < 16; ++r) ps += p0[r];
#pragma unroll
  for (int r = 0; r < 16; ++r) ps += p1[r];
  { auto rr = __builtin_amdgcn_permlane32_swap(__float_as_uint(ps), __float_as_uint(ps), false, false);
    ps = __uint_as_float(rr[0]) + __uint_as_float(rr[1]); }
  l_reg = l_reg * alpha + ps;
#define PK4(P, BASE, OUT) do { unsigned a0 = cvtpk(P[BASE + 0], P[BASE + 1]), a1 = cvtpk(P[BASE + 2], P[BASE + 3]);   \
    unsigned b0 = cvtpk(P[BASE + 4], P[BASE + 5]), b1 = cvtpk(P[BASE + 6], P[BASE + 7]);                              \
    auto r0 = __builtin_amdgcn_permlane32_swap(a0, b0, false, false); auto r1 = __builtin_amdgcn_permlane32_swap(a1, b1, false, false); \
    u32x4 w = {r0[0], r1[0], r0[1], r1[1]}; OUT = *reinterpret_cast<bf16x8*>(&w); } while (0)
  PK4(p0, 0, pa0); PK4(p0, 8, pa1); PK4(p1, 0, pa2); PK4(p1, 8, pa3);
#undef PK4
}
__device__ __forceinline__ void qkt(f32x16& p0, f32x16& p1, const bf16_t* Ks, const bf16x8* qr, int r32, int hi) {
  p0 = f32x16{}; p1 = f32x16{};
#pragma unroll
  for (int d0 = 0; d0 < 8; ++d0) { int cb = (d0 * 16 + hi * 8) * 2;
    bf16x8 b0 = *reinterpret_cast<const bf16x8*>((const char*)Ks + KSWZ(r32, cb));
    bf16x8 b1 = *reinterpret_cast<const bf16x8*>((const char*)Ks + KSWZ(32 + r32, cb));
    p0 = __builtin_amdgcn_mfma_f32_32x32x16_bf16(b0, qr[d0], p0, 0, 0, 0);
    p1 = __builtin_amdgcn_mfma_f32_32x32x16_bf16(b1, qr[d0], p1, 0, 0, 0); }
}
__device__ __forceinline__ int v_st(int k, int c) { const int kk = (k & ~0xC) | ((k & 4) << 1) | ((k & 8) >> 1); return ((kk >> 3) * 4 + (c >> 5)) * 512 + ((kk & 7) * 32 + (c & 31)) * 2; }
__device__ __forceinline__ int v_rd_base(int lane) { return ((lane & 3) << 3) | (((lane >> 2) & 3) << 6) | (((lane >> 4) & 1) << 5) | (((lane >> 5) & 1) << 8); }
constexpr int v_rd_off(int d0, int ks, int half) { return d0 * 512 + ks * 4096 + half * 2048; }
template <int OFF> __device__ __forceinline__ s16x4 tr_read(int vb) {
  s16x4 r; asm volatile("ds_read_b64_tr_b16 %0, %1 offset:%2" : "=&v"(r) : "v"(vb), "i"(OFF) : "memory"); return r;
}
template <int D0> __device__ __forceinline__ void pv_one(f32x16& od, int vb, bf16x8 pa0, bf16x8 pa1, bf16x8 pa2, bf16x8 pa3) {
  const s16x4 l0 = tr_read<v_rd_off(D0, 0, 0)>(vb), h0 = tr_read<v_rd_off(D0, 0, 1)>(vb), l1 = tr_read<v_rd_off(D0, 1, 0)>(vb), h1 = tr_read<v_rd_off(D0, 1, 1)>(vb);
  const s16x4 l2 = tr_read<v_rd_off(D0, 2, 0)>(vb), h2 = tr_read<v_rd_off(D0, 2, 1)>(vb), l3 = tr_read<v_rd_off(D0, 3, 0)>(vb), h3 = tr_read<v_rd_off(D0, 3, 1)>(vb);
  asm volatile("s_waitcnt lgkmcnt(0)" ::: "memory"); SBAR();
#define PK(L, H) (bf16x8){L[0], L[1], L[2], L[3], H[0], H[1], H[2], H[3]}
  od = __builtin_amdgcn_mfma_f32_32x32x16_bf16(pa0, PK(l0, h0), od, 0, 0, 0);
  od = __builtin_amdgcn_mfma_f32_32x32x16_bf16(pa1, PK(l1, h1), od, 0, 0, 0);
  od = __builtin_amdgcn_mfma_f32_32x32x16_bf16(pa2, PK(l2, h2), od, 0, 0, 0);
  od = __builtin_amdgcn_mfma_f32_32x32x16_bf16(pa3, PK(l3, h3), od, 0, 0, 0);
#undef PK
}
__device__ __forceinline__ void pv_d0(f32x16* o, int vb, bf16x8 pa0, bf16x8 pa1, bf16x8 pa2, bf16x8 pa3) {
  pv_one<0>(o[0], vb, pa0, pa1, pa2, pa3); pv_one<1>(o[1], vb, pa0, pa1, pa2, pa3); pv_one<2>(o[2], vb, pa0, pa1, pa2, pa3); pv_one<3>(o[3], vb, pa0, pa1, pa2, pa3);
}

__device__ __forceinline__ void attn_dense_body(const bf16_t* __restrict__ Qb, const bf16_t* __restrict__ Kh, const bf16_t* __restrict__ Vh,
                                                bf16_t* __restrict__ Ob, int seq, char* lds) {
  const int tid = threadIdx.x, wid = tid >> 6, lane = tid & 63, r32 = lane & 31, hi = lane >> 5;
  bf16_t* V_lds = (bf16_t*)lds; bf16_t* K_lds = (bf16_t*)(lds + 2 * SHM_V);
  float* ws = (float*)(lds + 2 * SHM_V + 2 * SHM_K) + wid * 64; float* li_l = ws; float* al_l = ws + 32;
  float m_reg = -1e30f, l_reg = 0; f32x16 o[4] = {}; bf16x8 qr[8];
  const bf16_t* Qw = Qb + (long)(wid * QBLK + r32) * LDQ + hi * 8;
#pragma unroll
  for (int d0 = 0; d0 < 8; ++d0) qr[d0] = ld8(Qw + d0 * 16);
  const int sr = tid >> 4, sc = (tid & 15) * 8, vst0 = v_st(sr, sc), vst1 = v_st(32 + sr, sc);
  const int vb0 = (int)(uintptr_t)V_lds + v_rd_base(lane);
  struct { bf16x8 vs0, vs1, ks0, ks1; } sr_[2];
#define SLOAD(i, k0) do { sr_[i].vs0 = ld8(&Vh[(long)((k0) + sr) * LDK + sc]); sr_[i].vs1 = ld8(&Vh[(long)((k0) + 32 + sr) * LDK + sc]); \
    sr_[i].ks0 = ld8(&Kh[(long)((k0) + sr) * LDK + sc]); sr_[i].ks1 = ld8(&Kh[(long)((k0) + 32 + sr) * LDK + sc]); } while (0)
#define SWRITE(b, i) do { *(bf16x8*)((char*)V_lds + (b) * SHM_V + vst0) = sr_[i].vs0;          \
    *(bf16x8*)((char*)V_lds + (b) * SHM_V + vst1) = sr_[i].vs1; int kc = sc * 2;               \
    *(bf16x8*)((char*)K_lds + (b) * SHM_K + KSWZ(sr, kc)) = sr_[i].ks0;                       \
    *(bf16x8*)((char*)K_lds + (b) * SHM_K + KSWZ(32 + sr, kc)) = sr_[i].ks1; } while (0)
#define SWAIT() do { asm volatile("s_waitcnt vmcnt(4)" ::: "memory"); } while (0)
#define RESC(a) do { if (__any((a) < 1.f)) { if (hi == 0) al_l[r32] = (a); asm volatile("s_waitcnt lgkmcnt(0)" ::: "memory"); \
    _Pragma("unroll") for (int d = 0; d < 4; ++d) _Pragma("unroll") for (int r = 0; r < 16; ++r) o[d][r] *= al_l[crow(r, hi)]; } } while (0)
  f32x16 pA0, pA1, pB0, pB1; float mnA, mnB, alA, alB; bf16x8 pa0, pa1, pa2, pa3; const int NT = seq / KVBLK;
  constexpr int SE = 0, SO = 1;
  SLOAD(SE, 0); asm volatile("s_waitcnt vmcnt(0)" ::: "memory"); SWRITE(0, SE); __syncthreads();
  qkt(pA0, pA1, K_lds, qr, r32, hi); partialSM(pA0, pA1, m_reg, mnA, alA);
  SLOAD(SO, KVBLK); if (2 < NT) SLOAD(SE, 2 * KVBLK);
  SWAIT(); SWRITE(1, SO); __syncthreads();
  for (int j = 1; j + 1 < NT; j += 2) {
    SBAR(); qkt(pB0, pB1, (bf16_t*)((char*)K_lds + SHM_K), qr, r32, hi);
    finishSM(pA0, pA1, alA, l_reg, pa0, pa1, pa2, pa3); SBAR();
    SLOAD(SO, (j + 2) * KVBLK); SBAR();
    pv_d0(o, vb0, pa0, pa1, pa2, pa3); partialSM(pB0, pB1, m_reg, mnB, alB);
    __syncthreads(); SWAIT(); SWRITE(0, SE);
    RESC(alB); __syncthreads();
    SBAR(); qkt(pA0, pA1, K_lds, qr, r32, hi);
    finishSM(pB0, pB1, alB, l_reg, pa0, pa1, pa2, pa3); SBAR();
    if (j + 3 < NT) SLOAD(SE, (j + 3) * KVBLK); SBAR();
    pv_d0(o, vb0 + (int)SHM_V, pa0, pa1, pa2, pa3); partialSM(pA0, pA1, m_reg, mnA, alA);
    __syncthreads(); SWAIT(); SWRITE(1, SO);
    RESC(alA); __syncthreads();
  }
  SBAR(); qkt(pB0, pB1, (bf16_t*)((char*)K_lds + SHM_K), qr, r32, hi);
  finishSM(pA0, pA1, alA, l_reg, pa0, pa1, pa2, pa3); SBAR();
  pv_d0(o, vb0, pa0, pa1, pa2, pa3); partialSM(pB0, pB1, m_reg, mnB, alB);
  __syncthreads(); RESC(alB);
  finishSM(pB0, pB1, alB, l_reg, pa0, pa1, pa2, pa3); SBAR();
  pv_d0(o, vb0 + (int)SHM_V, pa0, pa1, pa2, pa3);
  if (hi == 0) li_l[r32] = l_reg; asm volatile("s_waitcnt lgkmcnt(0)" ::: "memory");
  float rli[16];
#pragma unroll
  for (int r = 0; r < 16; ++r) rli[r] = __builtin_amdgcn_rcpf(li_l[crow(r, hi)]);
  bf16_t* Ow = Ob + (long)(wid * QBLK) * LDO;
#pragma unroll
  for (int r = 0; r < 16; ++r) { int orow = crow(r, hi);
#pragma unroll
    for (int d0 = 0; d0 < 4; ++d0) Ow[(long)orow * LDO + d0 * 32 + r32] = (bf16_t)f2bf(o[d0][r] * rli[r]); }
  __syncthreads();
#undef SLOAD
#undef SWRITE
#undef SWAIT
#undef RESC
}
}

__device__ __forceinline__ void transpose_item(const float* W, int K, int N, bf16_t* WT, LAS float* scr, int item, int lane, bool ffn_remap = false) {
    const int nblk = N / 32, kb = item / nblk, nb = item % nblk, k0 = 64 * kb, n0 = 32 * nb;
    int n0o = n0; if (ffn_remap) { const int half = n0 >= DFF ? 1 : 0, f = n0 - half * DFF; n0o = (f >> 7) * 256 + half * 128 + (f & 127); }
#pragma unroll 8
    for (int i = 0; i < 32; ++i) { const int kk = 2 * i + (lane >> 5); scr[kk * 33 + (lane & 31)] = W[(size_t)(k0 + kk) * N + n0 + (lane & 31)]; }
    asm volatile("s_waitcnt lgkmcnt(0)" ::: "memory");
    const int c = lane & 7;
#pragma unroll
    for (int j = 0; j < 4; ++j) { const int n = (lane >> 3) + 8 * j; const LAS float* s = scr + (8 * c) * 33 + n;
        u32x4 o; o.x = pk2(s[0 * 33], s[1 * 33]); o.y = pk2(s[2 * 33], s[3 * 33]); o.z = pk2(s[4 * 33], s[5 * 33]); o.w = pk2(s[6 * 33], s[7 * 33]);
        *(u32x4*)(WT + (size_t)(n0o + n) * K + k0 + 8 * c) = o; }
    asm volatile("s_waitcnt lgkmcnt(0)" ::: "memory");
}

__device__ __forceinline__ void ada_phase(const float* c, const float* c_ctx, const float* ada_w, const float* ada_b, float* mod, LAS unsigned char* lds, int wg, int G, int tid) {
    LAS float* sv = (LAS float*)lds;
    LAS float* part = sv + 3 * 2048;
    for (int i = tid; i < 3 * 2048; i += 512) { const int s = i >> 11, k = i & 2047; const float v = (s == 0) ? c_ctx[k] : c[(s - 1) * 2048 + k]; sv[i] = siluf(v); }
    __syncthreads();
    const int wave = tid >> 6, lane = tid & 63;
    for (int item = wg; item < 192; item += G) {
        const int L = item / 96, n0 = (item % 96) * 128;
        const float* W = ada_w + (size_t)L * 2048 * 12288 + n0 + lane * 2;
        float a0x = 0, a0y = 0, a1x = 0, a1y = 0, a2x = 0, a2y = 0;
        const int k0 = wave * 256;
#pragma unroll 8
        for (int k = 0; k < 256; ++k) {
            const f32x2 w = *(const f32x2*)(W + (size_t)(k0 + k) * 12288);
            const float s0 = sv[k0 + k], s1 = sv[2048 + k0 + k], s2 = sv[4096 + k0 + k];
            a0x += s0 * w.x; a0y += s0 * w.y; a1x += s1 * w.x; a1y += s1 * w.y; a2x += s2 * w.x; a2y += s2 * w.y;
        }
        part[(wave * 3 + 0) * 128 + lane * 2] = a0x; part[(wave * 3 + 0) * 128 + lane * 2 + 1] = a0y;
        part[(wave * 3 + 1) * 128 + lane * 2] = a1x; part[(wave * 3 + 1) * 128 + lane * 2 + 1] = a1y;
        part[(wave * 3 + 2) * 128 + lane * 2] = a2x; part[(wave * 3 + 2) * 128 + lane * 2 + 1] = a2y;
        __syncthreads();
        if (tid < 384) { const int s = tid >> 7, n = tid & 127; float acc = ada_b[L * 12288 + n0 + n];
#pragma unroll
            for (int w = 0; w < 8; ++w) acc += part[(w * 3 + s) * 128 + n];
            mod[(size_t)(L * 3 + s) * 12288 + n0 + n] = acc; }
        __syncthreads();
    }
}

template <bool XIN_BF, bool XOUT_BF>
__device__ __forceinline__ void row_phase(const float* xin_lat, const float* xin_ctx, float* xout_lat, float* xout_ctx, bf16_t* XR,
                                          const bf16_t* Y, const float* g_post, const float* g_pre, const float* modL, int jgate, int jshift, int jscale,
                                          bf16_t* H, bool has_y, bool make_h, bool lat_only, int gw, int NGW, int lane, const float* YS = nullptr, int nsplit = 0) {
    for (int r = gw; r < MR; r += NGW) {
        const int b = r / SB, p = r - b * SB; int s; const float* xi; float* xo; const bool ctxrow = p < CTX;
        size_t xrow;
        if (ctxrow) { if (lat_only) continue; s = 0; xrow = (size_t)(b * CTX + p) * DM; xi = xin_ctx + xrow; xo = xout_ctx + xrow; }
        else { s = 1 + b; xrow = (size_t)(b * SEQ + p - CTX) * DM; xi = xin_lat + xrow; xo = xout_lat + xrow; }
        const float* ms = modL + (size_t)s * 12288;
        f32x4 x[8];
#pragma unroll
        for (int j = 0; j < 8; ++j) {
            if (XIN_BF && !ctxrow) { const u32x2 xb = *(const u32x2*)(XR + xrow + (j * 64 + lane) * 4); x[j] = (f32x4){bflo(xb.x), bfhi(xb.x), bflo(xb.y), bfhi(xb.y)}; }
            else x[j] = *(const f32x4*)(xi + (j * 64 + lane) * 4);
        }
        if (has_y) {
            f32x4 y[8]; float ss = 0.f;
#pragma unroll
            for (int j = 0; j < 8; ++j) {
                if (ctxrow && nsplit > 0) { f32x4 t = {0.f, 0.f, 0.f, 0.f};
                    for (int sp = 0; sp < nsplit; ++sp) t += *(const f32x4*)(YS + ((size_t)sp * 512 + b * CTX + p) * DM + (j * 64 + lane) * 4);
                    y[j] = t; }
                else { const u32x2 yb = *(const u32x2*)(Y + (size_t)r * DM + (j * 64 + lane) * 4); y[j] = (f32x4){bflo(yb.x), bfhi(yb.x), bflo(yb.y), bfhi(yb.y)}; }
                ss += (y[j].x * y[j].x + y[j].y * y[j].y) + (y[j].z * y[j].z + y[j].w * y[j].w); }
            const float rs = rsqrtf(wave_sum(ss) * (1.f / DM) + EPS);
#pragma unroll
            for (int j = 0; j < 8; ++j) { const f32x4 gp = *(const f32x4*)(g_post + (j * 64 + lane) * 4); const f32x4 gt = *(const f32x4*)(ms + jgate * 2048 + (j * 64 + lane) * 4);
                x[j] = x[j] + gt * (y[j] * rs * gp);
                if (XOUT_BF && !ctxrow) { u32x2 w; w.x = cvt_pk_bf16(x[j].x, x[j].y); w.y = cvt_pk_bf16(x[j].z, x[j].w); *(u32x2*)(XR + xrow + (j * 64 + lane) * 4) = w;
                    x[j] = (f32x4){bflo(w.x), bfhi(w.x), bflo(w.y), bfhi(w.y)}; }
                else *(f32x4*)(xo + (j * 64 + lane) * 4) = x[j]; }
        }
        if (make_h) {
            float ss = 0.f;
#pragma unroll
            for (int j = 0; j < 8; ++j) ss += (x[j].x * x[j].x + x[j].y * x[j].y) + (x[j].z * x[j].z + x[j].w * x[j].w);
            const float rs = rsqrtf(wave_sum(ss) * (1.f / DM) + EPS);
#pragma unroll
            for (int j = 0; j < 8; ++j) { const f32x4 gp = *(const f32x4*)(g_pre + (j * 64 + lane) * 4); const f32x4 sh = *(const f32x4*)(ms + jshift * 2048 + (j * 64 + lane) * 4);
                const f32x4 sc = *(const f32x4*)(ms + jscale * 2048 + (j * 64 + lane) * 4);
                const f32x4 hv = (x[j] * rs * gp) * (sc + 1.f) + sh;
                u32x2 w; w.x = cvt_pk_bf16(hv.x, hv.y); w.y = cvt_pk_bf16(hv.z, hv.w);
                *(u32x2*)(H + (size_t)r * DM + (j * 64 + lane) * 4) = w; }
        }
    }
}

__device__ __forceinline__ void gla_prep_phase(bf16_t* P, bf16_t* QB, float* EB, const float* __restrict__ lbl, LAS unsigned char* lds, int wg, int G, int tid) {
    const int lane = tid & 63, w = __builtin_amdgcn_readfirstlane(tid >> 6);
    constexpr float L2E = 1.4426950408889634f;
    int par = 0;
    unsigned nq[8], nf[8], nb[8];
    if (wg < NB * NH * 132) { const int rb0 = wg % 132, bh0 = wg / 132; const size_t r0 = (size_t)(bh0 >> 4) * SB + rb0 * 64 + 8 * w; const int c0 = (bh0 & 15) * 128 + 2 * lane;
#pragma unroll
        for (int i = 0; i < 8; ++i) { const size_t ro = (r0 + i) * NHG + c0; nq[i] = *(const unsigned*)(P + ro); nf[i] = *(const unsigned*)(P + ro + 2048); nb[i] = *(const unsigned*)(P + ro + 4096); } }
    for (int item = wg; item < NB * NH * 132; item += G, par ^= 1) {
        LAS float* TOT = (LAS float*)lds + par * 2048;
        const int rb = item % 132, bh = item / 132, h = bh & 15, b = bh >> 4;
        float lb[2][2], oml[2][2];
#pragma unroll
        for (int d = 0; d < 2; ++d)
#pragma unroll
            for (int e = 0; e < 2; ++e) { const int ch = h * 128 + 2 * lane + e; const float l0 = lbl[(d * 2 + 0) * 2048 + ch], l1 = lbl[(d * 2 + 1) * 2048 + ch];
                lb[d][e] = __builtin_amdgcn_rcpf(1.f + __builtin_amdgcn_exp2f((l1 - l0) * L2E)); oml[d][e] = 1.f - lb[d][e]; }
        const size_t row0 = (size_t)b * SB + rb * 64 + 8 * w;
        const int col = h * 128 + 2 * lane;
        unsigned q2[8], ff[8], fb[8];
#pragma unroll
        for (int i = 0; i < 8; ++i) { q2[i] = nq[i]; ff[i] = nf[i]; fb[i] = nb[i]; }
        if (item + G < NB * NH * 132) {
            const int it2 = item + G, rb2 = it2 % 132, bh2 = it2 / 132;
            const size_t r2 = (size_t)(bh2 >> 4) * SB + rb2 * 64 + 8 * w; const int c2 = (bh2 & 15) * 128 + 2 * lane;
#pragma unroll
            for (int i = 0; i < 8; ++i) { const size_t ro = (r2 + i) * NHG + c2; nq[i] = *(const unsigned*)(P + ro); nf[i] = *(const unsigned*)(P + ro + 2048); nb[i] = *(const unsigned*)(P + ro + 4096); }
        }
        float blf[8][2], blb[8][2], kkf[8][2], kkb[8][2];
        { float r0 = 0.f, r1 = 0.f;
#pragma unroll
          for (int i = 0; i < 8; ++i) {
              { const float sg = __builtin_amdgcn_rcpf(1.f + __builtin_amdgcn_exp2f(bflo(ff[i]) * -L2E)); r0 += __builtin_amdgcn_logf(lb[0][0] + oml[0][0] * sg); blf[i][0] = r0; kkf[i][0] = oml[0][0] - oml[0][0] * sg; }
              { const float sg = __builtin_amdgcn_rcpf(1.f + __builtin_amdgcn_exp2f(bfhi(ff[i]) * -L2E)); r1 += __builtin_amdgcn_logf(lb[0][1] + oml[0][1] * sg); blf[i][1] = r1; kkf[i][1] = oml[0][1] - oml[0][1] * sg; }
          }
          *(LAS f32x2*)(TOT + w * 128 + 2 * lane) = (f32x2){r0, r1}; }
        { float r0 = 0.f, r1 = 0.f;
#pragma unroll
          for (int i = 7; i >= 0; --i) {
              { const float sg = __builtin_amdgcn_rcpf(1.f + __builtin_amdgcn_exp2f(bflo(fb[i]) * -L2E)); r0 += __builtin_amdgcn_logf(lb[1][0] + oml[1][0] * sg); blb[i][0] = r0; kkb[i][0] = oml[1][0] - oml[1][0] * sg; }
              { const float sg = __builtin_amdgcn_rcpf(1.f + __builtin_amdgcn_exp2f(bfhi(fb[i]) * -L2E)); r1 += __builtin_amdgcn_logf(lb[1][1] + oml[1][1] * sg); blb[i][1] = r1; kkb[i][1] = oml[1][1] - oml[1][1] * sg; }
          }
          *(LAS f32x2*)(TOT + 1024 + w * 128 + 2 * lane) = (f32x2){r0, r1}; }
        LBAR();
        float pf0 = 0.f, pf1 = 0.f, tf0 = 0.f, tf1 = 0.f, pb0 = 0.f, pb1 = 0.f, tb0 = 0.f, tb1 = 0.f;
#pragma unroll
        for (int g = 0; g < 8; ++g) { const f32x2 x = *(const LAS f32x2*)(TOT + g * 128 + 2 * lane), y = *(const LAS f32x2*)(TOT + 1024 + g * 128 + 2 * lane);
            tf0 += x.x; tf1 += x.y; tb0 += y.x; tb1 += y.y; if (g < w) { pf0 += x.x; pf1 += x.y; } if (g > w) { pb0 += y.x; pb1 += y.y; } }
#pragma unroll
        for (int i = 0; i < 8; ++i) {
            const float qs0 = bflo(q2[i]), qs1 = bfhi(q2[i]);
            const float s0 = qs0 * 0.08838834764831845f * __builtin_amdgcn_rcpf(1.f + __builtin_amdgcn_exp2f(qs0 * -L2E));
            const float s1 = qs1 * 0.08838834764831845f * __builtin_amdgcn_rcpf(1.f + __builtin_amdgcn_exp2f(qs1 * -L2E));
            const float df0 = pf0 + blf[i][0] - tf0, df1 = pf1 + blf[i][1] - tf1, db0 = pb0 + blb[i][0] - tb0, db1 = pb1 + blb[i][1] - tb1;
            const size_t ro = (row0 + i) * NHG + col;
            *(unsigned*)(P + ro) = cvt_pk_bf16(s0 * __builtin_amdgcn_exp2f(df0), s1 * __builtin_amdgcn_exp2f(df1));
            *(unsigned*)(P + ro + 2048) = cvt_pk_bf16(kkf[i][0] * __builtin_amdgcn_exp2f(-df0), kkf[i][1] * __builtin_amdgcn_exp2f(-df1));
            *(unsigned*)(P + ro + 4096) = cvt_pk_bf16(kkb[i][0] * __builtin_amdgcn_exp2f(-db0), kkb[i][1] * __builtin_amdgcn_exp2f(-db1));
            *(unsigned*)(QB + (row0 + i) * DM + col) = cvt_pk_bf16(s0 * __builtin_amdgcn_exp2f(db0), s1 * __builtin_amdgcn_exp2f(db1));
        }
        if (w == 0) {
            const int cb = rb < 4 ? 3 - rb : 135 - rb;
            *(f32x2*)(EB + ((size_t)((b * 16 + h) * 2 + 0) * 132 + rb) * 128 + 2 * lane) = (f32x2){__builtin_amdgcn_exp2f(tf0), __builtin_amdgcn_exp2f(tf1)};
            *(f32x2*)(EB + ((size_t)((b * 16 + h) * 2 + 1) * 132 + cb) * 128 + 2 * lane) = (f32x2){__builtin_amdgcn_exp2f(tb0), __builtin_amdgcn_exp2f(tb1)};
        }
    }
    __syncthreads();
}

__device__ __forceinline__ void gla_item(const bf16_t* __restrict__ P, const bf16_t* __restrict__ QS, int ldq, const float* __restrict__ EB, bf16_t* __restrict__ Od, LAS unsigned char* lds, int b, int h, int dir, int vs, int tid) {
    const int lane = tid & 63, w = __builtin_amdgcn_readfirstlane(tid >> 6), fr = lane & 15, fq = lane >> 4;
    constexpr int SETB = 66560;
    LAS unsigned char* PS = lds + 2 * SETB;
    for (int i = tid; i < 9216 / 4; i += 512) ((LAS unsigned*)PS)[i] = 0u;
    f32x4 S0 = {0.f, 0.f, 0.f, 0.f}, S1 = {0.f, 0.f, 0.f, 0.f};
    const int colq = h * 128 + 2 * lane, colf = 2048 * (1 + dir) + h * 128 + 2 * lane, colv = 3 * 2048 + h * 128 + vs * 32 + (tid & 7) * 4;
    const int tv = tid >> 3, base = b * SB, rofs = dir ? 63 : 0, rsign = dir ? -1 : 1;
    const float* ebp = EB + (size_t)((b * 16 + h) * 2 + dir) * 132 * 128 + 16 * w + 4 * fq;
    unsigned q2[4][8], f2[4][8]; u32x2 vv[4]; f32x4 eb[4];
#define GLA_R0(c) (dir ? ((c) < 4 ? base + 192 - 64 * (c) : base + 8640 - 64 * (c)) : base + 64 * (c))
#define GLA_LOAD(u, c) do { const int R0n = GLA_R0(c); \
        _Pragma("unroll") for (int i = 0; i < 8; ++i) { const size_t rr = (size_t)(R0n + rofs + rsign * (8 * w + i)); \
            q2[u][i] = *(const unsigned*)(QS + rr * ldq + colq); f2[u][i] = *(const unsigned*)(P + rr * NHG + colf); } \
        vv[u] = *(const u32x2*)(P + (size_t)(R0n + rofs + rsign * tv) * NHG + colv); eb[u] = *(const f32x4*)(ebp + (size_t)(c) * 128); } while (0)
    GLA_LOAD(0, 0); GLA_LOAD(1, 1); GLA_LOAD(2, 2); GLA_LOAD(3, 3);
    LBAR();
    for (int c0 = 0; c0 < 132; c0 += 4) {
#pragma unroll
      for (int u = 0; u < 4; ++u) {
        const int c = c0 + u;
        const int R0 = GLA_R0(c);
        LAS unsigned char* QD = lds + (u & 1) * SETB; LAS unsigned char* KD = QD + 17408; LAS unsigned char* KDT = QD + 34816; LAS unsigned char* VT = QD + 53248; LAS unsigned char* SDT = QD + 57856;
#pragma unroll
        for (int i = 0; i < 8; ++i) { *(LAS unsigned*)(QD + (8 * w + i) * 272 + lane * 4) = q2[u][i]; *(LAS unsigned*)(KD + (8 * w + i) * 272 + lane * 4) = f2[u][i]; }
        { u32x4 t0, t1;
          t0.x = (f2[u][0] & 0xffffu) | (f2[u][1] << 16); t0.y = (f2[u][2] & 0xffffu) | (f2[u][3] << 16); t0.z = (f2[u][4] & 0xffffu) | (f2[u][5] << 16); t0.w = (f2[u][6] & 0xffffu) | (f2[u][7] << 16);
          t1.x = (f2[u][0] >> 16) | (f2[u][1] & 0xffff0000u); t1.y = (f2[u][2] >> 16) | (f2[u][3] & 0xffff0000u); t1.z = (f2[u][4] >> 16) | (f2[u][5] & 0xffff0000u); t1.w = (f2[u][6] >> 16) | (f2[u][7] & 0xffff0000u);
          *(LAS u32x4*)(KDT + (2 * lane) * 144 + w * 16) = t0; *(LAS u32x4*)(KDT + (2 * lane + 1) * 144 + w * 16) = t1; }
        { LAS bf16_t* vt = (LAS bf16_t*)VT; const int v4 = (tid & 7) * 4;
          vt[(v4 + 0) * 72 + tv] = (bf16_t)(vv[u].x & 0xffffu); vt[(v4 + 1) * 72 + tv] = (bf16_t)(vv[u].x >> 16);
          vt[(v4 + 2) * 72 + tv] = (bf16_t)(vv[u].y & 0xffffu); vt[(v4 + 3) * 72 + tv] = (bf16_t)(vv[u].y >> 16); }
        S0 *= eb[u]; S1 *= eb[u];
        *(LAS u32x2*)(SDT + fr * 272 + (16 * w + 4 * fq) * 2) = (u32x2){cvt_pk_bf16(S0.x, S0.y), cvt_pk_bf16(S0.z, S0.w)};
        *(LAS u32x2*)(SDT + (16 + fr) * 272 + (16 * w + 4 * fq) * 2) = (u32x2){cvt_pk_bf16(S1.x, S1.y), cvt_pk_bf16(S1.z, S1.w)};
        if (c + 4 < 132) GLA_LOAD(u, c + 4);
        LBAR();
        for (int q = w; q < 10; q += 8) {
            const int ti = (q >= 1) + (q >= 3) + (q >= 6), si = q - ti * (ti + 1) / 2;
            f32x4 acc = {0.f, 0.f, 0.f, 0.f};
#pragma unroll
            for (int ks = 0; ks < 4; ++ks) { const bf16x8 a = *(const LAS bf16x8*)(KD + (16 * si + fr) * 272 + (ks * 32 + fq * 8) * 2);
                const bf16x8 bq = *(const LAS bf16x8*)(QD + (16 * ti + fr) * 272 + (ks * 32 + fq * 8) * 2);
                acc = __builtin_amdgcn_mfma_f32_16x16x32_bf16(a, bq, acc, 0, 0, 0); }
            if (si == ti) {
#pragma unroll
                for (int j = 0; j < 4; ++j) if (4 * fq + j > fr) acc[j] = 0.f;
            }
            *(LAS u32x2*)(PS + (16 * ti + fr) * 144 + (16 * si + 4 * fq) * 2) = (u32x2){cvt_pk_bf16(acc.x, acc.y), cvt_pk_bf16(acc.z, acc.w)};
        }
        LBAR();
        { const int ti = w >> 1, vi = w & 1; f32x4 o = {0.f, 0.f, 0.f, 0.f};
#pragma unroll
          for (int ks = 0; ks < 2; ++ks) { const bf16x8 a = *(const LAS bf16x8*)(VT + (16 * vi + fr) * 144 + (ks * 32 + fq * 8) * 2);
              const bf16x8 bp = *(const LAS bf16x8*)(PS + (16 * ti + fr) * 144 + (ks * 32 + fq * 8) * 2);
              o = __builtin_amdgcn_mfma_f32_16x16x32_bf16(a, bp, o, 0, 0, 0); }
#pragma unroll
          for (int ks = 0; ks < 4; ++ks) { const bf16x8 a = *(const LAS bf16x8*)(SDT + (16 * vi + fr) * 272 + (ks * 32 + fq * 8) * 2);
              const bf16x8 bq = *(const LAS bf16x8*)(QD + (16 * ti + fr) * 272 + (ks * 32 + fq * 8) * 2);
              o = __builtin_amdgcn_mfma_f32_16x16x32_bf16(a, bq, o, 0, 0, 0); }
          const size_t ro = (size_t)(R0 + rofs + rsign * (16 * ti + fr)) * DM;
          *(u32x2*)(Od + ro + h * 128 + vs * 32 + 16 * vi + 4 * fq) = (u32x2){cvt_pk_bf16(o.x, o.y), cvt_pk_bf16(o.z, o.w)}; }
#pragma unroll
        for (int ks = 0; ks < 2; ++ks) { const bf16x8 a = *(const LAS bf16x8*)(KDT + (16 * w + fr) * 144 + (ks * 32 + fq * 8) * 2);
            const bf16x8 b0 = *(const LAS bf16x8*)(VT + fr * 144 + (ks * 32 + fq * 8) * 2);
            const bf16x8 b1 = *(const LAS bf16x8*)(VT + (16 + fr) * 144 + (ks * 32 + fq * 8) * 2);
            S0 = __builtin_amdgcn_mfma_f32_16x16x32_bf16(a, b0, S0, 0, 0, 0);
            S1 = __builtin_amdgcn_mfma_f32_16x16x32_bf16(a, b1, S1, 0, 0, 0); }
      }
    }
#undef GLA_LOAD
#undef GLA_R0
    __syncthreads();
}

__device__ __forceinline__ void readout_phase(const bf16_t* Ofw, const bf16_t* Obw, const bf16_t* P, const float* o_gain, bf16_t* R, int gw, int NGW, int lane) {
    const int cl = (8 * lane) & 127;
    const f32x4 g0 = *(const f32x4*)(o_gain + cl), g1 = *(const f32x4*)(o_gain + cl + 4);
    const float gn[8] = {g0.x, g0.y, g0.z, g0.w, g1.x, g1.y, g1.z, g1.w};
    for (int it0 = gw * 4; it0 < MR * 4; it0 += NGW * 4) {
        u32x4 a[4], bq[4], g[4];
#pragma unroll
        for (int u = 0; u < 4; ++u) { const int it = it0 + u, r = it >> 2, c0 = (it & 3) * 512 + 8 * lane;
            a[u] = *(const u32x4*)(Ofw + (size_t)r * DM + c0); bq[u] = *(const u32x4*)(Obw + (size_t)r * DM + c0); g[u] = *(const u32x4*)(P + (size_t)r * NHG + 4 * DM + c0); }
#pragma unroll
        for (int u = 0; u < 4; ++u) { const int it = it0 + u, r = it >> 2, c0 = (it & 3) * 512 + 8 * lane;
            float o[8];
            o[0] = bflo(a[u].x) + bflo(bq[u].x); o[1] = bfhi(a[u].x) + bfhi(bq[u].x); o[2] = bflo(a[u].y) + bflo(bq[u].y); o[3] = bfhi(a[u].y) + bfhi(bq[u].y);
            o[4] = bflo(a[u].z) + bflo(bq[u].z); o[5] = bfhi(a[u].z) + bfhi(bq[u].z); o[6] = bflo(a[u].w) + bflo(bq[u].w); o[7] = bfhi(a[u].w) + bfhi(bq[u].w);
            float ss = 0.f;
#pragma unroll
            for (int e = 0; e < 8; ++e) ss += o[e] * o[e];
            ss += __shfl_xor(ss, 1); ss += __shfl_xor(ss, 2); ss += __shfl_xor(ss, 4); ss += __shfl_xor(ss, 8);
            const float rs = rsqrtf(ss * (1.f / 128.f) + EPS);
            const float gv[8] = {bflo(g[u].x), bfhi(g[u].x), bflo(g[u].y), bfhi(g[u].y), bflo(g[u].z), bfhi(g[u].z), bflo(g[u].w), bfhi(g[u].w)};
            float v[8];
#pragma unroll
            for (int e = 0; e < 8; ++e) v[e] = o[e] * rs * gn[e] * siluf(gv[e]);
            u32x4 wv; wv.x = cvt_pk_bf16(v[0], v[1]); wv.y = cvt_pk_bf16(v[2], v[3]); wv.z = cvt_pk_bf16(v[4], v[5]); wv.w = cvt_pk_bf16(v[6], v[7]);
            *(u32x4*)(R + (size_t)r * DM + c0) = wv; }
    }
}

__device__ __forceinline__ void conv_fix_phase(const float* BND, const float* cw, const float* cbias, bf16_t* ACT, bool lat_only, int gw, int NGW, int lane) {
    constexpr float L2E = 1.4426950408889634f;
    for (int it = gw; it < 66 * 2 * 11; it += NGW) {
        const int cbk = it % 11, rest = it / 11, which = rest & 1, pm = rest >> 1;
        if (lat_only && (pm == 0 || pm == 33)) continue;
        const int c0 = cbk * 512 + 8 * lane;
        const float* bn = BND + (size_t)pm * 6 * DFF + c0;
        f32x4 pv[2], cv[2], nv[2], uv[2]; size_t row;
        if (which == 0) {
            const bool seq_start = (pm == 0 || pm == 1 || pm == 33 || pm == 34);
#pragma unroll
            for (int hh = 0; hh < 2; ++hh) { pv[hh] = seq_start ? (f32x4){0.f, 0.f, 0.f, 0.f} : *(const f32x4*)(bn - 6 * DFF + 3 * DFF + 4 * hh);
                cv[hh] = *(const f32x4*)(bn + 4 * hh); nv[hh] = *(const f32x4*)(bn + DFF + 4 * hh); uv[hh] = *(const f32x4*)(bn + 4 * DFF + 4 * hh); }
            row = (size_t)pm * 256;
        } else {
            const bool seq_end = (pm == 0 || pm == 32 || pm == 33 || pm == 65);
#pragma unroll
            for (int hh = 0; hh < 2; ++hh) { pv[hh] = *(const f32x4*)(bn + 2 * DFF + 4 * hh); cv[hh] = *(const f32x4*)(bn + 3 * DFF + 4 * hh);
                nv[hh] = seq_end ? (f32x4){0.f, 0.f, 0.f, 0.f} : *(const f32x4*)(bn + 6 * DFF + 4 * hh); uv[hh] = *(const f32x4*)(bn + 5 * DFF + 4 * hh); }
            row = (size_t)pm * 256 + 255;
        }
        float v[8];
#pragma unroll
        for (int hh = 0; hh < 2; ++hh) {
            const f32x4 w0 = *(const f32x4*)(cw + c0 + 4 * hh), w1 = *(const f32x4*)(cw + DFF + c0 + 4 * hh), w2 = *(const f32x4*)(cw + 2 * DFF + c0 + 4 * hh), cb = *(const f32x4*)(cbias + c0 + 4 * hh);
#pragma unroll
            for (int j = 0; j < 4; ++j) { const float y = w0[j] * pv[hh][j] + w1[j] * cv[hh][j] + w2[j] * nv[hh][j] + cb[j];
                v[4 * hh + j] = y * __builtin_amdgcn_rcpf(1.f + __builtin_amdgcn_exp2f(y * -L2E)) * uv[hh][j]; }
        }
        u32x4 wv; wv.x = cvt_pk_bf16(v[0], v[1]); wv.y = cvt_pk_bf16(v[2], v[3]); wv.z = cvt_pk_bf16(v[4], v[5]); wv.w = cvt_pk_bf16(v[6], v[7]);
        *(u32x4*)(ACT + row * DFF + c0) = wv;
    }
}

__device__ __forceinline__ void qknorm_phase(bf16_t* QKV, const float* q_gain, const float* k_gain, int gw, int NGW, int lane) {
    const int cl = (8 * lane) & 127;
    for (int it = gw; it < MR * 5; it += NGW) {
        const int r = it / 5, grp = it - r * 5, p = r % SB;
        const bool lat = p >= CTX;
        if (!lat && grp < 4) continue;
        bf16_t* ptr = QKV + (size_t)r * NQKV + grp * 512 + 8 * lane;
        const float* gn = (grp < 4) ? q_gain : k_gain;
        const u32x4 a = *(const u32x4*)ptr;
        float x[8] = {bflo(a.x), bfhi(a.x), bflo(a.y), bfhi(a.y), bflo(a.z), bfhi(a.z), bflo(a.w), bfhi(a.w)};
        float ss = 0.f;
#pragma unroll
        for (int e = 0; e < 8; ++e) ss += x[e] * x[e];
        ss += __shfl_xor(ss, 1); ss += __shfl_xor(ss, 2); ss += __shfl_xor(ss, 4); ss += __shfl_xor(ss, 8);
        const float rs = rsqrtf(ss * (1.f / 128.f) + EPS);
#pragma unroll
        for (int e = 0; e < 8; ++e) x[e] = x[e] * rs * gn[cl + e];
        if (lat) {
            const int t = p - CTX; const float prow = (float)(t >> 6), pcol = (float)(t & 63);
#pragma unroll
            for (int e2 = 0; e2 < 4; ++e2) {
                const int i = (cl >> 1) + e2; const int fi = i & 31;
                const float invf = exp2f(-(float)fi * (13.287712379549449f / 32.f));
                const float ang = ((i >= 32) ? pcol : prow) * invf;
                float sn, cs; sincosf(ang, &sn, &cs);
                const float x1 = x[2 * e2], x2 = x[2 * e2 + 1];
                x[2 * e2] = x1 * cs - x2 * sn; x[2 * e2 + 1] = x1 * sn + x2 * cs;
            }
        }
        u32x4 wv; wv.x = cvt_pk_bf16(x[0], x[1]); wv.y = cvt_pk_bf16(x[2], x[3]); wv.z = cvt_pk_bf16(x[4], x[5]); wv.w = cvt_pk_bf16(x[6], x[7]);
        *(u32x4*)ptr = wv;
    }
}


#define XB_TMO      128
#define XB_XCNT(j)  (256  + 64 * (j))
#define XB_XSUB(j)  (1280 + 64 * (j))
#define XB_XGEN(j)  (2304 + 64 * (j))
#define XB_TOP      3328
#define XB_TOPGEN   3392
#define XCD_BAR_WORDS 3456
#define XB_SPIN_CAP (1u << 20)
__device__ __forceinline__ unsigned xb_ld(unsigned* p)              { return __hip_atomic_load(p, __ATOMIC_RELAXED, __HIP_MEMORY_SCOPE_AGENT); }
__device__ __forceinline__ unsigned xb_add(unsigned* p, unsigned v) { return __hip_atomic_fetch_add(p, v, __ATOMIC_RELAXED, __HIP_MEMORY_SCOPE_AGENT); }
__device__ __forceinline__ unsigned xb_xcc_id() { return (unsigned)__builtin_amdgcn_s_getreg((3 << 11) | 20) & 0xFu; }
#define XB_SPIN(cond, bar) do { unsigned _sp = 0; while (cond) { __builtin_amdgcn_s_sleep(1); \
    if ((++_sp & 255u) == 0u) { if (xb_ld(&(bar)[XB_TMO])) break; if (_sp > XB_SPIN_CAP) { atomicAdd(&(bar)[XB_TMO], 1u); break; } } } } while (0)
struct XcdBarrier { unsigned* bar; unsigned x; volatile LAS unsigned* st; };
__device__ __forceinline__ XcdBarrier xcd_barrier_post(unsigned* bar, volatile LAS unsigned* st) {
    XcdBarrier b; b.bar = bar; b.x = xb_xcc_id(); b.st = st;
    if (threadIdx.x == 0) (void)xb_add(&bar[XB_XCNT(b.x)], 1u);
    return b;
}
__device__ __forceinline__ void xcd_barrier_complete(unsigned* bar, unsigned x, unsigned& nloc, unsigned& nx) {
    const unsigned G = gridDim.x * gridDim.y * gridDim.z;
    unsigned sum, cnt, mine, sp = 0u;
    for (;;) {
        sum = 0u; cnt = 0u; mine = 0u;
#pragma unroll
        for (unsigned j = 0; j < 16; ++j) { const unsigned c = xb_ld(&bar[XB_XCNT(j)]); sum += c; cnt += (c > 0u) ? 1u : 0u; mine = (j == x) ? c : mine; }
        if (sum == G) break;
        __builtin_amdgcn_s_sleep(1);
        if ((++sp & 255u) == 0u) { if (xb_ld(&bar[XB_TMO])) break; if (sp > XB_SPIN_CAP) { atomicAdd(&bar[XB_TMO], 1u); break; } }
    }
    nloc = mine > 0u ? mine : 1u; nx = cnt > 0u ? cnt : 1u;
}
__device__ __forceinline__ void xcd_barrier(const XcdBarrier& b) {
    asm volatile("s_waitcnt vmcnt(0)" ::: "memory");
    __syncthreads();
    if (threadIdx.x == 0) {
        unsigned* bar = b.bar;
        __builtin_amdgcn_s_waitcnt(0);
        unsigned nloc = b.st[0], nx = b.st[1];
        if (nloc == 0u) { xcd_barrier_complete(bar, b.x, nloc, nx); b.st[0] = nloc; b.st[1] = nx; }
        const unsigned old = xb_add(&bar[XB_XSUB(b.x)], 1u);
        const unsigned gen = old / nloc;
        if (old + 1u == (gen + 1u) * nloc) {
            __builtin_amdgcn_fence(__ATOMIC_RELEASE, "agent");
            asm volatile("s_waitcnt vmcnt(0)" ::: "memory");
            const unsigned og = xb_add(&bar[XB_TOP], 1u);
            const unsigned tg = og / nx;
            if (og + 1u == (tg + 1u) * nx) xb_add(&bar[XB_TOPGEN], 1u);
            else XB_SPIN(xb_ld(&bar[XB_TOPGEN]) == tg, bar);
            __builtin_amdgcn_fence(__ATOMIC_ACQUIRE, "agent");
            xb_add(&bar[XB_XGEN(b.x)], 1u);
            asm volatile("s_waitcnt vmcnt(0)" ::: "memory");
        } else {
            XB_SPIN(xb_ld(&bar[XB_XGEN(b.x)]) == gen, bar);
            __builtin_amdgcn_fence(__ATOMIC_ACQUIRE, "agent");
            asm volatile("s_waitcnt vmcnt(0)" ::: "memory");
        }
    }
    __syncthreads();
}

struct KArgs { const float* in[22]; float* out; unsigned char* ws; int ph_lo, ph_hi; };
enum { I_X = 0, I_C, I_CTX, I_CCTX, I_ADAW, I_ADAB, I_NMPRE, I_NMPOST, I_NFPRE, I_NFPOST, I_HWIN, I_HLB, I_HONORM, I_HWOUT, I_AQKV, I_AQN, I_AKN, I_AWOUT, I_FWIN, I_FCW, I_FCB, I_FWOUT };
constexpr int N_PHASES = 20;

__global__ void __launch_bounds__(512, 2) mega_fwd(KArgs a) {
    extern __shared__ __attribute__((aligned(16))) unsigned char lds_raw[];
    LAS unsigned char* lds = (LAS unsigned char*)lds_raw;
    cg::grid_group grid = cg::this_grid();
    const int tid = threadIdx.x, lane = tid & 63, wave = __builtin_amdgcn_readfirstlane(tid >> 6);
    const int G = gridDim.x, wg = blockIdx.x;
    const int gw = wg * 8 + wave, NGW = G * 8;
    unsigned char* ws = a.ws;
    float* mod = (float*)(ws + WS_MOD);
    float* xctx = (float*)(ws + WS_XCTX);
    bf16_t* H = (bf16_t*)(ws + WS_H);
    bf16_t* BIG = (bf16_t*)(ws + WS_BIG);
    bf16_t* Y = (bf16_t*)(ws + WS_BIG);
    bf16_t* XR = (bf16_t*)(ws + WS_BIG + 256 * MiB);
    float* BND = (float*)(ws + WS_BIG + 200 * MiB);
    float* YS = (float*)(ws + WS_BIG + 132 * MiB);
    bf16_t* ACT = (bf16_t*)(ws + WS_ACT);
    bf16_t* OFW = ACT; bf16_t* OBW = ACT + (size_t)MR * DM;
    const int lo = a.ph_lo, hi = a.ph_hi;
#ifndef MK_REPMASK
#define MK_REPMASK 0u
#endif
#define PH(k) if (lo <= (k) && (k) < hi) for (int rep_ = 0; rep_ <= (int)((MK_REPMASK >> (k)) & 1u); ++rep_)
#define SEAM(k) do { if ((k) + 1 < hi) { if ((k) == 0) { asm volatile("s_waitcnt vmcnt(0) lgkmcnt(0)" ::: "memory"); grid.sync(); } else xcd_barrier(bar); } } while (0)
    LAS float* scr = (LAS float*)(lds + wave * 16384);
    volatile LAS unsigned* MISC = (volatile LAS unsigned*)(lds + LDS_BYTES - 256);
    if (tid < 16) MISC[tid] = 0u;
    __syncthreads();
    XcdBarrier bar = xcd_barrier_post((unsigned*)ws, MISC);

    PH(0) {
        ada_phase(a.in[I_C], a.in[I_CCTX], a.in[I_ADAW], a.in[I_ADAB], mod, lds, wg, G, tid);
        constexpr int I0 = 32 * (NHG / 32), I1 = 32 * (DM / 32), I2 = 32 * (2 * DFF / 32), I3 = (DFF / 64) * (DM / 32);
        for (int it = gw; it < I0 + I1 + I2 + I3; it += NGW) {
            int r = it;
            if (r < I0) { transpose_item(a.in[I_HWIN], DM, NHG, (bf16_t*)(ws + W_HIN), scr, r, lane); continue; } r -= I0;
            if (r < I1) { transpose_item(a.in[I_HWOUT], DM, DM, (bf16_t*)(ws + W_HOUT), scr, r, lane); continue; } r -= I1;
            if (r < I2) { transpose_item(a.in[I_FWIN], DM, 2 * DFF, (bf16_t*)(ws + W_FIN), scr, r, lane, true); continue; } r -= I2;
            transpose_item(a.in[I_FWOUT], DFF, DM, (bf16_t*)(ws + W_FOUT), scr, r, lane);
        }
        SEAM(0);
    }
    PH(1) {
        row_phase<false, false>(a.in[I_X], a.in[I_CTX], nullptr, nullptr, XR, nullptr, nullptr, a.in[I_NMPRE], mod, 0, 0, 1, H, false, true, false, gw, NGW, lane);
        SEAM(1);
    }
    PH(2) {
        pg8::Gemm g{H, (const bf16_t*)(ws + W_HIN), MR, NHG, DM}; pg8::Order S; S.init(MR / 256, NHG, DM, G, wg, 0, 0);
        pg8::EpiBf16 E{BIG, NHG};
        pg8::gemm_phase<pg8::EpiBf16, pg8::Order, true, true>(lds, g, S, E);
        SEAM(2);
    }
    PH(3) {
        float* EB = (float*)(ACT + (size_t)2 * MR * DM);
        if (rep_ == 0) gla_prep_phase(BIG, H, EB, a.in[I_HLB], lds, wg, G, tid);
        xcd_barrier(bar);
        for (int item = wg; item < 256; item += G) {
            const int xq = item & 7, yq = item >> 3, vs = yq & 3, sq = xq + 8 * (yq >> 2);
            const int dir = sq & 1, h = (sq >> 1) & 15, b = sq >> 5;
            gla_item(BIG, dir ? H : BIG, dir ? DM : NHG, EB, dir ? OBW : OFW, lds, b, h, dir, vs, tid);
        }
        SEAM(3);
    }
    PH(4) {
        readout_phase(OFW, OBW, BIG, a.in[I_HONORM], H, gw, NGW, lane);
        SEAM(4);
    }
    PH(5) {
        pg8::Gemm g{H, (const bf16_t*)(ws + W_HOUT), MR, DM, DM}; pg8::Order S; S.init(64, DM, DM, G, wg, 1, 16);
        pg8::EpiF32 E{Y, DM, YS, DM / 64};
        pg8::gemm_phase<pg8::EpiF32, pg8::Order, true, true>(lds, g, S, E);
        SEAM(5);
    }
    PH(6) {
        row_phase<false, true>(a.in[I_X], a.in[I_CTX], a.out, xctx, XR, Y, a.in[I_NMPOST], a.in[I_NFPRE], mod, 2, 3, 4, H, true, true, false, gw, NGW, lane, YS, 16);
        SEAM(6);
    }
    PH(7) {
        pg8::Gemm g{H, (const bf16_t*)(ws + W_FIN), MR, 2 * DFF, DM}; pg8::Order S; S.init(MR / 256, 2 * DFF, DM, G, wg, 0, 0);
        pg8::EpiConv E{ACT, a.in[I_FCW], a.in[I_FCB], BND, (LAS float*)(lds + 131072)};
        pg8::gemm_phase<pg8::EpiConv, pg8::Order, true, true>(lds, g, S, E);
        SEAM(7);
    }
    PH(8) {
        conv_fix_phase(BND, a.in[I_FCW], a.in[I_FCB], ACT, false, gw, NGW, lane);
        SEAM(8);
    }
    PH(9) {
        pg8::Gemm g{ACT, (const bf16_t*)(ws + W_FOUT), MR, DM, DFF}; pg8::Order S; S.init(64, DM, DFF, G, wg, 1, 11);
        pg8::EpiF32 E{Y, DM, YS, DFF / 64};
        pg8::gemm_phase<pg8::EpiF32, pg8::Order, true, true>(lds, g, S, E);
        SEAM(9);
    }
    PH(10) {
        row_phase<true, true>(a.out, xctx, a.out, xctx, XR, Y, a.in[I_NFPOST], a.in[I_NMPRE] + DM, mod, 5, 6 * 3 + 0, 6 * 3 + 1, H, true, true, false, gw, NGW, lane, YS, 11);
        __syncthreads();
        constexpr int I0 = 32 * (NQKV / 32), I1 = 32 * (DM / 32), I2 = 32 * (2 * DFF / 32), I3 = (DFF / 64) * (DM / 32);
        for (int it = gw; it < I0 + I1 + I2 + I3; it += NGW) {
            int r = it;
            if (r < I0) { transpose_item(a.in[I_AQKV], DM, NQKV, (bf16_t*)(ws + W_QKV), scr, r, lane); continue; } r -= I0;
            if (r < I1) { transpose_item(a.in[I_AWOUT], DM, DM, (bf16_t*)(ws + W_AOUT), scr, r, lane); continue; } r -= I1;
            if (r < I2) { transpose_item(a.in[I_FWIN] + (size_t)DM * 2 * DFF, DM, 2 * DFF, (bf16_t*)(ws + W_FIN), scr, r, lane, true); continue; } r -= I2;
            transpose_item(a.in[I_FWOUT] + (size_t)DFF * DM, DFF, DM, (bf16_t*)(ws + W_FOUT), scr, r, lane);
        }
        SEAM(10);
    }
    PH(11) {
        pg8::Gemm g{H, (const bf16_t*)(ws + W_QKV), MR, NQKV, DM}; pg8::Order S; S.init(MR / 256, NQKV, DM, G, wg, 0, 0);
        pg8::EpiBf16 E{BIG, NQKV};
        pg8::gemm_phase<pg8::EpiBf16, pg8::Order, true, true>(lds, g, S, E);
        SEAM(11);
    }
    PH(12) {
        qknorm_phase(BIG, a.in[I_AQN], a.in[I_AKN], gw, NGW, lane);
        SEAM(12);
    }
    PH(13) {
        for (int u = wg; u < 1024; u += G) {
            const int x = u & 7, rest = u >> 3, j = rest & 31, i = rest >> 5;
            const int b = x >> 2, kvh = x & 3, h = kvh * 4 + i;
            const size_t qrow = (size_t)b * SB + CTX + (size_t)j * 256;
            att::attn_dense_body(BIG + qrow * NQKV + h * 128, BIG + (size_t)b * SB * NQKV + 2048 + kvh * 128, BIG + (size_t)b * SB * NQKV + 2560 + kvh * 128,
                                 ACT + qrow * DM + h * 128, SB, (char*)lds_raw);
        }
        SEAM(13);
    }
    PH(14) {
        pg8::Gemm g{ACT, (const bf16_t*)(ws + W_AOUT), MR, DM, DM}; pg8::Order S; S.init(64, DM, DM, G, wg, 1, 0);
        pg8::EpiF32 E{Y, DM, nullptr, 0};
        pg8::gemm_phase<pg8::EpiF32, pg8::Order, true, true>(lds, g, S, E);
        SEAM(14);
    }
    PH(15) {
        row_phase<true, true>(a.out, xctx, a.out, xctx, XR, Y, a.in[I_NMPOST] + DM, a.in[I_NFPRE] + DM, mod + 3 * 12288, 2, 3, 4, H, true, true, true, gw, NGW, lane);
        SEAM(15);
    }
    PH(16) {
        pg8::Gemm g{H, (const bf16_t*)(ws + W_FIN), MR, 2 * DFF, DM}; pg8::Order S; S.init(64, 2 * DFF, DM, G, wg, 1, 0);
        pg8::EpiConv E{ACT, a.in[I_FCW] + 3 * DFF, a.in[I_FCB] + DFF, BND, (LAS float*)(lds + 131072)};
        pg8::gemm_phase<pg8::EpiConv, pg8::Order, true, true>(lds, g, S, E);
        SEAM(16);
    }
    PH(17) {
        conv_fix_phase(BND, a.in[I_FCW] + 3 * DFF, a.in[I_FCB] + DFF, ACT, true, gw, NGW, lane);
        SEAM(17);
    }
    PH(18) {
        pg8::Gemm g{ACT, (const bf16_t*)(ws + W_FOUT), MR, DM, DFF}; pg8::Order S; S.init(64, DM, DFF, G, wg, 1, 0);
        pg8::EpiF32 E{Y, DM, nullptr, 0};
        pg8::gemm_phase<pg8::EpiF32, pg8::Order, true, true>(lds, g, S, E);
        SEAM(18);
    }
    PH(19) {
        row_phase<true, false>(a.out, xctx, a.out, xctx, XR, Y, a.in[I_NFPOST] + DM, nullptr, mod + 3 * 12288, 5, 0, 0, H, true, false, true, gw, NGW, lane);
    }
#undef PH
#undef SEAM
}


extern "C" void kernel_launch(void* const* d_in, const int* in_sizes, int n_in, void* d_out, int out_size, void* d_ws, size_t ws_size, hipStream_t stream) {
    static int grid = 0;
    if (grid == 0) {
        if (n_in != 22 || ws_size < WS_END || out_size != NB * SEQ * DM) { fprintf(stderr, "kernel_launch: unexpected shapes n_in %d ws %zu out %d\n", n_in, ws_size, out_size); grid = -1; return; }
        int dev = 0, cus = 0, per_cu = 0;
        if (hipGetDevice(&dev) != hipSuccess || hipDeviceGetAttribute(&cus, hipDeviceAttributeMultiprocessorCount, dev) != hipSuccess) { grid = -1; return; }
        if (hipFuncSetAttribute((const void*)mega_fwd, hipFuncAttributeMaxDynamicSharedMemorySize, LDS_BYTES) != hipSuccess) { fprintf(stderr, "kernel_launch: hipFuncSetAttribute failed\n"); grid = -1; return; }
        if (hipOccupancyMaxActiveBlocksPerMultiprocessor(&per_cu, (const void*)mega_fwd, 512, LDS_BYTES) != hipSuccess || per_cu < 1) { fprintf(stderr, "kernel_launch: occupancy query says %d\n", per_cu); per_cu = 1; }
        (void)hipGetLastError();
        grid = cus * 1;
    }
    if (grid < 0) return;
    KArgs a{};
    for (int i = 0; i < 22; ++i) a.in[i] = (const float*)d_in[i];
    a.out = (float*)d_out; a.ws = (unsigned char*)d_ws;
    a.ph_lo = 0; a.ph_hi = N_PHASES;
    if (hipMemsetAsync(d_ws, 0, 16384, stream) != hipSuccess) { fprintf(stderr, "kernel_launch: memset failed\n"); return; }
    void* args[] = {&a};
    hipError_t e = hipLaunchCooperativeKernel((const void*)mega_fwd, dim3(grid), dim3(512), args, LDS_BYTES, stream);
    if (e != hipSuccess) fprintf(stderr, "cooperative launch failed: %s (grid %d)\n", hipGetErrorString(e), grid);
}
```

```cpp
#include <hip/hip_runtime.h>
#include <hip/hip_cooperative_groups.h>
#include <cstdio>
#include <cstdint>
namespace cg = cooperative_groups;

#define LAS __attribute__((address_space(3)))
typedef unsigned short bf16_t;
typedef short bf16x8 __attribute__((ext_vector_type(8)));
typedef float f32x4 __attribute__((ext_vector_type(4)));
typedef float f32x2 __attribute__((ext_vector_type(2)));
typedef float f32x16 __attribute__((ext_vector_type(16)));
typedef unsigned u32x4 __attribute__((ext_vector_type(4)));
typedef unsigned u32x2 __attribute__((ext_vector_type(2)));
typedef short s16x4 __attribute__((ext_vector_type(4)));

constexpr int DM = 2048, NB = 2, SEQ = 8192, CTX = 256, SB = SEQ + CTX, MR = NB * SB;
constexpr int NH = 16, HD = 128, NKV = 4, DFF = 5632, NQKV = 3072, NHG = 5 * DM;
constexpr float EPS = 1e-6f;

constexpr size_t MiB = 1u << 20;
constexpr size_t WS_MOD = 64 * 1024;
constexpr size_t WS_XCTX = 2 * MiB;
constexpr size_t WS_W = 6 * MiB;
constexpr size_t W_HIN = WS_W, W_HOUT = WS_W + 40 * MiB, W_FIN = WS_W + 48 * MiB, W_FOUT = WS_W + 92 * MiB;
constexpr size_t W_QKV = WS_W, W_AOUT = WS_W + 12 * MiB;
constexpr size_t WS_H = 120 * MiB;
constexpr size_t WS_BIG = 186 * MiB;
constexpr size_t WS_ACT = 549 * MiB;
constexpr size_t WS_END = WS_ACT + (size_t)MR * DFF * 2;
static_assert(WS_END <= 768 * MiB, "ws");

constexpr int LDS_BYTES = 147456;

typedef __bf16 bf16x2_t __attribute__((ext_vector_type(2)));
__device__ __forceinline__ unsigned cvt_pk_bf16(float lo, float hi) { f32x2 v = {lo, hi}; bf16x2_t b = __builtin_convertvector(v, bf16x2_t); return __builtin_bit_cast(unsigned, b); }
__device__ __forceinline__ unsigned f2bf(float f) { unsigned u = __builtin_bit_cast(unsigned, f); return (u + 0x7fffu + ((u >> 16) & 1u)) >> 16; }
__device__ __forceinline__ unsigned pk2(float lo, float hi) { return f2bf(lo) | (f2bf(hi) << 16); }
__device__ __forceinline__ float bflo(unsigned u) { return __builtin_bit_cast(float, u << 16); }
__device__ __forceinline__ float bfhi(unsigned u) { return __builtin_bit_cast(float, u & 0xffff0000u); }
__device__ __forceinline__ float wave_sum(float v) {
#pragma unroll
    for (int o = 1; o < 64; o <<= 1) v += __shfl_xor(v, o);
    return v;
}
__device__ __forceinline__ float siluf(float v) { return v / (1.f + __expf(-v)); }
#define LBAR() do { asm volatile("s_waitcnt lgkmcnt(0)" ::: "memory"); __builtin_amdgcn_s_barrier(); asm volatile("" ::: "memory"); } while (0)

namespace pg8 {
constexpr int BM = 256, BK = 64, HALF = 128, HTB = HALF * BK * 2, STAGE_BYTES = 8 * HTB, NXCD = 8, WGM = 4;
__host__ __device__ __forceinline__ int lds_byte(int r, int c) { const int st = (r >> 4) * 2 + (c >> 5), rr = r & 15, cc = c & 31, ob = rr * 64 + cc * 2; return st * 1024 + (ob ^ (((ob >> 9) & 1) << 5)); }
__host__ __device__ __forceinline__ void stage_rc(int b, int& R, int& C) { const int st = b / 1024, sb = b % 1024, swz = sb ^ (((sb >> 9) & 1) << 5); R = (st >> 1) * 16 + swz / 64; C = (st & 1) * 32 + (swz % 64) / 2; }
__host__ __device__ __forceinline__ int perm32(int rho) { const int n = rho >> 4, i = rho & 15; return 8 * (i >> 2) + 4 * n + (i & 3); }

struct Unit { int pm, pn, kn; };
struct Gemm { const bf16_t* A; const bf16_t* Bt; int M, N, K; };

struct Order {
    int nM, nN, nwg, G, c, skip, ntf, nsplit;
    __device__ void init(int nM_, int N, int K, int G_, int c_, int skip_, int nsplit_) { nM = nM_; nN = N / BM; nwg = nM * nN; G = G_; c = c_; skip = skip_; ntf = K / BK; nsplit = nsplit_; }
    __device__ bool next(int i, Unit& u) const {
        const long L = (long)i * G + c;
        if (L >= nwg) {
            const int j = (int)(L - nwg); if (j >= 2 * nN * nsplit) return false;
            const int sidx = j % nsplit, cu = j / nsplit, cr = cu / nN;
            const int ntu = ntf / nsplit; u.pm = cr ? 33 : 0; u.pn = cu % nN; u.kn = (sidx * ntu) | (ntu << 16); return true;
        }
        int wgid = (int)L; { const int q = nwg / NXCD, r = nwg % NXCD, xcd = wgid % NXCD, off = wgid / NXCD; wgid = (xcd < r ? xcd * (q + 1) : r * (q + 1) + (xcd - r) * q) + off; }
        const int nig = WGM * nN, gid = wgid / nig, fm = gid * WGM, gsz = (nM - fm) < WGM ? (nM - fm) : WGM;
        int pm = fm + ((wgid % nig) % gsz); u.pn = (wgid % nig) / gsz;
        if (skip) pm = pm + 1 + (pm >= 32 ? 1 : 0);
        u.pm = pm; u.kn = ntf << 16; return true;
    }
    __device__ __forceinline__ void a_ready(const Unit&) const {}
    __device__ __forceinline__ void done(const Unit&) const {}
};

struct EpiBf16 {
    static constexpr bool PERM = true, AFTER_DRAIN = false;
    bf16_t* O; int ldc;
    __device__ __forceinline__ void operator()(const f32x4 (&acc)[2][2][4][2], const Unit& u, int wr, int wc, int fr, int fq) const {
        const int row0 = u.pm * BM + wr * 64 + fr; const int col0 = u.pn * BM + wc * 32 + 8 * fq;
#pragma unroll
        for (int ai = 0; ai < 2; ++ai)
#pragma unroll
            for (int m = 0; m < 4; ++m) { bf16_t* rowp = O + (size_t)(row0 + ai * HALF + m * 16) * ldc + col0;
#pragma unroll
                for (int bj = 0; bj < 2; ++bj) { const f32x4 v0 = acc[ai][bj][m][0], v1 = acc[ai][bj][m][1];
                    u32x4 w; w.x = cvt_pk_bf16(v0[0], v0[1]); w.y = cvt_pk_bf16(v0[2], v0[3]); w.z = cvt_pk_bf16(v1[0], v1[1]); w.w = cvt_pk_bf16(v1[2], v1[3]);
                    *(u32x4*)(rowp + bj * HALF) = w; } }
    }
};
struct EpiF32 {
    static constexpr bool PERM = true, AFTER_DRAIN = false;
    bf16_t* O; int ldc; float* SL; int ntf;
    __device__ __forceinline__ void operator()(const f32x4 (&acc)[2][2][4][2], const Unit& u, int wr, int wc, int fr, int fq) const {
        const int ntu = u.kn >> 16, kt0 = u.kn & 0xffff;
        const int row0 = wr * 64 + fr; const int col0 = u.pn * BM + wc * 32 + 8 * fq;
        if (ntu < ntf) {
            float* basep = SL + ((size_t)(kt0 / ntu) * 512 + (u.pm == 33 ? 256 : 0)) * ldc;
#pragma unroll
            for (int ai = 0; ai < 2; ++ai)
#pragma unroll
                for (int m = 0; m < 4; ++m) { float* rowp = basep + (size_t)(row0 + ai * HALF + m * 16) * ldc + col0;
#pragma unroll
                    for (int bj = 0; bj < 2; ++bj) { *(f32x4*)(rowp + bj * HALF) = acc[ai][bj][m][0]; *(f32x4*)(rowp + bj * HALF + 4) = acc[ai][bj][m][1]; } }
        } else {
            bf16_t* basep = O + (size_t)u.pm * BM * ldc;
#pragma unroll
            for (int ai = 0; ai < 2; ++ai)
#pragma unroll
                for (int m = 0; m < 4; ++m) { bf16_t* rowp = basep + (size_t)(row0 + ai * HALF + m * 16) * ldc + col0;
#pragma unroll
                    for (int bj = 0; bj < 2; ++bj) { const f32x4 v0 = acc[ai][bj][m][0], v1 = acc[ai][bj][m][1];
                        u32x4 w; w.x = cvt_pk_bf16(v0[0], v0[1]); w.y = cvt_pk_bf16(v0[2], v0[3]); w.z = cvt_pk_bf16(v1[0], v1[1]); w.w = cvt_pk_bf16(v1[2], v1[3]);
                        *(u32x4*)(rowp + bj * HALF) = w; } }
        }
    }
};

template <int CTRL> __device__ __forceinline__ float dpp_upd(float oldv, float src) {
    return __builtin_bit_cast(float, __builtin_amdgcn_update_dpp(__builtin_bit_cast(int, oldv), __builtin_bit_cast(int, src), CTRL, 0xf, 0xf, false)); }
template <int M> __device__ __forceinline__ float conv_elem(float gp, float gc, float gn, float up, float hp, float hn, float w0, float w1, float w2, float cb) {
    const float X = (M == 0) ? hp : dpp_upd<0x121>(0.f, gp);
    const float prev = dpp_upd<0x111>(X, gc);
    const float Yv = (M == 3) ? hn : dpp_upd<0x12F>(0.f, gn);
    const float next = dpp_upd<0x101>(Yv, gc);
    const float y = w0 * prev + w1 * gc + w2 * next + cb;
    return y * __builtin_amdgcn_rcpf(1.f + __builtin_amdgcn_exp2f(y * -1.4426950408889634f)) * up;
}
template <int M> __device__ __forceinline__ f32x4 conv_group(const f32x4 GP, const f32x4 GC, const f32x4 GN, const f32x4 up, const f32x4 hp, const f32x4 hn, const f32x4 w0, const f32x4 w1, const f32x4 w2, const f32x4 cb) {
    f32x4 r;
    r.x = conv_elem<M>(GP.x, GC.x, GN.x, up.x, hp.x, hn.x, w0.x, w1.x, w2.x, cb.x);
    r.y = conv_elem<M>(GP.y, GC.y, GN.y, up.y, hp.y, hn.y, w0.y, w1.y, w2.y, cb.y);
    r.z = conv_elem<M>(GP.z, GC.z, GN.z, up.z, hp.z, hn.z, w0.z, w1.z, w2.z, cb.z);
    r.w = conv_elem<M>(GP.w, GC.w, GN.w, up.w, hp.w, hn.w, w0.w, w1.w, w2.w, cb.w);
    return r;
}
struct EpiConv {
    static constexpr bool PERM = true, AFTER_DRAIN = false;
    bf16_t* ACT; const float* cw; const float* cbias; float* BND; LAS float* xch;
    __device__ __forceinline__ void operator()(const f32x4 (&acc)[2][2][4][2], const Unit& u, int wr_, int wc_, int fr_, int fq_) const {
        int wr = wr_, wc = wc_, fr = fr_, fq = fq_;
        asm volatile("" : "+v"(fr), "+v"(fq), "+s"(wr), "+s"(wc));
        const int cl = wc * 32 + 8 * fq, f0 = u.pn * 128 + cl;
#pragma unroll
        for (int ai = 0; ai < 2; ++ai) { const int blk = 2 * ai + wr;
            if (fr == 0) { *(LAS f32x4*)(xch + (blk * 2 + 0) * 128 + cl) = acc[ai][0][0][0]; *(LAS f32x4*)(xch + (blk * 2 + 0) * 128 + cl + 4) = acc[ai][0][0][1]; }
            if (fr == 15) { *(LAS f32x4*)(xch + (blk * 2 + 1) * 128 + cl) = acc[ai][0][3][0]; *(LAS f32x4*)(xch + (blk * 2 + 1) * 128 + cl + 4) = acc[ai][0][3][1]; } }
        { float* bnd = BND + (size_t)u.pm * 6 * DFF + f0;
          if (wr == 0 && fr < 2) { *(f32x4*)(bnd + fr * DFF) = acc[0][0][0][0]; *(f32x4*)(bnd + fr * DFF + 4) = acc[0][0][0][1]; }
          asm volatile("" ::: "memory");
          if (wr == 0 && fr == 0) { *(f32x4*)(bnd + 4 * DFF) = acc[0][1][0][0]; *(f32x4*)(bnd + 4 * DFF + 4) = acc[0][1][0][1]; }
          asm volatile("" ::: "memory");
          if (wr == 1 && fr >= 14) { *(f32x4*)(bnd + (fr - 12) * DFF) = acc[1][0][3][0]; *(f32x4*)(bnd + (fr - 12) * DFF + 4) = acc[1][0][3][1]; }
          asm volatile("" ::: "memory");
          if (wr == 1 && fr == 15) { *(f32x4*)(bnd + 5 * DFF) = acc[1][1][3][0]; *(f32x4*)(bnd + 5 * DFF + 4) = acc[1][1][3][1]; }
        }
        LBAR(); __builtin_amdgcn_sched_barrier(0);
        const f32x4 w00 = *(const f32x4*)(cw + f0), w01 = *(const f32x4*)(cw + f0 + 4), w10 = *(const f32x4*)(cw + DFF + f0), w11 = *(const f32x4*)(cw + DFF + f0 + 4);
        const f32x4 w20 = *(const f32x4*)(cw + 2 * DFF + f0), w21 = *(const f32x4*)(cw + 2 * DFF + f0 + 4), cb0 = *(const f32x4*)(cbias + f0), cb1 = *(const f32x4*)(cbias + f0 + 4);
#pragma unroll
        for (int ai = 0; ai < 2; ++ai) { const int blk = 2 * ai + wr;
            f32x4 hp0 = {0.f, 0.f, 0.f, 0.f}, hp1 = hp0, hn0 = hp0, hn1 = hp0;
            if (blk > 0) { hp0 = *(const LAS f32x4*)(xch + ((blk - 1) * 2 + 1) * 128 + cl); hp1 = *(const LAS f32x4*)(xch + ((blk - 1) * 2 + 1) * 128 + cl + 4); }
            if (blk < 3) { hn0 = *(const LAS f32x4*)(xch + ((blk + 1) * 2 + 0) * 128 + cl); hn1 = *(const LAS f32x4*)(xch + ((blk + 1) * 2 + 0) * 128 + cl + 4); }
#define CONV_ROW(M, MP, MN) do { __builtin_amdgcn_sched_barrier(0); \
            const f32x4 v0 = conv_group<M>(acc[ai][0][MP][0], acc[ai][0][M][0], acc[ai][0][MN][0], acc[ai][1][M][0], hp0, hn0, w00, w10, w20, cb0); \
            const f32x4 v1 = conv_group<M>(acc[ai][0][MP][1], acc[ai][0][M][1], acc[ai][0][MN][1], acc[ai][1][M][1], hp1, hn1, w01, w11, w21, cb1); \
            const int rl = ai * HALF + wr * 64 + M * 16 + fr; \
            if (rl != 0 && rl != 255) { u32x4 w; w.x = cvt_pk_bf16(v0[0], v0[1]); w.y = cvt_pk_bf16(v0[2], v0[3]); w.z = cvt_pk_bf16(v1[0], v1[1]); w.w = cvt_pk_bf16(v1[2], v1[3]); \
                *(u32x4*)(ACT + (size_t)(u.pm * BM + rl) * DFF + f0) = w; } } while (0)
            CONV_ROW(0, 0, 1); CONV_ROW(1, 0, 2); CONV_ROW(2, 1, 3); CONV_ROW(3, 2, 3);
#undef CONV_ROW
            __builtin_amdgcn_sched_barrier(0);
        }
    }
};

template <class Epi, class Sched, bool ALIGN_EPI = false, bool SP2 = false>
__device__ __forceinline__ void gemm_phase(LAS unsigned char* lds, const Gemm g, const Sched& S, const Epi& E) {
    const int tid = threadIdx.x, wid = __builtin_amdgcn_readfirstlane(tid >> 6), lane = tid & 63, wr = wid >> 2, wc = wid & 3, fr = lane & 15, fq = lane >> 4;
    const int K = g.K;
    unsigned voffA[2], voffB[2];
#pragma unroll
    for (int i = 0; i < 2; ++i) { int R, C; stage_rc(tid * 16 + i * 8192, R, C); const int Rb = Epi::PERM ? ((R & ~31) + perm32(R & 31)) : R;
        voffA[i] = (unsigned)(R * K + C) * 2u; voffB[i] = (unsigned)(Rb * K + C) * 2u; }
    const size_t kstep = (size_t)(BK * 2);
    const size_t hstep = (size_t)HALF * K * 2;
    const size_t tstep = 2 * hstep;
    const unsigned ldsw = (unsigned)wid * 1024u;
    const int aoff = lds_byte(wr * 64 + fr, fq * 8), boff = lds_byte(wc * 32 + fr, fq * 8);
#define PG8_SA(b, h) (((b) * 2 + (h)) * HTB)
#define PG8_SB(b, h) ((4 + (b) * 2 + (h)) * HTB)
#define PG8_STAGE(bufoff, gbase, voff) do { _Pragma("unroll") for (int _i = 0; _i < 2; ++_i) \
        __builtin_amdgcn_global_load_lds((const unsigned*)((const char*)(gbase) + (voff)[_i]), (LAS unsigned*)(lds + (bufoff) + ldsw + _i * 8192), 16, 0, 0); } while (0)
#define PG8_LDA(dst, b, h) do { _Pragma("unroll") for (int m = 0; m < 4; ++m) _Pragma("unroll") for (int k = 0; k < 2; ++k) dst[m][k] = *(const LAS bf16x8*)(lds + PG8_SA(b, h) + aoff + m * 2048 + k * 1024); } while (0)
#define PG8_LDB(dst, b, h) do { _Pragma("unroll") for (int n = 0; n < 2; ++n) _Pragma("unroll") for (int k = 0; k < 2; ++k) dst[n][k] = *(const LAS bf16x8*)(lds + PG8_SB(b, h) + boff + n * 2048 + k * 1024); } while (0)
#define PG8_MMA(ai, bj, At, Bt) do { __builtin_amdgcn_s_setprio(1); _Pragma("unroll") for (int m = 0; m < 4; ++m) _Pragma("unroll") for (int n = 0; n < 2; ++n) _Pragma("unroll") for (int k = 0; k < 2; ++k) \
        acc[ai][bj][m][n] = __builtin_amdgcn_mfma_f32_16x16x32_bf16(Bt[n][k], At[m][k], acc[ai][bj][m][n], 0, 0, 0); __builtin_amdgcn_s_setprio(0); } while (0)
#define PG8_WAIT_V(n) asm volatile("s_waitcnt vmcnt(" #n ")" ::: "memory")
#define PG8_WAIT_L(n) asm volatile("s_waitcnt lgkmcnt(" #n ")" ::: "memory")
#define PG8_BAR __builtin_amdgcn_s_barrier()
#define PG8_SCHED __builtin_amdgcn_sched_barrier(0)
    Unit cur, nxt; int ui = 0;
    if (!S.next(0, cur)) return;
    f32x4 acc[2][2][4][2];
#pragma unroll
    for (int a = 0; a < 2; ++a)
#pragma unroll
        for (int b = 0; b < 2; ++b)
#pragma unroll
            for (int m = 0; m < 4; ++m)
#pragma unroll
                for (int n = 0; n < 2; ++n) acc[a][b][m][n] = (f32x4){0.f, 0.f, 0.f, 0.f};
    bf16x8 At[4][2], B0[2][2], B1[2][2];
    const char* cA = (const char*)g.A + (size_t)cur.pm * tstep + (size_t)(cur.kn & 0xffff) * kstep; const char* cB = (const char*)g.Bt + (size_t)cur.pn * tstep + (size_t)(cur.kn & 0xffff) * kstep;
    S.a_ready(cur);
    if constexpr (SP2) {
        PG8_STAGE(PG8_SB(0, 0), cB, voffB); PG8_STAGE(PG8_SB(0, 1), cB + hstep, voffB); PG8_STAGE(PG8_SA(0, 0), cA, voffA); PG8_STAGE(PG8_SA(0, 1), cA + hstep, voffA);
        if (wr == 1) PG8_BAR;
        PG8_WAIT_V(2); PG8_BAR;
        PG8_STAGE(PG8_SB(1, 0), cB + kstep, voffB); PG8_STAGE(PG8_SA(1, 0), cA + kstep, voffA); PG8_STAGE(PG8_SB(1, 1), cB + hstep + kstep, voffB);
        PG8_WAIT_V(6); PG8_BAR;
    } else {
        PG8_STAGE(PG8_SB(0, 0), cB, voffB); PG8_STAGE(PG8_SA(0, 0), cA, voffA); PG8_STAGE(PG8_SB(0, 1), cB + hstep, voffB); PG8_STAGE(PG8_SA(0, 1), cA + hstep, voffA);
        if (wr == 1) PG8_BAR;
        PG8_WAIT_V(4); PG8_BAR;
        PG8_STAGE(PG8_SB(1, 0), cB + kstep, voffB); PG8_STAGE(PG8_SA(1, 0), cA + kstep, voffA); PG8_STAGE(PG8_SB(1, 1), cB + hstep + kstep, voffB);
        PG8_WAIT_V(6); PG8_BAR;
    }
    for (;;) {
        const bool has_next = S.next(ui + 1, nxt);
        const char* nA = has_next ? (const char*)g.A + (size_t)nxt.pm * tstep + (size_t)(nxt.kn & 0xffff) * kstep : cA; const char* nB = has_next ? (const char*)g.Bt + (size_t)nxt.pn * tstep + (size_t)(nxt.kn & 0xffff) * kstep : cB;
        const int nt = cur.kn >> 16;
        for (int t = 0; t < nt; t += 2) {
            const bool last = (t == nt - 2);
            const char* a1 = cA + (size_t)(t + 1) * kstep;
            const char* a2 = last ? nA : cA + (size_t)(t + 2) * kstep; const char* b2 = last ? nB : cB + (size_t)(t + 2) * kstep;
            const char* a3 = a2 + kstep; const char* b3 = b2 + kstep;
            if (last && has_next) S.a_ready(nxt);
            if constexpr (SP2) {
            PG8_LDB(B0, 0, 0); PG8_LDB(B1, 0, 1); PG8_SCHED; PG8_LDA(At, 0, 0); PG8_STAGE(PG8_SA(1, 1), a1 + hstep, voffA);
            PG8_WAIT_V(8); PG8_WAIT_L(0); PG8_BAR; PG8_MMA(0, 0, At, B0); PG8_MMA(0, 1, At, B1); PG8_BAR; PG8_SCHED;
            PG8_LDA(At, 0, 1); PG8_STAGE(PG8_SB(0, 0), b2, voffB); PG8_STAGE(PG8_SB(0, 1), b2 + hstep, voffB); PG8_STAGE(PG8_SA(0, 0), a2, voffA);
            PG8_WAIT_V(8); PG8_WAIT_L(0); PG8_BAR; PG8_MMA(1, 0, At, B0); PG8_MMA(1, 1, At, B1); PG8_BAR; PG8_SCHED;
            PG8_LDB(B0, 1, 0); PG8_LDB(B1, 1, 1); PG8_SCHED; PG8_LDA(At, 1, 0); PG8_STAGE(PG8_SA(0, 1), a2 + hstep, voffA);
            PG8_WAIT_V(8); PG8_WAIT_L(0); PG8_BAR; PG8_MMA(0, 0, At, B0); PG8_MMA(0, 1, At, B1); PG8_BAR; PG8_SCHED;
            PG8_LDA(At, 1, 1); PG8_STAGE(PG8_SB(1, 0), b3, voffB); PG8_STAGE(PG8_SB(1, 1), b3 + hstep, voffB); PG8_STAGE(PG8_SA(1, 0), a3, voffA);
            PG8_WAIT_V(8); PG8_WAIT_L(0); PG8_BAR; PG8_MMA(1, 0, At, B0); PG8_MMA(1, 1, At, B1); PG8_BAR; PG8_SCHED;
            } else {
            PG8_LDB(B0, 0, 0); PG8_SCHED; PG8_LDA(At, 0, 0); PG8_STAGE(PG8_SA(1, 1), a1 + hstep, voffA);
            PG8_WAIT_L(8); PG8_BAR; PG8_WAIT_L(0); PG8_MMA(0, 0, At, B0); PG8_BAR; PG8_SCHED;
            PG8_LDB(B1, 0, 1); PG8_STAGE(PG8_SB(0, 0), b2, voffB);
            PG8_BAR; PG8_WAIT_L(0); PG8_MMA(0, 1, At, B1); PG8_BAR;
            PG8_LDA(At, 0, 1); PG8_STAGE(PG8_SA(0, 0), a2, voffA);
            PG8_BAR; PG8_WAIT_L(0); PG8_MMA(1, 0, At, B0); PG8_BAR; PG8_SCHED;
            PG8_STAGE(PG8_SB(0, 1), b2 + hstep, voffB);
            PG8_WAIT_V(6); PG8_BAR; PG8_MMA(1, 1, At, B1); PG8_BAR;
            PG8_LDB(B0, 1, 0); PG8_SCHED; PG8_LDA(At, 1, 0); PG8_STAGE(PG8_SA(0, 1), a2 + hstep, voffA);
            PG8_WAIT_L(8); PG8_BAR; PG8_WAIT_L(0); PG8_MMA(0, 0, At, B0); PG8_BAR; PG8_SCHED;
            PG8_LDB(B1, 1, 1); PG8_STAGE(PG8_SB(1, 0), b3, voffB);
            PG8_BAR; PG8_WAIT_L(0); PG8_MMA(0, 1, At, B1); PG8_BAR;
            PG8_LDA(At, 1, 1); PG8_STAGE(PG8_SA(1, 0), a3, voffA);
            PG8_BAR; PG8_WAIT_L(0); PG8_MMA(1, 0, At, B0); PG8_BAR; PG8_SCHED;
            PG8_STAGE(PG8_SB(1, 1), b3 + hstep, voffB);
            PG8_WAIT_V(6); PG8_BAR; PG8_MMA(1, 1, At, B1); PG8_BAR;
            }
        }
        if constexpr (ALIGN_EPI) { if (wr == 0) PG8_BAR; }
        if constexpr (!Epi::AFTER_DRAIN) { E(acc, cur, wr, wc, fr, fq); S.done(cur); }
        if (!has_next) break;
#pragma unroll
        for (int a = 0; a < 2; ++a)
#pragma unroll
            for (int b = 0; b < 2; ++b)
#pragma unroll
                for (int m = 0; m < 4; ++m)
#pragma unroll
                    for (int n = 0; n < 2; ++n) acc[a][b][m][n] = (f32x4){0.f, 0.f, 0.f, 0.f};
        cur = nxt; cA = nA; cB = nB; ++ui;
        if constexpr (ALIGN_EPI) { if (wr == 1) PG8_BAR; }
    }
    PG8_WAIT_V(0);
    if constexpr (!ALIGN_EPI) { if (wr == 0) PG8_BAR; }
    PG8_BAR;
#undef PG8_SA
#undef PG8_SB
#undef PG8_STAGE
#undef PG8_LDA
#undef PG8_LDB
#undef PG8_MMA
#undef PG8_WAIT_V
#undef PG8_WAIT_L
#undef PG8_BAR
#undef PG8_SCHED
}
}

namespace att {
constexpr int D = 128, NW = 8, QBLK = 32, KVBLK = 64;
constexpr float SCALE = 0.088388347648318440f;
constexpr float THR = 8.f;
constexpr int LDQ = NQKV, LDK = NQKV, LDO = DM;
constexpr size_t SHM_V = KVBLK * D * 2, SHM_K = KVBLK * D * 2, SHM_ATTN = 2 * SHM_V + 2 * SHM_K + NW * 64 * 4;
#define KSWZ(row, colB) ((row) * 256 + ((colB) ^ (((row) & 7) << 4)))
#define SBAR() __builtin_amdgcn_sched_barrier(0)
__device__ __forceinline__ int crow(int r, int hi) { return (r & 3) + 8 * (r >> 2) + 4 * hi; }
__device__ __forceinline__ unsigned cvtpk(float lo, float hi) { unsigned r; asm volatile("v_cvt_pk_bf16_f32 %0, %1, %2" : "=v"(r) : "v"(lo), "v"(hi)); return r; }
__device__ __forceinline__ bf16x8 ld8(const bf16_t* p) { return *reinterpret_cast<const bf16x8*>(p); }

__device__ __forceinline__ void partialSM(f32x16& p0, f32x16& p1, float& m_reg, float& mn, float& alpha) {
  constexpr float C = SCALE * 1.4426950408889634f;
  float pmax = p0[0];
#pragma unroll
  for (int r = 1; r < 16; ++r) pmax = fmaxf(pmax, p0[r]);
#pragma unroll
  for (int r = 0; r < 16; ++r) pmax = fmaxf(pmax, p1[r]);
  { auto rr = __builtin_amdgcn_permlane32_swap(__float_as_uint(pmax), __float_as_uint(pmax), false, false);
    pmax = fmaxf(__uint_as_float(rr[0]), __uint_as_float(rr[1])); }
  if (__builtin_expect(__all(pmax - m_reg <= THR / SCALE), 1)) { mn = m_reg; alpha = 1.f; }
  else { mn = fmaxf(m_reg, pmax); alpha = __builtin_amdgcn_exp2f((m_reg - mn) * C); m_reg = mn; }
  float mnC = -mn * C;
#pragma unroll
  for (int r = 0; r < 16; ++r) p0[r] = fmaf(p0[r], C, mnC);
#pragma unroll
  for (int r = 0; r < 16; ++r) p1[r] = fmaf(p1[r], C, mnC);
#pragma unroll
  for (int r = 0; r < 16; ++r) p0[r] = __builtin_amdgcn_exp2f(p0[r]);
}
__device__ __forceinline__ void finishSM(f32x16& p0, f32x16& p1, float alpha, float& l_reg, bf16x8& pa0, bf16x8& pa1, bf16x8& pa2, bf16x8& pa3) {
#pragma unroll
  for (int r = 0; r < 16; ++r) p1[r] = __builtin_amdgcn_exp2f(p1[r]);
  float ps = 0;
#pragma unroll
  for (int r = 0; r < 16; ++r) ps += p0[r];
#pragma unroll
  for (int r = 0; r < 16; ++r) ps += p1[r];
  { auto rr = __builtin_amdgcn_permlane32_swap(__float_as_uint(ps), __float_as_uint(ps), false, false);
    ps = __uint_as_float(rr[0]) + __uint_as_float(rr[1]); }
  l_reg = l_reg * alpha + ps;
#define PK4(P, BASE, OUT) do { unsigned a0 = cvtpk(P[BASE + 0], P[BASE + 1]), a1 = cvtpk(P[BASE + 2], P[BASE + 3]);   \
    unsigned b0 = cvtpk(P[BASE + 4], P[BASE + 5]), b1 = cvtpk(P[BASE + 6], P[BASE + 7]);                              \
    auto r0 = __builtin_amdgcn_permlane32_swap(a0, b0, false, false); auto r1 = __builtin_amdgcn_permlane32_swap(a1, b1, false, false); \
    u32x4 w = {r0[0], r1[0], r0[1], r1[1]}; OUT = *reinterpret_cast<bf16x8*>(&w); } while (0)
  PK4(p0, 0, pa0); PK4(p0, 8, pa1); PK4(p1, 0, pa2); PK4(p1, 8, pa3);
#undef PK4
}
__device__ __forceinline__ void qkt(f32x16& p0, f32x16& p1, const bf16_t* Ks, const bf16x8* qr, int r32, int hi) {
  p0 = f32x16{}; p1 = f32x16{};
#pragma unroll
  for (int d0 = 0; d0 < 8; ++d0) { int cb = (d0 * 16 + hi * 8) * 2;
    bf16x8 b0 = *reinterpret_cast<const bf16x8*>((const char*)Ks + KSWZ(r32, cb));
    bf16x8 b1 = *reinterpret_cast<const bf16x8*>((const char*)Ks + KSWZ(32 + r32, cb));
    p0 = __builtin_amdgcn_mfma_f32_32x32x16_bf16(b0, qr[d0], p0, 0, 0, 0);
    p1 = __builtin_amdgcn_mfma_f32_32x32x16_bf16(b1, qr[d0], p1, 0, 0, 0); }
}
__device__ __forceinline__ int v_st(int k, int c) { const int kk = (k & ~0xC) | ((k & 4) << 1) | ((k & 8) >> 1); return ((kk >> 3) * 4 + (c >> 5)) * 512 + ((kk & 7) * 32 + (c & 31)) * 2; }
__device__ __forceinline__ int v_rd_base(int lane) { return ((lane & 3) << 3) | (((lane >> 2) & 3) << 6) | (((lane >> 4) & 1) << 5) | (((lane >> 5) & 1) << 8); }
constexpr int v_rd_off(int d0, int ks, int half) { return d0 * 512 + ks * 4096 + half * 2048; }
template <int OFF> __device__ __forceinline__ s16x4 tr_read(int vb) {
  s16x4 r; asm volatile("ds_read_b64_tr_b16 %0, %1 offset:%2" : "=&v"(r) : "v"(vb), "i"(OFF) : "memory"); return r;
}
template <int D0> __device__ __forceinline__ void pv_one(f32x16& od, int vb, bf16x8 pa0, bf16x8 pa1, bf16x8 pa2, bf16x8 pa3) {
  const s16x4 l0 = tr_read<v_rd_off(D0, 0, 0)>(vb), h0 = tr_read<v_rd_off(D0, 0, 1)>(vb), l1 = tr_read<v_rd_off(D0, 1, 0)>(vb), h1 = tr_read<v_rd_off(D0, 1, 1)>(vb);
  const s16x4 l2 = tr_read<v_rd_off(D0, 2, 0)>(vb), h2 = tr_read<v_rd_off(D0, 2, 1)>(vb), l3 = tr_read<v_rd_off(D0, 3, 0)>(vb), h3 = tr_read<v_rd_off(D0, 3, 1)>(vb);
  asm volatile("s_waitcnt lgkmcnt(0)" ::: "memory"); SBAR();
#define PK(L, H) (bf16x8){L[0], L[1], L[2], L[3], H[0], H[1], H[2], H[3]}
  od = __builtin_amdgcn_mfma_f32_32x32x16_bf16(pa0, PK(l0, h0), od, 0, 0, 0);
  od = __builtin_amdgcn_mfma_f32_32x32x16_bf16(pa1, PK(l1, h1), od, 0, 0, 0);
  od = __builtin_amdgcn_mfma_f32_32x32x16_bf16(pa2, PK(l2, h2), od, 0, 0, 0);
  od = __builtin_amdgcn_mfma_f32_32x32x16_bf16(pa3, PK(l3, h3), od, 0, 0, 0);
#undef PK
}
__device__ __forceinline__ void pv_d0(f32x16* o, int vb, bf16x8 pa0, bf16x8 pa1, bf16x8 pa2, bf16x8 pa3) {
  pv_one<0>(o[0], vb, pa0, pa1, pa2, pa3); pv_one<1>(o[1], vb, pa0, pa1, pa2, pa3); pv_one<2>(o[2], vb, pa0, pa1, pa2, pa3); pv_one<3>(o[3], vb, pa0, pa1, pa2, pa3);
}

__device__ __forceinline__ void attn_dense_body(const bf16_t* __restrict__ Qb, const bf16_t* __restrict__ Kh, const bf16_t* __restrict__ Vh,
                                                bf16_t* __restrict__ Ob, int seq, char* lds) {
  const int tid = threadIdx.x, wid = tid >> 6, lane = tid & 63, r32 = lane & 31, hi = lane >> 5;
  bf16_t* V_lds = (bf16_t*)lds; bf16_t* K_lds = (bf16_t*)(lds + 2 * SHM_V);
  float* ws = (float*)(lds + 2 * SHM_V + 2 * SHM_K) + wid * 64; float* li_l = ws; float* al_l = ws + 32;
  float m_reg = -1e30f, l_reg = 0; f32x16 o[4] = {}; bf16x8 qr[8];
  const bf16_t* Qw = Qb + (long)(wid * QBLK + r32) * LDQ + hi * 8;
#pragma unroll
  for (int d0 = 0; d0 < 8; ++d0) qr[d0] = ld8(Qw + d0 * 16);
  const int sr = tid >> 4, sc = (tid & 15) * 8, vst0 = v_st(sr, sc), vst1 = v_st(32 + sr, sc);
  const int vb0 = (int)(uintptr_t)V_lds + v_rd_base(lane);
  struct { bf16x8 vs0, vs1, ks0, ks1; } sr_[2];
#define SLOAD(i, k0) do { sr_[i].vs0 = ld8(&Vh[(long)((k0) + sr) * LDK + sc]); sr_[i].vs1 = ld8(&Vh[(long)((k0) + 32 + sr) * LDK + sc]); \
    sr_[i].ks0 = ld8(&Kh[(long)((k0) + sr) * LDK + sc]); sr_[i].ks1 = ld8(&Kh[(long)((k0) + 32 + sr) * LDK + sc]); } while (0)
#define SWRITE(b, i) do { *(bf16x8*)((char*)V_lds + (b) * SHM_V + vst0) = sr_[i].vs0;          \
    *(bf16x8*)((char*)V_lds + (b) * SHM_V + vst1) = sr_[i].vs1; int kc = sc * 2;               \
    *(bf16x8*)((char*)K_lds + (b) * SHM_K + KSWZ(sr, kc)) = sr_[i].ks0;                       \
    *(bf16x8*)((char*)K_lds + (b) * SHM_K + KSWZ(32 + sr, kc)) = sr_[i].ks1; } while (0)
#define SWAIT() do { asm volatile("s_waitcnt vmcnt(4)" ::: "memory"); } while (0)
#define RESC(a) do { if (__any((a) < 1.f)) { if (hi == 0) al_l[r32] = (a); asm volatile("s_waitcnt lgkmcnt(0)" ::: "memory"); \
    _Pragma("unroll") for (int d = 0; d < 4; ++d) _Pragma("unroll") for (int r = 0; r < 16; ++r) o[d][r] *= al_l[crow(r, hi)]; } } while (0)
  f32x16 pA0, pA1, pB0, pB1; float mnA, mnB, alA, alB; bf16x8 pa0, pa1, pa2, pa3; const int NT = seq / KVBLK;
  constexpr int SE = 0, SO = 1;
  SLOAD(SE, 0); asm volatile("s_waitcnt vmcnt(0)" ::: "memory"); SWRITE(0, SE); __syncthreads();
  qkt(pA0, pA1, K_lds, qr, r32, hi); partialSM(pA0, pA1, m_reg, mnA, alA);
  SLOAD(SO, KVBLK); if (2 < NT) SLOAD(SE, 2 * KVBLK);
  SWAIT(); SWRITE(1, SO); __syncthreads();
  for (int j = 1; j + 1 < NT; j += 2) {
    SBAR(); qkt(pB0, pB1, (bf16_t*)((char*)K_lds + SHM_K), qr, r32, hi);
    finishSM(pA0, pA1, alA, l_reg, pa0, pa1, pa2, pa3); SBAR();
    SLOAD(SO, (j + 2) * KVBLK); SBAR();
    pv_d0(o, vb0, pa0, pa1, pa2, pa3); partialSM(pB0, pB1, m_reg, mnB, alB);
    __syncthreads(); SWAIT(); SWRITE(0, SE);
    RESC(alB); __syncthreads();
    SBAR(); qkt(pA0, pA1, K_lds, qr, r32, hi);
    finishSM(pB0, pB1, alB, l_reg, pa0, pa1, pa2, pa3); SBAR();
    if (j + 3 < NT) SLOAD(SE, (j + 3) * KVBLK); SBAR();
    pv_d0(o, vb0 + (int)SHM_V, pa0, pa1, pa2, pa3); partialSM(pA0, pA1, m_reg, mnA, alA);
    __syncthreads(); SWAIT(); SWRITE(1, SO);
    RESC(alA); __syncthreads();
  }
  SBAR(); qkt(pB0, pB1, (bf16_t*)((char*)K_lds + SHM_K), qr, r32, hi);
  finishSM(pA0, pA1, alA, l_reg, pa0, pa1, pa2, pa3); SBAR();
  pv_d0(o, vb0, pa0, pa1, pa2, pa3); partialSM(pB0, pB1, m_reg, mnB, alB);
  __syncthreads(); RESC(alB);
  finishSM(pB0, pB1, alB, l_reg, pa0, pa1, pa2, pa3); SBAR();
  pv_d0(o, vb0 + (int)SHM_V, pa0, pa1, pa2, pa3);
  if (hi == 0) li_l[r32] = l_reg; asm volatile("s_waitcnt lgkmcnt(0)" ::: "memory");
  float rli[16];
#pragma unroll
  for (int r = 0; r < 16; ++r) rli[r] = __builtin_amdgcn_rcpf(li_l[crow(r, hi)]);
  bf16_t* Ow = Ob + (long)(wid * QBLK) * LDO;
#pragma unroll
  for (int r = 0; r < 16; ++r) { int orow = crow(r, hi);
#pragma unroll
    for (int d0 = 0; d0 < 4; ++d0) Ow[(long)orow * LDO + d0 * 32 + r32] = (bf16_t)f2bf(o[d0][r] * rli[r]); }
  __syncthreads();
#undef SLOAD
#undef SWRITE
#undef SWAIT
#undef RESC
}
}

__device__ __forceinline__ void transpose_item(const float* W, int K, int N, bf16_t* WT, LAS float* scr, int item, int lane, bool ffn_remap = false) {
    const int nblk = N / 32, kb = item / nblk, nb = item % nblk, k0 = 64 * kb, n0 = 32 * nb;
    int n0o = n0; if (ffn_remap) { const int half = n0 >= DFF ? 1 : 0, f = n0 - half * DFF; n0o = (f >> 7) * 256 + half * 128 + (f & 127); }
#pragma unroll 8
    for (int i = 0; i < 32; ++i) { const int kk = 2 * i + (lane >> 5); scr[kk * 33 + (lane & 31)] = W[(size_t)(k0 + kk) * N + n0 + (lane & 31)]; }
    asm volatile("s_waitcnt lgkmcnt(0)" ::: "memory");
    const int c = lane & 7;
#pragma unroll
    for (int j = 0; j < 4; ++j) { const int n = (lane >> 3) + 8 * j; const LAS float* s = scr + (8 * c) * 33 + n;
        u32x4 o; o.x = pk2(s[0 * 33], s[1 * 33]); o.y = pk2(s[2 * 33], s[3 * 33]); o.z = pk2(s[4 * 33], s[5 * 33]); o.w = pk2(s[6 * 33], s[7 * 33]);
        *(u32x4*)(WT + (size_t)(n0o + n) * K + k0 + 8 * c) = o; }
    asm volatile("s_waitcnt lgkmcnt(0)" ::: "memory");
}

__device__ __forceinline__ void ada_phase(const float* c, const float* c_ctx, const float* ada_w, const float* ada_b, float* mod, LAS unsigned char* lds, int wg, int G, int tid) {
    LAS float* sv = (LAS float*)lds;
    LAS float* part = sv + 3 * 2048;
    for (int i = tid; i < 3 * 2048; i += 512) { const int s = i >> 11, k = i & 2047; const float v = (s == 0) ? c_ctx[k] : c[(s - 1) * 2048 + k]; sv[i] = siluf(v); }
    __syncthreads();
    const int wave = tid >> 6, lane = tid & 63;
    for (int item = wg; item < 192; item += G) {
        const int L = item / 96, n0 = (item % 96) * 128;
        const float* W = ada_w + (size_t)L * 2048 * 12288 + n0 + lane * 2;
        float a0x = 0, a0y = 0, a1x = 0, a1y = 0, a2x = 0, a2y = 0;
        const int k0 = wave * 256;
#pragma unroll 8
        for (int k = 0; k < 256; ++k) {
            const f32x2 w = *(const f32x2*)(W + (size_t)(k0 + k) * 12288);
            const float s0 = sv[k0 + k], s1 = sv[2048 + k0 + k], s2 = sv[4096 + k0 + k];
            a0x += s0 * w.x; a0y += s0 * w.y; a1x += s1 * w.x; a1y += s1 * w.y; a2x += s2 * w.x; a2y += s2 * w.y;
        }
        part[(wave * 3 + 0) * 128 + lane * 2] = a0x; part[(wave * 3 + 0) * 128 + lane * 2 + 1] = a0y;
        part[(wave * 3 + 1) * 128 + lane * 2] = a1x; part[(wave * 3 + 1) * 128 + lane * 2 + 1] = a1y;
        part[(wave * 3 + 2) * 128 + lane * 2] = a2x; part[(wave * 3 + 2) * 128 + lane * 2 + 1] = a2y;
        __syncthreads();
        if (tid < 384) { const int s = tid >> 7, n = tid & 127; float acc = ada_b[L * 12288 + n0 + n];
#pragma unroll
            for (int w = 0; w < 8; ++w) acc += part[(w * 3 + s) * 128 + n];
            mod[(size_t)(L * 3 + s) * 12288 + n0 + n] = acc; }
        __syncthreads();
    }
}

template <bool XIN_BF, bool XOUT_BF>
__device__ __forceinline__ void row_phase(const float* xin_lat, const float* xin_ctx, float* xout_lat, float* xout_ctx, bf16_t* XR,
                                          const bf16_t* Y, const float* g_post, const float* g_pre, const float* modL, int jgate, int jshift, int jscale,
                                          bf16_t* H, bool has_y, bool make_h, bool lat_only, int gw, int NGW, int lane, const float* YS = nullptr, int nsplit = 0) {
    for (int r = gw; r < MR; r += NGW) {
        const int b = r / SB, p = r - b * SB; int s; const float* xi; float* xo; const bool ctxrow = p < CTX;
        size_t xrow;
        if (ctxrow) { if (lat_only) continue; s = 0; xrow = (size_t)(b * CTX + p) * DM; xi = xin_ctx + xrow; xo = xout_ctx + xrow; }
        else { s = 1 + b; xrow = (size_t)(b * SEQ + p - CTX) * DM; xi = xin_lat + xrow; xo = xout_lat + xrow; }
        const float* ms = modL + (size_t)s * 12288;
        f32x4 x[8];
#pragma unroll
        for (int j = 0; j < 8; ++j) {
            if (XIN_BF && !ctxrow) { const u32x2 xb = *(const u32x2*)(XR + xrow + (j * 64 + lane) * 4); x[j] = (f32x4){bflo(xb.x), bfhi(xb.x), bflo(xb.y), bfhi(xb.y)}; }
            else x[j] = *(const f32x4*)(xi + (j * 64 + lane) * 4);
        }
        if (has_y) {
            f32x4 y[8]; float ss = 0.f;
#pragma unroll
            for (int j = 0; j < 8; ++j) {
                if (ctxrow && nsplit > 0) { f32x4 t = {0.f, 0.f, 0.f, 0.f};
                    for (int sp = 0; sp < nsplit; ++sp) t += *(const f32x4*)(YS + ((size_t)sp * 512 + b * CTX + p) * DM + (j * 64 + lane) * 4);
                    y[j] = t; }
                else { const u32x2 yb = *(const u32x2*)(Y + (size_t)r * DM + (j * 64 + lane) * 4); y[j] = (f32x4){bflo(yb.x), bfhi(yb.x), bflo(yb.y), bfhi(yb.y)}; }
                ss += (y[j].x * y[j].x + y[j].y * y[j].y) + (y[j].z * y[j].z + y[j].w * y[j].w); }
            const float rs = rsqrtf(wave_sum(ss) * (1.f / DM) + EPS);
#pragma unroll
            for (int j = 0; j < 8; ++j) { const f32x4 gp = *(const f32x4*)(g_post + (j * 64 + lane) * 4); const f32x4 gt = *(const f32x4*)(ms + jgate * 2048 + (j * 64 + lane) * 4);
                x[j] = x[j] + gt * (y[j] * rs * gp);
                if (XOUT_BF && !ctxrow) { u32x2 w; w.x = cvt_pk_bf16(x[j].x, x[j].y); w.y = cvt_pk_bf16(x[j].z, x[j].w); *(u32x2*)(XR + xrow + (j * 64 + lane) * 4) = w;
                    x[j] = (f32x4){bflo(w.x), bfhi(w.x), bflo(w.y), bfhi(w.y)}; }
                else *(f32x4*)(xo + (j * 64 + lane) * 4) = x[j]; }
        }
        if (make_h) {
            float ss = 0.f;
#pragma unroll
            for (int j = 0; j < 8; ++j) ss += (x[j].x * x[j].x + x[j].y * x[j].y) + (x[j].z * x[j].z + x[j].w * x[j].w);
            const float rs = rsqrtf(wave_sum(ss) * (1.f / DM) + EPS);
#pragma unroll
            for (int j = 0; j < 8; ++j) { const f32x4 gp = *(const f32x4*)(g_pre + (j * 64 + lane) * 4); const f32x4 sh = *(const f32x4*)(ms + jshift * 2048 + (j * 64 + lane) * 4);
                const f32x4 sc = *(const f32x4*)(ms + jscale * 2048 + (j * 64 + lane) * 4);
                const f32x4 hv = (x[j] * rs * gp) * (sc + 1.f) + sh;
                u32x2 w; w.x = cvt_pk_bf16(hv.x, hv.y); w.y = cvt_pk_bf16(hv.z, hv.w);
                *(u32x2*)(H + (size_t)r * DM + (j * 64 + lane) * 4) = w; }
        }
    }
}

__device__ __forceinline__ void gla_prep_phase(bf16_t* P, bf16_t* QB, float* EB, const float* __restrict__ lbl, LAS unsigned char* lds, int wg, int G, int tid) {
    const int lane = tid & 63, w = __builtin_amdgcn_readfirstlane(tid >> 6);
    constexpr float L2E = 1.4426950408889634f;
    int par = 0;
    unsigned nq[8], nf[8], nb[8];
    if (wg < NB * NH * 132) { const int rb0 = wg % 132, bh0 = wg / 132; const size_t r0 = (size_t)(bh0 >> 4) * SB + rb0 * 64 + 8 * w; const int c0 = (bh0 & 15) * 128 + 2 * lane;
#pragma unroll
        for (int i = 0; i < 8; ++i) { const size_t ro = (r0 + i) * NHG + c0; nq[i] = *(const unsigned*)(P + ro); nf[i] = *(const unsigned*)(P + ro + 2048); nb[i] = *(const unsigned*)(P + ro + 4096); } }
    for (int item = wg; item < NB * NH * 132; item += G, par ^= 1) {
        LAS float* TOT = (LAS float*)lds + par * 2048;
        const int rb = item % 132, bh = item / 132, h = bh & 15, b = bh >> 4;
        float lb[2][2], oml[2][2];
#pragma unroll
        for (int d = 0; d < 2; ++d)
#pragma unroll
            for (int e = 0; e < 2; ++e) { const int ch = h * 128 + 2 * lane + e; const float l0 = lbl[(d * 2 + 0) * 2048 + ch], l1 = lbl[(d * 2 + 1) * 2048 + ch];
                lb[d][e] = __builtin_amdgcn_rcpf(1.f + __builtin_amdgcn_exp2f((l1 - l0) * L2E)); oml[d][e] = 1.f - lb[d][e]; }
        const size_t row0 = (size_t)b * SB + rb * 64 + 8 * w;
        const int col = h * 128 + 2 * lane;
        unsigned q2[8], ff[8], fb[8];
#pragma unroll
        for (int i = 0; i < 8; ++i) { q2[i] = nq[i]; ff[i] = nf[i]; fb[i] = nb[i]; }
        if (item + G < NB * NH * 132) {
            const int it2 = item + G, rb2 = it2 % 132, bh2 = it2 / 132;
            const size_t r2 = (size_t)(bh2 >> 4) * SB + rb2 * 64 + 8 * w; const int c2 = (bh2 & 15) * 128 + 2 * lane;
#pragma unroll
            for (int i = 0; i < 8; ++i) { const size_t ro = (r2 + i) * NHG + c2; nq[i] = *(const unsigned*)(P + ro); nf[i] = *(const unsigned*)(P + ro + 2048); nb[i] = *(const unsigned*)(P + ro + 4096); }
        }
        float blf[8][2], blb[8][2], kkf[8][2], kkb[8][2];
        { float r0 = 0.f, r1 = 0.f;
#pragma unroll
          for (int i = 0; i < 8; ++i) {
              { const float sg = __builtin_amdgcn_rcpf(1.f + __builtin_amdgcn_exp2f(bflo(ff[i]) * -L2E)); r0 += __builtin_amdgcn_logf(lb[0][0] + oml[0][0] * sg); blf[i][0] = r0; kkf[i][0] = oml[0][0] - oml[0][0] * sg; }
              { const float sg = __builtin_amdgcn_rcpf(1.f + __builtin_amdgcn_exp2f(bfhi(ff[i]) * -L2E)); r1 += __builtin_amdgcn_logf(lb[0][1] + oml[0][1] * sg); blf[i][1] = r1; kkf[i][1] = oml[0][1] - oml[0][1] * sg; }
          }
          *(LAS f32x2*)(TOT + w * 128 + 2 * lane) = (f32x2){r0, r1}; }
        { float r0 = 0.f, r1 = 0.f;
#pragma unroll
          for (int i = 7; i >= 0; --i) {
              { const float sg = __builtin_amdgcn_rcpf(1.f + __builtin_amdgcn_exp2f(bflo(fb[i]) * -L2E)); r0 += __builtin_amdgcn_logf(lb[1][0] + oml[1][0] * sg); blb[i][0] = r0; kkb[i][0] = oml[1][0] - oml[1][0] * sg; }
              { const float sg = __builtin_amdgcn_rcpf(1.f + __builtin_amdgcn_exp2f(bfhi(fb[i]) * -L2E)); r1 += __builtin_amdgcn_logf(lb[1][1] + oml[1][1] * sg); blb[i][1] = r1; kkb[i][1] = oml[1][1] - oml[1][1] * sg; }
          }
          *(LAS f32x2*)(TOT + 1024 + w * 128 + 2 * lane) = (f32x2){r0, r1}; }
        LBAR();
        float pf0 = 0.f, pf1 = 0.f, tf0 = 0.f, tf1 = 0.f, pb0 = 0.f, pb1 = 0.f, tb0 = 0.f, tb1 = 0.f;
#pragma unroll
        for (int g = 0; g < 8; ++g) { const f32x2 x = *(const LAS f32x2*)(TOT + g * 128 + 2 * lane), y = *(const LAS f32x2*)(TOT + 1024 + g * 128 + 2 * lane);
            tf0 += x.x; tf1 += x.y; tb0 += y.x; tb1 += y.y; if (g < w) { pf0 += x.x; pf1 += x.y; } if (g > w) { pb0 += y.x; pb1 += y.y; } }
#pragma unroll
        for (int i = 0; i < 8; ++i) {
            const float qs0 = bflo(q2[i]), qs1 = bfhi(q2[i]);
            const float s0 = qs0 * 0.08838834764831845f * __builtin_amdgcn_rcpf(1.f + __builtin_amdgcn_exp2f(qs0 * -L2E));
            const float s1 = qs1 * 0.08838834764831845f * __builtin_amdgcn_rcpf(1.f + __builtin_amdgcn_exp2f(qs1 * -L2E));
            const float df0 = pf0 + blf[i][0] - tf0, df1 = pf1 + blf[i][1] - tf1, db0 = pb0 + blb[i][0] - tb0, db1 = pb1 + blb[i][1] - tb1;
            const size_t ro = (row0 + i) * NHG + col;
            *(unsigned*)(P + ro) = cvt_pk_bf16(s0 * __builtin_amdgcn_exp2f(df0), s1 * __builtin_amdgcn_exp2f(df1));
            *(unsigned*)(P + ro + 2048) = cvt_pk_bf16(kkf[i][0] * __builtin_amdgcn_exp2f(-df0), kkf[i][1] * __builtin_amdgcn_exp2f(-df1));
            *(unsigned*)(P + ro + 4096) = cvt_pk_bf16(kkb[i][0] * __builtin_amdgcn_exp2f(-db0), kkb[i][1] * __builtin_amdgcn_exp2f(-db1));
            *(unsigned*)(QB + (row0 + i) * DM + col) = cvt_pk_bf16(s0 * __builtin_amdgcn_exp2f(db0), s1 * __builtin_amdgcn_exp2f(db1));
        }
        if (w == 0) {
            const int cb = rb < 4 ? 3 - rb : 135 - rb;
            *(f32x2*)(EB + ((size_t)((b * 16 + h) * 2 + 0) * 132 + rb) * 128 + 2 * lane) = (f32x2){__builtin_amdgcn_exp2f(tf0), __builtin_amdgcn_exp2f(tf1)};
            *(f32x2*)(EB + ((size_t)((b * 16 + h) * 2 + 1) * 132 + cb) * 128 + 2 * lane) = (f32x2){__builtin_amdgcn_exp2f(tb0), __builtin_amdgcn_exp2f(tb1)};
        }
    }
    __syncthreads();
}

__device__ __forceinline__ void gla_item(const bf16_t* __restrict__ P, const bf16_t* __restrict__ QS, int ldq, const float* __restrict__ EB, bf16_t* __restrict__ Od, LAS unsigned char* lds, int b, int h, int dir, int vs, int tid) {
    const int lane = tid & 63, w = __builtin_amdgcn_readfirstlane(tid >> 6), fr = lane & 15, fq = lane >> 4;
    constexpr int SETB = 66560;
    f32x4 S0 = {0.f, 0.f, 0.f, 0.f}, S1 = {0.f, 0.f, 0.f, 0.f};
    const int qrow = tid >> 4, colq = h * 128 + (tid & 15) * 8;
    const int kq = tid & 31, tg = tid >> 5, colf = 2048 * (1 + dir) + h * 128 + 4 * kq;
    const int colv = 3 * 2048 + h * 128 + vs * 32 + (tid & 7) * 4;
    const int tv = tid >> 3, base = b * SB, rofs = dir ? 63 : 0, rsign = dir ? -1 : 1;
    const float* ebp = EB + (size_t)((b * 16 + h) * 2 + dir) * 132 * 128 + 16 * w + 4 * fq;
    u32x4 q4[2][2]; u32x2 k2[2][4]; u32x2 vv[2]; f32x4 eb[2];
#define GLA_R0(c) (dir ? ((c) < 4 ? base + 192 - 64 * (c) : base + 8640 - 64 * (c)) : base + 64 * (c))
#define GLA_LOAD(u, c) do { const int R0n = GLA_R0(c); \
        _Pragma("unroll") for (int i = 0; i < 2; ++i) q4[u][i] = *(const u32x4*)(QS + (size_t)(R0n + rofs + rsign * (qrow + 32 * i)) * ldq + colq); \
        _Pragma("unroll") for (int i = 0; i < 4; ++i) k2[u][i] = *(const u32x2*)(P + (size_t)(R0n + rofs + rsign * (4 * tg + i)) * NHG + colf); \
        vv[u] = *(const u32x2*)(P + (size_t)(R0n + rofs + rsign * tv) * NHG + colv); eb[u] = *(const f32x4*)(ebp + (size_t)(c) * 128); __builtin_amdgcn_sched_barrier(0); } while (0)
    GLA_LOAD(0, 0); __builtin_amdgcn_sched_barrier(0); GLA_LOAD(1, 1); __builtin_amdgcn_sched_barrier(0);
    const int ti = w >> 1, vi = w & 1;
    for (int c0 = 0; c0 < 132; c0 += 2) {
#pragma unroll
      for (int u = 0; u < 2; ++u) {
        const int c = c0 + u;
        const int R0 = GLA_R0(c);
        LAS unsigned char* QD = lds + (u & 1) * SETB; LAS unsigned char* KD = QD + 17408; LAS unsigned char* KDT = QD + 34816; LAS unsigned char* VT = QD + 53248; LAS unsigned char* SDT = QD + 57856;
#pragma unroll
        for (int i = 0; i < 2; ++i) *(LAS u32x4*)(QD + (qrow + 32 * i) * 272 + (tid & 15) * 16) = q4[u][i];
#pragma unroll
        for (int i = 0; i < 4; ++i) *(LAS u32x2*)(KD + (4 * tg + i) * 272 + kq * 8) = k2[u][i];
        { const u32x2 r0 = k2[u][0], r1 = k2[u][1], r2 = k2[u][2], r3 = k2[u][3];
          *(LAS u32x2*)(KDT + (4 * kq + 0) * 144 + tg * 8) = (u32x2){(r0.x & 0xffffu) | (r1.x << 16), (r2.x & 0xffffu) | (r3.x << 16)};
          *(LAS u32x2*)(KDT + (4 * kq + 1) * 144 + tg * 8) = (u32x2){(r0.x >> 16) | (r1.x & 0xffff0000u), (r2.x >> 16) | (r3.x & 0xffff0000u)};
          *(LAS u32x2*)(KDT + (4 * kq + 2) * 144 + tg * 8) = (u32x2){(r0.y & 0xffffu) | (r1.y << 16), (r2.y & 0xffffu) | (r3.y << 16)};
          *(LAS u32x2*)(KDT + (4 * kq + 3) * 144 + tg * 8) = (u32x2){(r0.y >> 16) | (r1.y & 0xffff0000u), (r2.y >> 16) | (r3.y & 0xffff0000u)}; }
        { LAS bf16_t* vt = (LAS bf16_t*)VT; const int v4 = (tid & 7) * 4;
          vt[(v4 + 0) * 72 + tv] = (bf16_t)(vv[u].x & 0xffffu); vt[(v4 + 1) * 72 + tv] = (bf16_t)(vv[u].x >> 16);
          vt[(v4 + 2) * 72 + tv] = (bf16_t)(vv[u].y & 0xffffu); vt[(v4 + 3) * 72 + tv] = (bf16_t)(vv[u].y >> 16); }
        S0 *= eb[u]; S1 *= eb[u];
        *(LAS u32x2*)(SDT + fr * 272 + (16 * w + 4 * fq) * 2) = (u32x2){cvt_pk_bf16(S0.x, S0.y), cvt_pk_bf16(S0.z, S0.w)};
        *(LAS u32x2*)(SDT + (16 + fr) * 272 + (16 * w + 4 * fq) * 2) = (u32x2){cvt_pk_bf16(S1.x, S1.y), cvt_pk_bf16(S1.z, S1.w)};
        { const int cn = (c + 2 < 132) ? c + 2 : 131; GLA_LOAD(u, cn); }
        LBAR();
        { bf16x8 bq[4], ak[4][4], as_[4], kt[2], vb0[2], vb1[2]; s16x4 av[4];
#pragma unroll
          for (int ks = 0; ks < 4; ++ks) bq[ks] = *(const LAS bf16x8*)(QD + (16 * ti + fr) * 272 + (ks * 32 + fq * 8) * 2);
#pragma unroll
          for (int si = 0; si < 4; ++si) if (si <= ti) {
#pragma unroll
              for (int ks = 0; ks < 4; ++ks) ak[si][ks] = *(const LAS bf16x8*)(KD + (16 * si + fr) * 272 + (ks * 32 + fq * 8) * 2);
              av[si] = *(const LAS s16x4*)(VT + (16 * vi + fr) * 144 + (16 * si + 4 * fq) * 2); }
#pragma unroll
          for (int ks = 0; ks < 4; ++ks) as_[ks] = *(const LAS bf16x8*)(SDT + (16 * vi + fr) * 272 + (ks * 32 + fq * 8) * 2);
#pragma unroll
          for (int ks = 0; ks < 2; ++ks) { kt[ks] = *(const LAS bf16x8*)(KDT + (16 * w + fr) * 144 + (ks * 32 + fq * 8) * 2);
              vb0[ks] = *(const LAS bf16x8*)(VT + fr * 144 + (ks * 32 + fq * 8) * 2); vb1[ks] = *(const LAS bf16x8*)(VT + (16 + fr) * 144 + (ks * 32 + fq * 8) * 2); }
          f32x4 o = {0.f, 0.f, 0.f, 0.f};
#pragma unroll
          for (int ks = 0; ks < 4; ++ks) o = __builtin_amdgcn_mfma_f32_16x16x32_bf16(as_[ks], bq[ks], o, 0, 0, 0);
#pragma unroll
          for (int si = 0; si < 4; ++si) if (si <= ti) {
              f32x4 acc = {0.f, 0.f, 0.f, 0.f};
#pragma unroll
              for (int ks = 0; ks < 4; ++ks) acc = __builtin_amdgcn_mfma_f32_16x16x32_bf16(ak[si][ks], bq[ks], acc, 0, 0, 0);
              if (si == ti) {
#pragma unroll
                  for (int j = 0; j < 4; ++j) if (4 * fq + j > fr) acc[j] = 0.f;
              }
              const u32x2 pk = {cvt_pk_bf16(acc.x, acc.y), cvt_pk_bf16(acc.z, acc.w)};
              o = __builtin_amdgcn_mfma_f32_16x16x16bf16_1k(av[si], __builtin_bit_cast(s16x4, pk), o, 0, 0, 0);
          }
#pragma unroll
          for (int ks = 0; ks < 2; ++ks) { S0 = __builtin_amdgcn_mfma_f32_16x16x32_bf16(kt[ks], vb0[ks], S0, 0, 0, 0); S1 = __builtin_amdgcn_mfma_f32_16x16x32_bf16(kt[ks], vb1[ks], S1, 0, 0, 0); }
          const size_t ro = (size_t)(R0 + rofs + rsign * (16 * ti + fr)) * DM;
          *(u32x2*)(Od + ro + h * 128 + vs * 32 + 16 * vi + 4 * fq) = (u32x2){cvt_pk_bf16(o.x, o.y), cvt_pk_bf16(o.z, o.w)}; }
      }
    }
#undef GLA_LOAD
#undef GLA_R0
    __syncthreads();
}

__device__ __forceinline__ void readout_phase(const bf16_t* Ofw, const bf16_t* Obw, const bf16_t* P, const float* o_gain, bf16_t* R, int gw, int NGW, int lane) {
    const int cl = (8 * lane) & 127;
    const f32x4 g0 = *(const f32x4*)(o_gain + cl), g1 = *(const f32x4*)(o_gain + cl + 4);
    const float gn[8] = {g0.x, g0.y, g0.z, g0.w, g1.x, g1.y, g1.z, g1.w};
    for (int it0 = gw * 4; it0 < MR * 4; it0 += NGW * 4) {
        u32x4 a[4], bq[4], g[4];
#pragma unroll
        for (int u = 0; u < 4; ++u) { const int it = it0 + u, r = it >> 2, c0 = (it & 3) * 512 + 8 * lane;
            a[u] = *(const u32x4*)(Ofw + (size_t)r * DM + c0); bq[u] = *(const u32x4*)(Obw + (size_t)r * DM + c0); g[u] = *(const u32x4*)(P + (size_t)r * NHG + 4 * DM + c0); }
#pragma unroll
        for (int u = 0; u < 4; ++u) { const int it = it0 + u, r = it >> 2, c0 = (it & 3) * 512 + 8 * lane;
            float o[8];
            o[0] = bflo(a[u].x) + bflo(bq[u].x); o[1] = bfhi(a[u].x) + bfhi(bq[u].x); o[2] = bflo(a[u].y) + bflo(bq[u].y); o[3] = bfhi(a[u].y) + bfhi(bq[u].y);
            o[4] = bflo(a[u].z) + bflo(bq[u].z); o[5] = bfhi(a[u].z) + bfhi(bq[u].z); o[6] = bflo(a[u].w) + bflo(bq[u].w); o[7] = bfhi(a[u].w) + bfhi(bq[u].w);
            float ss = 0.f;
#pragma unroll
            for (int e = 0; e < 8; ++e) ss += o[e] * o[e];
            ss += __shfl_xor(ss, 1); ss += __shfl_xor(ss, 2); ss += __shfl_xor(ss, 4); ss += __shfl_xor(ss, 8);
            const float rs = rsqrtf(ss * (1.f / 128.f) + EPS);
            const float gv[8] = {bflo(g[u].x), bfhi(g[u].x), bflo(g[u].y), bfhi(g[u].y), bflo(g[u].z), bfhi(g[u].z), bflo(g[u].w), bfhi(g[u].w)};
            float v[8];
#pragma unroll
            for (int e = 0; e < 8; ++e) v[e] = o[e] * rs * gn[e] * siluf(gv[e]);
            u32x4 wv; wv.x = cvt_pk_bf16(v[0], v[1]); wv.y = cvt_pk_bf16(v[2], v[3]); wv.z = cvt_pk_bf16(v[4], v[5]); wv.w = cvt_pk_bf16(v[6], v[7]);
            *(u32x4*)(R + (size_t)r * DM + c0) = wv; }
    }
}

__device__ __forceinline__ void conv_fix_phase(const float* BND, const float* cw, const float* cbias, bf16_t* ACT, bool lat_only, int gw, int NGW, int lane) {
    constexpr float L2E = 1.4426950408889634f;
    for (int it = gw; it < 66 * 2 * 11; it += NGW) {
        const int cbk = it % 11, rest = it / 11, which = rest & 1, pm = rest >> 1;
        if (lat_only && (pm == 0 || pm == 33)) continue;
        const int c0 = cbk * 512 + 8 * lane;
        const float* bn = BND + (size_t)pm * 6 * DFF + c0;
        f32x4 pv[2], cv[2], nv[2], uv[2]; size_t row;
        if (which == 0) {
            const bool seq_start = (pm == 0 || pm == 1 || pm == 33 || pm == 34);
#pragma unroll
            for (int hh = 0; hh < 2; ++hh) { pv[hh] = seq_start ? (f32x4){0.f, 0.f, 0.f, 0.f} : *(const f32x4*)(bn - 6 * DFF + 3 * DFF + 4 * hh);
                cv[hh] = *(const f32x4*)(bn + 4 * hh); nv[hh] = *(const f32x4*)(bn + DFF + 4 * hh); uv[hh] = *(const f32x4*)(bn + 4 * DFF + 4 * hh); }
            row = (size_t)pm * 256;
        } else {
            const bool seq_end = (pm == 0 || pm == 32 || pm == 33 || pm == 65);
#pragma unroll
            for (int hh = 0; hh < 2; ++hh) { pv[hh] = *(const f32x4*)(bn + 2 * DFF + 4 * hh); cv[hh] = *(const f32x4*)(bn + 3 * DFF + 4 * hh);
                nv[hh] = seq_end ? (f32x4){0.f, 0.f, 0.f, 0.f} : *(const f32x4*)(bn + 6 * DFF + 4 * hh); uv[hh] = *(const f32x4*)(bn + 5 * DFF + 4 * hh); }
            row = (size_t)pm * 256 + 255;
        }
        float v[8];
#pragma unroll
        for (int hh = 0; hh < 2; ++hh) {
            const f32x4 w0 = *(const f32x4*)(cw + c0 + 4 * hh), w1 = *(const f32x4*)(cw + DFF + c0 + 4 * hh), w2 = *(const f32x4*)(cw + 2 * DFF + c0 + 4 * hh), cb = *(const f32x4*)(cbias + c0 + 4 * hh);
#pragma unroll
            for (int j = 0; j < 4; ++j) { const float y = w0[j] * pv[hh][j] + w1[j] * cv[hh][j] + w2[j] * nv[hh][j] + cb[j];
                v[4 * hh + j] = y * __builtin_amdgcn_rcpf(1.f + __builtin_amdgcn_exp2f(y * -L2E)) * uv[hh][j]; }
        }
        u32x4 wv; wv.x = cvt_pk_bf16(v[0], v[1]); wv.y = cvt_pk_bf16(v[2], v[3]); wv.z = cvt_pk_bf16(v[4], v[5]); wv.w = cvt_pk_bf16(v[6], v[7]);
        *(u32x4*)(ACT + row * DFF + c0) = wv;
    }
}

__device__ __forceinline__ void qknorm_phase(bf16_t* QKV, const float* q_gain, const float* k_gain, int gw, int NGW, int lane) {
    const int cl = (8 * lane) & 127;
    for (int it = gw; it < MR * 5; it += NGW) {
        const int r = it / 5, grp = it - r * 5, p = r % SB;
        const bool lat = p >= CTX;
        if (!lat && grp < 4) continue;
        bf16_t* ptr = QKV + (size_t)r * NQKV + grp * 512 + 8 * lane;
        const float* gn = (grp < 4) ? q_gain : k_gain;
        const u32x4 a = *(const u32x4*)ptr;
        float x[8] = {bflo(a.x), bfhi(a.x), bflo(a.y), bfhi(a.y), bflo(a.z), bfhi(a.z), bflo(a.w), bfhi(a.w)};
        float ss = 0.f;
#pragma unroll
        for (int e = 0; e < 8; ++e) ss += x[e] * x[e];
        ss += __shfl_xor(ss, 1); ss += __shfl_xor(ss, 2); ss += __shfl_xor(ss, 4); ss += __shfl_xor(ss, 8);
        const float rs = rsqrtf(ss * (1.f / 128.f) + EPS);
#pragma unroll
        for (int e = 0; e < 8; ++e) x[e] = x[e] * rs * gn[cl + e];
        if (lat) {
            const int t = p - CTX; const float prow = (float)(t >> 6), pcol = (float)(t & 63);
#pragma unroll
            for (int e2 = 0; e2 < 4; ++e2) {
                const int i = (cl >> 1) + e2; const int fi = i & 31;
                const float invf = exp2f(-(float)fi * (13.287712379549449f / 32.f));
                const float ang = ((i >= 32) ? pcol : prow) * invf;
                float sn, cs; sincosf(ang, &sn, &cs);
                const float x1 = x[2 * e2], x2 = x[2 * e2 + 1];
                x[2 * e2] = x1 * cs - x2 * sn; x[2 * e2 + 1] = x1 * sn + x2 * cs;
            }
        }
        u32x4 wv; wv.x = cvt_pk_bf16(x[0], x[1]); wv.y = cvt_pk_bf16(x[2], x[3]); wv.z = cvt_pk_bf16(x[4], x[5]); wv.w = cvt_pk_bf16(x[6], x[7]);
        *(u32x4*)ptr = wv;
    }
}


#define XB_TMO      128
#define XB_XCNT(j)  (256  + 64 * (j))
#define XB_XSUB(j)  (1280 + 64 * (j))
#define XB_XGEN(j)  (2304 + 64 * (j))
#define XB_TOP      3328
#define XB_TOPGEN   3392
#define XCD_BAR_WORDS 3456
#define XB_SPIN_CAP (1u << 20)
__device__ __forceinline__ unsigned xb_ld(unsigned* p)              { return __hip_atomic_load(p, __ATOMIC_RELAXED, __HIP_MEMORY_SCOPE_AGENT); }
__device__ __forceinline__ unsigned xb_add(unsigned* p, unsigned v) { return __hip_atomic_fetch_add(p, v, __ATOMIC_RELAXED, __HIP_MEMORY_SCOPE_AGENT); }
__device__ __forceinline__ unsigned xb_xcc_id() { return (unsigned)__builtin_amdgcn_s_getreg((3 << 11) | 20) & 0xFu; }
#define XB_SPIN(cond, bar) do { unsigned _sp = 0; while (cond) { __builtin_amdgcn_s_sleep(1); \
    if ((++_sp & 255u) == 0u) { if (xb_ld(&(bar)[XB_TMO])) break; if (_sp > XB_SPIN_CAP) { atomicAdd(&(bar)[XB_TMO], 1u); break; } } } } while (0)
struct XcdBarrier { unsigned* bar; unsigned x; volatile LAS unsigned* st; };
__device__ __forceinline__ XcdBarrier xcd_barrier_post(unsigned* bar, volatile LAS unsigned* st) {
    XcdBarrier b; b.bar = bar; b.x = xb_xcc_id(); b.st = st;
    if (threadIdx.x == 0) (void)xb_add(&bar[XB_XCNT(b.x)], 1u);
    return b;
}
__device__ __forceinline__ void xcd_barrier_complete(unsigned* bar, unsigned x, unsigned& nloc, unsigned& nx) {
    const unsigned G = gridDim.x * gridDim.y * gridDim.z;
    unsigned sum, cnt, mine, sp = 0u;
    for (;;) {
        sum = 0u; cnt = 0u; mine = 0u;
#pragma unroll
        for (unsigned j = 0; j < 16; ++j) { const unsigned c = xb_ld(&bar[XB_XCNT(j)]); sum += c; cnt += (c > 0u) ? 1u : 0u; mine = (j == x) ? c : mine; }
        if (sum == G) break;
        __builtin_amdgcn_s_sleep(1);
        if ((++sp & 255u) == 0u) { if (xb_ld(&bar[XB_TMO])) break; if (sp > XB_SPIN_CAP) { atomicAdd(&bar[XB_TMO], 1u); break; } }
    }
    nloc = mine > 0u ? mine : 1u; nx = cnt > 0u ? cnt : 1u;
}
__device__ __forceinline__ void xcd_barrier(const XcdBarrier& b) {
    asm volatile("s_waitcnt vmcnt(0)" ::: "memory");
    __syncthreads();
    if (threadIdx.x == 0) {
        unsigned* bar = b.bar;
        __builtin_amdgcn_s_waitcnt(0);
        unsigned nloc = b.st[0], nx = b.st[1];
        if (nloc == 0u) { xcd_barrier_complete(bar, b.x, nloc, nx); b.st[0] = nloc; b.st[1] = nx; }
        const unsigned old = xb_add(&bar[XB_XSUB(b.x)], 1u);
        const unsigned gen = old / nloc;
        if (old + 1u == (gen + 1u) * nloc) {
            __builtin_amdgcn_fence(__ATOMIC_RELEASE, "agent");
            asm volatile("s_waitcnt vmcnt(0)" ::: "memory");
            const unsigned og = xb_add(&bar[XB_TOP], 1u);
            const unsigned tg = og / nx;
            if (og + 1u == (tg + 1u) * nx) xb_add(&bar[XB_TOPGEN], 1u);
            else XB_SPIN(xb_ld(&bar[XB_TOPGEN]) == tg, bar);
            __builtin_amdgcn_fence(__ATOMIC_ACQUIRE, "agent");
            xb_add(&bar[XB_XGEN(b.x)], 1u);
            asm volatile("s_waitcnt vmcnt(0)" ::: "memory");
        } else {
            XB_SPIN(xb_ld(&bar[XB_XGEN(b.x)]) == gen, bar);
            __builtin_amdgcn_fence(__ATOMIC_ACQUIRE, "agent");
            asm volatile("s_waitcnt vmcnt(0)" ::: "memory");
        }
    }
    __syncthreads();
}

struct KArgs { const float* in[22]; float* out; unsigned char* ws; int ph_lo, ph_hi; };
enum { I_X = 0, I_C, I_CTX, I_CCTX, I_ADAW, I_ADAB, I_NMPRE, I_NMPOST, I_NFPRE, I_NFPOST, I_HWIN, I_HLB, I_HONORM, I_HWOUT, I_AQKV, I_AQN, I_AKN, I_AWOUT, I_FWIN, I_FCW, I_FCB, I_FWOUT };
constexpr int N_PHASES = 20;

__global__ void __launch_bounds__(512, 2) mega_fwd(KArgs a) {
    extern __shared__ __attribute__((aligned(16))) unsigned char lds_raw[];
    LAS unsigned char* lds = (LAS unsigned char*)lds_raw;
    cg::grid_group grid = cg::this_grid();
    const int tid = threadIdx.x, lane = tid & 63, wave = __builtin_amdgcn_readfirstlane(tid >> 6);
    const int G = gridDim.x, wg = blockIdx.x;
    const int gw = wg * 8 + wave, NGW = G * 8;
    unsigned char* ws = a.ws;
    float* mod = (float*)(ws + WS_MOD);
    float* xctx = (float*)(ws + WS_XCTX);
    bf16_t* H = (bf16_t*)(ws + WS_H);
    bf16_t* BIG = (bf16_t*)(ws + WS_BIG);
    bf16_t* Y = (bf16_t*)(ws + WS_BIG);
    bf16_t* XR = (bf16_t*)(ws + WS_BIG + 256 * MiB);
    float* BND = (float*)(ws + WS_BIG + 200 * MiB);
    float* YS = (float*)(ws + WS_BIG + 132 * MiB);
    bf16_t* ACT = (bf16_t*)(ws + WS_ACT);
    bf16_t* OFW = ACT; bf16_t* OBW = ACT + (size_t)MR * DM;
    const int lo = a.ph_lo, hi = a.ph_hi;
#ifndef MK_REPMASK
#define MK_REPMASK 0u
#endif
#define PH(k) if (lo <= (k) && (k) < hi) for (int rep_ = 0; rep_ <= (int)((MK_REPMASK >> (k)) & 1u); ++rep_)
#define SEAM(k) do { if ((k) + 1 < hi) { if ((k) == 0) { asm volatile("s_waitcnt vmcnt(0) lgkmcnt(0)" ::: "memory"); grid.sync(); } else xcd_barrier(bar); } } while (0)
    LAS float* scr = (LAS float*)(lds + wave * 16384);
    volatile LAS unsigned* MISC = (volatile LAS unsigned*)(lds + LDS_BYTES - 256);
    if (tid < 16) MISC[tid] = 0u;
    __syncthreads();
    XcdBarrier bar = xcd_barrier_post((unsigned*)ws, MISC);

    PH(0) {
        ada_phase(a.in[I_C], a.in[I_CCTX], a.in[I_ADAW], a.in[I_ADAB], mod, lds, wg, G, tid);
        constexpr int I0 = 32 * (NHG / 32), I1 = 32 * (DM / 32), I2 = 32 * (2 * DFF / 32), I3 = (DFF / 64) * (DM / 32);
        for (int it = gw; it < I0 + I1 + I2 + I3; it += NGW) {
            int r = it;
            if (r < I0) { transpose_item(a.in[I_HWIN], DM, NHG, (bf16_t*)(ws + W_HIN), scr, r, lane); continue; } r -= I0;
            if (r < I1) { transpose_item(a.in[I_HWOUT], DM, DM, (bf16_t*)(ws + W_HOUT), scr, r, lane); continue; } r -= I1;
            if (r < I2) { transpose_item(a.in[I_FWIN], DM, 2 * DFF, (bf16_t*)(ws + W_FIN), scr, r, lane, true); continue; } r -= I2;
            transpose_item(a.in[I_FWOUT], DFF, DM, (bf16_t*)(ws + W_FOUT), scr, r, lane);
        }
        SEAM(0);
    }
    PH(1) {
        row_phase<false, false>(a.in[I_X], a.in[I_CTX], nullptr, nullptr, XR, nullptr, nullptr, a.in[I_NMPRE], mod, 0, 0, 1, H, false, true, false, gw, NGW, lane);
        SEAM(1);
    }
    PH(2) {
        pg8::Gemm g{H, (const bf16_t*)(ws + W_HIN), MR, NHG, DM}; pg8::Order S; S.init(MR / 256, NHG, DM, G, wg, 0, 0);
        pg8::EpiBf16 E{BIG, NHG};
        pg8::gemm_phase<pg8::EpiBf16, pg8::Order, true, true>(lds, g, S, E);
        SEAM(2);
    }
    PH(3) {
        float* EB = (float*)(ACT + (size_t)2 * MR * DM);
        if (rep_ == 0) gla_prep_phase(BIG, H, EB, a.in[I_HLB], lds, wg, G, tid);
        xcd_barrier(bar);
        for (int item = wg; item < 256; item += G) {
            const int xq = item & 7, yq = item >> 3, vs = yq & 3, sq = xq + 8 * (yq >> 2);
            const int dir = sq & 1, h = (sq >> 1) & 15, b = sq >> 5;
            gla_item(BIG, dir ? H : BIG, dir ? DM : NHG, EB, dir ? OBW : OFW, lds, b, h, dir, vs, tid);
        }
        SEAM(3);
    }
    PH(4) {
        readout_phase(OFW, OBW, BIG, a.in[I_HONORM], H, gw, NGW, lane);
        SEAM(4);
    }
    PH(5) {
        pg8::Gemm g{H, (const bf16_t*)(ws + W_HOUT), MR, DM, DM}; pg8::Order S; S.init(64, DM, DM, G, wg, 1, 16);
        pg8::EpiF32 E{Y, DM, YS, DM / 64};
        pg8::gemm_phase<pg8::EpiF32, pg8::Order, true, true>(lds, g, S, E);
        SEAM(5);
    }
    PH(6) {
        row_phase<false, true>(a.in[I_X], a.in[I_CTX], a.out, xctx, XR, Y, a.in[I_NMPOST], a.in[I_NFPRE], mod, 2, 3, 4, H, true, true, false, gw, NGW, lane, YS, 16);
        SEAM(6);
    }
    PH(7) {
        pg8::Gemm g{H, (const bf16_t*)(ws + W_FIN), MR, 2 * DFF, DM}; pg8::Order S; S.init(MR / 256, 2 * DFF, DM, G, wg, 0, 0);
        pg8::EpiConv E{ACT, a.in[I_FCW], a.in[I_FCB], BND, (LAS float*)(lds + 131072)};
        pg8::gemm_phase<pg8::EpiConv, pg8::Order, true, true>(lds, g, S, E);
        SEAM(7);
    }
    PH(8) {
        conv_fix_phase(BND, a.in[I_FCW], a.in[I_FCB], ACT, false, gw, NGW, lane);
        SEAM(8);
    }
    PH(9) {
        pg8::Gemm g{ACT, (const bf16_t*)(ws + W_FOUT), MR, DM, DFF}; pg8::Order S; S.init(64, DM, DFF, G, wg, 1, 11);
        pg8::EpiF32 E{Y, DM, YS, DFF / 64};
        pg8::gemm_phase<pg8::EpiF32, pg8::Order, true, true>(lds, g, S, E);
        SEAM(9);
    }
    PH(10) {
        row_phase<true, true>(a.out, xctx, a.out, xctx, XR, Y, a.in[I_NFPOST], a.in[I_NMPRE] + DM, mod, 5, 6 * 3 + 0, 6 * 3 + 1, H, true, true, false, gw, NGW, lane, YS, 11);
        __syncthreads();
        constexpr int I0 = 32 * (NQKV / 32), I1 = 32 * (DM / 32), I2 = 32 * (2 * DFF / 32), I3 = (DFF / 64) * (DM / 32);
        for (int it = gw; it < I0 + I1 + I2 + I3; it += NGW) {
            int r = it;
            if (r < I0) { transpose_item(a.in[I_AQKV], DM, NQKV, (bf16_t*)(ws + W_QKV), scr, r, lane); continue; } r -= I0;
            if (r < I1) { transpose_item(a.in[I_AWOUT], DM, DM, (bf16_t*)(ws + W_AOUT), scr, r, lane); continue; } r -= I1;
            if (r < I2) { transpose_item(a.in[I_FWIN] + (size_t)DM * 2 * DFF, DM, 2 * DFF, (bf16_t*)(ws + W_FIN), scr, r, lane, true); continue; } r -= I2;
            transpose_item(a.in[I_FWOUT] + (size_t)DFF * DM, DFF, DM, (bf16_t*)(ws + W_FOUT), scr, r, lane);
        }
        SEAM(10);
    }
    PH(11) {
        pg8::Gemm g{H, (const bf16_t*)(ws + W_QKV), MR, NQKV, DM}; pg8::Order S; S.init(MR / 256, NQKV, DM, G, wg, 0, 0);
        pg8::EpiBf16 E{BIG, NQKV};
        pg8::gemm_phase<pg8::EpiBf16, pg8::Order, true, true>(lds, g, S, E);
        SEAM(11);
    }
    PH(12) {
        qknorm_phase(BIG, a.in[I_AQN], a.in[I_AKN], gw, NGW, lane);
        SEAM(12);
    }
    PH(13) {
        for (int u = wg; u < 1024; u += G) {
            const int x = u & 7, rest = u >> 3, j = rest & 31, i = rest >> 5;
            const int b = x >> 2, kvh = x & 3, h = kvh * 4 + i;
            const size_t qrow = (size_t)b * SB + CTX + (size_t)j * 256;
            att::attn_dense_body(BIG + qrow * NQKV + h * 128, BIG + (size_t)b * SB * NQKV + 2048 + kvh * 128, BIG + (size_t)b * SB * NQKV + 2560 + kvh * 128,
                                 ACT + qrow * DM + h * 128, SB, (char*)lds_raw);
        }
        SEAM(13);
    }
    PH(14) {
        pg8::Gemm g{ACT, (const bf16_t*)(ws + W_AOUT), MR, DM, DM}; pg8::Order S; S.init(64, DM, DM, G, wg, 1, 0);
        pg8::EpiF32 E{Y, DM, nullptr, 0};
        pg8::gemm_phase<pg8::EpiF32, pg8::Order, true, true>(lds, g, S, E);
        SEAM(14);
    }
    PH(15) {
        row_phase<true, true>(a.out, xctx, a.out, xctx, XR, Y, a.in[I_NMPOST] + DM, a.in[I_NFPRE] + DM, mod + 3 * 12288, 2, 3, 4, H, true, true, true, gw, NGW, lane);
        SEAM(15);
    }
    PH(16) {
        pg8::Gemm g{H, (const bf16_t*)(ws + W_FIN), MR, 2 * DFF, DM}; pg8::Order S; S.init(64, 2 * DFF, DM, G, wg, 1, 0);
        pg8::EpiConv E{ACT, a.in[I_FCW] + 3 * DFF, a.in[I_FCB] + DFF, BND, (LAS float*)(lds + 131072)};
        pg8::gemm_phase<pg8::EpiConv, pg8::Order, true, true>(lds, g, S, E);
        SEAM(16);
    }
    PH(17) {
        conv_fix_phase(BND, a.in[I_FCW] + 3 * DFF, a.in[I_FCB] + DFF, ACT, true, gw, NGW, lane);
        SEAM(17);
    }
    PH(18) {
        pg8::Gemm g{ACT, (const bf16_t*)(ws + W_FOUT), MR, DM, DFF}; pg8::Order S; S.init(64, DM, DFF, G, wg, 1, 0);
        pg8::EpiF32 E{Y, DM, nullptr, 0};
        pg8::gemm_phase<pg8::EpiF32, pg8::Order, true, true>(lds, g, S, E);
        SEAM(18);
    }
    PH(19) {
        row_phase<true, false>(a.out, xctx, a.out, xctx, XR, Y, a.in[I_NFPOST] + DM, nullptr, mod + 3 * 12288, 5, 0, 0, H, true, false, true, gw, NGW, lane);
    }
#undef PH
#undef SEAM
}


extern "C" void kernel_launch(void* const* d_in, const int* in_sizes, int n_in, void* d_out, int out_size, void* d_ws, size_t ws_size, hipStream_t stream) {
    static int grid = 0;
    if (grid == 0) {
        if (n_in != 22 || ws_size < WS_END || out_size != NB * SEQ * DM) { fprintf(stderr, "kernel_launch: unexpected shapes n_in %d ws %zu out %d\n", n_in, ws_size, out_size); grid = -1; return; }
        int dev = 0, cus = 0, per_cu = 0;
        if (hipGetDevice(&dev) != hipSuccess || hipDeviceGetAttribute(&cus, hipDeviceAttributeMultiprocessorCount, dev) != hipSuccess) { grid = -1; return; }
        if (hipFuncSetAttribute((const void*)mega_fwd, hipFuncAttributeMaxDynamicSharedMemorySize, LDS_BYTES) != hipSuccess) { fprintf(stderr, "kernel_launch: hipFuncSetAttribute failed\n"); grid = -1; return; }
        if (hipOccupancyMaxActiveBlocksPerMultiprocessor(&per_cu, (const void*)mega_fwd, 512, LDS_BYTES) != hipSuccess || per_cu < 1) { fprintf(stderr, "kernel_launch: occupancy query says %d\n", per_cu); per_cu = 1; }
        (void)hipGetLastError();
        grid = cus * 1;
    }
    if (grid < 0) return;
    KArgs a{};
    for (int i = 0; i < 22; ++i) a.in[i] = (const float*)d_in[i];
    a.out = (float*)d_out; a.ws = (unsigned char*)d_ws;
    a.ph_lo = 0; a.ph_hi = N_PHASES;
    if (hipMemsetAsync(d_ws, 0, 16384, stream) != hipSuccess) { fprintf(stderr, "kernel_launch: memset failed\n"); return; }
    void* args[] = {&a};
    hipError_t e = hipLaunchCooperativeKernel((const void*)mega_fwd, dim3(grid), dim3(512), args, LDS_BYTES, stream);
    if (e != hipSuccess) fprintf(stderr, "cooperative launch failed: %s (grid %d)\n", hipGetErrorString(e), grid);
}
```

```cpp
#include <hip/hip_runtime.h>
#include <hip/hip_cooperative_groups.h>
#include <cstdio>
#include <cstdint>
namespace cg = cooperative_groups;

#define LAS __attribute__((address_space(3)))
typedef unsigned short bf16_t;
typedef short bf16x8 __attribute__((ext_vector_type(8)));
typedef float f32x4 __attribute__((ext_vector_type(4)));
typedef float f32x2 __attribute__((ext_vector_type(2)));
typedef float f32x16 __attribute__((ext_vector_type(16)));
typedef unsigned u32x4 __attribute__((ext_vector_type(4)));
typedef unsigned u32x2 __attribute__((ext_vector_type(2)));
typedef short s16x4 __attribute__((ext_vector_type(4)));

constexpr int DM = 2048, NB = 2, SEQ = 8192, CTX = 256, SB = SEQ + CTX, MR = NB * SB;
constexpr int NH = 16, HD = 128, NKV = 4, DFF = 5632, NQKV = 3072, NHG = 5 * DM;
constexpr float EPS = 1e-6f;

constexpr size_t MiB = 1u << 20;
constexpr size_t WS_MOD = 64 * 1024;
constexpr size_t WS_XCTX = 2 * MiB;
constexpr size_t WS_W = 6 * MiB;
constexpr size_t W_HIN = WS_W, W_HOUT = WS_W + 40 * MiB, W_FIN = WS_W + 48 * MiB, W_FOUT = WS_W + 92 * MiB;
constexpr size_t W_QKV = WS_W, W_AOUT = WS_W + 12 * MiB;
constexpr size_t WS_H = 120 * MiB;
constexpr size_t WS_BIG = 186 * MiB;
constexpr size_t WS_ACT = 549 * MiB;
constexpr size_t WS_END = WS_ACT + (size_t)MR * DFF * 2;
static_assert(WS_END <= 768 * MiB, "ws");

constexpr int LDS_BYTES = 147456;

typedef __bf16 bf16x2_t __attribute__((ext_vector_type(2)));
__device__ __forceinline__ unsigned cvt_pk_bf16(float lo, float hi) { f32x2 v = {lo, hi}; bf16x2_t b = __builtin_convertvector(v, bf16x2_t); return __builtin_bit_cast(unsigned, b); }
__device__ __forceinline__ unsigned f2bf(float f) { unsigned u = __builtin_bit_cast(unsigned, f); return (u + 0x7fffu + ((u >> 16) & 1u)) >> 16; }
__device__ __forceinline__ unsigned pk2(float lo, float hi) { return f2bf(lo) | (f2bf(hi) << 16); }
__device__ __forceinline__ float bflo(unsigned u) { return __builtin_bit_cast(float, u << 16); }
__device__ __forceinline__ float bfhi(unsigned u) { return __builtin_bit_cast(float, u & 0xffff0000u); }
__device__ __forceinline__ float wave_sum(float v) {
#pragma unroll
    for (int o = 1; o < 64; o <<= 1) v += __shfl_xor(v, o);
    return v;
}
__device__ __forceinline__ float siluf(float v) { return v / (1.f + __expf(-v)); }
#define LBAR() do { asm volatile("s_waitcnt lgkmcnt(0)" ::: "memory"); __builtin_amdgcn_s_barrier(); asm volatile("" ::: "memory"); } while (0)

namespace pg8 {
constexpr int BM = 256, BK = 64, HALF = 128, HTB = HALF * BK * 2, STAGE_BYTES = 8 * HTB, NXCD = 8, WGM = 4;
__host__ __device__ __forceinline__ int lds_byte(int r, int c) { const int st = (r >> 4) * 2 + (c >> 5), rr = r & 15, cc = c & 31, ob = rr * 64 + cc * 2; return st * 1024 + (ob ^ (((ob >> 9) & 1) << 5)); }
__host__ __device__ __forceinline__ void stage_rc(int b, int& R, int& C) { const int st = b / 1024, sb = b % 1024, swz = sb ^ (((sb >> 9) & 1) << 5); R = (st >> 1) * 16 + swz / 64; C = (st & 1) * 32 + (swz % 64) / 2; }
__host__ __device__ __forceinline__ int perm32(int rho) { const int n = rho >> 4, i = rho & 15; return 8 * (i >> 2) + 4 * n + (i & 3); }

struct Unit { int pm, pn, kn; };
struct Gemm { const bf16_t* A; const bf16_t* Bt; int M, N, K; };

struct Order {
    int nM, nN, nwg, G, c, skip, ntf, nsplit;
    __device__ void init(int nM_, int N, int K, int G_, int c_, int skip_, int nsplit_) { nM = nM_; nN = N / BM; nwg = nM * nN; G = G_; c = c_; skip = skip_; ntf = K / BK; nsplit = nsplit_; }
    __device__ bool next(int i, Unit& u) const {
        const long L = (long)i * G + c;
        if (L >= nwg) {
            const int j = (int)(L - nwg); if (j >= 2 * nN * nsplit) return false;
            const int sidx = j % nsplit, cu = j / nsplit, cr = cu / nN;
            const int ntu = ntf / nsplit; u.pm = cr ? 33 : 0; u.pn = cu % nN; u.kn = (sidx * ntu) | (ntu << 16); return true;
        }
        int wgid = (int)L; { const int q = nwg / NXCD, r = nwg % NXCD, xcd = wgid % NXCD, off = wgid / NXCD; wgid = (xcd < r ? xcd * (q + 1) : r * (q + 1) + (xcd - r) * q) + off; }
        const int nig = WGM * nN, gid = wgid / nig, fm = gid * WGM, gsz = (nM - fm) < WGM ? (nM - fm) : WGM;
        int pm = fm + ((wgid % nig) % gsz); u.pn = (wgid % nig) / gsz;
        if (skip) pm = pm + 1 + (pm >= 32 ? 1 : 0);
        u.pm = pm; u.kn = ntf << 16; return true;
    }
    __device__ __forceinline__ void a_ready(const Unit&) const {}
    __device__ __forceinline__ void done(const Unit&) const {}
};

struct EpiBf16 {
    static constexpr bool PERM = true, AFTER_DRAIN = false;
    bf16_t* O; int ldc;
    __device__ __forceinline__ void operator()(const f32x4 (&acc)[2][2][4][2], const Unit& u, int wr, int wc, int fr, int fq) const {
        const int row0 = u.pm * BM + wr * 64 + fr; const int col0 = u.pn * BM + wc * 32 + 8 * fq;
#pragma unroll
        for (int ai = 0; ai < 2; ++ai)
#pragma unroll
            for (int m = 0; m < 4; ++m) { bf16_t* rowp = O + (size_t)(row0 + ai * HALF + m * 16) * ldc + col0;
#pragma unroll
                for (int bj = 0; bj < 2; ++bj) { const f32x4 v0 = acc[ai][bj][m][0], v1 = acc[ai][bj][m][1];
                    u32x4 w; w.x = cvt_pk_bf16(v0[0], v0[1]); w.y = cvt_pk_bf16(v0[2], v0[3]); w.z = cvt_pk_bf16(v1[0], v1[1]); w.w = cvt_pk_bf16(v1[2], v1[3]);
                    *(u32x4*)(rowp + bj * HALF) = w; } }
    }
};
struct EpiF32 {
    static constexpr bool PERM = true, AFTER_DRAIN = false;
    bf16_t* O; int ldc; float* SL; int ntf;
    __device__ __forceinline__ void operator()(const f32x4 (&acc)[2][2][4][2], const Unit& u, int wr, int wc, int fr, int fq) const {
        const int ntu = u.kn >> 16, kt0 = u.kn & 0xffff;
        const int row0 = wr * 64 + fr; const int col0 = u.pn * BM + wc * 32 + 8 * fq;
        if (ntu < ntf) {
            float* basep = SL + ((size_t)(kt0 / ntu) * 512 + (u.pm == 33 ? 256 : 0)) * ldc;
#pragma unroll
            for (int ai = 0; ai < 2; ++ai)
#pragma unroll
                for (int m = 0; m < 4; ++m) { float* rowp = basep + (size_t)(row0 + ai * HALF + m * 16) * ldc + col0;
#pragma unroll
                    for (int bj = 0; bj < 2; ++bj) { *(f32x4*)(rowp + bj * HALF) = acc[ai][bj][m][0]; *(f32x4*)(rowp + bj * HALF + 4) = acc[ai][bj][m][1]; } }
        } else {
            bf16_t* basep = O + (size_t)u.pm * BM * ldc;
#pragma unroll
            for (int ai = 0; ai < 2; ++ai)
#pragma unroll
                for (int m = 0; m < 4; ++m) { bf16_t* rowp = basep + (size_t)(row0 + ai * HALF + m * 16) * ldc + col0;
#pragma unroll
                    for (int bj = 0; bj < 2; ++bj) { const f32x4 v0 = acc[ai][bj][m][0], v1 = acc[ai][bj][m][1];
                        u32x4 w; w.x = cvt_pk_bf16(v0[0], v0[1]); w.y = cvt_pk_bf16(v0[2], v0[3]); w.z = cvt_pk_bf16(v1[0], v1[1]); w.w = cvt_pk_bf16(v1[2], v1[3]);
                        *(u32x4*)(rowp + bj * HALF) = w; } }
        }
    }
};

template <int CTRL> __device__ __forceinline__ float dpp_upd(float oldv, float src) {
    return __builtin_bit_cast(float, __builtin_amdgcn_update_dpp(__builtin_bit_cast(int, oldv), __builtin_bit_cast(int, src), CTRL, 0xf, 0xf, false)); }
template <int M> __device__ __forceinline__ float conv_elem(float gp, float gc, float gn, float up, float hp, float hn, float w0, float w1, float w2, float cb) {
    const float X = (M == 0) ? hp : dpp_upd<0x121>(0.f, gp);
    const float prev = dpp_upd<0x111>(X, gc);
    const float Yv = (M == 3) ? hn : dpp_upd<0x12F>(0.f, gn);
    const float next = dpp_upd<0x101>(Yv, gc);
    const float y = w0 * prev + w1 * gc + w2 * next + cb;
    return y * __builtin_amdgcn_rcpf(1.f + __builtin_amdgcn_exp2f(y * -1.4426950408889634f)) * up;
}
template <int M> __device__ __forceinline__ f32x4 conv_group(const f32x4 GP, const f32x4 GC, const f32x4 GN, const f32x4 up, const f32x4 hp, const f32x4 hn, const f32x4 w0, const f32x4 w1, const f32x4 w2, const f32x4 cb) {
    f32x4 r;
    r.x = conv_elem<M>(GP.x, GC.x, GN.x, up.x, hp.x, hn.x, w0.x, w1.x, w2.x, cb.x);
    r.y = conv_elem<M>(GP.y, GC.y, GN.y, up.y, hp.y, hn.y, w0.y, w1.y, w2.y, cb.y);
    r.z = conv_elem<M>(GP.z, GC.z, GN.z, up.z, hp.z, hn.z, w0.z, w1.z, w2.z, cb.z);
    r.w = conv_elem<M>(GP.w, GC.w, GN.w, up.w, hp.w, hn.w, w0.w, w1.w, w2.w, cb.w);
    return r;
}
struct EpiConv {
    static constexpr bool PERM = true, AFTER_DRAIN = false;
    bf16_t* ACT; const float* cw; const float* cbias; float* BND; LAS float* xch;
    __device__ __forceinline__ void operator()(const f32x4 (&acc)[2][2][4][2], const Unit& u, int wr_, int wc_, int fr_, int fq_) const {
        int wr = wr_, wc = wc_, fr = fr_, fq = fq_;
        asm volatile("" : "+v"(fr), "+v"(fq), "+s"(wr), "+s"(wc));
        const int cl = wc * 32 + 8 * fq, f0 = u.pn * 128 + cl;
#pragma unroll
        for (int ai = 0; ai < 2; ++ai) { const int blk = 2 * ai + wr;
            if (fr == 0) { *(LAS f32x4*)(xch + (blk * 2 + 0) * 128 + cl) = acc[ai][0][0][0]; *(LAS f32x4*)(xch + (blk * 2 + 0) * 128 + cl + 4) = acc[ai][0][0][1]; }
            if (fr == 15) { *(LAS f32x4*)(xch + (blk * 2 + 1) * 128 + cl) = acc[ai][0][3][0]; *(LAS f32x4*)(xch + (blk * 2 + 1) * 128 + cl + 4) = acc[ai][0][3][1]; } }
        { float* bnd = BND + (size_t)u.pm * 6 * DFF + f0;
          if (wr == 0 && fr < 2) { *(f32x4*)(bnd + fr * DFF) = acc[0][0][0][0]; *(f32x4*)(bnd + fr * DFF + 4) = acc[0][0][0][1]; }
          asm volatile("" ::: "memory");
          if (wr == 0 && fr == 0) { *(f32x4*)(bnd + 4 * DFF) = acc[0][1][0][0]; *(f32x4*)(bnd + 4 * DFF + 4) = acc[0][1][0][1]; }
          asm volatile("" ::: "memory");
          if (wr == 1 && fr >= 14) { *(f32x4*)(bnd + (fr - 12) * DFF) = acc[1][0][3][0]; *(f32x4*)(bnd + (fr - 12) * DFF + 4) = acc[1][0][3][1]; }
          asm volatile("" ::: "memory");
          if (wr == 1 && fr == 15) { *(f32x4*)(bnd + 5 * DFF) = acc[1][1][3][0]; *(f32x4*)(bnd + 5 * DFF + 4) = acc[1][1][3][1]; }
        }
        LBAR(); __builtin_amdgcn_sched_barrier(0);
        const f32x4 w00 = *(const f32x4*)(cw + f0), w01 = *(const f32x4*)(cw + f0 + 4), w10 = *(const f32x4*)(cw + DFF + f0), w11 = *(const f32x4*)(cw + DFF + f0 + 4);
        const f32x4 w20 = *(const f32x4*)(cw + 2 * DFF + f0), w21 = *(const f32x4*)(cw + 2 * DFF + f0 + 4), cb0 = *(const f32x4*)(cbias + f0), cb1 = *(const f32x4*)(cbias + f0 + 4);
#pragma unroll
        for (int ai = 0; ai < 2; ++ai) { const int blk = 2 * ai + wr;
            f32x4 hp0 = {0.f, 0.f, 0.f, 0.f}, hp1 = hp0, hn0 = hp0, hn1 = hp0;
            if (blk > 0) { hp0 = *(const LAS f32x4*)(xch + ((blk - 1) * 2 + 1) * 128 + cl); hp1 = *(const LAS f32x4*)(xch + ((blk - 1) * 2 + 1) * 128 + cl + 4); }
            if (blk < 3) { hn0 = *(const LAS f32x4*)(xch + ((blk + 1) * 2 + 0) * 128 + cl); hn1 = *(const LAS f32x4*)(xch + ((blk + 1) * 2 + 0) * 128 + cl + 4); }
#define CONV_ROW(M, MP, MN) do { __builtin_amdgcn_sched_barrier(0); \
            const f32x4 v0 = conv_group<M>(acc[ai][0][MP][0], acc[ai][0][M][0], acc[ai][0][MN][0], acc[ai][1][M][0], hp0, hn0, w00, w10, w20, cb0); \
            const f32x4 v1 = conv_group<M>(acc[ai][0][MP][1], acc[ai][0][M][1], acc[ai][0][MN][1], acc[ai][1][M][1], hp1, hn1, w01, w11, w21, cb1); \
            const int rl = ai * HALF + wr * 64 + M * 16 + fr; \
            if (rl != 0 && rl != 255) { u32x4 w; w.x = cvt_pk_bf16(v0[0], v0[1]); w.y = cvt_pk_bf16(v0[2], v0[3]); w.z = cvt_pk_bf16(v1[0], v1[1]); w.w = cvt_pk_bf16(v1[2], v1[3]); \
                *(u32x4*)(ACT + (size_t)(u.pm * BM + rl) * DFF + f0) = w; } } while (0)
            CONV_ROW(0, 0, 1); CONV_ROW(1, 0, 2); CONV_ROW(2, 1, 3); CONV_ROW(3, 2, 3);
#undef CONV_ROW
            __builtin_amdgcn_sched_barrier(0);
        }
    }
};

template <class Epi, class Sched, bool ALIGN_EPI = false, bool SP2 = false>
__device__ __forceinline__ void gemm_phase(LAS unsigned char* lds, const Gemm g, const Sched& S, const Epi& E) {
    const int tid = threadIdx.x, wid = __builtin_amdgcn_readfirstlane(tid >> 6), lane = tid & 63, wr = wid >> 2, wc = wid & 3, fr = lane & 15, fq = lane >> 4;
    const int K = g.K;
    unsigned voffA[2], voffB[2];
#pragma unroll
    for (int i = 0; i < 2; ++i) { int R, C; stage_rc(tid * 16 + i * 8192, R, C); const int Rb = Epi::PERM ? ((R & ~31) + perm32(R & 31)) : R;
        voffA[i] = (unsigned)(R * K + C) * 2u; voffB[i] = (unsigned)(Rb * K + C) * 2u; }
    const size_t kstep = (size_t)(BK * 2);
    const size_t hstep = (size_t)HALF * K * 2;
    const size_t tstep = 2 * hstep;
    const unsigned ldsw = (unsigned)wid * 1024u;
    const int aoff = lds_byte(wr * 64 + fr, fq * 8), boff = lds_byte(wc * 32 + fr, fq * 8);
#define PG8_SA(b, h) (((b) * 2 + (h)) * HTB)
#define PG8_SB(b, h) ((4 + (b) * 2 + (h)) * HTB)
#define PG8_STAGE(bufoff, gbase, voff) do { _Pragma("unroll") for (int _i = 0; _i < 2; ++_i) \
        __builtin_amdgcn_global_load_lds((const unsigned*)((const char*)(gbase) + (voff)[_i]), (LAS unsigned*)(lds + (bufoff) + ldsw + _i * 8192), 16, 0, 0); } while (0)
#define PG8_LDA(dst, b, h) do { _Pragma("unroll") for (int m = 0; m < 4; ++m) _Pragma("unroll") for (int k = 0; k < 2; ++k) dst[m][k] = *(const LAS bf16x8*)(lds + PG8_SA(b, h) + aoff + m * 2048 + k * 1024); } while (0)
#define PG8_LDB(dst, b, h) do { _Pragma("unroll") for (int n = 0; n < 2; ++n) _Pragma("unroll") for (int k = 0; k < 2; ++k) dst[n][k] = *(const LAS bf16x8*)(lds + PG8_SB(b, h) + boff + n * 2048 + k * 1024); } while (0)
#define PG8_MMA(ai, bj, At, Bt) do { __builtin_amdgcn_s_setprio(1); _Pragma("unroll") for (int m = 0; m < 4; ++m) _Pragma("unroll") for (int n = 0; n < 2; ++n) _Pragma("unroll") for (int k = 0; k < 2; ++k) \
        acc[ai][bj][m][n] = __builtin_amdgcn_mfma_f32_16x16x32_bf16(Bt[n][k], At[m][k], acc[ai][bj][m][n], 0, 0, 0); __builtin_amdgcn_s_setprio(0); } while (0)
#define PG8_WAIT_V(n) asm volatile("s_waitcnt vmcnt(" #n ")" ::: "memory")
#define PG8_WAIT_L(n) asm volatile("s_waitcnt lgkmcnt(" #n ")" ::: "memory")
#define PG8_BAR __builtin_amdgcn_s_barrier()
#define PG8_SCHED __builtin_amdgcn_sched_barrier(0)
    Unit cur, nxt; int ui = 0;
    if (!S.next(0, cur)) return;
    f32x4 acc[2][2][4][2];
#pragma unroll
    for (int a = 0; a < 2; ++a)
#pragma unroll
        for (int b = 0; b < 2; ++b)
#pragma unroll
            for (int m = 0; m < 4; ++m)
#pragma unroll
                for (int n = 0; n < 2; ++n) acc[a][b][m][n] = (f32x4){0.f, 0.f, 0.f, 0.f};
    bf16x8 At[4][2], B0[2][2], B1[2][2];
    const char* cA = (const char*)g.A + (size_t)cur.pm * tstep + (size_t)(cur.kn & 0xffff) * kstep; const char* cB = (const char*)g.Bt + (size_t)cur.pn * tstep + (size_t)(cur.kn & 0xffff) * kstep;
    S.a_ready(cur);
    if constexpr (SP2) {
        PG8_STAGE(PG8_SB(0, 0), cB, voffB); PG8_STAGE(PG8_SB(0, 1), cB + hstep, voffB); PG8_STAGE(PG8_SA(0, 0), cA, voffA); PG8_STAGE(PG8_SA(0, 1), cA + hstep, voffA);
        if (wr == 1) PG8_BAR;
        PG8_WAIT_V(2); PG8_BAR;
        PG8_STAGE(PG8_SB(1, 0), cB + kstep, voffB); PG8_STAGE(PG8_SA(1, 0), cA + kstep, voffA); PG8_STAGE(PG8_SB(1, 1), cB + hstep + kstep, voffB);
        PG8_WAIT_V(6); PG8_BAR;
    } else {
        PG8_STAGE(PG8_SB(0, 0), cB, voffB); PG8_STAGE(PG8_SA(0, 0), cA, voffA); PG8_STAGE(PG8_SB(0, 1), cB + hstep, voffB); PG8_STAGE(PG8_SA(0, 1), cA + hstep, voffA);
        if (wr == 1) PG8_BAR;
        PG8_WAIT_V(4); PG8_BAR;
        PG8_STAGE(PG8_SB(1, 0), cB + kstep, voffB); PG8_STAGE(PG8_SA(1, 0), cA + kstep, voffA); PG8_STAGE(PG8_SB(1, 1), cB + hstep + kstep, voffB);
        PG8_WAIT_V(6); PG8_BAR;
    }
    for (;;) {
        const bool has_next = S.next(ui + 1, nxt);
        const char* nA = has_next ? (const char*)g.A + (size_t)nxt.pm * tstep + (size_t)(nxt.kn & 0xffff) * kstep : cA; const char* nB = has_next ? (const char*)g.Bt + (size_t)nxt.pn * tstep + (size_t)(nxt.kn & 0xffff) * kstep : cB;
        const int nt = cur.kn >> 16;
        for (int t = 0; t < nt; t += 2) {
            const bool last = (t == nt - 2);
            const char* a1 = cA + (size_t)(t + 1) * kstep;
            const char* a2 = last ? nA : cA + (size_t)(t + 2) * kstep; const char* b2 = last ? nB : cB + (size_t)(t + 2) * kstep;
            const char* a3 = a2 + kstep; const char* b3 = b2 + kstep;
            if (last && has_next) S.a_ready(nxt);
            if constexpr (SP2) {
            PG8_LDB(B0, 0, 0); PG8_LDB(B1, 0, 1); PG8_SCHED; PG8_LDA(At, 0, 0); PG8_STAGE(PG8_SA(1, 1), a1 + hstep, voffA);
            PG8_WAIT_V(8); PG8_WAIT_L(0); PG8_BAR; PG8_MMA(0, 0, At, B0); PG8_MMA(0, 1, At, B1); PG8_BAR; PG8_SCHED;
            PG8_LDA(At, 0, 1); PG8_STAGE(PG8_SB(0, 0), b2, voffB); PG8_STAGE(PG8_SB(0, 1), b2 + hstep, voffB); PG8_STAGE(PG8_SA(0, 0), a2, voffA);
            PG8_WAIT_V(8); PG8_WAIT_L(0); PG8_BAR; PG8_MMA(1, 0, At, B0); PG8_MMA(1, 1, At, B1); PG8_BAR; PG8_SCHED;
            PG8_LDB(B0, 1, 0); PG8_LDB(B1, 1, 1); PG8_SCHED; PG8_LDA(At, 1, 0); PG8_STAGE(PG8_SA(0, 1), a2 + hstep, voffA);
            PG8_WAIT_V(8); PG8_WAIT_L(0); PG8_BAR; PG8_MMA(0, 0, At, B0); PG8_MMA(0, 1, At, B1); PG8_BAR; PG8_SCHED;
            PG8_LDA(At, 1, 1); PG8_STAGE(PG8_SB(1, 0), b3, voffB); PG8_STAGE(PG8_SB(1, 1), b3 + hstep, voffB); PG8_STAGE(PG8_SA(1, 0), a3, voffA);
            PG8_WAIT_V(8); PG8_WAIT_L(0); PG8_BAR; PG8_MMA(1, 0, At, B0); PG8_MMA(1, 1, At, B1); PG8_BAR; PG8_SCHED;
            } else {
            PG8_LDB(B0, 0, 0); PG8_SCHED; PG8_LDA(At, 0, 0); PG8_STAGE(PG8_SA(1, 1), a1 + hstep, voffA);
            PG8_WAIT_L(8); PG8_BAR; PG8_WAIT_L(0); PG8_MMA(0, 0, At, B0); PG8_BAR; PG8_SCHED;
            PG8_LDB(B1, 0, 1); PG8_STAGE(PG8_SB(0, 0), b2, voffB);
            PG8_BAR; PG8_WAIT_L(0); PG8_MMA(0, 1, At, B1); PG8_BAR;
            PG8_LDA(At, 0, 1); PG8_STAGE(PG8_SA(0, 0), a2, voffA);
            PG8_BAR; PG8_WAIT_L(0); PG8_MMA(1, 0, At, B0); PG8_BAR; PG8_SCHED;
            PG8_STAGE(PG8_SB(0, 1), b2 + hstep, voffB);
            PG8_WAIT_V(6); PG8_BAR; PG8_MMA(1, 1, At, B1); PG8_BAR;
            PG8_LDB(B0, 1, 0); PG8_SCHED; PG8_LDA(At, 1, 0); PG8_STAGE(PG8_SA(0, 1), a2 + hstep, voffA);
            PG8_WAIT_L(8); PG8_BAR; PG8_WAIT_L(0); PG8_MMA(0, 0, At, B0); PG8_BAR; PG8_SCHED;
            PG8_LDB(B1, 1, 1); PG8_STAGE(PG8_SB(1, 0), b3, voffB);
            PG8_BAR; PG8_WAIT_L(0); PG8_MMA(0, 1, At, B1); PG8_BAR;
            PG8_LDA(At, 1, 1); PG8_STAGE(PG8_SA(1, 0), a3, voffA);
            PG8_BAR; PG8_WAIT_L(0); PG8_MMA(1, 0, At, B0); PG8_BAR; PG8_SCHED;
            PG8_STAGE(PG8_SB(1, 1), b3 + hstep, voffB);
            PG8_WAIT_V(6); PG8_BAR; PG8_MMA(1, 1, At, B1); PG8_BAR;
            }
        }
        if constexpr (ALIGN_EPI) { if (wr == 0) PG8_BAR; }
        if constexpr (!Epi::AFTER_DRAIN) { E(acc, cur, wr, wc, fr, fq); S.done(cur); }
        if (!has_next) break;
#pragma unroll
        for (int a = 0; a < 2; ++a)
#pragma unroll
            for (int b = 0; b < 2; ++b)
#pragma unroll
                for (int m = 0; m < 4; ++m)
#pragma unroll
                    for (int n = 0; n < 2; ++n) acc[a][b][m][n] = (f32x4){0.f, 0.f, 0.f, 0.f};
        cur = nxt; cA = nA; cB = nB; ++ui;
        if constexpr (ALIGN_EPI) { if (wr == 1) PG8_BAR; }
    }
    PG8_WAIT_V(0);
    if constexpr (!ALIGN_EPI) { if (wr == 0) PG8_BAR; }
    PG8_BAR;
#undef PG8_SA
#undef PG8_SB
#undef PG8_STAGE
#undef PG8_LDA
#undef PG8_LDB
#undef PG8_MMA
#undef PG8_WAIT_V
#undef PG8_WAIT_L
#undef PG8_BAR
#undef PG8_SCHED
}
}

namespace att {
constexpr int D = 128, NW = 8, QBLK = 32, KVBLK = 64;
constexpr float SCALE = 0.088388347648318440f;
constexpr float THR = 8.f;
constexpr int LDQ = NQKV, LDK = NQKV, LDO = DM;
constexpr size_t SHM_V = KVBLK * D * 2, SHM_K = KVBLK * D * 2, SHM_ATTN = 2 * SHM_V + 2 * SHM_K + NW * 64 * 4;
#define KSWZ(row, colB) ((row) * 256 + ((colB) ^ (((row) & 7) << 4)))
#define SBAR() __builtin_amdgcn_sched_barrier(0)
__device__ __forceinline__ int crow(int r, int hi) { return (r & 3) + 8 * (r >> 2) + 4 * hi; }
__device__ __forceinline__ unsigned cvtpk(float lo, float hi) { unsigned r; asm volatile("v_cvt_pk_bf16_f32 %0, %1, %2" : "=v"(r) : "v"(lo), "v"(hi)); return r; }
__device__ __forceinline__ bf16x8 ld8(const bf16_t* p) { return *reinterpret_cast<const bf16x8*>(p); }

__device__ __forceinline__ void partialSM(f32x16& p0, f32x16& p1, float& m_reg, float& mn, float& alpha) {
  constexpr float C = SCALE * 1.4426950408889634f;
  float pmax = p0[0];
#pragma unroll
  for (int r = 1; r < 16; ++r) pmax = fmaxf(pmax, p0[r]);
#pragma unroll
  for (int r = 0; r < 16; ++r) pmax = fmaxf(pmax, p1[r]);
  { auto rr = __builtin_amdgcn_permlane32_swap(__float_as_uint(pmax), __float_as_uint(pmax), false, false);
    pmax = fmaxf(__uint_as_float(rr[0]), __uint_as_float(rr[1])); }
  if (__builtin_expect(__all(pmax - m_reg <= THR / SCALE), 1)) { mn = m_reg; alpha = 1.f; }
  else { mn = fmaxf(m_reg, pmax); alpha = __builtin_amdgcn_exp2f((m_reg - mn) * C); m_reg = mn; }
  float mnC = -mn * C;
#pragma unroll
  for (int r = 0; r < 16; ++r) p0[r] = fmaf(p0[r], C, mnC);
#pragma unroll
  for (int r = 0; r < 16; ++r) p1[r] = fmaf(p1[r], C, mnC);
#pragma unroll
  for (int r = 0; r < 16; ++r) p0[r] = __builtin_amdgcn_exp2f(p0[r]);
}
__device__ __forceinline__ void finishSM(f32x16& p0, f32x16& p1, float alpha, float& l_reg, bf16x8& pa0, bf16x8& pa1, bf16x8& pa2, bf16x8& pa3) {
#pragma unroll
  for (int r = 0; r < 16; ++r) p1[r] = __builtin_amdgcn_exp2f(p1[r]);
  float ps = 0;
#pragma unroll
  for (int r = 0; r < 16; ++r) ps += p0[r];
#pragma unroll
  for (int r = 0; r < 16; ++r) ps += p1[r];
  { auto rr = __builtin_amdgcn_permlane32_swap(__float_as_uint(ps), __float_as_uint(ps), false, false);
    ps = __uint_as_float(rr[0]) + __uint_as_float(rr[1]); }
  l_reg = l_reg * alpha + ps;
#define PK4(P, BASE, OUT) do { unsigned a0 = cvtpk(P[BASE + 0], P[BASE + 1]), a1 = cvtpk(P[BASE + 2], P[BASE + 3]);   \
    unsigned b0 = cvtpk(P[BASE + 4], P[BASE + 5]), b1 = cvtpk(P[BASE + 6], P[BASE + 7]);                              \
    auto r0 = __builtin_amdgcn_permlane32_swap(a0, b0, false, false); auto r1 = __builtin_amdgcn_permlane32_swap(a1, b1, false, false); \
    u32x4 w = {r0[0], r1[0], r0[1], r1[1]}; OUT = *reinterpret_cast<bf16x8*>(&w); } while (0)
  PK4(p0, 0, pa0); PK4(p0, 8, pa1); PK4(p1, 0, pa2); PK4(p1, 8, pa3);
#undef PK4
}
__device__ __forceinline__ void qkt(f32x16& p0, f32x16& p1, const bf16_t* Ks, const bf16x8* qr, int r32, int hi) {
  p0 = f32x16{}; p1 = f32x16{};
#pragma unroll
  for (int d0 = 0; d0 < 8; ++d0) { int cb = (d0 * 16 + hi * 8) * 2;
    bf16x8 b0 = *reinterpret_cast<const bf16x8*>((const char*)Ks + KSWZ(r32, cb));
    bf16x8 b1 = *reinterpret_cast<const bf16x8*>((const char*)Ks + KSWZ(32 + r32, cb));
    p0 = __builtin_amdgcn_mfma_f32_32x32x16_bf16(b0, qr[d0], p0, 0, 0, 0);
    p1 = __builtin_amdgcn_mfma_f32_32x32x16_bf16(b1, qr[d0], p1, 0, 0, 0); }
}
__device__ __forceinline__ int v_st(int k, int c) { const int kk = (k & ~0xC) | ((k & 4) << 1) | ((k & 8) >> 1); return ((kk >> 3) * 4 + (c >> 5)) * 512 + ((kk & 7) * 32 + (c & 31)) * 2; }
__device__ __forceinline__ int v_rd_base(int lane) { return ((lane & 3) << 3) | (((lane >> 2) & 3) << 6) | (((lane >> 4) & 1) << 5) | (((lane >> 5) & 1) << 8); }
constexpr int v_rd_off(int d0, int ks, int half) { return d0 * 512 + ks * 4096 + half * 2048; }
template <int OFF> __device__ __forceinline__ s16x4 tr_read(int vb) {
  s16x4 r; asm volatile("ds_read_b64_tr_b16 %0, %1 offset:%2" : "=&v"(r) : "v"(vb), "i"(OFF) : "memory"); return r;
}
template <int D0> __device__ __forceinline__ void pv_one(f32x16& od, int vb, bf16x8 pa0, bf16x8 pa1, bf16x8 pa2, bf16x8 pa3) {
  const s16x4 l0 = tr_read<v_rd_off(D0, 0, 0)>(vb), h0 = tr_read<v_rd_off(D0, 0, 1)>(vb), l1 = tr_read<v_rd_off(D0, 1, 0)>(vb), h1 = tr_read<v_rd_off(D0, 1, 1)>(vb);
  const s16x4 l2 = tr_read<v_rd_off(D0, 2, 0)>(vb), h2 = tr_read<v_rd_off(D0, 2, 1)>(vb), l3 = tr_read<v_rd_off(D0, 3, 0)>(vb), h3 = tr_read<v_rd_off(D0, 3, 1)>(vb);
  asm volatile("s_waitcnt lgkmcnt(0)" ::: "memory"); SBAR();
#define PK(L, H) (bf16x8){L[0], L[1], L[2], L[3], H[0], H[1], H[2], H[3]}
  od = __builtin_amdgcn_mfma_f32_32x32x16_bf16(pa0, PK(l0, h0), od, 0, 0, 0);
  od = __builtin_amdgcn_mfma_f32_32x32x16_bf16(pa1, PK(l1, h1), od, 0, 0, 0);
  od = __builtin_amdgcn_mfma_f32_32x32x16_bf16(pa2, PK(l2, h2), od, 0, 0, 0);
  od = __builtin_amdgcn_mfma_f32_32x32x16_bf16(pa3, PK(l3, h3), od, 0, 0, 0);
#undef PK
}
__device__ __forceinline__ void pv_d0(f32x16* o, int vb, bf16x8 pa0, bf16x8 pa1, bf16x8 pa2, bf16x8 pa3) {
  pv_one<0>(o[0], vb, pa0, pa1, pa2, pa3); pv_one<1>(o[1], vb, pa0, pa1, pa2, pa3); pv_one<2>(o[2], vb, pa0, pa1, pa2, pa3); pv_one<3>(o[3], vb, pa0, pa1, pa2, pa3);
}

__device__ __forceinline__ void attn_dense_body(const bf16_t* __restrict__ Qb, const bf16_t* __restrict__ Kh, const bf16_t* __restrict__ Vh,
                                                bf16_t* __restrict__ Ob, int seq, char* lds) {
  const int tid = threadIdx.x, wid = tid >> 6, lane = tid & 63, r32 = lane & 31, hi = lane >> 5;
  bf16_t* V_lds = (bf16_t*)lds; bf16_t* K_lds = (bf16_t*)(lds + 2 * SHM_V);
  float* ws = (float*)(lds + 2 * SHM_V + 2 * SHM_K) + wid * 64; float* li_l = ws; float* al_l = ws + 32;
  float m_reg = -1e30f, l_reg = 0; f32x16 o[4] = {}; bf16x8 qr[8];
  const bf16_t* Qw = Qb + (long)(wid * QBLK + r32) * LDQ + hi * 8;
#pragma unroll
  for (int d0 = 0; d0 < 8; ++d0) qr[d0] = ld8(Qw + d0 * 16);
  const int sr = tid >> 4, sc = (tid & 15) * 8, vst0 = v_st(sr, sc), vst1 = v_st(32 + sr, sc);
  const int vb0 = (int)(uintptr_t)V_lds + v_rd_base(lane);
  struct { bf16x8 vs0, vs1, ks0, ks1; } sr_[2];
#define SLOAD(i, k0) do { sr_[i].vs0 = ld8(&Vh[(long)((k0) + sr) * LDK + sc]); sr_[i].vs1 = ld8(&Vh[(long)((k0) + 32 + sr) * LDK + sc]); \
    sr_[i].ks0 = ld8(&Kh[(long)((k0) + sr) * LDK + sc]); sr_[i].ks1 = ld8(&Kh[(long)((k0) + 32 + sr) * LDK + sc]); } while (0)
#define SWRITE(b, i) do { *(bf16x8*)((char*)V_lds + (b) * SHM_V + vst0) = sr_[i].vs0;          \
    *(bf16x8*)((char*)V_lds + (b) * SHM_V + vst1) = sr_[i].vs1; int kc = sc * 2;               \
    *(bf16x8*)((char*)K_lds + (b) * SHM_K + KSWZ(sr, kc)) = sr_[i].ks0;                       \
    *(bf16x8*)((char*)K_lds + (b) * SHM_K + KSWZ(32 + sr, kc)) = sr_[i].ks1; } while (0)
#define SWAIT() do { asm volatile("s_waitcnt vmcnt(4)" ::: "memory"); } while (0)
#define RESC(a) do { if (__any((a) < 1.f)) { if (hi == 0) al_l[r32] = (a); asm volatile("s_waitcnt lgkmcnt(0)" ::: "memory"); \
    _Pragma("unroll") for (int d = 0; d < 4; ++d) _Pragma("unroll") for (int r = 0; r < 16; ++r) o[d][r] *= al_l[crow(r, hi)]; } } while (0)
  f32x16 pA0, pA1, pB0, pB1; float mnA, mnB, alA, alB; bf16x8 pa0, pa1, pa2, pa3; const int NT = seq / KVBLK;
  constexpr int SE = 0, SO = 1;
  SLOAD(SE, 0); asm volatile("s_waitcnt vmcnt(0)" ::: "memory"); SWRITE(0, SE); __syncthreads();
  qkt(pA0, pA1, K_lds, qr, r32, hi); partialSM(pA0, pA1, m_reg, mnA, alA);
  SLOAD(SO, KVBLK); if (2 < NT) SLOAD(SE, 2 * KVBLK);
  SWAIT(); SWRITE(1, SO); __syncthreads();
  for (int j = 1; j + 1 < NT; j += 2) {
    SBAR(); qkt(pB0, pB1, (bf16_t*)((char*)K_lds + SHM_K), qr, r32, hi);
    finishSM(pA0, pA1, alA, l_reg, pa0, pa1, pa2, pa3); SBAR();
    SLOAD(SO, (j + 2) * KVBLK); SBAR();
    pv_d0(o, vb0, pa0, pa1, pa2, pa3); partialSM(pB0, pB1, m_reg, mnB, alB);
    __syncthreads(); SWAIT(); SWRITE(0, SE);
    RESC(alB); __syncthreads();
    SBAR(); qkt(pA0, pA1, K_lds, qr, r32, hi);
    finishSM(pB0, pB1, alB, l_reg, pa0, pa1, pa2, pa3); SBAR();
    if (j + 3 < NT) SLOAD(SE, (j + 3) * KVBLK); SBAR();
    pv_d0(o, vb0 + (int)SHM_V, pa0, pa1, pa2, pa3); partialSM(pA0, pA1, m_reg, mnA, alA);
    __syncthreads(); SWAIT(); SWRITE(1, SO);
    RESC(alA); __syncthreads();
  }
  SBAR(); qkt(pB0, pB1, (bf16_t*)((char*)K_lds + SHM_K), qr, r32, hi);
  finishSM(pA0, pA1, alA, l_reg, pa0, pa1, pa2, pa3); SBAR();
  pv_d0(o, vb0, pa0, pa1, pa2, pa3); partialSM(pB0, pB1, m_reg, mnB, alB);
  __syncthreads(); RESC(alB);
  finishSM(pB0, pB1, alB, l_reg, pa0, pa1, pa2, pa3); SBAR();
  pv_d0(o, vb0 + (int)SHM_V, pa0, pa1, pa2, pa3);
  if (hi == 0) li_l[r32] = l_reg; asm volatile("s_waitcnt lgkmcnt(0)" ::: "memory");
  float rli[16];
#pragma unroll
  for (int r = 0; r < 16; ++r) rli[r] = __builtin_amdgcn_rcpf(li_l[crow(r, hi)]);
  bf16_t* Ow = Ob + (long)(wid * QBLK) * LDO;
#pragma unroll
  for (int r = 0; r < 16; ++r) { int orow = crow(r, hi);
#pragma unroll
    for (int d0 = 0; d0 < 4; ++d0) Ow[(long)orow * LDO + d0 * 32 + r32] = (bf16_t)f2bf(o[d0][r] * rli[r]); }
  __syncthreads();
#undef SLOAD
#undef SWRITE
#undef SWAIT
#undef RESC
}
}

__device__ __forceinline__ void transpose_item(const float* W, int K, int N, bf16_t* WT, LAS float* scr, int item, int lane, bool ffn_remap = false) {
    const int nblk = N / 32, kb = item / nblk, nb = item % nblk, k0 = 64 * kb, n0 = 32 * nb;
    int n0o = n0; if (ffn_remap) { const int half = n0 >= DFF ? 1 : 0, f = n0 - half * DFF; n0o = (f >> 7) * 256 + half * 128 + (f & 127); }
#pragma unroll 8
    for (int i = 0; i < 32; ++i) { const int kk = 2 * i + (lane >> 5); scr[kk * 33 + (lane & 31)] = __builtin_nontemporal_load(W + (size_t)(k0 + kk) * N + n0 + (lane & 31)); }
    asm volatile("s_waitcnt lgkmcnt(0)" ::: "memory");
    const int c = lane & 7;
#pragma unroll
    for (int j = 0; j < 4; ++j) { const int n = (lane >> 3) + 8 * j; const LAS float* s = scr + (8 * c) * 33 + n;
        u32x4 o; o.x = pk2(s[0 * 33], s[1 * 33]); o.y = pk2(s[2 * 33], s[3 * 33]); o.z = pk2(s[4 * 33], s[5 * 33]); o.w = pk2(s[6 * 33], s[7 * 33]);
        *(u32x4*)(WT + (size_t)(n0o + n) * K + k0 + 8 * c) = o; }
    asm volatile("s_waitcnt lgkmcnt(0)" ::: "memory");
}

__device__ __forceinline__ void ada_phase(const float* c, const float* c_ctx, const float* ada_w, const float* ada_b, float* mod, LAS unsigned char* lds, int wg, int G, int tid) {
    LAS float* sv = (LAS float*)lds;
    LAS float* part = sv + 3 * 2048;
    for (int i = tid; i < 3 * 2048; i += 512) { const int s = i >> 11, k = i & 2047; const float v = (s == 0) ? c_ctx[k] : c[(s - 1) * 2048 + k]; sv[i] = siluf(v); }
    __syncthreads();
    const int wave = tid >> 6, lane = tid & 63;
    for (int item = wg; item < 192; item += G) {
        const int L = item / 96, n0 = (item % 96) * 128;
        const float* W = ada_w + (size_t)L * 2048 * 12288 + n0 + lane * 2;
        float a0x = 0, a0y = 0, a1x = 0, a1y = 0, a2x = 0, a2y = 0;
        const int k0 = wave * 256;
#pragma unroll 8
        for (int k = 0; k < 256; ++k) {
            const f32x2 w = __builtin_nontemporal_load((const f32x2*)(W + (size_t)(k0 + k) * 12288));
            const float s0 = sv[k0 + k], s1 = sv[2048 + k0 + k], s2 = sv[4096 + k0 + k];
            a0x += s0 * w.x; a0y += s0 * w.y; a1x += s1 * w.x; a1y += s1 * w.y; a2x += s2 * w.x; a2y += s2 * w.y;
        }
        part[(wave * 3 + 0) * 128 + lane * 2] = a0x; part[(wave * 3 + 0) * 128 + lane * 2 + 1] = a0y;
        part[(wave * 3 + 1) * 128 + lane * 2] = a1x; part[(wave * 3 + 1) * 128 + lane * 2 + 1] = a1y;
        part[(wave * 3 + 2) * 128 + lane * 2] = a2x; part[(wave * 3 + 2) * 128 + lane * 2 + 1] = a2y;
        __syncthreads();
        if (tid < 384) { const int s = tid >> 7, n = tid & 127; float acc = ada_b[L * 12288 + n0 + n];
#pragma unroll
            for (int w = 0; w < 8; ++w) acc += part[(w * 3 + s) * 128 + n];
            mod[(size_t)(L * 3 + s) * 12288 + n0 + n] = acc; }
        __syncthreads();
    }
}

template <bool XIN_BF, bool XOUT_BF>
__device__ __forceinline__ void row_phase(const float* xin_lat, const float* xin_ctx, float* xout_lat, float* xout_ctx, bf16_t* XR,
                                          const bf16_t* Y, const float* g_post, const float* g_pre, const float* modL, int jgate, int jshift, int jscale,
                                          bf16_t* H, bool has_y, bool make_h, bool lat_only, int gw, int NGW, int lane, const float* YS = nullptr, int nsplit = 0) {
    for (int r = gw; r < MR; r += NGW) {
        const int b = r / SB, p = r - b * SB; int s; const float* xi; float* xo; const bool ctxrow = p < CTX;
        size_t xrow;
        if (ctxrow) { if (lat_only) continue; s = 0; xrow = (size_t)(b * CTX + p) * DM; xi = xin_ctx + xrow; xo = xout_ctx + xrow; }
        else { s = 1 + b; xrow = (size_t)(b * SEQ + p - CTX) * DM; xi = xin_lat + xrow; xo = xout_lat + xrow; }
        const float* ms = modL + (size_t)s * 12288;
        f32x4 x[8];
#pragma unroll
        for (int j = 0; j < 8; ++j) {
            if (XIN_BF && !ctxrow) { const u32x2 xb = *(const u32x2*)(XR + xrow + (j * 64 + lane) * 4); x[j] = (f32x4){bflo(xb.x), bfhi(xb.x), bflo(xb.y), bfhi(xb.y)}; }
            else x[j] = XIN_BF ? *(const f32x4*)(xi + (j * 64 + lane) * 4) : __builtin_nontemporal_load((const f32x4*)(xi + (j * 64 + lane) * 4));
        }
        if (has_y) {
            f32x4 y[8]; float ss = 0.f;
#pragma unroll
            for (int j = 0; j < 8; ++j) {
                if (ctxrow && nsplit > 0) { f32x4 t = {0.f, 0.f, 0.f, 0.f};
                    for (int sp = 0; sp < nsplit; ++sp) t += *(const f32x4*)(YS + ((size_t)sp * 512 + b * CTX + p) * DM + (j * 64 + lane) * 4);
                    y[j] = t; }
                else { const u32x2 yb = *(const u32x2*)(Y + (size_t)r * DM + (j * 64 + lane) * 4); y[j] = (f32x4){bflo(yb.x), bfhi(yb.x), bflo(yb.y), bfhi(yb.y)}; }
                ss += (y[j].x * y[j].x + y[j].y * y[j].y) + (y[j].z * y[j].z + y[j].w * y[j].w); }
            const float rs = rsqrtf(wave_sum(ss) * (1.f / DM) + EPS);
#pragma unroll
            for (int j = 0; j < 8; ++j) { const f32x4 gp = *(const f32x4*)(g_post + (j * 64 + lane) * 4); const f32x4 gt = *(const f32x4*)(ms + jgate * 2048 + (j * 64 + lane) * 4);
                x[j] = x[j] + gt * (y[j] * rs * gp);
                if (XOUT_BF && !ctxrow) { u32x2 w; w.x = cvt_pk_bf16(x[j].x, x[j].y); w.y = cvt_pk_bf16(x[j].z, x[j].w); *(u32x2*)(XR + xrow + (j * 64 + lane) * 4) = w;
                    x[j] = (f32x4){bflo(w.x), bfhi(w.x), bflo(w.y), bfhi(w.y)}; }
                else *(f32x4*)(xo + (j * 64 + lane) * 4) = x[j]; }
        }
        if (make_h) {
            float ss = 0.f;
#pragma unroll
            for (int j = 0; j < 8; ++j) ss += (x[j].x * x[j].x + x[j].y * x[j].y) + (x[j].z * x[j].z + x[j].w * x[j].w);
            const float rs = rsqrtf(wave_sum(ss) * (1.f / DM) + EPS);
#pragma unroll
            for (int j = 0; j < 8; ++j) { const f32x4 gp = *(const f32x4*)(g_pre + (j * 64 + lane) * 4); const f32x4 sh = *(const f32x4*)(ms + jshift * 2048 + (j * 64 + lane) * 4);
                const f32x4 sc = *(const f32x4*)(ms + jscale * 2048 + (j * 64 + lane) * 4);
                const f32x4 hv = (x[j] * rs * gp) * (sc + 1.f) + sh;
                u32x2 w; w.x = cvt_pk_bf16(hv.x, hv.y); w.y = cvt_pk_bf16(hv.z, hv.w);
                *(u32x2*)(H + (size_t)r * DM + (j * 64 + lane) * 4) = w; }
        }
    }
}

__device__ __forceinline__ void gla_prep_phase(bf16_t* P, bf16_t* QB, float* EB, const float* __restrict__ lbl, LAS unsigned char* lds, int wg, int G, int tid) {
    const int lane = tid & 63, w = __builtin_amdgcn_readfirstlane(tid >> 6);
    constexpr float L2E = 1.4426950408889634f;
    int par = 0;
    unsigned nq[8], nf[8], nb[8];
    if (wg < NB * NH * 132) { const int rb0 = wg % 132, bh0 = wg / 132; const size_t r0 = (size_t)(bh0 >> 4) * SB + rb0 * 64 + 8 * w; const int c0 = (bh0 & 15) * 128 + 2 * lane;
#pragma unroll
        for (int i = 0; i < 8; ++i) { const size_t ro = (r0 + i) * NHG + c0; nq[i] = *(const unsigned*)(P + ro); nf[i] = *(const unsigned*)(P + ro + 2048); nb[i] = *(const unsigned*)(P + ro + 4096); } }
    for (int item = wg; item < NB * NH * 132; item += G, par ^= 1) {
        LAS float* TOT = (LAS float*)lds + par * 2048;
        const int rb = item % 132, bh = item / 132, h = bh & 15, b = bh >> 4;
        float lb[2][2], oml[2][2];
#pragma unroll
        for (int d = 0; d < 2; ++d)
#pragma unroll
            for (int e = 0; e < 2; ++e) { const int ch = h * 128 + 2 * lane + e; const float l0 = lbl[(d * 2 + 0) * 2048 + ch], l1 = lbl[(d * 2 + 1) * 2048 + ch];
                lb[d][e] = __builtin_amdgcn_rcpf(1.f + __builtin_amdgcn_exp2f((l1 - l0) * L2E)); oml[d][e] = 1.f - lb[d][e]; }
        const size_t row0 = (size_t)b * SB + rb * 64 + 8 * w;
        const int col = h * 128 + 2 * lane;
        unsigned q2[8], ff[8], fb[8];
#pragma unroll
        for (int i = 0; i < 8; ++i) { q2[i] = nq[i]; ff[i] = nf[i]; fb[i] = nb[i]; }
        if (item + G < NB * NH * 132) {
            const int it2 = item + G, rb2 = it2 % 132, bh2 = it2 / 132;
            const size_t r2 = (size_t)(bh2 >> 4) * SB + rb2 * 64 + 8 * w; const int c2 = (bh2 & 15) * 128 + 2 * lane;
#pragma unroll
            for (int i = 0; i < 8; ++i) { const size_t ro = (r2 + i) * NHG + c2; nq[i] = *(const unsigned*)(P + ro); nf[i] = *(const unsigned*)(P + ro + 2048); nb[i] = *(const unsigned*)(P + ro + 4096); }
        }
        float blf[8][2], blb[8][2], kkf[8][2], kkb[8][2];
        { float r0 = 0.f, r1 = 0.f;
#pragma unroll
          for (int i = 0; i < 8; ++i) {
              { const float sg = __builtin_amdgcn_rcpf(1.f + __builtin_amdgcn_exp2f(bflo(ff[i]) * -L2E)); r0 += __builtin_amdgcn_logf(lb[0][0] + oml[0][0] * sg); blf[i][0] = r0; kkf[i][0] = oml[0][0] - oml[0][0] * sg; }
              { const float sg = __builtin_amdgcn_rcpf(1.f + __builtin_amdgcn_exp2f(bfhi(ff[i]) * -L2E)); r1 += __builtin_amdgcn_logf(lb[0][1] + oml[0][1] * sg); blf[i][1] = r1; kkf[i][1] = oml[0][1] - oml[0][1] * sg; }
          }
          *(LAS f32x2*)(TOT + w * 128 + 2 * lane) = (f32x2){r0, r1}; }
        { float r0 = 0.f, r1 = 0.f;
#pragma unroll
          for (int i = 7; i >= 0; --i) {
              { const float sg = __builtin_amdgcn_rcpf(1.f + __builtin_amdgcn_exp2f(bflo(fb[i]) * -L2E)); r0 += __builtin_amdgcn_logf(lb[1][0] + oml[1][0] * sg); blb[i][0] = r0; kkb[i][0] = oml[1][0] - oml[1][0] * sg; }
              { const float sg = __builtin_amdgcn_rcpf(1.f + __builtin_amdgcn_exp2f(bfhi(fb[i]) * -L2E)); r1 += __builtin_amdgcn_logf(lb[1][1] + oml[1][1] * sg); blb[i][1] = r1; kkb[i][1] = oml[1][1] - oml[1][1] * sg; }
          }
          *(LAS f32x2*)(TOT + 1024 + w * 128 + 2 * lane) = (f32x2){r0, r1}; }
        LBAR();
        float pf0 = 0.f, pf1 = 0.f, tf0 = 0.f, tf1 = 0.f, pb0 = 0.f, pb1 = 0.f, tb0 = 0.f, tb1 = 0.f;
#pragma unroll
        for (int g = 0; g < 8; ++g) { const f32x2 x = *(const LAS f32x2*)(TOT + g * 128 + 2 * lane), y = *(const LAS f32x2*)(TOT + 1024 + g * 128 + 2 * lane);
            tf0 += x.x; tf1 += x.y; tb0 += y.x; tb1 += y.y; if (g < w) { pf0 += x.x; pf1 += x.y; } if (g > w) { pb0 += y.x; pb1 += y.y; } }
#pragma unroll
        for (int i = 0; i < 8; ++i) {
            const float qs0 = bflo(q2[i]), qs1 = bfhi(q2[i]);
            const float s0 = qs0 * 0.08838834764831845f * __builtin_amdgcn_rcpf(1.f + __builtin_amdgcn_exp2f(qs0 * -L2E));
            const float s1 = qs1 * 0.08838834764831845f * __builtin_amdgcn_rcpf(1.f + __builtin_amdgcn_exp2f(qs1 * -L2E));
            const float df0 = pf0 + blf[i][0] - tf0, df1 = pf1 + blf[i][1] - tf1, db0 = pb0 + blb[i][0] - tb0, db1 = pb1 + blb[i][1] - tb1;
            const size_t ro = (row0 + i) * NHG + col;
            *(unsigned*)(P + ro) = cvt_pk_bf16(s0 * __builtin_amdgcn_exp2f(df0), s1 * __builtin_amdgcn_exp2f(df1));
            *(unsigned*)(P + ro + 2048) = cvt_pk_bf16(kkf[i][0] * __builtin_amdgcn_exp2f(-df0), kkf[i][1] * __builtin_amdgcn_exp2f(-df1));
            *(unsigned*)(P + ro + 4096) = cvt_pk_bf16(kkb[i][0] * __builtin_amdgcn_exp2f(-db0), kkb[i][1] * __builtin_amdgcn_exp2f(-db1));
            *(unsigned*)(QB + (row0 + i) * DM + col) = cvt_pk_bf16(s0 * __builtin_amdgcn_exp2f(db0), s1 * __builtin_amdgcn_exp2f(db1));
        }
        if (w == 0) {
            const int cb = rb < 4 ? 3 - rb : 135 - rb;
            *(f32x2*)(EB + ((size_t)((b * 16 + h) * 2 + 0) * 132 + rb) * 128 + 2 * lane) = (f32x2){__builtin_amdgcn_exp2f(tf0), __builtin_amdgcn_exp2f(tf1)};
            *(f32x2*)(EB + ((size_t)((b * 16 + h) * 2 + 1) * 132 + cb) * 128 + 2 * lane) = (f32x2){__builtin_amdgcn_exp2f(tb0), __builtin_amdgcn_exp2f(tb1)};
        }
    }
    __syncthreads();
}

__device__ __forceinline__ void gla_item(const bf16_t* __restrict__ P, const bf16_t* __restrict__ QS, int ldq, const float* __restrict__ EB, bf16_t* __restrict__ Od, LAS unsigned char* lds, int b, int h, int dir, int vs, int tid) {
    const int lane = tid & 63, w = __builtin_amdgcn_readfirstlane(tid >> 6), fr = lane & 15, fq = lane >> 4;
    constexpr int SETB = 66560;
    f32x4 S0 = {0.f, 0.f, 0.f, 0.f}, S1 = {0.f, 0.f, 0.f, 0.f};
    const int qrow = tid >> 4, colq = h * 128 + (tid & 15) * 8;
    const int kq = tid & 31, tg = tid >> 5, colf = 2048 * (1 + dir) + h * 128 + 4 * kq;
    const int colv = 3 * 2048 + h * 128 + vs * 32 + (tid & 7) * 4;
    const int tv = tid >> 3, base = b * SB, rofs = dir ? 63 : 0, rsign = dir ? -1 : 1;
    const float* ebp = EB + (size_t)((b * 16 + h) * 2 + dir) * 132 * 128 + 16 * w + 4 * fq;
    u32x4 q4[2][2]; u32x2 k2[2][4]; u32x2 vv[2]; f32x4 eb[2];
#define GLA_R0(c) (dir ? ((c) < 4 ? base + 192 - 64 * (c) : base + 8640 - 64 * (c)) : base + 64 * (c))
#define GLA_LOAD(u, c) do { const int R0n = GLA_R0(c); \
        _Pragma("unroll") for (int i = 0; i < 2; ++i) q4[u][i] = *(const u32x4*)(QS + (size_t)(R0n + rofs + rsign * (qrow + 32 * i)) * ldq + colq); \
        _Pragma("unroll") for (int i = 0; i < 4; ++i) k2[u][i] = *(const u32x2*)(P + (size_t)(R0n + rofs + rsign * (4 * tg + i)) * NHG + colf); \
        vv[u] = *(const u32x2*)(P + (size_t)(R0n + rofs + rsign * tv) * NHG + colv); eb[u] = *(const f32x4*)(ebp + (size_t)(c) * 128); __builtin_amdgcn_sched_barrier(0); } while (0)
    GLA_LOAD(0, 0); __builtin_amdgcn_sched_barrier(0); GLA_LOAD(1, 1); __builtin_amdgcn_sched_barrier(0);
    const int ti = w >> 1, vi = w & 1;
    for (int c0 = 0; c0 < 132; c0 += 2) {
#pragma unroll
      for (int u = 0; u < 2; ++u) {
        const int c = c0 + u;
        const int R0 = GLA_R0(c);
        LAS unsigned char* QD = lds + (u & 1) * SETB; LAS unsigned char* KD = QD + 17408; LAS unsigned char* KDT = QD + 34816; LAS unsigned char* VT = QD + 53248; LAS unsigned char* SDT = QD + 57856;
#pragma unroll
        for (int i = 0; i < 2; ++i) *(LAS u32x4*)(QD + (qrow + 32 * i) * 272 + (tid & 15) * 16) = q4[u][i];
#pragma unroll
        for (int i = 0; i < 4; ++i) *(LAS u32x2*)(KD + (4 * tg + i) * 272 + kq * 8) = k2[u][i];
        { const u32x2 r0 = k2[u][0], r1 = k2[u][1], r2 = k2[u][2], r3 = k2[u][3];
          *(LAS u32x2*)(KDT + (4 * kq + 0) * 144 + tg * 8) = (u32x2){(r0.x & 0xffffu) | (r1.x << 16), (r2.x & 0xffffu) | (r3.x << 16)};
          *(LAS u32x2*)(KDT + (4 * kq + 1) * 144 + tg * 8) = (u32x2){(r0.x >> 16) | (r1.x & 0xffff0000u), (r2.x >> 16) | (r3.x & 0xffff0000u)};
          *(LAS u32x2*)(KDT + (4 * kq + 2) * 144 + tg * 8) = (u32x2){(r0.y & 0xffffu) | (r1.y << 16), (r2.y & 0xffffu) | (r3.y << 16)};
          *(LAS u32x2*)(KDT + (4 * kq + 3) * 144 + tg * 8) = (u32x2){(r0.y >> 16) | (r1.y & 0xffff0000u), (r2.y >> 16) | (r3.y & 0xffff0000u)}; }
        { LAS bf16_t* vt = (LAS bf16_t*)VT; const int v4 = (tid & 7) * 4;
          vt[(v4 + 0) * 72 + tv] = (bf16_t)(vv[u].x & 0xffffu); vt[(v4 + 1) * 72 + tv] = (bf16_t)(vv[u].x >> 16);
          vt[(v4 + 2) * 72 + tv] = (bf16_t)(vv[u].y & 0xffffu); vt[(v4 + 3) * 72 + tv] = (bf16_t)(vv[u].y >> 16); }
        S0 *= eb[u]; S1 *= eb[u];
        *(LAS u32x2*)(SDT + fr * 272 + (16 * w + 4 * fq) * 2) = (u32x2){cvt_pk_bf16(S0.x, S0.y), cvt_pk_bf16(S0.z, S0.w)};
        *(LAS u32x2*)(SDT + (16 + fr) * 272 + (16 * w + 4 * fq) * 2) = (u32x2){cvt_pk_bf16(S1.x, S1.y), cvt_pk_bf16(S1.z, S1.w)};
        { const int cn = (c + 2 < 132) ? c + 2 : 131; GLA_LOAD(u, cn); }
        LBAR();
        { bf16x8 bq[4], ak[4][4], as_[4], kt[2], vb0[2], vb1[2]; s16x4 av[4];
#pragma unroll
          for (int ks = 0; ks < 4; ++ks) bq[ks] = *(const LAS bf16x8*)(QD + (16 * ti + fr) * 272 + (ks * 32 + fq * 8) * 2);
#pragma unroll
          for (int si = 0; si < 4; ++si) if (si <= ti) {
#pragma unroll
              for (int ks = 0; ks < 4; ++ks) ak[si][ks] = *(const LAS bf16x8*)(KD + (16 * si + fr) * 272 + (ks * 32 + fq * 8) * 2);
              av[si] = *(const LAS s16x4*)(VT + (16 * vi + fr) * 144 + (16 * si + 4 * fq) * 2); }
#pragma unroll
          for (int ks = 0; ks < 4; ++ks) as_[ks] = *(const LAS bf16x8*)(SDT + (16 * vi + fr) * 272 + (ks * 32 + fq * 8) * 2);
#pragma unroll
          for (int ks = 0; ks < 2; ++ks) { kt[ks] = *(const LAS bf16x8*)(KDT + (16 * w + fr) * 144 + (ks * 32 + fq * 8) * 2);
              vb0[ks] = *(const LAS bf16x8*)(VT + fr * 144 + (ks * 32 + fq * 8) * 2); vb1[ks] = *(const LAS bf16x8*)(VT + (16 + fr) * 144 + (ks * 32 + fq * 8) * 2); }
          f32x4 o = {0.f, 0.f, 0.f, 0.f};
#pragma unroll
          for (int ks = 0; ks < 4; ++ks) o = __builtin_amdgcn_mfma_f32_16x16x32_bf16(as_[ks], bq[ks], o, 0, 0, 0);
#pragma unroll
          for (int si = 0; si < 4; ++si) if (si <= ti) {
              f32x4 acc = {0.f, 0.f, 0.f, 0.f};
#pragma unroll
              for (int ks = 0; ks < 4; ++ks) acc = __builtin_amdgcn_mfma_f32_16x16x32_bf16(ak[si][ks], bq[ks], acc, 0, 0, 0);
              if (si == ti) {
#pragma unroll
                  for (int j = 0; j < 4; ++j) if (4 * fq + j > fr) acc[j] = 0.f;
              }
              const u32x2 pk = {cvt_pk_bf16(acc.x, acc.y), cvt_pk_bf16(acc.z, acc.w)};
              o = __builtin_amdgcn_mfma_f32_16x16x16bf16_1k(av[si], __builtin_bit_cast(s16x4, pk), o, 0, 0, 0);
          }
#pragma unroll
          for (int ks = 0; ks < 2; ++ks) { S0 = __builtin_amdgcn_mfma_f32_16x16x32_bf16(kt[ks], vb0[ks], S0, 0, 0, 0); S1 = __builtin_amdgcn_mfma_f32_16x16x32_bf16(kt[ks], vb1[ks], S1, 0, 0, 0); }
          const size_t ro = (size_t)(R0 + rofs + rsign * (16 * ti + fr)) * DM;
          *(u32x2*)(Od + ro + h * 128 + vs * 32 + 16 * vi + 4 * fq) = (u32x2){cvt_pk_bf16(o.x, o.y), cvt_pk_bf16(o.z, o.w)}; }
      }
    }
#undef GLA_LOAD
#undef GLA_R0
    __syncthreads();
}

__device__ __forceinline__ void readout_phase(const bf16_t* Ofw, const bf16_t* Obw, const bf16_t* P, const float* o_gain, bf16_t* R, int gw, int NGW, int lane) {
    const int cl = (8 * lane) & 127;
    const f32x4 g0 = *(const f32x4*)(o_gain + cl), g1 = *(const f32x4*)(o_gain + cl + 4);
    const float gn[8] = {g0.x, g0.y, g0.z, g0.w, g1.x, g1.y, g1.z, g1.w};
    for (int it0 = gw * 4; it0 < MR * 4; it0 += NGW * 4) {
        u32x4 a[4], bq[4], g[4];
#pragma unroll
        for (int u = 0; u < 4; ++u) { const int it = it0 + u, r = it >> 2, c0 = (it & 3) * 512 + 8 * lane;
            a[u] = *(const u32x4*)(Ofw + (size_t)r * DM + c0); bq[u] = *(const u32x4*)(Obw + (size_t)r * DM + c0); g[u] = *(const u32x4*)(P + (size_t)r * NHG + 4 * DM + c0); }
#pragma unroll
        for (int u = 0; u < 4; ++u) { const int it = it0 + u, r = it >> 2, c0 = (it & 3) * 512 + 8 * lane;
            float o[8];
            o[0] = bflo(a[u].x) + bflo(bq[u].x); o[1] = bfhi(a[u].x) + bfhi(bq[u].x); o[2] = bflo(a[u].y) + bflo(bq[u].y); o[3] = bfhi(a[u].y) + bfhi(bq[u].y);
            o[4] = bflo(a[u].z) + bflo(bq[u].z); o[5] = bfhi(a[u].z) + bfhi(bq[u].z); o[6] = bflo(a[u].w) + bflo(bq[u].w); o[7] = bfhi(a[u].w) + bfhi(bq[u].w);
            float ss = 0.f;
#pragma unroll
            for (int e = 0; e < 8; ++e) ss += o[e] * o[e];
            ss += __shfl_xor(ss, 1); ss += __shfl_xor(ss, 2); ss += __shfl_xor(ss, 4); ss += __shfl_xor(ss, 8);
            const float rs = rsqrtf(ss * (1.f / 128.f) + EPS);
            const float gv[8] = {bflo(g[u].x), bfhi(g[u].x), bflo(g[u].y), bfhi(g[u].y), bflo(g[u].z), bfhi(g[u].z), bflo(g[u].w), bfhi(g[u].w)};
            float v[8];
#pragma unroll
            for (int e = 0; e < 8; ++e) v[e] = o[e] * rs * gn[e] * siluf(gv[e]);
            u32x4 wv; wv.x = cvt_pk_bf16(v[0], v[1]); wv.y = cvt_pk_bf16(v[2], v[3]); wv.z = cvt_pk_bf16(v[4], v[5]); wv.w = cvt_pk_bf16(v[6], v[7]);
            *(u32x4*)(R + (size_t)r * DM + c0) = wv; }
    }
}

__device__ __forceinline__ void conv_fix_phase(const float* BND, const float* cw, const float* cbias, bf16_t* ACT, bool lat_only, int gw, int NGW, int lane) {
    constexpr float L2E = 1.4426950408889634f;
    for (int it = gw; it < 66 * 2 * 11; it += NGW) {
        const int cbk = it % 11, rest = it / 11, which = rest & 1, pm = rest >> 1;
        if (lat_only && (pm == 0 || pm == 33)) continue;
        const int c0 = cbk * 512 + 8 * lane;
        const float* bn = BND + (size_t)pm * 6 * DFF + c0;
        f32x4 pv[2], cv[2], nv[2], uv[2]; size_t row;
        if (which == 0) {
            const bool seq_start = (pm == 0 || pm == 1 || pm == 33 || pm == 34);
#pragma unroll
            for (int hh = 0; hh < 2; ++hh) { pv[hh] = seq_start ? (f32x4){0.f, 0.f, 0.f, 0.f} : *(const f32x4*)(bn - 6 * DFF + 3 * DFF + 4 * hh);
                cv[hh] = *(const f32x4*)(bn + 4 * hh); nv[hh] = *(const f32x4*)(bn + DFF + 4 * hh); uv[hh] = *(const f32x4*)(bn + 4 * DFF + 4 * hh); }
            row = (size_t)pm * 256;
        } else {
            const bool seq_end = (pm == 0 || pm == 32 || pm == 33 || pm == 65);
#pragma unroll
            for (int hh = 0; hh < 2; ++hh) { pv[hh] = *(const f32x4*)(bn + 2 * DFF + 4 * hh); cv[hh] = *(const f32x4*)(bn + 3 * DFF + 4 * hh);
                nv[hh] = seq_end ? (f32x4){0.f, 0.f, 0.f, 0.f} : *(const f32x4*)(bn + 6 * DFF + 4 * hh); uv[hh] = *(const f32x4*)(bn + 5 * DFF + 4 * hh); }
            row = (size_t)pm * 256 + 255;
        }
        float v[8];
#pragma unroll
        for (int hh = 0; hh < 2; ++hh) {
            const f32x4 w0 = *(const f32x4*)(cw + c0 + 4 * hh), w1 = *(const f32x4*)(cw + DFF + c0 + 4 * hh), w2 = *(const f32x4*)(cw + 2 * DFF + c0 + 4 * hh), cb = *(const f32x4*)(cbias + c0 + 4 * hh);
#pragma unroll
            for (int j = 0; j < 4; ++j) { const float y = w0[j] * pv[hh][j] + w1[j] * cv[hh][j] + w2[j] * nv[hh][j] + cb[j];
                v[4 * hh + j] = y * __builtin_amdgcn_rcpf(1.f + __builtin_amdgcn_exp2f(y * -L2E)) * uv[hh][j]; }
        }
        u32x4 wv; wv.x = cvt_pk_bf16(v[0], v[1]); wv.y = cvt_pk_bf16(v[2], v[3]); wv.z = cvt_pk_bf16(v[4], v[5]); wv.w = cvt_pk_bf16(v[6], v[7]);
        *(u32x4*)(ACT + row * DFF + c0) = wv;
    }
}

__device__ __forceinline__ void qknorm_phase(bf16_t* QKV, const float* q_gain, const float* k_gain, int gw, int NGW, int lane) {
    const int cl = (8 * lane) & 127;
    for (int it = gw; it < MR * 5; it += NGW) {
        const int r = it / 5, grp = it - r * 5, p = r % SB;
        const bool lat = p >= CTX;
        if (!lat && grp < 4) continue;
        bf16_t* ptr = QKV + (size_t)r * NQKV + grp * 512 + 8 * lane;
        const float* gn = (grp < 4) ? q_gain : k_gain;
        const u32x4 a = *(const u32x4*)ptr;
        float x[8] = {bflo(a.x), bfhi(a.x), bflo(a.y), bfhi(a.y), bflo(a.z), bfhi(a.z), bflo(a.w), bfhi(a.w)};
        float ss = 0.f;
#pragma unroll
        for (int e = 0; e < 8; ++e) ss += x[e] * x[e];
        ss += __shfl_xor(ss, 1); ss += __shfl_xor(ss, 2); ss += __shfl_xor(ss, 4); ss += __shfl_xor(ss, 8);
        const float rs = rsqrtf(ss * (1.f / 128.f) + EPS);
#pragma unroll
        for (int e = 0; e < 8; ++e) x[e] = x[e] * rs * gn[cl + e];
        if (lat) {
            const int t = p - CTX; const float prow = (float)(t >> 6), pcol = (float)(t & 63);
#pragma unroll
            for (int e2 = 0; e2 < 4; ++e2) {
                const int i = (cl >> 1) + e2; const int fi = i & 31;
                const float invf = exp2f(-(float)fi * (13.287712379549449f / 32.f));
                const float ang = ((i >= 32) ? pcol : prow) * invf;
                float sn, cs; sincosf(ang, &sn, &cs);
                const float x1 = x[2 * e2], x2 = x[2 * e2 + 1];
                x[2 * e2] = x1 * cs - x2 * sn; x[2 * e2 + 1] = x1 * sn + x2 * cs;
            }
        }
        u32x4 wv; wv.x = cvt_pk_bf16(x[0], x[1]); wv.y = cvt_pk_bf16(x[2], x[3]); wv.z = cvt_pk_bf16(x[4], x[5]); wv.w = cvt_pk_bf16(x[6], x[7]);
        *(u32x4*)ptr = wv;
    }
}


#define XB_TMO      128
#define XB_XCNT(j)  (256  + 64 * (j))
#define XB_XSUB(j)  (1280 + 64 * (j))
#define XB_XGEN(j)  (2304 + 64 * (j))
#define XB_TOP      3328
#define XB_TOPGEN   3392
#define XCD_BAR_WORDS 3456
#define XB_SPIN_CAP (1u << 20)
__device__ __forceinline__ unsigned xb_ld(unsigned* p)              { return __hip_atomic_load(p, __ATOMIC_RELAXED, __HIP_MEMORY_SCOPE_AGENT); }
__device__ __forceinline__ unsigned xb_add(unsigned* p, unsigned v) { return __hip_atomic_fetch_add(p, v, __ATOMIC_RELAXED, __HIP_MEMORY_SCOPE_AGENT); }
__device__ __forceinline__ unsigned xb_xcc_id() { return (unsigned)__builtin_amdgcn_s_getreg((3 << 11) | 20) & 0xFu; }
#define XB_SPIN(cond, bar) do { unsigned _sp = 0; while (cond) { __builtin_amdgcn_s_sleep(1); \
    if ((++_sp & 255u) == 0u) { if (xb_ld(&(bar)[XB_TMO])) break; if (_sp > XB_SPIN_CAP) { atomicAdd(&(bar)[XB_TMO], 1u); break; } } } } while (0)
struct XcdBarrier { unsigned* bar; unsigned x; volatile LAS unsigned* st; };
__device__ __forceinline__ XcdBarrier xcd_barrier_post(unsigned* bar, volatile LAS unsigned* st) {
    XcdBarrier b; b.bar = bar; b.x = xb_xcc_id(); b.st = st;
    if (threadIdx.x == 0) (void)xb_add(&bar[XB_XCNT(b.x)], 1u);
    return b;
}
__device__ __forceinline__ void xcd_barrier_complete(unsigned* bar, unsigned x, unsigned& nloc, unsigned& nx) {
    const unsigned G = gridDim.x * gridDim.y * gridDim.z;
    unsigned sum, cnt, mine, sp = 0u;
    for (;;) {
        sum = 0u; cnt = 0u; mine = 0u;
#pragma unroll
        for (unsigned j = 0; j < 16; ++j) { const unsigned c = xb_ld(&bar[XB_XCNT(j)]); sum += c; cnt += (c > 0u) ? 1u : 0u; mine = (j == x) ? c : mine; }
        if (sum == G) break;
        __builtin_amdgcn_s_sleep(1);
        if ((++sp & 255u) == 0u) { if (xb_ld(&bar[XB_TMO])) break; if (sp > XB_SPIN_CAP) { atomicAdd(&bar[XB_TMO], 1u); break; } }
    }
    nloc = mine > 0u ? mine : 1u; nx = cnt > 0u ? cnt : 1u;
}
__device__ __forceinline__ void xcd_barrier(const XcdBarrier& b) {
    asm volatile("s_waitcnt vmcnt(0)" ::: "memory");
    __syncthreads();
    if (threadIdx.x == 0) {
        unsigned* bar = b.bar;
        __builtin_amdgcn_s_waitcnt(0);
        unsigned nloc = b.st[0], nx = b.st[1];
        if (nloc == 0u) { xcd_barrier_complete(bar, b.x, nloc, nx); b.st[0] = nloc; b.st[1] = nx; }
        const unsigned old = xb_add(&bar[XB_XSUB(b.x)], 1u);
        const unsigned gen = old / nloc;
        if (old + 1u == (gen + 1u) * nloc) {
            __builtin_amdgcn_fence(__ATOMIC_RELEASE, "agent");
            asm volatile("s_waitcnt vmcnt(0)" ::: "memory");
            const unsigned og = xb_add(&bar[XB_TOP], 1u);
            const unsigned tg = og / nx;
            if (og + 1u == (tg + 1u) * nx) xb_add(&bar[XB_TOPGEN], 1u);
            else XB_SPIN(xb_ld(&bar[XB_TOPGEN]) == tg, bar);
            __builtin_amdgcn_fence(__ATOMIC_ACQUIRE, "agent");
            xb_add(&bar[XB_XGEN(b.x)], 1u);
            asm volatile("s_waitcnt vmcnt(0)" ::: "memory");
        } else {
            XB_SPIN(xb_ld(&bar[XB_XGEN(b.x)]) == gen, bar);
            __builtin_amdgcn_fence(__ATOMIC_ACQUIRE, "agent");
            asm volatile("s_waitcnt vmcnt(0)" ::: "memory");
        }
    }
    __syncthreads();
}

struct KArgs { const float* in[22]; float* out; unsigned char* ws; int ph_lo, ph_hi; };
enum { I_X = 0, I_C, I_CTX, I_CCTX, I_ADAW, I_ADAB, I_NMPRE, I_NMPOST, I_NFPRE, I_NFPOST, I_HWIN, I_HLB, I_HONORM, I_HWOUT, I_AQKV, I_AQN, I_AKN, I_AWOUT, I_FWIN, I_FCW, I_FCB, I_FWOUT };
constexpr int N_PHASES = 20;

__global__ void __launch_bounds__(512, 2) mega_fwd(KArgs a) {
    extern __shared__ __attribute__((aligned(16))) unsigned char lds_raw[];
    LAS unsigned char* lds = (LAS unsigned char*)lds_raw;
    cg::grid_group grid = cg::this_grid();
    const int tid = threadIdx.x, lane = tid & 63, wave = __builtin_amdgcn_readfirstlane(tid >> 6);
    const int G = gridDim.x, wg = blockIdx.x;
    const int gw = wg * 8 + wave, NGW = G * 8;
    unsigned char* ws = a.ws;
    float* mod = (float*)(ws + WS_MOD);
    float* xctx = (float*)(ws + WS_XCTX);
    bf16_t* H = (bf16_t*)(ws + WS_H);
    bf16_t* BIG = (bf16_t*)(ws + WS_BIG);
    bf16_t* Y = (bf16_t*)(ws + WS_BIG);
    bf16_t* XR = (bf16_t*)(ws + WS_BIG + 256 * MiB);
    float* BND = (float*)(ws + WS_BIG + 200 * MiB);
    float* YS = (float*)(ws + WS_BIG + 132 * MiB);
    bf16_t* ACT = (bf16_t*)(ws + WS_ACT);
    bf16_t* OFW = ACT; bf16_t* OBW = ACT + (size_t)MR * DM;
    const int lo = a.ph_lo, hi = a.ph_hi;
#ifndef MK_REPMASK
#define MK_REPMASK 0u
#endif
#define PH(k) if (lo <= (k) && (k) < hi) for (int rep_ = 0; rep_ <= (int)((MK_REPMASK >> (k)) & 1u); ++rep_)
#define SEAM(k) do { if ((k) + 1 < hi) { if ((k) == 0) { asm volatile("s_waitcnt vmcnt(0) lgkmcnt(0)" ::: "memory"); grid.sync(); } else xcd_barrier(bar); } } while (0)
    LAS float* scr = (LAS float*)(lds + wave * 16384);
    volatile LAS unsigned* MISC = (volatile LAS unsigned*)(lds + LDS_BYTES - 256);
    if (tid < 16) MISC[tid] = 0u;
    __syncthreads();
    XcdBarrier bar = xcd_barrier_post((unsigned*)ws, MISC);

    PH(0) {
        ada_phase(a.in[I_C], a.in[I_CCTX], a.in[I_ADAW], a.in[I_ADAB], mod, lds, wg, G, tid);
        constexpr int I0 = 32 * (NHG / 32), I1 = 32 * (DM / 32), I2 = 32 * (2 * DFF / 32), I3 = (DFF / 64) * (DM / 32);
        for (int it = gw; it < I0 + I1 + I2 + I3; it += NGW) {
            int r = it;
            if (r < I0) { transpose_item(a.in[I_HWIN], DM, NHG, (bf16_t*)(ws + W_HIN), scr, r, lane); continue; } r -= I0;
            if (r < I1) { transpose_item(a.in[I_HWOUT], DM, DM, (bf16_t*)(ws + W_HOUT), scr, r, lane); continue; } r -= I1;
            if (r < I2) { transpose_item(a.in[I_FWIN], DM, 2 * DFF, (bf16_t*)(ws + W_FIN), scr, r, lane, true); continue; } r -= I2;
            transpose_item(a.in[I_FWOUT], DFF, DM, (bf16_t*)(ws + W_FOUT), scr, r, lane);
        }
        SEAM(0);
    }
    PH(1) {
        row_phase<false, false>(a.in[I_X], a.in[I_CTX], nullptr, nullptr, XR, nullptr, nullptr, a.in[I_NMPRE], mod, 0, 0, 1, H, false, true, false, gw, NGW, lane);
        SEAM(1);
    }
    PH(2) {
        pg8::Gemm g{H, (const bf16_t*)(ws + W_HIN), MR, NHG, DM}; pg8::Order S; S.init(MR / 256, NHG, DM, G, wg, 0, 0);
        pg8::EpiBf16 E{BIG, NHG};
        pg8::gemm_phase<pg8::EpiBf16, pg8::Order, true, true>(lds, g, S, E);
        SEAM(2);
    }
    PH(3) {
        float* EB = (float*)(ACT + (size_t)2 * MR * DM);
        if (rep_ == 0) gla_prep_phase(BIG, H, EB, a.in[I_HLB], lds, wg, G, tid);
        xcd_barrier(bar);
        for (int item = wg; item < 256; item += G) {
            const int xq = item & 7, yq = item >> 3, vs = yq & 3, sq = xq + 8 * (yq >> 2);
            const int dir = sq & 1, h = (sq >> 1) & 15, b = sq >> 5;
            gla_item(BIG, dir ? H : BIG, dir ? DM : NHG, EB, dir ? OBW : OFW, lds, b, h, dir, vs, tid);
        }
        SEAM(3);
    }
    PH(4) {
        readout_phase(OFW, OBW, BIG, a.in[I_HONORM], H, gw, NGW, lane);
        SEAM(4);
    }
    PH(5) {
        pg8::Gemm g{H, (const bf16_t*)(ws + W_HOUT), MR, DM, DM}; pg8::Order S; S.init(64, DM, DM, G, wg, 1, 16);
        pg8::EpiF32 E{Y, DM, YS, DM / 64};
        pg8::gemm_phase<pg8::EpiF32, pg8::Order, true, true>(lds, g, S, E);
        SEAM(5);
    }
    PH(6) {
        row_phase<false, true>(a.in[I_X], a.in[I_CTX], a.out, xctx, XR, Y, a.in[I_NMPOST], a.in[I_NFPRE], mod, 2, 3, 4, H, true, true, false, gw, NGW, lane, YS, 16);
        SEAM(6);
    }
    PH(7) {
        pg8::Gemm g{H, (const bf16_t*)(ws + W_FIN), MR, 2 * DFF, DM}; pg8::Order S; S.init(MR / 256, 2 * DFF, DM, G, wg, 0, 0);
        pg8::EpiConv E{ACT, a.in[I_FCW], a.in[I_FCB], BND, (LAS float*)(lds + 131072)};
        pg8::gemm_phase<pg8::EpiConv, pg8::Order, true, true>(lds, g, S, E);
        SEAM(7);
    }
    PH(8) {
        conv_fix_phase(BND, a.in[I_FCW], a.in[I_FCB], ACT, false, gw, NGW, lane);
        SEAM(8);
    }
    PH(9) {
        pg8::Gemm g{ACT, (const bf16_t*)(ws + W_FOUT), MR, DM, DFF}; pg8::Order S; S.init(64, DM, DFF, G, wg, 1, 11);
        pg8::EpiF32 E{Y, DM, YS, DFF / 64};
        pg8::gemm_phase<pg8::EpiF32, pg8::Order, true, true>(lds, g, S, E);
        SEAM(9);
    }
    PH(10) {
        row_phase<true, true>(a.out, xctx, a.out, xctx, XR, Y, a.in[I_NFPOST], a.in[I_NMPRE] + DM, mod, 5, 6 * 3 + 0, 6 * 3 + 1, H, true, true, false, gw, NGW, lane, YS, 11);
        __syncthreads();
        constexpr int I0 = 32 * (NQKV / 32), I1 = 32 * (DM / 32), I2 = 32 * (2 * DFF / 32), I3 = (DFF / 64) * (DM / 32);
        for (int it = gw; it < I0 + I1 + I2 + I3; it += NGW) {
            int r = it;
            if (r < I0) { transpose_item(a.in[I_AQKV], DM, NQKV, (bf16_t*)(ws + W_QKV), scr, r, lane); continue; } r -= I0;
            if (r < I1) { transpose_item(a.in[I_AWOUT], DM, DM, (bf16_t*)(ws + W_AOUT), scr, r, lane); continue; } r -= I1;
            if (r < I2) { transpose_item(a.in[I_FWIN] + (size_t)DM * 2 * DFF, DM, 2 * DFF, (bf16_t*)(ws + W_FIN), scr, r, lane, true); continue; } r -= I2;
            transpose_item(a.in[I_FWOUT] + (size_t)DFF * DM, DFF, DM, (bf16_t*)(ws + W_FOUT), scr, r, lane);
        }
        SEAM(10);
    }
    PH(11) {
        pg8::Gemm g{H, (const bf16_t*)(ws + W_QKV), MR, NQKV, DM}; pg8::Order S; S.init(MR / 256, NQKV, DM, G, wg, 0, 0);
        pg8::EpiBf16 E{BIG, NQKV};
        pg8::gemm_phase<pg8::EpiBf16, pg8::Order, true, true>(lds, g, S, E);
        SEAM(11);
    }
    PH(12) {
        qknorm_phase(BIG, a.in[I_AQN], a.in[I_AKN], gw, NGW, lane);
        SEAM(12);
    }
    PH(13) {
        for (int u = wg; u < 1024; u += G) {
            const int x = u & 7, rest = u >> 3, j = rest & 31, i = rest >> 5;
            const int b = x >> 2, kvh = x & 3, h = kvh * 4 + i;
            const size_t qrow = (size_t)b * SB + CTX + (size_t)j * 256;
            att::attn_dense_body(BIG + qrow * NQKV + h * 128, BIG + (size_t)b * SB * NQKV + 2048 + kvh * 128, BIG + (size_t)b * SB * NQKV + 2560 + kvh * 128,
                                 ACT + qrow * DM + h * 128, SB, (char*)lds_raw);
        }
        SEAM(13);
    }
    PH(14) {
        pg8::Gemm g{ACT, (const bf16_t*)(ws + W_AOUT), MR, DM, DM}; pg8::Order S; S.init(64, DM, DM, G, wg, 1, 0);
        pg8::EpiF32 E{Y, DM, nullptr, 0};
        pg8::gemm_phase<pg8::EpiF32, pg8::Order, true, true>(lds, g, S, E);
        SEAM(14);
    }
    PH(15) {
        row_phase<true, true>(a.out, xctx, a.out, xctx, XR, Y, a.in[I_NMPOST] + DM, a.in[I_NFPRE] + DM, mod + 3 * 12288, 2, 3, 4, H, true, true, true, gw, NGW, lane);
        SEAM(15);
    }
    PH(16) {
        pg8::Gemm g{H, (const bf16_t*)(ws + W_FIN), MR, 2 * DFF, DM}; pg8::Order S; S.init(64, 2 * DFF, DM, G, wg, 1, 0);
        pg8::EpiConv E{ACT, a.in[I_FCW] + 3 * DFF, a.in[I_FCB] + DFF, BND, (LAS float*)(lds + 131072)};
        pg8::gemm_phase<pg8::EpiConv, pg8::Order, true, true>(lds, g, S, E);
        SEAM(16);
    }
    PH(17) {
        conv_fix_phase(BND, a.in[I_FCW] + 3 * DFF, a.in[I_FCB] + DFF, ACT, true, gw, NGW, lane);
        SEAM(17);
    }
    PH(18) {
        pg8::Gemm g{ACT, (const bf16_t*)(ws + W_FOUT), MR, DM, DFF}; pg8::Order S; S.init(64, DM, DFF, G, wg, 1, 0);
        pg8::EpiF32 E{Y, DM, nullptr, 0};
        pg8::gemm_phase<pg8::EpiF32, pg8::Order, true, true>(lds, g, S, E);
        SEAM(18);
    }
    PH(19) {
        row_phase<true, false>(a.out, xctx, a.out, xctx, XR, Y, a.in[I_NFPOST] + DM, nullptr, mod + 3 * 12288, 5, 0, 0, H, true, false, true, gw, NGW, lane);
    }
#undef PH
#undef SEAM
}


extern "C" void kernel_launch(void* const* d_in, const int* in_sizes, int n_in, void* d_out, int out_size, void* d_ws, size_t ws_size, hipStream_t stream) {
    static int grid = 0;
    if (grid == 0) {
        if (n_in != 22 || ws_size < WS_END || out_size != NB * SEQ * DM) { fprintf(stderr, "kernel_launch: unexpected shapes n_in %d ws %zu out %d\n", n_in, ws_size, out_size); grid = -1; return; }
        int dev = 0, cus = 0, per_cu = 0;
        if (hipGetDevice(&dev) != hipSuccess || hipDeviceGetAttribute(&cus, hipDeviceAttributeMultiprocessorCount, dev) != hipSuccess) { grid = -1; return; }
        if (hipFuncSetAttribute((const void*)mega_fwd, hipFuncAttributeMaxDynamicSharedMemorySize, LDS_BYTES) != hipSuccess) { fprintf(stderr, "kernel_launch: hipFuncSetAttribute failed\n"); grid = -1; return; }
        if (hipOccupancyMaxActiveBlocksPerMultiprocessor(&per_cu, (const void*)mega_fwd, 512, LDS_BYTES) != hipSuccess || per_cu < 1) { fprintf(stderr, "kernel_launch: occupancy query says %d\n", per_cu); per_cu = 1; }
        (void)hipGetLastError();
        grid = cus * 1;
    }
    if (grid < 0) return;
    KArgs a{};
    for (int i = 0; i < 22; ++i) a.in[i] = (const float*)d_in[i];
    a.out = (float*)d_out; a.ws = (unsigned char*)d_ws;
    a.ph_lo = 0; a.ph_hi = N_PHASES;
    if (hipMemsetAsync(d_ws, 0, 16384, stream) != hipSuccess) { fprintf(stderr, "kernel_launch: memset failed\n"); return; }
    void* args[] = {&a};
    hipError_t e = hipLaunchCooperativeKernel((const void*)mega_fwd, dim3(grid), dim3(512), args, LDS_BYTES, stream);
    if (e != hipSuccess) fprintf(stderr, "cooperative launch failed: %s (grid %d)\n", hipGetErrorString(e), grid);
}
```

```cpp
#include <hip/hip_runtime.h>
#include <hip/hip_cooperative_groups.h>
#include <cstdio>
#include <cstdint>
namespace cg = cooperative_groups;

#define LAS __attribute__((address_space(3)))
typedef unsigned short bf16_t;
typedef short bf16x8 __attribute__((ext_vector_type(8)));
typedef float f32x4 __attribute__((ext_vector_type(4)));
typedef float f32x2 __attribute__((ext_vector_type(2)));
typedef float f32x16 __attribute__((ext_vector_type(16)));
typedef unsigned u32x4 __attribute__((ext_vector_type(4)));
typedef unsigned u32x2 __attribute__((ext_vector_type(2)));
typedef short s16x4 __attribute__((ext_vector_type(4)));

constexpr int DM = 2048, NB = 2, SEQ = 8192, CTX = 256, SB = SEQ + CTX, MR = NB * SB;
constexpr int NH = 16, HD = 128, NKV = 4, DFF = 5632, NQKV = 3072, NHG = 5 * DM;
constexpr float EPS = 1e-6f;

constexpr size_t MiB = 1u << 20;
constexpr size_t WS_MOD = 64 * 1024;
constexpr size_t WS_XCTX = 2 * MiB;
constexpr size_t WS_W = 6 * MiB;
constexpr size_t W_HIN = WS_W, W_HOUT = WS_W + 40 * MiB, W_FIN = WS_W + 48 * MiB, W_FOUT = WS_W + 92 * MiB;
constexpr size_t W_QKV = WS_W, W_AOUT = WS_W + 12 * MiB;
constexpr size_t WS_H = 120 * MiB;
constexpr size_t WS_BIG = 186 * MiB;
constexpr size_t WS_ACT = 549 * MiB;
constexpr size_t WS_END = WS_ACT + (size_t)MR * DFF * 2;
static_assert(WS_END <= 768 * MiB, "ws");

constexpr int LDS_BYTES = 147456;

typedef __bf16 bf16x2_t __attribute__((ext_vector_type(2)));
__device__ __forceinline__ unsigned cvt_pk_bf16(float lo, float hi) { f32x2 v = {lo, hi}; bf16x2_t b = __builtin_convertvector(v, bf16x2_t); return __builtin_bit_cast(unsigned, b); }
__device__ __forceinline__ unsigned f2bf(float f) { unsigned u = __builtin_bit_cast(unsigned, f); return (u + 0x7fffu + ((u >> 16) & 1u)) >> 16; }
__device__ __forceinline__ unsigned pk2(float lo, float hi) { return f2bf(lo) | (f2bf(hi) << 16); }
__device__ __forceinline__ float bflo(unsigned u) { return __builtin_bit_cast(float, u << 16); }
__device__ __forceinline__ float bfhi(unsigned u) { return __builtin_bit_cast(float, u & 0xffff0000u); }
__device__ __forceinline__ float wave_sum(float v) {
#pragma unroll
    for (int o = 1; o < 64; o <<= 1) v += __shfl_xor(v, o);
    return v;
}
__device__ __forceinline__ float siluf(float v) { return v / (1.f + __expf(-v)); }
#define LBAR() do { asm volatile("s_waitcnt lgkmcnt(0)" ::: "memory"); __builtin_amdgcn_s_barrier(); asm volatile("" ::: "memory"); } while (0)

namespace pg8 {
constexpr int BM = 256, BK = 64, HALF = 128, HTB = HALF * BK * 2, STAGE_BYTES = 8 * HTB, NXCD = 8, WGM = 4;
__host__ __device__ __forceinline__ int lds_byte(int r, int c) { const int st = (r >> 4) * 2 + (c >> 5), rr = r & 15, cc = c & 31, ob = rr * 64 + cc * 2; return st * 1024 + (ob ^ (((ob >> 9) & 1) << 5)); }
__host__ __device__ __forceinline__ void stage_rc(int b, int& R, int& C) { const int st = b / 1024, sb = b % 1024, swz = sb ^ (((sb >> 9) & 1) << 5); R = (st >> 1) * 16 + swz / 64; C = (st & 1) * 32 + (swz % 64) / 2; }
__host__ __device__ __forceinline__ int perm32(int rho) { const int n = rho >> 4, i = rho & 15; return 8 * (i >> 2) + 4 * n + (i & 3); }

struct Unit { int pm, pn, kn; };
struct Gemm { const bf16_t* A; const bf16_t* Bt; int M, N, K; };

struct Order {
    int nM, nN, nwg, G, c, skip, ntf, nsplit;
    __device__ void init(int nM_, int N, int K, int G_, int c_, int skip_, int nsplit_) { nM = nM_; nN = N / BM; nwg = nM * nN; G = G_; c = c_; skip = skip_; ntf = K / BK; nsplit = nsplit_; }
    __device__ bool next(int i, Unit& u) const {
        const long L = (long)i * G + c;
        if (L >= nwg) {
            const int j = (int)(L - nwg); if (j >= 2 * nN * nsplit) return false;
            const int sidx = j % nsplit, cu = j / nsplit, cr = cu / nN;
            const int ntu = ntf / nsplit; u.pm = cr ? 33 : 0; u.pn = cu % nN; u.kn = (sidx * ntu) | (ntu << 16); return true;
        }
        int wgid = (int)L; { const int q = nwg / NXCD, r = nwg % NXCD, xcd = wgid % NXCD, off = wgid / NXCD; wgid = (xcd < r ? xcd * (q + 1) : r * (q + 1) + (xcd - r) * q) + off; }
        const int nig = WGM * nN, gid = wgid / nig, fm = gid * WGM, gsz = (nM - fm) < WGM ? (nM - fm) : WGM;
        int pm = fm + ((wgid % nig) % gsz); u.pn = (wgid % nig) / gsz;
        if (skip) pm = pm + 1 + (pm >= 32 ? 1 : 0);
        u.pm = pm; u.kn = ntf << 16; return true;
    }
    __device__ __forceinline__ void a_ready(const Unit&) const {}
    __device__ __forceinline__ void done(const Unit&) const {}
};

struct EpiBf16 {
    static constexpr bool PERM = true, AFTER_DRAIN = false;
    bf16_t* O; int ldc;
    __device__ __forceinline__ void operator()(const f32x4 (&acc)[2][2][4][2], const Unit& u, int wr, int wc, int fr, int fq) const {
        const int row0 = u.pm * BM + wr * 64 + fr; const int col0 = u.pn * BM + wc * 32 + 8 * fq;
#pragma unroll
        for (int ai = 0; ai < 2; ++ai)
#pragma unroll
            for (int m = 0; m < 4; ++m) { bf16_t* rowp = O + (size_t)(row0 + ai * HALF + m * 16) * ldc + col0;
#pragma unroll
                for (int bj = 0; bj < 2; ++bj) { const f32x4 v0 = acc[ai][bj][m][0], v1 = acc[ai][bj][m][1];
                    u32x4 w; w.x = cvt_pk_bf16(v0[0], v0[1]); w.y = cvt_pk_bf16(v0[2], v0[3]); w.z = cvt_pk_bf16(v1[0], v1[1]); w.w = cvt_pk_bf16(v1[2], v1[3]);
                    *(u32x4*)(rowp + bj * HALF) = w; } }
    }
};
struct EpiF32 {
    static constexpr bool PERM = true, AFTER_DRAIN = false;
    bf16_t* O; int ldc; float* SL; int ntf;
    __device__ __forceinline__ void operator()(const f32x4 (&acc)[2][2][4][2], const Unit& u, int wr, int wc, int fr, int fq) const {
        const int ntu = u.kn >> 16, kt0 = u.kn & 0xffff;
        const int row0 = wr * 64 + fr; const int col0 = u.pn * BM + wc * 32 + 8 * fq;
        if (ntu < ntf) {
            float* basep = SL + ((size_t)(kt0 / ntu) * 512 + (u.pm == 33 ? 256 : 0)) * ldc;
#pragma unroll
            for (int ai = 0; ai < 2; ++ai)
#pragma unroll
                for (int m = 0; m < 4; ++m) { float* rowp = basep + (size_t)(row0 + ai * HALF + m * 16) * ldc + col0;
#pragma unroll
                    for (int bj = 0; bj < 2; ++bj) { *(f32x4*)(rowp + bj * HALF) = acc[ai][bj][m][0]; *(f32x4*)(rowp + bj * HALF + 4) = acc[ai][bj][m][1]; } }
        } else {
            bf16_t* basep = O + (size_t)u.pm * BM * ldc;
#pragma unroll
            for (int ai = 0; ai < 2; ++ai)
#pragma unroll
                for (int m = 0; m < 4; ++m) { bf16_t* rowp = basep + (size_t)(row0 + ai * HALF + m * 16) * ldc + col0;
#pragma unroll
                    for (int bj = 0; bj < 2; ++bj) { const f32x4 v0 = acc[ai][bj][m][0], v1 = acc[ai][bj][m][1];
                        u32x4 w; w.x = cvt_pk_bf16(v0[0], v0[1]); w.y = cvt_pk_bf16(v0[2], v0[3]); w.z = cvt_pk_bf16(v1[0], v1[1]); w.w = cvt_pk_bf16(v1[2], v1[3]);
                        *(u32x4*)(rowp + bj * HALF) = w; } }
        }
    }
};

template <int CTRL> __device__ __forceinline__ float dpp_upd(float oldv, float src) {
    return __builtin_bit_cast(float, __builtin_amdgcn_update_dpp(__builtin_bit_cast(int, oldv), __builtin_bit_cast(int, src), CTRL, 0xf, 0xf, false)); }
template <int M> __device__ __forceinline__ float conv_elem(float gp, float gc, float gn, float up, float hp, float hn, float w0, float w1, float w2, float cb) {
    const float X = (M == 0) ? hp : dpp_upd<0x121>(0.f, gp);
    const float prev = dpp_upd<0x111>(X, gc);
    const float Yv = (M == 3) ? hn : dpp_upd<0x12F>(0.f, gn);
    const float next = dpp_upd<0x101>(Yv, gc);
    const float y = w0 * prev + w1 * gc + w2 * next + cb;
    return y * __builtin_amdgcn_rcpf(1.f + __builtin_amdgcn_exp2f(y * -1.4426950408889634f)) * up;
}
template <int M> __device__ __forceinline__ f32x4 conv_group(const f32x4 GP, const f32x4 GC, const f32x4 GN, const f32x4 up, const f32x4 hp, const f32x4 hn, const f32x4 w0, const f32x4 w1, const f32x4 w2, const f32x4 cb) {
    f32x4 r;
    r.x = conv_elem<M>(GP.x, GC.x, GN.x, up.x, hp.x, hn.x, w0.x, w1.x, w2.x, cb.x);
    r.y = conv_elem<M>(GP.y, GC.y, GN.y, up.y, hp.y, hn.y, w0.y, w1.y, w2.y, cb.y);
    r.z = conv_elem<M>(GP.z, GC.z, GN.z, up.z, hp.z, hn.z, w0.z, w1.z, w2.z, cb.z);
    r.w = conv_elem<M>(GP.w, GC.w, GN.w, up.w, hp.w, hn.w, w0.w, w1.w, w2.w, cb.w);
    return r;
}
struct EpiConv {
    static constexpr bool PERM = true, AFTER_DRAIN = false;
    bf16_t* ACT; const float* cw; const float* cbias; float* BND; LAS float* xch;
    __device__ __forceinline__ void operator()(const f32x4 (&acc)[2][2][4][2], const Unit& u, int wr_, int wc_, int fr_, int fq_) const {
        int wr = wr_, wc = wc_, fr = fr_, fq = fq_;
        asm volatile("" : "+v"(fr), "+v"(fq), "+s"(wr), "+s"(wc));
        const int cl = wc * 32 + 8 * fq, f0 = u.pn * 128 + cl;
#pragma unroll
        for (int ai = 0; ai < 2; ++ai) { const int blk = 2 * ai + wr;
            if (fr == 0) { *(LAS f32x4*)(xch + (blk * 2 + 0) * 128 + cl) = acc[ai][0][0][0]; *(LAS f32x4*)(xch + (blk * 2 + 0) * 128 + cl + 4) = acc[ai][0][0][1]; }
            if (fr == 15) { *(LAS f32x4*)(xch + (blk * 2 + 1) * 128 + cl) = acc[ai][0][3][0]; *(LAS f32x4*)(xch + (blk * 2 + 1) * 128 + cl + 4) = acc[ai][0][3][1]; } }
        { float* bnd = BND + (size_t)u.pm * 6 * DFF + f0;
          if (wr == 0 && fr < 2) { *(f32x4*)(bnd + fr * DFF) = acc[0][0][0][0]; *(f32x4*)(bnd + fr * DFF + 4) = acc[0][0][0][1]; }
          asm volatile("" ::: "memory");
          if (wr == 0 && fr == 0) { *(f32x4*)(bnd + 4 * DFF) = acc[0][1][0][0]; *(f32x4*)(bnd + 4 * DFF + 4) = acc[0][1][0][1]; }
          asm volatile("" ::: "memory");
          if (wr == 1 && fr >= 14) { *(f32x4*)(bnd + (fr - 12) * DFF) = acc[1][0][3][0]; *(f32x4*)(bnd + (fr - 12) * DFF + 4) = acc[1][0][3][1]; }
          asm volatile("" ::: "memory");
          if (wr == 1 && fr == 15) { *(f32x4*)(bnd + 5 * DFF) = acc[1][1][3][0]; *(f32x4*)(bnd + 5 * DFF + 4) = acc[1][1][3][1]; }
        }
        LBAR(); __builtin_amdgcn_sched_barrier(0);
        const f32x4 w00 = *(const f32x4*)(cw + f0), w01 = *(const f32x4*)(cw + f0 + 4), w10 = *(const f32x4*)(cw + DFF + f0), w11 = *(const f32x4*)(cw + DFF + f0 + 4);
        const f32x4 w20 = *(const f32x4*)(cw + 2 * DFF + f0), w21 = *(const f32x4*)(cw + 2 * DFF + f0 + 4), cb0 = *(const f32x4*)(cbias + f0), cb1 = *(const f32x4*)(cbias + f0 + 4);
#pragma unroll
        for (int ai = 0; ai < 2; ++ai) { const int blk = 2 * ai + wr;
            f32x4 hp0 = {0.f, 0.f, 0.f, 0.f}, hp1 = hp0, hn0 = hp0, hn1 = hp0;
            if (blk > 0) { hp0 = *(const LAS f32x4*)(xch + ((blk - 1) * 2 + 1) * 128 + cl); hp1 = *(const LAS f32x4*)(xch + ((blk - 1) * 2 + 1) * 128 + cl + 4); }
            if (blk < 3) { hn0 = *(const LAS f32x4*)(xch + ((blk + 1) * 2 + 0) * 128 + cl); hn1 = *(const LAS f32x4*)(xch + ((blk + 1) * 2 + 0) * 128 + cl + 4); }
#define CONV_ROW(M, MP, MN) do { __builtin_amdgcn_sched_barrier(0); \
            const f32x4 v0 = conv_group<M>(acc[ai][0][MP][0], acc[ai][0][M][0], acc[ai][0][MN][0], acc[ai][1][M][0], hp0, hn0, w00, w10, w20, cb0); \
            const f32x4 v1 = conv_group<M>(acc[ai][0][MP][1], acc[ai][0][M][1], acc[ai][0][MN][1], acc[ai][1][M][1], hp1, hn1, w01, w11, w21, cb1); \
            const int rl = ai * HALF + wr * 64 + M * 16 + fr; \
            if (rl != 0 && rl != 255) { u32x4 w; w.x = cvt_pk_bf16(v0[0], v0[1]); w.y = cvt_pk_bf16(v0[2], v0[3]); w.z = cvt_pk_bf16(v1[0], v1[1]); w.w = cvt_pk_bf16(v1[2], v1[3]); \
                *(u32x4*)(ACT + (size_t)(u.pm * BM + rl) * DFF + f0) = w; } } while (0)
            CONV_ROW(0, 0, 1); CONV_ROW(1, 0, 2); CONV_ROW(2, 1, 3); CONV_ROW(3, 2, 3);
#undef CONV_ROW
            __builtin_amdgcn_sched_barrier(0);
        }
    }
};

template <class Epi, class Sched, bool ALIGN_EPI = false, bool SP2 = false>
__device__ __forceinline__ void gemm_phase(LAS unsigned char* lds, const Gemm g, const Sched& S, const Epi& E) {
    const int tid = threadIdx.x, wid = __builtin_amdgcn_readfirstlane(tid >> 6), lane = tid & 63, wr = wid >> 2, wc = wid & 3, fr = lane & 15, fq = lane >> 4;
    const int K = g.K;
    unsigned voffA[2], voffB[2];
#pragma unroll
    for (int i = 0; i < 2; ++i) { int R, C; stage_rc(tid * 16 + i * 8192, R, C); const int Rb = Epi::PERM ? ((R & ~31) + perm32(R & 31)) : R;
        voffA[i] = (unsigned)(R * K + C) * 2u; voffB[i] = (unsigned)(Rb * K + C) * 2u; }
    const size_t kstep = (size_t)(BK * 2);
    const size_t hstep = (size_t)HALF * K * 2;
    const size_t tstep = 2 * hstep;
    const unsigned ldsw = (unsigned)wid * 1024u;
    const int aoff = lds_byte(wr * 64 + fr, fq * 8), boff = lds_byte(wc * 32 + fr, fq * 8);
#define PG8_SA(b, h) (((b) * 2 + (h)) * HTB)
#define PG8_SB(b, h) ((4 + (b) * 2 + (h)) * HTB)
#define PG8_STAGE(bufoff, gbase, voff) do { _Pragma("unroll") for (int _i = 0; _i < 2; ++_i) \
        __builtin_amdgcn_global_load_lds((const unsigned*)((const char*)(gbase) + (voff)[_i]), (LAS unsigned*)(lds + (bufoff) + ldsw + _i * 8192), 16, 0, 0); } while (0)
#define PG8_LDA(dst, b, h) do { _Pragma("unroll") for (int m = 0; m < 4; ++m) _Pragma("unroll") for (int k = 0; k < 2; ++k) dst[m][k] = *(const LAS bf16x8*)(lds + PG8_SA(b, h) + aoff + m * 2048 + k * 1024); } while (0)
#define PG8_LDB(dst, b, h) do { _Pragma("unroll") for (int n = 0; n < 2; ++n) _Pragma("unroll") for (int k = 0; k < 2; ++k) dst[n][k] = *(const LAS bf16x8*)(lds + PG8_SB(b, h) + boff + n * 2048 + k * 1024); } while (0)
#define PG8_MMA(ai, bj, At, Bt) do { __builtin_amdgcn_s_setprio(1); _Pragma("unroll") for (int m = 0; m < 4; ++m) _Pragma("unroll") for (int n = 0; n < 2; ++n) _Pragma("unroll") for (int k = 0; k < 2; ++k) \
        acc[ai][bj][m][n] = __builtin_amdgcn_mfma_f32_16x16x32_bf16(Bt[n][k], At[m][k], acc[ai][bj][m][n], 0, 0, 0); __builtin_amdgcn_s_setprio(0); } while (0)
#define PG8_WAIT_V(n) asm volatile("s_waitcnt vmcnt(" #n ")" ::: "memory")
#define PG8_WAIT_L(n) asm volatile("s_waitcnt lgkmcnt(" #n ")" ::: "memory")
#define PG8_BAR __builtin_amdgcn_s_barrier()
#define PG8_SCHED __builtin_amdgcn_sched_barrier(0)
    Unit cur, nxt; int ui = 0;
    if (!S.next(0, cur)) return;
    f32x4 acc[2][2][4][2];
#pragma unroll
    for (int a = 0; a < 2; ++a)
#pragma unroll
        for (int b = 0; b < 2; ++b)
#pragma unroll
            for (int m = 0; m < 4; ++m)
#pragma unroll
                for (int n = 0; n < 2; ++n) acc[a][b][m][n] = (f32x4){0.f, 0.f, 0.f, 0.f};
    bf16x8 At[4][2], B0[2][2], B1[2][2];
    const char* cA = (const char*)g.A + (size_t)cur.pm * tstep + (size_t)(cur.kn & 0xffff) * kstep; const char* cB = (const char*)g.Bt + (size_t)cur.pn * tstep + (size_t)(cur.kn & 0xffff) * kstep;
    S.a_ready(cur);
    if constexpr (SP2) {
        PG8_STAGE(PG8_SB(0, 0), cB, voffB); PG8_STAGE(PG8_SB(0, 1), cB + hstep, voffB); PG8_STAGE(PG8_SA(0, 0), cA, voffA); PG8_STAGE(PG8_SA(0, 1), cA + hstep, voffA);
        if (wr == 1) PG8_BAR;
        PG8_WAIT_V(2); PG8_BAR;
        PG8_STAGE(PG8_SB(1, 0), cB + kstep, voffB); PG8_STAGE(PG8_SA(1, 0), cA + kstep, voffA); PG8_STAGE(PG8_SB(1, 1), cB + hstep + kstep, voffB);
        PG8_WAIT_V(6); PG8_BAR;
    } else {
        PG8_STAGE(PG8_SB(0, 0), cB, voffB); PG8_STAGE(PG8_SA(0, 0), cA, voffA); PG8_STAGE(PG8_SB(0, 1), cB + hstep, voffB); PG8_STAGE(PG8_SA(0, 1), cA + hstep, voffA);
        if (wr == 1) PG8_BAR;
        PG8_WAIT_V(4); PG8_BAR;
        PG8_STAGE(PG8_SB(1, 0), cB + kstep, voffB); PG8_STAGE(PG8_SA(1, 0), cA + kstep, voffA); PG8_STAGE(PG8_SB(1, 1), cB + hstep + kstep, voffB);
        PG8_WAIT_V(6); PG8_BAR;
    }
    for (;;) {
        const bool has_next = S.next(ui + 1, nxt);
        const char* nA = has_next ? (const char*)g.A + (size_t)nxt.pm * tstep + (size_t)(nxt.kn & 0xffff) * kstep : cA; const char* nB = has_next ? (const char*)g.Bt + (size_t)nxt.pn * tstep + (size_t)(nxt.kn & 0xffff) * kstep : cB;
        const int nt = cur.kn >> 16;
        for (int t = 0; t < nt; t += 2) {
            const bool last = (t == nt - 2);
            const char* a1 = cA + (size_t)(t + 1) * kstep;
            const char* a2 = last ? nA : cA + (size_t)(t + 2) * kstep; const char* b2 = last ? nB : cB + (size_t)(t + 2) * kstep;
            const char* a3 = a2 + kstep; const char* b3 = b2 + kstep;
            if (last && has_next) S.a_ready(nxt);
            if constexpr (SP2) {
            PG8_LDB(B0, 0, 0); PG8_LDB(B1, 0, 1); PG8_SCHED; PG8_LDA(At, 0, 0); PG8_STAGE(PG8_SA(1, 1), a1 + hstep, voffA);
            PG8_WAIT_V(8); PG8_WAIT_L(0); PG8_BAR; PG8_MMA(0, 0, At, B0); PG8_MMA(0, 1, At, B1); PG8_BAR; PG8_SCHED;
            PG8_LDA(At, 0, 1); PG8_STAGE(PG8_SB(0, 0), b2, voffB); PG8_STAGE(PG8_SB(0, 1), b2 + hstep, voffB); PG8_STAGE(PG8_SA(0, 0), a2, voffA);
            PG8_WAIT_V(8); PG8_WAIT_L(0); PG8_BAR; PG8_MMA(1, 0, At, B0); PG8_MMA(1, 1, At, B1); PG8_BAR; PG8_SCHED;
            PG8_LDB(B0, 1, 0); PG8_LDB(B1, 1, 1); PG8_SCHED; PG8_LDA(At, 1, 0); PG8_STAGE(PG8_SA(0, 1), a2 + hstep, voffA);
            PG8_WAIT_V(8); PG8_WAIT_L(0); PG8_BAR; PG8_MMA(0, 0, At, B0); PG8_MMA(0, 1, At, B1); PG8_BAR; PG8_SCHED;
            PG8_LDA(At, 1, 1); PG8_STAGE(PG8_SB(1, 0), b3, voffB); PG8_STAGE(PG8_SB(1, 1), b3 + hstep, voffB); PG8_STAGE(PG8_SA(1, 0), a3, voffA);
            PG8_WAIT_V(8); PG8_WAIT_L(0); PG8_BAR; PG8_MMA(1, 0, At, B0); PG8_MMA(1, 1, At, B1); PG8_BAR; PG8_SCHED;
            } else {
            PG8_LDB(B0, 0, 0); PG8_SCHED; PG8_LDA(At, 0, 0); PG8_STAGE(PG8_SA(1, 1), a1 + hstep, voffA);
            PG8_WAIT_L(8); PG8_BAR; PG8_WAIT_L(0); PG8_MMA(0, 0, At, B0); PG8_BAR; PG8_SCHED;
            PG8_LDB(B1, 0, 1); PG8_STAGE(PG8_SB(0, 0), b2, voffB);
            PG8_BAR; PG8_WAIT_L(0); PG8_MMA(0, 1, At, B1); PG8_BAR;
            PG8_LDA(At, 0, 1); PG8_STAGE(PG8_SA(0, 0), a2, voffA);
            PG8_BAR; PG8_WAIT_L(0); PG8_MMA(1, 0, At, B0); PG8_BAR; PG8_SCHED;
            PG8_STAGE(PG8_SB(0, 1), b2 + hstep, voffB);
            PG8_WAIT_V(6); PG8_BAR; PG8_MMA(1, 1, At, B1); PG8_BAR;
            PG8_LDB(B0, 1, 0); PG8_SCHED; PG8_LDA(At, 1, 0); PG8_STAGE(PG8_SA(0, 1), a2 + hstep, voffA);
            PG8_WAIT_L(8); PG8_BAR; PG8_WAIT_L(0); PG8_MMA(0, 0, At, B0); PG8_BAR; PG8_SCHED;
            PG8_LDB(B1, 1, 1); PG8_STAGE(PG8_SB(1, 0), b3, voffB);
            PG8_BAR; PG8_WAIT_L(0); PG8_MMA(0, 1, At, B1); PG8_BAR;
            PG8_LDA(At, 1, 1); PG8_STAGE(PG8_SA(1, 0), a3, voffA);
            PG8_BAR; PG8_WAIT_L(0); PG8_MMA(1, 0, At, B0); PG8_BAR; PG8_SCHED;
            PG8_STAGE(PG8_SB(1, 1), b3 + hstep, voffB);
            PG8_WAIT_V(6); PG8_BAR; PG8_MMA(1, 1, At, B1); PG8_BAR;
            }
        }
        if constexpr (ALIGN_EPI) { if (wr == 0) PG8_BAR; }
        if constexpr (!Epi::AFTER_DRAIN) { E(acc, cur, wr, wc, fr, fq); S.done(cur); }
        if (!has_next) break;
#pragma unroll
        for (int a = 0; a < 2; ++a)
#pragma unroll
            for (int b = 0; b < 2; ++b)
#pragma unroll
                for (int m = 0; m < 4; ++m)
#pragma unroll
                    for (int n = 0; n < 2; ++n) acc[a][b][m][n] = (f32x4){0.f, 0.f, 0.f, 0.f};
        cur = nxt; cA = nA; cB = nB; ++ui;
        if constexpr (ALIGN_EPI) { if (wr == 1) PG8_BAR; }
    }
    PG8_WAIT_V(0);
    if constexpr (!ALIGN_EPI) { if (wr == 0) PG8_BAR; }
    PG8_BAR;
#undef PG8_SA
#undef PG8_SB
#undef PG8_STAGE
#undef PG8_LDA
#undef PG8_LDB
#undef PG8_MMA
#undef PG8_WAIT_V
#undef PG8_WAIT_L
#undef PG8_BAR
#undef PG8_SCHED
}
}

namespace att {
constexpr int D = 128, NW = 8, QBLK = 32, KVBLK = 64;
constexpr float SCALE = 0.088388347648318440f;
constexpr float THR = 8.f;
constexpr int LDQ = NQKV, LDK = NQKV, LDO = DM;
constexpr size_t SHM_V = KVBLK * D * 2, SHM_K = KVBLK * D * 2, SHM_ATTN = 2 * SHM_V + 2 * SHM_K + NW * 64 * 4;
#define KSWZ(row, colB) ((row) * 256 + ((colB) ^ (((row) & 7) << 4)))
#define SBAR() __builtin_amdgcn_sched_barrier(0)
__device__ __forceinline__ int crow(int r, int hi) { return (r & 3) + 8 * (r >> 2) + 4 * hi; }
__device__ __forceinline__ unsigned cvtpk(float lo, float hi) { unsigned r; asm volatile("v_cvt_pk_bf16_f32 %0, %1, %2" : "=v"(r) : "v"(lo), "v"(hi)); return r; }
__device__ __forceinline__ bf16x8 ld8(const bf16_t* p) { return *reinterpret_cast<const bf16x8*>(p); }

__device__ __forceinline__ void partialSM(f32x16& p0, f32x16& p1, float& m_reg, float& mn, float& alpha) {
  constexpr float C = SCALE * 1.4426950408889634f;
  float pmax = p0[0];
#pragma unroll
  for (int r = 1; r < 16; ++r) pmax = fmaxf(pmax, p0[r]);
#pragma unroll
  for (int r = 0; r < 16; ++r) pmax = fmaxf(pmax, p1[r]);
  { auto rr = __builtin_amdgcn_permlane32_swap(__float_as_uint(pmax), __float_as_uint(pmax), false, false);
    pmax = fmaxf(__uint_as_float(rr[0]), __uint_as_float(rr[1])); }
  if (__builtin_expect(__all(pmax - m_reg <= THR / SCALE), 1)) { mn = m_reg; alpha = 1.f; }
  else { mn = fmaxf(m_reg, pmax); alpha = __builtin_amdgcn_exp2f((m_reg - mn) * C); m_reg = mn; }
  float mnC = -mn * C;
#pragma unroll
  for (int r = 0; r < 16; ++r) p0[r] = fmaf(p0[r], C, mnC);
#pragma unroll
  for (int r = 0; r < 16; ++r) p1[r] = fmaf(p1[r], C, mnC);
#pragma unroll
  for (int r = 0; r < 16; ++r) p0[r] = __builtin_amdgcn_exp2f(p0[r]);
}
__device__ __forceinline__ void finishSM(f32x16& p0, f32x16& p1, float alpha, float& l_reg, bf16x8& pa0, bf16x8& pa1, bf16x8& pa2, bf16x8& pa3) {
#pragma unroll
  for (int r = 0; r < 16; ++r) p1[r] = __builtin_amdgcn_exp2f(p1[r]);
  float ps = 0;
#pragma unroll
  for (int r = 0; r < 16; ++r) ps += p0[r];
#pragma unroll
  for (int r = 0; r < 16; ++r) ps += p1[r];
  { auto rr = __builtin_amdgcn_permlane32_swap(__float_as_uint(ps), __float_as_uint(ps), false, false);
    ps = __uint_as_float(rr[0]) + __uint_as_float(rr[1]); }
  l_reg = l_reg * alpha + ps;
#define PK4(P, BASE, OUT) do { unsigned a0 = cvtpk(P[BASE + 0], P[BASE + 1]), a1 = cvtpk(P[BASE + 2], P[BASE + 3]);   \
    unsigned b0 = cvtpk(P[BASE + 4], P[BASE + 5]), b1 = cvtpk(P[BASE + 6], P[BASE + 7]);                              \
    auto r0 = __builtin_amdgcn_permlane32_swap(a0, b0, false, false); auto r1 = __builtin_amdgcn_permlane32_swap(a1, b1, false, false); \
    u32x4 w = {r0[0], r1[0], r0[1], r1[1]}; OUT = *reinterpret_cast<bf16x8*>(&w); } while (0)
  PK4(p0, 0, pa0); PK4(p0, 8, pa1); PK4(p1, 0, pa2); PK4(p1, 8, pa3);
#undef PK4
}
__device__ __forceinline__ void qkt(f32x16& p0, f32x16& p1, const bf16_t* Ks, const bf16x8* qr, int r32, int hi) {
  p0 = f32x16{}; p1 = f32x16{};
#pragma unroll
  for (int d0 = 0; d0 < 8; ++d0) { int cb = (d0 * 16 + hi * 8) * 2;
    bf16x8 b0 = *reinterpret_cast<const bf16x8*>((const char*)Ks + KSWZ(r32, cb));
    bf16x8 b1 = *reinterpret_cast<const bf16x8*>((const char*)Ks + KSWZ(32 + r32, cb));
    p0 = __builtin_amdgcn_mfma_f32_32x32x16_bf16(b0, qr[d0], p0, 0, 0, 0);
    p1 = __builtin_amdgcn_mfma_f32_32x32x16_bf16(b1, qr[d0], p1, 0, 0, 0); }
}
__device__ __forceinline__ int v_st(int k, int c) { const int kk = (k & ~0xC) | ((k & 4) << 1) | ((k & 8) >> 1); return ((kk >> 3) * 4 + (c >> 5)) * 512 + ((kk & 7) * 32 + (c & 31)) * 2; }
__device__ __forceinline__ int v_rd_base(int lane) { return ((lane & 3) << 3) | (((lane >> 2) & 3) << 6) | (((lane >> 4) & 1) << 5) | (((lane >> 5) & 1) << 8); }
constexpr int v_rd_off(int d0, int ks, int half) { return d0 * 512 + ks * 4096 + half * 2048; }
template <int OFF> __device__ __forceinline__ s16x4 tr_read(int vb) {
  s16x4 r; asm volatile("ds_read_b64_tr_b16 %0, %1 offset:%2" : "=&v"(r) : "v"(vb), "i"(OFF) : "memory"); return r;
}
template <int D0> __device__ __forceinline__ void pv_one(f32x16& od, int vb, bf16x8 pa0, bf16x8 pa1, bf16x8 pa2, bf16x8 pa3) {
  const s16x4 l0 = tr_read<v_rd_off(D0, 0, 0)>(vb), h0 = tr_read<v_rd_off(D0, 0, 1)>(vb), l1 = tr_read<v_rd_off(D0, 1, 0)>(vb), h1 = tr_read<v_rd_off(D0, 1, 1)>(vb);
  const s16x4 l2 = tr_read<v_rd_off(D0, 2, 0)>(vb), h2 = tr_read<v_rd_off(D0, 2, 1)>(vb), l3 = tr_read<v_rd_off(D0, 3, 0)>(vb), h3 = tr_read<v_rd_off(D0, 3, 1)>(vb);
  asm volatile("s_waitcnt lgkmcnt(0)" ::: "memory"); SBAR();
#define PK(L, H) (bf16x8){L[0], L[1], L[2], L[3], H[0], H[1], H[2], H[3]}
  od = __builtin_amdgcn_mfma_f32_32x32x16_bf16(pa0, PK(l0, h0), od, 0, 0, 0);
  od = __builtin_amdgcn_mfma_f32_32x32x16_bf16(pa1, PK(l1, h1), od, 0, 0, 0);
  od = __builtin_amdgcn_mfma_f32_32x32x16_bf16(pa2, PK(l2, h2), od, 0, 0, 0);
  od = __builtin_amdgcn_mfma_f32_32x32x16_bf16(pa3, PK(l3, h3), od, 0, 0, 0);
#undef PK
}
__device__ __forceinline__ void pv_d0(f32x16* o, int vb, bf16x8 pa0, bf16x8 pa1, bf16x8 pa2, bf16x8 pa3) {
  pv_one<0>(o[0], vb, pa0, pa1, pa2, pa3); pv_one<1>(o[1], vb, pa0, pa1, pa2, pa3); pv_one<2>(o[2], vb, pa0, pa1, pa2, pa3); pv_one<3>(o[3], vb, pa0, pa1, pa2, pa3);
}

__device__ __forceinline__ void attn_dense_body(const bf16_t* __restrict__ Qb, const bf16_t* __restrict__ Kh, const bf16_t* __restrict__ Vh,
                                                bf16_t* __restrict__ Ob, int seq, char* lds) {
  const int tid = threadIdx.x, wid = tid >> 6, lane = tid & 63, r32 = lane & 31, hi = lane >> 5;
  bf16_t* V_lds = (bf16_t*)lds; bf16_t* K_lds = (bf16_t*)(lds + 2 * SHM_V);
  float* ws = (float*)(lds + 2 * SHM_V + 2 * SHM_K) + wid * 64; float* li_l = ws; float* al_l = ws + 32;
  float m_reg = -1e30f, l_reg = 0; f32x16 o[4] = {}; bf16x8 qr[8];
  const bf16_t* Qw = Qb + (long)(wid * QBLK + r32) * LDQ + hi * 8;
#pragma unroll
  for (int d0 = 0; d0 < 8; ++d0) qr[d0] = ld8(Qw + d0 * 16);
  const int sr = tid >> 4, sc = (tid & 15) * 8, vst0 = v_st(sr, sc), vst1 = v_st(32 + sr, sc);
  const int vb0 = (int)(uintptr_t)V_lds + v_rd_base(lane);
  struct { bf16x8 vs0, vs1, ks0, ks1; } sr_[2];
#define SLOAD(i, k0) do { sr_[i].vs0 = ld8(&Vh[(long)((k0) + sr) * LDK + sc]); sr_[i].vs1 = ld8(&Vh[(long)((k0) + 32 + sr) * LDK + sc]); \
    sr_[i].ks0 = ld8(&Kh[(long)((k0) + sr) * LDK + sc]); sr_[i].ks1 = ld8(&Kh[(long)((k0) + 32 + sr) * LDK + sc]); } while (0)
#define SWRITE(b, i) do { *(bf16x8*)((char*)V_lds + (b) * SHM_V + vst0) = sr_[i].vs0;          \
    *(bf16x8*)((char*)V_lds + (b) * SHM_V + vst1) = sr_[i].vs1; int kc = sc * 2;               \
    *(bf16x8*)((char*)K_lds + (b) * SHM_K + KSWZ(sr, kc)) = sr_[i].ks0;                       \
    *(bf16x8*)((char*)K_lds + (b) * SHM_K + KSWZ(32 + sr, kc)) = sr_[i].ks1; } while (0)
#define SWAIT() do { asm volatile("s_waitcnt vmcnt(4)" ::: "memory"); } while (0)
#define RESC(a) do { if (__any((a) < 1.f)) { if (hi == 0) al_l[r32] = (a); asm volatile("s_waitcnt lgkmcnt(0)" ::: "memory"); \
    _Pragma("unroll") for (int d = 0; d < 4; ++d) _Pragma("unroll") for (int r = 0; r < 16; ++r) o[d][r] *= al_l[crow(r, hi)]; } } while (0)
  f32x16 pA0, pA1, pB0, pB1; float mnA, mnB, alA, alB; bf16x8 pa0, pa1, pa2, pa3; const int NT = seq / KVBLK;
  constexpr int SE = 0, SO = 1;
  SLOAD(SE, 0); asm volatile("s_waitcnt vmcnt(0)" ::: "memory"); SWRITE(0, SE); __syncthreads();
  qkt(pA0, pA1, K_lds, qr, r32, hi); partialSM(pA0, pA1, m_reg, mnA, alA);
  SLOAD(SO, KVBLK); if (2 < NT) SLOAD(SE, 2 * KVBLK);
  SWAIT(); SWRITE(1, SO); __syncthreads();
  for (int j = 1; j + 1 < NT; j += 2) {
    SBAR(); qkt(pB0, pB1, (bf16_t*)((char*)K_lds + SHM_K), qr, r32, hi);
    finishSM(pA0, pA1, alA, l_reg, pa0, pa1, pa2, pa3); SBAR();
    SLOAD(SO, (j + 2) * KVBLK); SBAR();
    pv_d0(o, vb0, pa0, pa1, pa2, pa3); partialSM(pB0, pB1, m_reg, mnB, alB);
    __syncthreads(); SWAIT(); SWRITE(0, SE);
    RESC(alB); __syncthreads();
    SBAR(); qkt(pA0, pA1, K_lds, qr, r32, hi);
    finishSM(pB0, pB1, alB, l_reg, pa0, pa1, pa2, pa3); SBAR();
    if (j + 3 < NT) SLOAD(SE, (j + 3) * KVBLK); SBAR();
    pv_d0(o, vb0 + (int)SHM_V, pa0, pa1, pa2, pa3); partialSM(pA0, pA1, m_reg, mnA, alA);
    __syncthreads(); SWAIT(); SWRITE(1, SO);
    RESC(alA); __syncthreads();
  }
  SBAR(); qkt(pB0, pB1, (bf16_t*)((char*)K_lds + SHM_K), qr, r32, hi);
  finishSM(pA0, pA1, alA, l_reg, pa0, pa1, pa2, pa3); SBAR();
  pv_d0(o, vb0, pa0, pa1, pa2, pa3); partialSM(pB0, pB1, m_reg, mnB, alB);
  __syncthreads(); RESC(alB);
  finishSM(pB0, pB1, alB, l_reg, pa0, pa1, pa2, pa3); SBAR();
  pv_d0(o, vb0 + (int)SHM_V, pa0, pa1, pa2, pa3);
  if (hi == 0) li_l[r32] = l_reg; asm volatile("s_waitcnt lgkmcnt(0)" ::: "memory");
  float rli[16];
#pragma unroll
  for (int r = 0; r < 16; ++r) rli[r] = __builtin_amdgcn_rcpf(li_l[crow(r, hi)]);
  bf16_t* Ow = Ob + (long)(wid * QBLK) * LDO;
#pragma unroll
  for (int r = 0; r < 16; ++r) { int orow = crow(r, hi);
#pragma unroll
    for (int d0 = 0; d0 < 4; ++d0) Ow[(long)orow * LDO + d0 * 32 + r32] = (bf16_t)f2bf(o[d0][r] * rli[r]); }
  __syncthreads();
#undef SLOAD
#undef SWRITE
#undef SWAIT
#undef RESC
}
}

__device__ __forceinline__ void transpose_item(const float* W, int K, int N, bf16_t* WT, LAS float* scr, int item, int lane, bool ffn_remap = false) {
    const int nblk = N / 32, kb = item / nblk, nb = item % nblk, k0 = 64 * kb, n0 = 32 * nb;
    int n0o = n0; if (ffn_remap) { const int half = n0 >= DFF ? 1 : 0, f = n0 - half * DFF; n0o = (f >> 7) * 256 + half * 128 + (f & 127); }
#pragma unroll 8
    for (int i = 0; i < 32; ++i) { const int kk = 2 * i + (lane >> 5); scr[kk * 33 + (lane & 31)] = __builtin_nontemporal_load(W + (size_t)(k0 + kk) * N + n0 + (lane & 31)); }
    asm volatile("s_waitcnt lgkmcnt(0)" ::: "memory");
    const int c = lane & 7;
#pragma unroll
    for (int j = 0; j < 4; ++j) { const int n = (lane >> 3) + 8 * j; const LAS float* s = scr + (8 * c) * 33 + n;
        u32x4 o; o.x = pk2(s[0 * 33], s[1 * 33]); o.y = pk2(s[2 * 33], s[3 * 33]); o.z = pk2(s[4 * 33], s[5 * 33]); o.w = pk2(s[6 * 33], s[7 * 33]);
        *(u32x4*)(WT + (size_t)(n0o + n) * K + k0 + 8 * c) = o; }
    asm volatile("s_waitcnt lgkmcnt(0)" ::: "memory");
}

__device__ __forceinline__ void ada_phase(const float* c, const float* c_ctx, const float* ada_w, const float* ada_b, float* mod, LAS unsigned char* lds, int wg, int G, int tid) {
    LAS float* sv = (LAS float*)lds;
    LAS float* part = sv + 3 * 2048;
    for (int i = tid; i < 3 * 2048; i += 512) { const int s = i >> 11, k = i & 2047; const float v = (s == 0) ? c_ctx[k] : c[(s - 1) * 2048 + k]; sv[i] = siluf(v); }
    __syncthreads();
    const int wave = tid >> 6, lane = tid & 63;
    for (int item = wg; item < 192; item += G) {
        const int L = item / 96, n0 = (item % 96) * 128;
        const float* W = ada_w + (size_t)L * 2048 * 12288 + n0 + lane * 2;
        float a0x = 0, a0y = 0, a1x = 0, a1y = 0, a2x = 0, a2y = 0;
        const int k0 = wave * 256;
#pragma unroll 8
        for (int k = 0; k < 256; ++k) {
            const f32x2 w = __builtin_nontemporal_load((const f32x2*)(W + (size_t)(k0 + k) * 12288));
            const float s0 = sv[k0 + k], s1 = sv[2048 + k0 + k], s2 = sv[4096 + k0 + k];
            a0x += s0 * w.x; a0y += s0 * w.y; a1x += s1 * w.x; a1y += s1 * w.y; a2x += s2 * w.x; a2y += s2 * w.y;
        }
        part[(wave * 3 + 0) * 128 + lane * 2] = a0x; part[(wave * 3 + 0) * 128 + lane * 2 + 1] = a0y;
        part[(wave * 3 + 1) * 128 + lane * 2] = a1x; part[(wave * 3 + 1) * 128 + lane * 2 + 1] = a1y;
        part[(wave * 3 + 2) * 128 + lane * 2] = a2x; part[(wave * 3 + 2) * 128 + lane * 2 + 1] = a2y;
        __syncthreads();
        if (tid < 384) { const int s = tid >> 7, n = tid & 127; float acc = ada_b[L * 12288 + n0 + n];
#pragma unroll
            for (int w = 0; w < 8; ++w) acc += part[(w * 3 + s) * 128 + n];
            mod[(size_t)(L * 3 + s) * 12288 + n0 + n] = acc; }
        __syncthreads();
    }
}

template <bool XIN_BF, bool XOUT_BF>
__device__ __forceinline__ void row_phase(const float* xin_lat, const float* xin_ctx, float* xout_lat, float* xout_ctx, bf16_t* XR,
                                          const bf16_t* Y, const float* g_post, const float* g_pre, const float* modL, int jgate, int jshift, int jscale,
                                          bf16_t* H, bool has_y, bool make_h, bool lat_only, int gw, int NGW, int lane, const float* YS = nullptr, int nsplit = 0) {
    for (int r = gw; r < MR; r += NGW) {
        const int b = r / SB, p = r - b * SB; int s; const float* xi; float* xo; const bool ctxrow = p < CTX;
        size_t xrow;
        if (ctxrow) { if (lat_only) continue; s = 0; xrow = (size_t)(b * CTX + p) * DM; xi = xin_ctx + xrow; xo = xout_ctx + xrow; }
        else { s = 1 + b; xrow = (size_t)(b * SEQ + p - CTX) * DM; xi = xin_lat + xrow; xo = xout_lat + xrow; }
        const float* ms = modL + (size_t)s * 12288;
        f32x4 x[8];
#pragma unroll
        for (int j = 0; j < 8; ++j) {
            if (XIN_BF && !ctxrow) { const u32x2 xb = __builtin_nontemporal_load((const u32x2*)(XR + xrow + (j * 64 + lane) * 4)); x[j] = (f32x4){bflo(xb.x), bfhi(xb.x), bflo(xb.y), bfhi(xb.y)}; }
            else x[j] = XIN_BF ? *(const f32x4*)(xi + (j * 64 + lane) * 4) : __builtin_nontemporal_load((const f32x4*)(xi + (j * 64 + lane) * 4));
        }
        if (has_y) {
            f32x4 y[8]; float ss = 0.f;
#pragma unroll
            for (int j = 0; j < 8; ++j) {
                if (ctxrow && nsplit > 0) { f32x4 t = {0.f, 0.f, 0.f, 0.f};
                    for (int sp = 0; sp < nsplit; ++sp) t += *(const f32x4*)(YS + ((size_t)sp * 512 + b * CTX + p) * DM + (j * 64 + lane) * 4);
                    y[j] = t; }
                else { const u32x2 yb = __builtin_nontemporal_load((const u32x2*)(Y + (size_t)r * DM + (j * 64 + lane) * 4)); y[j] = (f32x4){bflo(yb.x), bfhi(yb.x), bflo(yb.y), bfhi(yb.y)}; }
                ss += (y[j].x * y[j].x + y[j].y * y[j].y) + (y[j].z * y[j].z + y[j].w * y[j].w); }
            const float rs = rsqrtf(wave_sum(ss) * (1.f / DM) + EPS);
#pragma unroll
            for (int j = 0; j < 8; ++j) { const f32x4 gp = *(const f32x4*)(g_post + (j * 64 + lane) * 4); const f32x4 gt = *(const f32x4*)(ms + jgate * 2048 + (j * 64 + lane) * 4);
                x[j] = x[j] + gt * (y[j] * rs * gp);
                if (XOUT_BF && !ctxrow) { u32x2 w; w.x = cvt_pk_bf16(x[j].x, x[j].y); w.y = cvt_pk_bf16(x[j].z, x[j].w); *(u32x2*)(XR + xrow + (j * 64 + lane) * 4) = w;
                    x[j] = (f32x4){bflo(w.x), bfhi(w.x), bflo(w.y), bfhi(w.y)}; }
                else *(f32x4*)(xo + (j * 64 + lane) * 4) = x[j]; }
        }
        if (make_h) {
            float ss = 0.f;
#pragma unroll
            for (int j = 0; j < 8; ++j) ss += (x[j].x * x[j].x + x[j].y * x[j].y) + (x[j].z * x[j].z + x[j].w * x[j].w);
            const float rs = rsqrtf(wave_sum(ss) * (1.f / DM) + EPS);
#pragma unroll
            for (int j = 0; j < 8; ++j) { const f32x4 gp = *(const f32x4*)(g_pre + (j * 64 + lane) * 4); const f32x4 sh = *(const f32x4*)(ms + jshift * 2048 + (j * 64 + lane) * 4);
                const f32x4 sc = *(const f32x4*)(ms + jscale * 2048 + (j * 64 + lane) * 4);
                const f32x4 hv = (x[j] * rs * gp) * (sc + 1.f) + sh;
                u32x2 w; w.x = cvt_pk_bf16(hv.x, hv.y); w.y = cvt_pk_bf16(hv.z, hv.w);
                *(u32x2*)(H + (size_t)r * DM + (j * 64 + lane) * 4) = w; }
        }
    }
}

__device__ __forceinline__ void gla_prep_phase(bf16_t* P, bf16_t* QB, float* EB, const float* __restrict__ lbl, LAS unsigned char* lds, int wg, int G, int tid) {
    const int lane = tid & 63, w = __builtin_amdgcn_readfirstlane(tid >> 6);
    constexpr float L2E = 1.4426950408889634f;
    int par = 0;
    unsigned nq[8], nf[8], nb[8];
    if (wg < NB * NH * 132) { const int rb0 = wg % 132, bh0 = wg / 132; const size_t r0 = (size_t)(bh0 >> 4) * SB + rb0 * 64 + 8 * w; const int c0 = (bh0 & 15) * 128 + 2 * lane;
#pragma unroll
        for (int i = 0; i < 8; ++i) { const size_t ro = (r0 + i) * NHG + c0; nq[i] = __builtin_nontemporal_load((const unsigned*)(P + ro)); nf[i] = __builtin_nontemporal_load((const unsigned*)(P + ro + 2048)); nb[i] = __builtin_nontemporal_load((const unsigned*)(P + ro + 4096)); } }
    for (int item = wg; item < NB * NH * 132; item += G, par ^= 1) {
        LAS float* TOT = (LAS float*)lds + par * 2048;
        const int rb = item % 132, bh = item / 132, h = bh & 15, b = bh >> 4;
        float lb[2][2], oml[2][2];
#pragma unroll
        for (int d = 0; d < 2; ++d)
#pragma unroll
            for (int e = 0; e < 2; ++e) { const int ch = h * 128 + 2 * lane + e; const float l0 = lbl[(d * 2 + 0) * 2048 + ch], l1 = lbl[(d * 2 + 1) * 2048 + ch];
                lb[d][e] = __builtin_amdgcn_rcpf(1.f + __builtin_amdgcn_exp2f((l1 - l0) * L2E)); oml[d][e] = 1.f - lb[d][e]; }
        const size_t row0 = (size_t)b * SB + rb * 64 + 8 * w;
        const int col = h * 128 + 2 * lane;
        unsigned q2[8], ff[8], fb[8];
#pragma unroll
        for (int i = 0; i < 8; ++i) { q2[i] = nq[i]; ff[i] = nf[i]; fb[i] = nb[i]; }
        if (item + G < NB * NH * 132) {
            const int it2 = item + G, rb2 = it2 % 132, bh2 = it2 / 132;
            const size_t r2 = (size_t)(bh2 >> 4) * SB + rb2 * 64 + 8 * w; const int c2 = (bh2 & 15) * 128 + 2 * lane;
#pragma unroll
            for (int i = 0; i < 8; ++i) { const size_t ro = (r2 + i) * NHG + c2; nq[i] = __builtin_nontemporal_load((const unsigned*)(P + ro)); nf[i] = __builtin_nontemporal_load((const unsigned*)(P + ro + 2048)); nb[i] = __builtin_nontemporal_load((const unsigned*)(P + ro + 4096)); }
        }
        float blf[8][2], blb[8][2], kkf[8][2], kkb[8][2];
        { float r0 = 0.f, r1 = 0.f;
#pragma unroll
          for (int i = 0; i < 8; ++i) {
              { const float sg = __builtin_amdgcn_rcpf(1.f + __builtin_amdgcn_exp2f(bflo(ff[i]) * -L2E)); r0 += __builtin_amdgcn_logf(lb[0][0] + oml[0][0] * sg); blf[i][0] = r0; kkf[i][0] = oml[0][0] - oml[0][0] * sg; }
              { const float sg = __builtin_amdgcn_rcpf(1.f + __builtin_amdgcn_exp2f(bfhi(ff[i]) * -L2E)); r1 += __builtin_amdgcn_logf(lb[0][1] + oml[0][1] * sg); blf[i][1] = r1; kkf[i][1] = oml[0][1] - oml[0][1] * sg; }
          }
          *(LAS f32x2*)(TOT + w * 128 + 2 * lane) = (f32x2){r0, r1}; }
        { float r0 = 0.f, r1 = 0.f;
#pragma unroll
          for (int i = 7; i >= 0; --i) {
              { const float sg = __builtin_amdgcn_rcpf(1.f + __builtin_amdgcn_exp2f(bflo(fb[i]) * -L2E)); r0 += __builtin_amdgcn_logf(lb[1][0] + oml[1][0] * sg); blb[i][0] = r0; kkb[i][0] = oml[1][0] - oml[1][0] * sg; }
              { const float sg = __builtin_amdgcn_rcpf(1.f + __builtin_amdgcn_exp2f(bfhi(fb[i]) * -L2E)); r1 += __builtin_amdgcn_logf(lb[1][1] + oml[1][1] * sg); blb[i][1] = r1; kkb[i][1] = oml[1][1] - oml[1][1] * sg; }
          }
          *(LAS f32x2*)(TOT + 1024 + w * 128 + 2 * lane) = (f32x2){r0, r1}; }
        LBAR();
        float pf0 = 0.f, pf1 = 0.f, tf0 = 0.f, tf1 = 0.f, pb0 = 0.f, pb1 = 0.f, tb0 = 0.f, tb1 = 0.f;
#pragma unroll
        for (int g = 0; g < 8; ++g) { const f32x2 x = *(const LAS f32x2*)(TOT + g * 128 + 2 * lane), y = *(const LAS f32x2*)(TOT + 1024 + g * 128 + 2 * lane);
            tf0 += x.x; tf1 += x.y; tb0 += y.x; tb1 += y.y; if (g < w) { pf0 += x.x; pf1 += x.y; } if (g > w) { pb0 += y.x; pb1 += y.y; } }
#pragma unroll
        for (int i = 0; i < 8; ++i) {
            const float qs0 = bflo(q2[i]), qs1 = bfhi(q2[i]);
            const float s0 = qs0 * 0.08838834764831845f * __builtin_amdgcn_rcpf(1.f + __builtin_amdgcn_exp2f(qs0 * -L2E));
            const float s1 = qs1 * 0.08838834764831845f * __builtin_amdgcn_rcpf(1.f + __builtin_amdgcn_exp2f(qs1 * -L2E));
            const float df0 = pf0 + blf[i][0] - tf0, df1 = pf1 + blf[i][1] - tf1, db0 = pb0 + blb[i][0] - tb0, db1 = pb1 + blb[i][1] - tb1;
            const size_t ro = (row0 + i) * NHG + col;
            *(unsigned*)(P + ro) = cvt_pk_bf16(s0 * __builtin_amdgcn_exp2f(df0), s1 * __builtin_amdgcn_exp2f(df1));
            *(unsigned*)(P + ro + 2048) = cvt_pk_bf16(kkf[i][0] * __builtin_amdgcn_exp2f(-df0), kkf[i][1] * __builtin_amdgcn_exp2f(-df1));
            *(unsigned*)(P + ro + 4096) = cvt_pk_bf16(kkb[i][0] * __builtin_amdgcn_exp2f(-db0), kkb[i][1] * __builtin_amdgcn_exp2f(-db1));
            *(unsigned*)(QB + (row0 + i) * DM + col) = cvt_pk_bf16(s0 * __builtin_amdgcn_exp2f(db0), s1 * __builtin_amdgcn_exp2f(db1));
        }
        if (w == 0) {
            const int cb = rb < 4 ? 3 - rb : 135 - rb;
            *(f32x2*)(EB + ((size_t)((b * 16 + h) * 2 + 0) * 132 + rb) * 128 + 2 * lane) = (f32x2){__builtin_amdgcn_exp2f(tf0), __builtin_amdgcn_exp2f(tf1)};
            *(f32x2*)(EB + ((size_t)((b * 16 + h) * 2 + 1) * 132 + cb) * 128 + 2 * lane) = (f32x2){__builtin_amdgcn_exp2f(tb0), __builtin_amdgcn_exp2f(tb1)};
        }
    }
    __syncthreads();
}

__device__ __forceinline__ void gla_item(const bf16_t* __restrict__ P, const bf16_t* __restrict__ QS, int ldq, const float* __restrict__ EB, bf16_t* __restrict__ Od, LAS unsigned char* lds, int b, int h, int dir, int vs, int tid) {
    const int lane = tid & 63, w = __builtin_amdgcn_readfirstlane(tid >> 6), fr = lane & 15, fq = lane >> 4;
    constexpr int SETB = 66560;
    f32x4 S0 = {0.f, 0.f, 0.f, 0.f}, S1 = {0.f, 0.f, 0.f, 0.f};
    const int qrow = tid >> 4, colq = h * 128 + (tid & 15) * 8;
    const int kq = tid & 31, tg = tid >> 5, colf = 2048 * (1 + dir) + h * 128 + 4 * kq;
    const int colv = 3 * 2048 + h * 128 + vs * 32 + (tid & 7) * 4;
    const int tv = tid >> 3, base = b * SB, rofs = dir ? 63 : 0, rsign = dir ? -1 : 1;
    const float* ebp = EB + (size_t)((b * 16 + h) * 2 + dir) * 132 * 128 + 16 * w + 4 * fq;
    u32x4 q4[2][2]; u32x2 k2[2][4]; u32x2 vv[2]; f32x4 eb[2];
#define GLA_R0(c) (dir ? ((c) < 4 ? base + 192 - 64 * (c) : base + 8640 - 64 * (c)) : base + 64 * (c))
#define GLA_LOAD(u, c) do { const int R0n = GLA_R0(c); \
        _Pragma("unroll") for (int i = 0; i < 2; ++i) q4[u][i] = *(const u32x4*)(QS + (size_t)(R0n + rofs + rsign * (qrow + 32 * i)) * ldq + colq); \
        _Pragma("unroll") for (int i = 0; i < 4; ++i) k2[u][i] = *(const u32x2*)(P + (size_t)(R0n + rofs + rsign * (4 * tg + i)) * NHG + colf); \
        vv[u] = *(const u32x2*)(P + (size_t)(R0n + rofs + rsign * tv) * NHG + colv); eb[u] = *(const f32x4*)(ebp + (size_t)(c) * 128); __builtin_amdgcn_sched_barrier(0); } while (0)
    GLA_LOAD(0, 0); __builtin_amdgcn_sched_barrier(0); GLA_LOAD(1, 1); __builtin_amdgcn_sched_barrier(0);
    const int ti = w >> 1, vi = w & 1;
    for (int c0 = 0; c0 < 132; c0 += 2) {
#pragma unroll
      for (int u = 0; u < 2; ++u) {
        const int c = c0 + u;
        const int R0 = GLA_R0(c);
        LAS unsigned char* QD = lds + (u & 1) * SETB; LAS unsigned char* KD = QD + 17408; LAS unsigned char* KDT = QD + 34816; LAS unsigned char* VT = QD + 53248; LAS unsigned char* SDT = QD + 57856;
#pragma unroll
        for (int i = 0; i < 2; ++i) *(LAS u32x4*)(QD + (qrow + 32 * i) * 272 + (tid & 15) * 16) = q4[u][i];
#pragma unroll
        for (int i = 0; i < 4; ++i) *(LAS u32x2*)(KD + (4 * tg + i) * 272 + kq * 8) = k2[u][i];
        { const u32x2 r0 = k2[u][0], r1 = k2[u][1], r2 = k2[u][2], r3 = k2[u][3];
          *(LAS u32x2*)(KDT + (4 * kq + 0) * 144 + tg * 8) = (u32x2){(r0.x & 0xffffu) | (r1.x << 16), (r2.x & 0xffffu) | (r3.x << 16)};
          *(LAS u32x2*)(KDT + (4 * kq + 1) * 144 + tg * 8) = (u32x2){(r0.x >> 16) | (r1.x & 0xffff0000u), (r2.x >> 16) | (r3.x & 0xffff0000u)};
          *(LAS u32x2*)(KDT + (4 * kq + 2) * 144 + tg * 8) = (u32x2){(r0.y & 0xffffu) | (r1.y << 16), (r2.y & 0xffffu) | (r3.y << 16)};
          *(LAS u32x2*)(KDT + (4 * kq + 3) * 144 + tg * 8) = (u32x2){(r0.y >> 16) | (r1.y & 0xffff0000u), (r2.y >> 16) | (r3.y & 0xffff0000u)}; }
        { LAS bf16_t* vt = (LAS bf16_t*)VT; const int v4 = (tid & 7) * 4;
          vt[(v4 + 0) * 72 + tv] = (bf16_t)(vv[u].x & 0xffffu); vt[(v4 + 1) * 72 + tv] = (bf16_t)(vv[u].x >> 16);
          vt[(v4 + 2) * 72 + tv] = (bf16_t)(vv[u].y & 0xffffu); vt[(v4 + 3) * 72 + tv] = (bf16_t)(vv[u].y >> 16); }
        S0 *= eb[u]; S1 *= eb[u];
        *(LAS u32x2*)(SDT + fr * 272 + (16 * w + 4 * fq) * 2) = (u32x2){cvt_pk_bf16(S0.x, S0.y), cvt_pk_bf16(S0.z, S0.w)};
        *(LAS u32x2*)(SDT + (16 + fr) * 272 + (16 * w + 4 * fq) * 2) = (u32x2){cvt_pk_bf16(S1.x, S1.y), cvt_pk_bf16(S1.z, S1.w)};
        { const int cn = (c + 2 < 132) ? c + 2 : 131; GLA_LOAD(u, cn); }
        LBAR();
        { bf16x8 bq[4], ak[4][4], as_[4], kt[2], vb0[2], vb1[2]; s16x4 av[4];
#pragma unroll
          for (int ks = 0; ks < 4; ++ks) bq[ks] = *(const LAS bf16x8*)(QD + (16 * ti + fr) * 272 + (ks * 32 + fq * 8) * 2);
#pragma unroll
          for (int si = 0; si < 4; ++si) if (si <= ti) {
#pragma unroll
              for (int ks = 0; ks < 4; ++ks) ak[si][ks] = *(const LAS bf16x8*)(KD + (16 * si + fr) * 272 + (ks * 32 + fq * 8) * 2);
              av[si] = *(const LAS s16x4*)(VT + (16 * vi + fr) * 144 + (16 * si + 4 * fq) * 2); }
#pragma unroll
          for (int ks = 0; ks < 4; ++ks) as_[ks] = *(const LAS bf16x8*)(SDT + (16 * vi + fr) * 272 + (ks * 32 + fq * 8) * 2);
#pragma unroll
          for (int ks = 0; ks < 2; ++ks) { kt[ks] = *(const LAS bf16x8*)(KDT + (16 * w + fr) * 144 + (ks * 32 + fq * 8) * 2);
              vb0[ks] = *(const LAS bf16x8*)(VT + fr * 144 + (ks * 32 + fq * 8) * 2); vb1[ks] = *(const LAS bf16x8*)(VT + (16 + fr) * 144 + (ks * 32 + fq * 8) * 2); }
          f32x4 o = {0.f, 0.f, 0.f, 0.f};
#pragma unroll
          for (int ks = 0; ks < 4; ++ks) o = __builtin_amdgcn_mfma_f32_16x16x32_bf16(as_[ks], bq[ks], o, 0, 0, 0);
#pragma unroll
          for (int si = 0; si < 4; ++si) if (si <= ti) {
              f32x4 acc = {0.f, 0.f, 0.f, 0.f};
#pragma unroll
              for (int ks = 0; ks < 4; ++ks) acc = __builtin_amdgcn_mfma_f32_16x16x32_bf16(ak[si][ks], bq[ks], acc, 0, 0, 0);
              if (si == ti) {
#pragma unroll
                  for (int j = 0; j < 4; ++j) if (4 * fq + j > fr) acc[j] = 0.f;
              }
              const u32x2 pk = {cvt_pk_bf16(acc.x, acc.y), cvt_pk_bf16(acc.z, acc.w)};
              o = __builtin_amdgcn_mfma_f32_16x16x16bf16_1k(av[si], __builtin_bit_cast(s16x4, pk), o, 0, 0, 0);
          }
#pragma unroll
          for (int ks = 0; ks < 2; ++ks) { S0 = __builtin_amdgcn_mfma_f32_16x16x32_bf16(kt[ks], vb0[ks], S0, 0, 0, 0); S1 = __builtin_amdgcn_mfma_f32_16x16x32_bf16(kt[ks], vb1[ks], S1, 0, 0, 0); }
          const size_t ro = (size_t)(R0 + rofs + rsign * (16 * ti + fr)) * DM;
          *(u32x2*)(Od + ro + h * 128 + vs * 32 + 16 * vi + 4 * fq) = (u32x2){cvt_pk_bf16(o.x, o.y), cvt_pk_bf16(o.z, o.w)}; }
      }
    }
#undef GLA_LOAD
#undef GLA_R0
    __syncthreads();
}

__device__ __forceinline__ void readout_phase(const bf16_t* Ofw, const bf16_t* Obw, const bf16_t* P, const float* o_gain, bf16_t* R, int gw, int NGW, int lane) {
    const int cl = (8 * lane) & 127;
    const f32x4 g0 = *(const f32x4*)(o_gain + cl), g1 = *(const f32x4*)(o_gain + cl + 4);
    const float gn[8] = {g0.x, g0.y, g0.z, g0.w, g1.x, g1.y, g1.z, g1.w};
    for (int it0 = gw * 4; it0 < MR * 4; it0 += NGW * 4) {
        u32x4 a[4], bq[4], g[4];
#pragma unroll
        for (int u = 0; u < 4; ++u) { const int it = it0 + u, r = it >> 2, c0 = (it & 3) * 512 + 8 * lane;
            a[u] = __builtin_nontemporal_load((const u32x4*)(Ofw + (size_t)r * DM + c0)); bq[u] = __builtin_nontemporal_load((const u32x4*)(Obw + (size_t)r * DM + c0)); g[u] = __builtin_nontemporal_load((const u32x4*)(P + (size_t)r * NHG + 4 * DM + c0)); }
#pragma unroll
        for (int u = 0; u < 4; ++u) { const int it = it0 + u, r = it >> 2, c0 = (it & 3) * 512 + 8 * lane;
            float o[8];
            o[0] = bflo(a[u].x) + bflo(bq[u].x); o[1] = bfhi(a[u].x) + bfhi(bq[u].x); o[2] = bflo(a[u].y) + bflo(bq[u].y); o[3] = bfhi(a[u].y) + bfhi(bq[u].y);
            o[4] = bflo(a[u].z) + bflo(bq[u].z); o[5] = bfhi(a[u].z) + bfhi(bq[u].z); o[6] = bflo(a[u].w) + bflo(bq[u].w); o[7] = bfhi(a[u].w) + bfhi(bq[u].w);
            float ss = 0.f;
#pragma unroll
            for (int e = 0; e < 8; ++e) ss += o[e] * o[e];
            ss += __shfl_xor(ss, 1); ss += __shfl_xor(ss, 2); ss += __shfl_xor(ss, 4); ss += __shfl_xor(ss, 8);
            const float rs = rsqrtf(ss * (1.f / 128.f) + EPS);
            const float gv[8] = {bflo(g[u].x), bfhi(g[u].x), bflo(g[u].y), bfhi(g[u].y), bflo(g[u].z), bfhi(g[u].z), bflo(g[u].w), bfhi(g[u].w)};
            float v[8];
#pragma unroll
            for (int e = 0; e < 8; ++e) v[e] = o[e] * rs * gn[e] * siluf(gv[e]);
            u32x4 wv; wv.x = cvt_pk_bf16(v[0], v[1]); wv.y = cvt_pk_bf16(v[2], v[3]); wv.z = cvt_pk_bf16(v[4], v[5]); wv.w = cvt_pk_bf16(v[6], v[7]);
            *(u32x4*)(R + (size_t)r * DM + c0) = wv; }
    }
}

__device__ __forceinline__ void conv_fix_phase(const float* BND, const float* cw, const float* cbias, bf16_t* ACT, bool lat_only, int gw, int NGW, int lane) {
    constexpr float L2E = 1.4426950408889634f;
    for (int it = gw; it < 66 * 2 * 11; it += NGW) {
        const int cbk = it % 11, rest = it / 11, which = rest & 1, pm = rest >> 1;
        if (lat_only && (pm == 0 || pm == 33)) continue;
        const int c0 = cbk * 512 + 8 * lane;
        const float* bn = BND + (size_t)pm * 6 * DFF + c0;
        f32x4 pv[2], cv[2], nv[2], uv[2]; size_t row;
        if (which == 0) {
            const bool seq_start = (pm == 0 || pm == 1 || pm == 33 || pm == 34);
#pragma unroll
            for (int hh = 0; hh < 2; ++hh) { pv[hh] = seq_start ? (f32x4){0.f, 0.f, 0.f, 0.f} : *(const f32x4*)(bn - 6 * DFF + 3 * DFF + 4 * hh);
                cv[hh] = *(const f32x4*)(bn + 4 * hh); nv[hh] = *(const f32x4*)(bn + DFF + 4 * hh); uv[hh] = *(const f32x4*)(bn + 4 * DFF + 4 * hh); }
            row = (size_t)pm * 256;
        } else {
            const bool seq_end = (pm == 0 || pm == 32 || pm == 33 || pm == 65);
#pragma unroll
            for (int hh = 0; hh < 2; ++hh) { pv[hh] = *(const f32x4*)(bn + 2 * DFF + 4 * hh); cv[hh] = *(const f32x4*)(bn + 3 * DFF + 4 * hh);
                nv[hh] = seq_end ? (f32x4){0.f, 0.f, 0.f, 0.f} : *(const f32x4*)(bn + 6 * DFF + 4 * hh); uv[hh] = *(const f32x4*)(bn + 5 * DFF + 4 * hh); }
            row = (size_t)pm * 256 + 255;
        }
        float v[8];
#pragma unroll
        for (int hh = 0; hh < 2; ++hh) {
            const f32x4 w0 = *(const f32x4*)(cw + c0 + 4 * hh), w1 = *(const f32x4*)(cw + DFF + c0 + 4 * hh), w2 = *(const f32x4*)(cw + 2 * DFF + c0 + 4 * hh), cb = *(const f32x4*)(cbias + c0 + 4 * hh);
#pragma unroll
            for (int j = 0; j < 4; ++j) { const float y = w0[j] * pv[hh][j] + w1[j] * cv[hh][j] + w2[j] * nv[hh][j] + cb[j];
                v[4 * hh + j] = y * __builtin_amdgcn_rcpf(1.f + __builtin_amdgcn_exp2f(y * -L2E)) * uv[hh][j]; }
        }
        u32x4 wv; wv.x = cvt_pk_bf16(v[0], v[1]); wv.y = cvt_pk_bf16(v[2], v[3]); wv.z = cvt_pk_bf16(v[4], v[5]); wv.w = cvt_pk_bf16(v[6], v[7]);
        *(u32x4*)(ACT + row * DFF + c0) = wv;
    }
}

__device__ __forceinline__ void qknorm_phase(bf16_t* QKV, const float* q_gain, const float* k_gain, int gw, int NGW, int lane) {
    const int cl = (8 * lane) & 127;
    for (int it = gw; it < MR * 5; it += NGW) {
        const int r = it / 5, grp = it - r * 5, p = r % SB;
        const bool lat = p >= CTX;
        if (!lat && grp < 4) continue;
        bf16_t* ptr = QKV + (size_t)r * NQKV + grp * 512 + 8 * lane;
        const float* gn = (grp < 4) ? q_gain : k_gain;
        const u32x4 a = *(const u32x4*)ptr;
        float x[8] = {bflo(a.x), bfhi(a.x), bflo(a.y), bfhi(a.y), bflo(a.z), bfhi(a.z), bflo(a.w), bfhi(a.w)};
        float ss = 0.f;
#pragma unroll
        for (int e = 0; e < 8; ++e) ss += x[e] * x[e];
        ss += __shfl_xor(ss, 1); ss += __shfl_xor(ss, 2); ss += __shfl_xor(ss, 4); ss += __shfl_xor(ss, 8);
        const float rs = rsqrtf(ss * (1.f / 128.f) + EPS);
#pragma unroll
        for (int e = 0; e < 8; ++e) x[e] = x[e] * rs * gn[cl + e];
        if (lat) {
            const int t = p - CTX; const float prow = (float)(t >> 6), pcol = (float)(t & 63);
#pragma unroll
            for (int e2 = 0; e2 < 4; ++e2) {
                const int i = (cl >> 1) + e2; const int fi = i & 31;
                const float invf = exp2f(-(float)fi * (13.287712379549449f / 32.f));
                const float ang = ((i >= 32) ? pcol : prow) * invf;
                float sn, cs; sincosf(ang, &sn, &cs);
                const float x1 = x[2 * e2], x2 = x[2 * e2 + 1];
                x[2 * e2] = x1 * cs - x2 * sn; x[2 * e2 + 1] = x1 * sn + x2 * cs;
            }
        }
        u32x4 wv; wv.x = cvt_pk_bf16(x[0], x[1]); wv.y = cvt_pk_bf16(x[2], x[3]); wv.z = cvt_pk_bf16(x[4], x[5]); wv.w = cvt_pk_bf16(x[6], x[7]);
        *(u32x4*)ptr = wv;
    }
}


#define XB_TMO      128
#define XB_XCNT(j)  (256  + 64 * (j))
#define XB_XSUB(j)  (1280 + 64 * (j))
#define XB_XGEN(j)  (2304 + 64 * (j))
#define XB_TOP      3328
#define XB_TOPGEN   3392
#define XCD_BAR_WORDS 3456
#define XB_SPIN_CAP (1u << 20)
__device__ __forceinline__ unsigned xb_ld(unsigned* p)              { return __hip_atomic_load(p, __ATOMIC_RELAXED, __HIP_MEMORY_SCOPE_AGENT); }
__device__ __forceinline__ unsigned xb_add(unsigned* p, unsigned v) { return __hip_atomic_fetch_add(p, v, __ATOMIC_RELAXED, __HIP_MEMORY_SCOPE_AGENT); }
__device__ __forceinline__ unsigned xb_xcc_id() { return (unsigned)__builtin_amdgcn_s_getreg((3 << 11) | 20) & 0xFu; }
#define XB_SPIN(cond, bar) do { unsigned _sp = 0; while (cond) { __builtin_amdgcn_s_sleep(1); \
    if ((++_sp & 255u) == 0u) { if (xb_ld(&(bar)[XB_TMO])) break; if (_sp > XB_SPIN_CAP) { atomicAdd(&(bar)[XB_TMO], 1u); break; } } } } while (0)
struct XcdBarrier { unsigned* bar; unsigned x; volatile LAS unsigned* st; };
__device__ __forceinline__ XcdBarrier xcd_barrier_post(unsigned* bar, volatile LAS unsigned* st) {
    XcdBarrier b; b.bar = bar; b.x = xb_xcc_id(); b.st = st;
    if (threadIdx.x == 0) (void)xb_add(&bar[XB_XCNT(b.x)], 1u);
    return b;
}
__device__ __forceinline__ void xcd_barrier_complete(unsigned* bar, unsigned x, unsigned& nloc, unsigned& nx) {
    const unsigned G = gridDim.x * gridDim.y * gridDim.z;
    unsigned sum, cnt, mine, sp = 0u;
    for (;;) {
        sum = 0u; cnt = 0u; mine = 0u;
#pragma unroll
        for (unsigned j = 0; j < 16; ++j) { const unsigned c = xb_ld(&bar[XB_XCNT(j)]); sum += c; cnt += (c > 0u) ? 1u : 0u; mine = (j == x) ? c : mine; }
        if (sum == G) break;
        __builtin_amdgcn_s_sleep(1);
        if ((++sp & 255u) == 0u) { if (xb_ld(&bar[XB_TMO])) break; if (sp > XB_SPIN_CAP) { atomicAdd(&bar[XB_TMO], 1u); break; } }
    }
    nloc = mine > 0u ? mine : 1u; nx = cnt > 0u ? cnt : 1u;
}
__device__ __forceinline__ void xcd_barrier(const XcdBarrier& b) {
    asm volatile("s_waitcnt vmcnt(0)" ::: "memory");
    __syncthreads();
    if (threadIdx.x == 0) {
        unsigned* bar = b.bar;
        __builtin_amdgcn_s_waitcnt(0);
        unsigned nloc = b.st[0], nx = b.st[1];
        if (nloc == 0u) { xcd_barrier_complete(bar, b.x, nloc, nx); b.st[0] = nloc; b.st[1] = nx; }
        const unsigned old = xb_add(&bar[XB_XSUB(b.x)], 1u);
        const unsigned gen = old / nloc;
        if (old + 1u == (gen + 1u) * nloc) {
            __builtin_amdgcn_fence(__ATOMIC_RELEASE, "agent");
            asm volatile("s_waitcnt vmcnt(0)" ::: "memory");
            const unsigned og = xb_add(&bar[XB_TOP], 1u);
            const unsigned tg = og / nx;
            if (og + 1u == (tg + 1u) * nx) xb_add(&bar[XB_TOPGEN], 1u);
            else XB_SPIN(xb_ld(&bar[XB_TOPGEN]) == tg, bar);
            __builtin_amdgcn_fence(__ATOMIC_ACQUIRE, "agent");
            xb_add(&bar[XB_XGEN(b.x)], 1u);
            asm volatile("s_waitcnt vmcnt(0)" ::: "memory");
        } else {
            XB_SPIN(xb_ld(&bar[XB_XGEN(b.x)]) == gen, bar);
            __builtin_amdgcn_fence(__ATOMIC_ACQUIRE, "agent");
            asm volatile("s_waitcnt vmcnt(0)" ::: "memory");
        }
    }
    __syncthreads();
}

struct KArgs { const float* in[22]; float* out; unsigned char* ws; int ph_lo, ph_hi; };
enum { I_X = 0, I_C, I_CTX, I_CCTX, I_ADAW, I_ADAB, I_NMPRE, I_NMPOST, I_NFPRE, I_NFPOST, I_HWIN, I_HLB, I_HONORM, I_HWOUT, I_AQKV, I_AQN, I_AKN, I_AWOUT, I_FWIN, I_FCW, I_FCB, I_FWOUT };
constexpr int N_PHASES = 20;

__global__ void __launch_bounds__(512, 2) mega_fwd(KArgs a) {
    extern __shared__ __attribute__((aligned(16))) unsigned char lds_raw[];
    LAS unsigned char* lds = (LAS unsigned char*)lds_raw;
    cg::grid_group grid = cg::this_grid();
    const int tid = threadIdx.x, lane = tid & 63, wave = __builtin_amdgcn_readfirstlane(tid >> 6);
    const int G = gridDim.x, wg = blockIdx.x;
    const int gw = wg * 8 + wave, NGW = G * 8;
    unsigned char* ws = a.ws;
    float* mod = (float*)(ws + WS_MOD);
    float* xctx = (float*)(ws + WS_XCTX);
    bf16_t* H = (bf16_t*)(ws + WS_H);
    bf16_t* BIG = (bf16_t*)(ws + WS_BIG);
    bf16_t* Y = (bf16_t*)(ws + WS_BIG);
    bf16_t* XR = (bf16_t*)(ws + WS_BIG + 256 * MiB);
    float* BND = (float*)(ws + WS_BIG + 200 * MiB);
    float* YS = (float*)(ws + WS_BIG + 132 * MiB);
    bf16_t* ACT = (bf16_t*)(ws + WS_ACT);
    bf16_t* OFW = ACT; bf16_t* OBW = ACT + (size_t)MR * DM;
    const int lo = a.ph_lo, hi = a.ph_hi;
#ifndef MK_REPMASK
#define MK_REPMASK 0u
#endif
#define PH(k) if (lo <= (k) && (k) < hi) for (int rep_ = 0; rep_ <= (int)((MK_REPMASK >> (k)) & 1u); ++rep_)
#define SEAM(k) do { if ((k) + 1 < hi) { if ((k) == 0) { asm volatile("s_waitcnt vmcnt(0) lgkmcnt(0)" ::: "memory"); grid.sync(); } else xcd_barrier(bar); } } while (0)
    LAS float* scr = (LAS float*)(lds + wave * 16384);
    volatile LAS unsigned* MISC = (volatile LAS unsigned*)(lds + LDS_BYTES - 256);
    if (tid < 16) MISC[tid] = 0u;
    __syncthreads();
    XcdBarrier bar = xcd_barrier_post((unsigned*)ws, MISC);

    PH(0) {
        ada_phase(a.in[I_C], a.in[I_CCTX], a.in[I_ADAW], a.in[I_ADAB], mod, lds, wg, G, tid);
        constexpr int I0 = 32 * (NHG / 32), I1 = 32 * (DM / 32), I2 = 32 * (2 * DFF / 32), I3 = (DFF / 64) * (DM / 32);
        for (int it = gw; it < I0 + I1 + I2 + I3; it += NGW) {
            int r = it;
            if (r < I0) { transpose_item(a.in[I_HWIN], DM, NHG, (bf16_t*)(ws + W_HIN), scr, r, lane); continue; } r -= I0;
            if (r < I1) { transpose_item(a.in[I_HWOUT], DM, DM, (bf16_t*)(ws + W_HOUT), scr, r, lane); continue; } r -= I1;
            if (r < I2) { transpose_item(a.in[I_FWIN], DM, 2 * DFF, (bf16_t*)(ws + W_FIN), scr, r, lane, true); continue; } r -= I2;
            transpose_item(a.in[I_FWOUT], DFF, DM, (bf16_t*)(ws + W_FOUT), scr, r, lane);
        }
        SEAM(0);
    }
    PH(1) {
        row_phase<false, false>(a.in[I_X], a.in[I_CTX], nullptr, nullptr, XR, nullptr, nullptr, a.in[I_NMPRE], mod, 0, 0, 1, H, false, true, false, gw, NGW, lane);
        SEAM(1);
    }
    PH(2) {
        pg8::Gemm g{H, (const bf16_t*)(ws + W_HIN), MR, NHG, DM}; pg8::Order S; S.init(MR / 256, NHG, DM, G, wg, 0, 0);
        pg8::EpiBf16 E{BIG, NHG};
        pg8::gemm_phase<pg8::EpiBf16, pg8::Order, true, true>(lds, g, S, E);
        SEAM(2);
    }
    PH(3) {
        float* EB = (float*)(ACT + (size_t)2 * MR * DM);
        if (rep_ == 0) gla_prep_phase(BIG, H, EB, a.in[I_HLB], lds, wg, G, tid);
        xcd_barrier(bar);
        for (int item = wg; item < 256; item += G) {
            const int xq = item & 7, yq = item >> 3, vs = yq & 3, sq = xq + 8 * (yq >> 2);
            const int dir = sq & 1, h = (sq >> 1) & 15, b = sq >> 5;
            gla_item(BIG, dir ? H : BIG, dir ? DM : NHG, EB, dir ? OBW : OFW, lds, b, h, dir, vs, tid);
        }
        SEAM(3);
    }
    PH(4) {
        readout_phase(OFW, OBW, BIG, a.in[I_HONORM], H, gw, NGW, lane);
        SEAM(4);
    }
    PH(5) {
        pg8::Gemm g{H, (const bf16_t*)(ws + W_HOUT), MR, DM, DM}; pg8::Order S; S.init(64, DM, DM, G, wg, 1, 16);
        pg8::EpiF32 E{Y, DM, YS, DM / 64};
        pg8::gemm_phase<pg8::EpiF32, pg8::Order, true, true>(lds, g, S, E);
        SEAM(5);
    }
    PH(6) {
        row_phase<false, true>(a.in[I_X], a.in[I_CTX], a.out, xctx, XR, Y, a.in[I_NMPOST], a.in[I_NFPRE], mod, 2, 3, 4, H, true, true, false, gw, NGW, lane, YS, 16);
        SEAM(6);
    }
    PH(7) {
        pg8::Gemm g{H, (const bf16_t*)(ws + W_FIN), MR, 2 * DFF, DM}; pg8::Order S; S.init(MR / 256, 2 * DFF, DM, G, wg, 0, 0);
        pg8::EpiConv E{ACT, a.in[I_FCW], a.in[I_FCB], BND, (LAS float*)(lds + 131072)};
        pg8::gemm_phase<pg8::EpiConv, pg8::Order, true, true>(lds, g, S, E);
        SEAM(7);
    }
    PH(8) {
        conv_fix_phase(BND, a.in[I_FCW], a.in[I_FCB], ACT, false, gw, NGW, lane);
        SEAM(8);
    }
    PH(9) {
        pg8::Gemm g{ACT, (const bf16_t*)(ws + W_FOUT), MR, DM, DFF}; pg8::Order S; S.init(64, DM, DFF, G, wg, 1, 11);
        pg8::EpiF32 E{Y, DM, YS, DFF / 64};
        pg8::gemm_phase<pg8::EpiF32, pg8::Order, true, true>(lds, g, S, E);
        SEAM(9);
    }
    PH(10) {
        row_phase<true, true>(a.out, xctx, a.out, xctx, XR, Y, a.in[I_NFPOST], a.in[I_NMPRE] + DM, mod, 5, 6 * 3 + 0, 6 * 3 + 1, H, true, true, false, gw, NGW, lane, YS, 11);
        __syncthreads();
        constexpr int I0 = 32 * (NQKV / 32), I1 = 32 * (DM / 32), I2 = 32 * (2 * DFF / 32), I3 = (DFF / 64) * (DM / 32);
        for (int it = gw; it < I0 + I1 + I2 + I3; it += NGW) {
            int r = it;
            if (r < I0) { transpose_item(a.in[I_AQKV], DM, NQKV, (bf16_t*)(ws + W_QKV), scr, r, lane); continue; } r -= I0;
            if (r < I1) { transpose_item(a.in[I_AWOUT], DM, DM, (bf16_t*)(ws + W_AOUT), scr, r, lane); continue; } r -= I1;
            if (r < I2) { transpose_item(a.in[I_FWIN] + (size_t)DM * 2 * DFF, DM, 2 * DFF, (bf16_t*)(ws + W_FIN), scr, r, lane, true); continue; } r -= I2;
            transpose_item(a.in[I_FWOUT] + (size_t)DFF * DM, DFF, DM, (bf16_t*)(ws + W_FOUT), scr, r, lane);
        }
        SEAM(10);
    }
    PH(11) {
        pg8::Gemm g{H, (const bf16_t*)(ws + W_QKV), MR, NQKV, DM}; pg8::Order S; S.init(MR / 256, NQKV, DM, G, wg, 0, 0);
        pg8::EpiBf16 E{BIG, NQKV};
        pg8::gemm_phase<pg8::EpiBf16, pg8::Order, true, true>(lds, g, S, E);
        SEAM(11);
    }
    PH(12) {
        qknorm_phase(BIG, a.in[I_AQN], a.in[I_AKN], gw, NGW, lane);
        SEAM(12);
    }
    PH(13) {
        for (int u = wg; u < 1024; u += G) {
            const int x = u & 7, rest = u >> 3, j = rest & 31, i = rest >> 5;
            const int b = x >> 2, kvh = x & 3, h = kvh * 4 + i;
            const size_t qrow = (size_t)b * SB + CTX + (size_t)j * 256;
            att::attn_dense_body(BIG + qrow * NQKV + h * 128, BIG + (size_t)b * SB * NQKV + 2048 + kvh * 128, BIG + (size_t)b * SB * NQKV + 2560 + kvh * 128,
                                 ACT + qrow * DM + h * 128, SB, (char*)lds_raw);
        }
        SEAM(13);
    }
    PH(14) {
        pg8::Gemm g{ACT, (const bf16_t*)(ws + W_AOUT), MR, DM, DM}; pg8::Order S; S.init(64, DM, DM, G, wg, 1, 0);
        pg8::EpiF32 E{Y, DM, nullptr, 0};
        pg8::gemm_phase<pg8::EpiF32, pg8::Order, true, true>(lds, g, S, E);
        SEAM(14);
    }
    PH(15) {
        row_phase<true, true>(a.out, xctx, a.out, xctx, XR, Y, a.in[I_NMPOST] + DM, a.in[I_NFPRE] + DM, mod + 3 * 12288, 2, 3, 4, H, true, true, true, gw, NGW, lane);
        SEAM(15);
    }
    PH(16) {
        pg8::Gemm g{H, (const bf16_t*)(ws + W_FIN), MR, 2 * DFF, DM}; pg8::Order S; S.init(64, 2 * DFF, DM, G, wg, 1, 0);
        pg8::EpiConv E{ACT, a.in[I_FCW] + 3 * DFF, a.in[I_FCB] + DFF, BND, (LAS float*)(lds + 131072)};
        pg8::gemm_phase<pg8::EpiConv, pg8::Order, true, true>(lds, g, S, E);
        SEAM(16);
    }
    PH(17) {
        conv_fix_phase(BND, a.in[I_FCW] + 3 * DFF, a.in[I_FCB] + DFF, ACT, true, gw, NGW, lane);
        SEAM(17);
    }
    PH(18) {
        pg8::Gemm g{ACT, (const bf16_t*)(ws + W_FOUT), MR, DM, DFF}; pg8::Order S; S.init(64, DM, DFF, G, wg, 1, 0);
        pg8::EpiF32 E{Y, DM, nullptr, 0};
        pg8::gemm_phase<pg8::EpiF32, pg8::Order, true, true>(lds, g, S, E);
        SEAM(18);
    }
    PH(19) {
        row_phase<true, false>(a.out, xctx, a.out, xctx, XR, Y, a.in[I_NFPOST] + DM, nullptr, mod + 3 * 12288, 5, 0, 0, H, true, false, true, gw, NGW, lane);
    }
#undef PH
#undef SEAM
}


extern "C" void kernel_launch(void* const* d_in, const int* in_sizes, int n_in, void* d_out, int out_size, void* d_ws, size_t ws_size, hipStream_t stream) {
    static int grid = 0;
    if (grid == 0) {
        if (n_in != 22 || ws_size < WS_END || out_size != NB * SEQ * DM) { fprintf(stderr, "kernel_launch: unexpected shapes n_in %d ws %zu out %d\n", n_in, ws_size, out_size); grid = -1; return; }
        int dev = 0, cus = 0, per_cu = 0;
        if (hipGetDevice(&dev) != hipSuccess || hipDeviceGetAttribute(&cus, hipDeviceAttributeMultiprocessorCount, dev) != hipSuccess) { grid = -1; return; }
        if (hipFuncSetAttribute((const void*)mega_fwd, hipFuncAttributeMaxDynamicSharedMemorySize, LDS_BYTES) != hipSuccess) { fprintf(stderr, "kernel_launch: hipFuncSetAttribute failed\n"); grid = -1; return; }
        if (hipOccupancyMaxActiveBlocksPerMultiprocessor(&per_cu, (const void*)mega_fwd, 512, LDS_BYTES) != hipSuccess || per_cu < 1) { fprintf(stderr, "kernel_launch: occupancy query says %d\n", per_cu); per_cu = 1; }
        (void)hipGetLastError();
        grid = cus * 1;
    }
    if (grid < 0) return;
    KArgs a{};
    for (int i = 0; i < 22; ++i) a.in[i] = (const float*)d_in[i];
    a.out = (float*)d_out; a.ws = (unsigned char*)d_ws;
    a.ph_lo = 0; a.ph_hi = N_PHASES;
    if (hipMemsetAsync(d_ws, 0, 16384, stream) != hipSuccess) { fprintf(stderr, "kernel_launch: memset failed\n"); return; }
    void* args[] = {&a};
    hipError_t e = hipLaunchCooperativeKernel((const void*)mega_fwd, dim3(grid), dim3(512), args, LDS_BYTES, stream);
    if (e != hipSuccess) fprintf(stderr, "cooperative launch failed: %s (grid %d)\n", hipGetErrorString(e), grid);
}
```

```cpp
#include <hip/hip_runtime.h>
#include <hip/hip_cooperative_groups.h>
#include <cstdio>
#include <cstdint>
namespace cg = cooperative_groups;

#define LAS __attribute__((address_space(3)))
typedef unsigned short bf16_t;
typedef short bf16x8 __attribute__((ext_vector_type(8)));
typedef float f32x4 __attribute__((ext_vector_type(4)));
typedef float f32x2 __attribute__((ext_vector_type(2)));
typedef float f32x16 __attribute__((ext_vector_type(16)));
typedef unsigned u32x4 __attribute__((ext_vector_type(4)));
typedef unsigned u32x2 __attribute__((ext_vector_type(2)));
typedef short s16x4 __attribute__((ext_vector_type(4)));

constexpr int DM = 2048, NB = 2, SEQ = 8192, CTX = 256, SB = SEQ + CTX, MR = NB * SB;
constexpr int NH = 16, HD = 128, NKV = 4, DFF = 5632, NQKV = 3072, NHG = 5 * DM;
constexpr float EPS = 1e-6f;

constexpr size_t MiB = 1u << 20;
constexpr size_t WS_MOD = 64 * 1024;
constexpr size_t WS_XCTX = 2 * MiB;
constexpr size_t WS_W = 6 * MiB;
constexpr size_t W_HIN = WS_W, W_HOUT = WS_W + 40 * MiB, W_FIN = WS_W + 48 * MiB, W_FOUT = WS_W + 92 * MiB;
constexpr size_t W_QKV = WS_W, W_AOUT = WS_W + 12 * MiB;
constexpr size_t WS_H = 120 * MiB;
constexpr size_t WS_BIG = 186 * MiB;
constexpr size_t WS_ACT = 549 * MiB;
constexpr size_t WS_END = WS_ACT + (size_t)MR * DFF * 2;
static_assert(WS_END <= 768 * MiB, "ws");

constexpr int LDS_BYTES = 147456;

typedef __bf16 bf16x2_t __attribute__((ext_vector_type(2)));
__device__ __forceinline__ unsigned cvt_pk_bf16(float lo, float hi) { f32x2 v = {lo, hi}; bf16x2_t b = __builtin_convertvector(v, bf16x2_t); return __builtin_bit_cast(unsigned, b); }
__device__ __forceinline__ unsigned f2bf(float f) { unsigned u = __builtin_bit_cast(unsigned, f); return (u + 0x7fffu + ((u >> 16) & 1u)) >> 16; }
__device__ __forceinline__ unsigned pk2(float lo, float hi) { return f2bf(lo) | (f2bf(hi) << 16); }
__device__ __forceinline__ float bflo(unsigned u) { return __builtin_bit_cast(float, u << 16); }
__device__ __forceinline__ float bfhi(unsigned u) { return __builtin_bit_cast(float, u & 0xffff0000u); }
__device__ __forceinline__ float wave_sum(float v) {
#pragma unroll
    for (int o = 1; o < 64; o <<= 1) v += __shfl_xor(v, o);
    return v;
}
__device__ __forceinline__ float siluf(float v) { return v / (1.f + __expf(-v)); }
#define LBAR() do { asm volatile("s_waitcnt lgkmcnt(0)" ::: "memory"); __builtin_amdgcn_s_barrier(); asm volatile("" ::: "memory"); } while (0)

namespace pg8 {
constexpr int BM = 256, BK = 64, HALF = 128, HTB = HALF * BK * 2, STAGE_BYTES = 8 * HTB, NXCD = 8, WGM = 4;
__host__ __device__ __forceinline__ int lds_byte(int r, int c) { const int st = (r >> 4) * 2 + (c >> 5), rr = r & 15, cc = c & 31, ob = rr * 64 + cc * 2; return st * 1024 + (ob ^ (((ob >> 9) & 1) << 5)); }
__host__ __device__ __forceinline__ void stage_rc(int b, int& R, int& C) { const int st = b / 1024, sb = b % 1024, swz = sb ^ (((sb >> 9) & 1) << 5); R = (st >> 1) * 16 + swz / 64; C = (st & 1) * 32 + (swz % 64) / 2; }
__host__ __device__ __forceinline__ int perm32(int rho) { const int n = rho >> 4, i = rho & 15; return 8 * (i >> 2) + 4 * n + (i & 3); }

struct Unit { int pm, pn, kn; };
struct Gemm { const bf16_t* A; const bf16_t* Bt; int M, N, K; };

struct Order {
    int nM, nN, nwg, G, c, skip, ntf, nsplit;
    __device__ void init(int nM_, int N, int K, int G_, int c_, int skip_, int nsplit_) { nM = nM_; nN = N / BM; nwg = nM * nN; G = G_; c = c_; skip = skip_; ntf = K / BK; nsplit = nsplit_; }
    __device__ bool next(int i, Unit& u) const {
        const long L = (long)i * G + c;
        if (L >= nwg) {
            const int j = (int)(L - nwg); if (j >= 2 * nN * nsplit) return false;
            const int sidx = j % nsplit, cu = j / nsplit, cr = cu / nN;
            const int ntu = ntf / nsplit; u.pm = cr ? 33 : 0; u.pn = cu % nN; u.kn = (sidx * ntu) | (ntu << 16); return true;
        }
        int wgid = (int)L; { const int q = nwg / NXCD, r = nwg % NXCD, xcd = wgid % NXCD, off = wgid / NXCD; wgid = (xcd < r ? xcd * (q + 1) : r * (q + 1) + (xcd - r) * q) + off; }
        const int nig = WGM * nN, gid = wgid / nig, fm = gid * WGM, gsz = (nM - fm) < WGM ? (nM - fm) : WGM;
        int pm = fm + ((wgid % nig) % gsz); u.pn = (wgid % nig) / gsz;
        if (skip) pm = pm + 1 + (pm >= 32 ? 1 : 0);
        u.pm = pm; u.kn = ntf << 16; return true;
    }
    __device__ __forceinline__ void a_ready(const Unit&) const {}
    __device__ __forceinline__ void done(const Unit&) const {}
};

struct EpiBf16 {
    static constexpr bool PERM = true, AFTER_DRAIN = false;
    bf16_t* O; int ldc;
    __device__ __forceinline__ void operator()(const f32x4 (&acc)[2][2][4][2], const Unit& u, int wr, int wc, int fr, int fq) const {
        const int row0 = u.pm * BM + wr * 64 + fr; const int col0 = u.pn * BM + wc * 32 + 8 * fq;
#pragma unroll
        for (int ai = 0; ai < 2; ++ai)
#pragma unroll
            for (int m = 0; m < 4; ++m) { bf16_t* rowp = O + (size_t)(row0 + ai * HALF + m * 16) * ldc + col0;
#pragma unroll
                for (int bj = 0; bj < 2; ++bj) { const f32x4 v0 = acc[ai][bj][m][0], v1 = acc[ai][bj][m][1];
                    u32x4 w; w.x = cvt_pk_bf16(v0[0], v0[1]); w.y = cvt_pk_bf16(v0[2], v0[3]); w.z = cvt_pk_bf16(v1[0], v1[1]); w.w = cvt_pk_bf16(v1[2], v1[3]);
                    *(u32x4*)(rowp + bj * HALF) = w; } }
    }
};
struct EpiF32 {
    static constexpr bool PERM = true, AFTER_DRAIN = false;
    bf16_t* O; int ldc; float* SL; int ntf;
    __device__ __forceinline__ void operator()(const f32x4 (&acc)[2][2][4][2], const Unit& u, int wr, int wc, int fr, int fq) const {
        const int ntu = u.kn >> 16, kt0 = u.kn & 0xffff;
        const int row0 = wr * 64 + fr; const int col0 = u.pn * BM + wc * 32 + 8 * fq;
        if (ntu < ntf) {
            float* basep = SL + ((size_t)(kt0 / ntu) * 512 + (u.pm == 33 ? 256 : 0)) * ldc;
#pragma unroll
            for (int ai = 0; ai < 2; ++ai)
#pragma unroll
                for (int m = 0; m < 4; ++m) { float* rowp = basep + (size_t)(row0 + ai * HALF + m * 16) * ldc + col0;
#pragma unroll
                    for (int bj = 0; bj < 2; ++bj) { *(f32x4*)(rowp + bj * HALF) = acc[ai][bj][m][0]; *(f32x4*)(rowp + bj * HALF + 4) = acc[ai][bj][m][1]; } }
        } else {
            bf16_t* basep = O + (size_t)u.pm * BM * ldc;
#pragma unroll
            for (int ai = 0; ai < 2; ++ai)
#pragma unroll
                for (int m = 0; m < 4; ++m) { bf16_t* rowp = basep + (size_t)(row0 + ai * HALF + m * 16) * ldc + col0;
#pragma unroll
                    for (int bj = 0; bj < 2; ++bj) { const f32x4 v0 = acc[ai][bj][m][0], v1 = acc[ai][bj][m][1];
                        u32x4 w; w.x = cvt_pk_bf16(v0[0], v0[1]); w.y = cvt_pk_bf16(v0[2], v0[3]); w.z = cvt_pk_bf16(v1[0], v1[1]); w.w = cvt_pk_bf16(v1[2], v1[3]);
                        *(u32x4*)(rowp + bj * HALF) = w; } }
        }
    }
};

template <int CTRL> __device__ __forceinline__ float dpp_upd(float oldv, float src) {
    return __builtin_bit_cast(float, __builtin_amdgcn_update_dpp(__builtin_bit_cast(int, oldv), __builtin_bit_cast(int, src), CTRL, 0xf, 0xf, false)); }
template <int M> __device__ __forceinline__ float conv_elem(float gp, float gc, float gn, float up, float hp, float hn, float w0, float w1, float w2, float cb) {
    const float X = (M == 0) ? hp : dpp_upd<0x121>(0.f, gp);
    const float prev = dpp_upd<0x111>(X, gc);
    const float Yv = (M == 3) ? hn : dpp_upd<0x12F>(0.f, gn);
    const float next = dpp_upd<0x101>(Yv, gc);
    const float y = w0 * prev + w1 * gc + w2 * next + cb;
    return y * __builtin_amdgcn_rcpf(1.f + __builtin_amdgcn_exp2f(y * -1.4426950408889634f)) * up;
}
template <int M> __device__ __forceinline__ f32x4 conv_group(const f32x4 GP, const f32x4 GC, const f32x4 GN, const f32x4 up, const f32x4 hp, const f32x4 hn, const f32x4 w0, const f32x4 w1, const f32x4 w2, const f32x4 cb) {
    f32x4 r;
    r.x = conv_elem<M>(GP.x, GC.x, GN.x, up.x, hp.x, hn.x, w0.x, w1.x, w2.x, cb.x);
    r.y = conv_elem<M>(GP.y, GC.y, GN.y, up.y, hp.y, hn.y, w0.y, w1.y, w2.y, cb.y);
    r.z = conv_elem<M>(GP.z, GC.z, GN.z, up.z, hp.z, hn.z, w0.z, w1.z, w2.z, cb.z);
    r.w = conv_elem<M>(GP.w, GC.w, GN.w, up.w, hp.w, hn.w, w0.w, w1.w, w2.w, cb.w);
    return r;
}
struct EpiConv {
    static constexpr bool PERM = true, AFTER_DRAIN = false;
    bf16_t* ACT; const float* cw; const float* cbias; float* BND; LAS float* xch;
    __device__ __forceinline__ void operator()(const f32x4 (&acc)[2][2][4][2], const Unit& u, int wr_, int wc_, int fr_, int fq_) const {
        int wr = wr_, wc = wc_, fr = fr_, fq = fq_;
        asm volatile("" : "+v"(fr), "+v"(fq), "+s"(wr), "+s"(wc));
        const int cl = wc * 32 + 8 * fq, f0 = u.pn * 128 + cl;
#pragma unroll
        for (int ai = 0; ai < 2; ++ai) { const int blk = 2 * ai + wr;
            if (fr == 0) { *(LAS f32x4*)(xch + (blk * 2 + 0) * 128 + cl) = acc[ai][0][0][0]; *(LAS f32x4*)(xch + (blk * 2 + 0) * 128 + cl + 4) = acc[ai][0][0][1]; }
            if (fr == 15) { *(LAS f32x4*)(xch + (blk * 2 + 1) * 128 + cl) = acc[ai][0][3][0]; *(LAS f32x4*)(xch + (blk * 2 + 1) * 128 + cl + 4) = acc[ai][0][3][1]; } }
        { float* bnd = BND + (size_t)u.pm * 6 * DFF + f0;
          if (wr == 0 && fr < 2) { *(f32x4*)(bnd + fr * DFF) = acc[0][0][0][0]; *(f32x4*)(bnd + fr * DFF + 4) = acc[0][0][0][1]; }
          asm volatile("" ::: "memory");
          if (wr == 0 && fr == 0) { *(f32x4*)(bnd + 4 * DFF) = acc[0][1][0][0]; *(f32x4*)(bnd + 4 * DFF + 4) = acc[0][1][0][1]; }
          asm volatile("" ::: "memory");
          if (wr == 1 && fr >= 14) { *(f32x4*)(bnd + (fr - 12) * DFF) = acc[1][0][3][0]; *(f32x4*)(bnd + (fr - 12) * DFF + 4) = acc[1][0][3][1]; }
          asm volatile("" ::: "memory");
          if (wr == 1 && fr == 15) { *(f32x4*)(bnd + 5 * DFF) = acc[1][1][3][0]; *(f32x4*)(bnd + 5 * DFF + 4) = acc[1][1][3][1]; }
        }
        LBAR(); __builtin_amdgcn_sched_barrier(0);
        const f32x4 w00 = *(const f32x4*)(cw + f0), w01 = *(const f32x4*)(cw + f0 + 4), w10 = *(const f32x4*)(cw + DFF + f0), w11 = *(const f32x4*)(cw + DFF + f0 + 4);
        const f32x4 w20 = *(const f32x4*)(cw + 2 * DFF + f0), w21 = *(const f32x4*)(cw + 2 * DFF + f0 + 4), cb0 = *(const f32x4*)(cbias + f0), cb1 = *(const f32x4*)(cbias + f0 + 4);
#pragma unroll
        for (int ai = 0; ai < 2; ++ai) { const int blk = 2 * ai + wr;
            f32x4 hp0 = {0.f, 0.f, 0.f, 0.f}, hp1 = hp0, hn0 = hp0, hn1 = hp0;
            if (blk > 0) { hp0 = *(const LAS f32x4*)(xch + ((blk - 1) * 2 + 1) * 128 + cl); hp1 = *(const LAS f32x4*)(xch + ((blk - 1) * 2 + 1) * 128 + cl + 4); }
            if (blk < 3) { hn0 = *(const LAS f32x4*)(xch + ((blk + 1) * 2 + 0) * 128 + cl); hn1 = *(const LAS f32x4*)(xch + ((blk + 1) * 2 + 0) * 128 + cl + 4); }
#define CONV_ROW(M, MP, MN) do { __builtin_amdgcn_sched_barrier(0); \
            const f32x4 v0 = conv_group<M>(acc[ai][0][MP][0], acc[ai][0][M][0], acc[ai][0][MN][0], acc[ai][1][M][0], hp0, hn0, w00, w10, w20, cb0); \
            const f32x4 v1 = conv_group<M>(acc[ai][0][MP][1], acc[ai][0][M][1], acc[ai][0][MN][1], acc[ai][1][M][1], hp1, hn1, w01, w11, w21, cb1); \
            const int rl = ai * HALF + wr * 64 + M * 16 + fr; \
            if (rl != 0 && rl != 255) { u32x4 w; w.x = cvt_pk_bf16(v0[0], v0[1]); w.y = cvt_pk_bf16(v0[2], v0[3]); w.z = cvt_pk_bf16(v1[0], v1[1]); w.w = cvt_pk_bf16(v1[2], v1[3]); \
                *(u32x4*)(ACT + (size_t)(u.pm * BM + rl) * DFF + f0) = w; } } while (0)
            CONV_ROW(0, 0, 1); CONV_ROW(1, 0, 2); CONV_ROW(2, 1, 3); CONV_ROW(3, 2, 3);
#undef CONV_ROW
            __builtin_amdgcn_sched_barrier(0);
        }
    }
};

template <class Epi, class Sched, bool ALIGN_EPI = false, bool SP2 = false>
__device__ __forceinline__ void gemm_phase(LAS unsigned char* lds, const Gemm g, const Sched& S, const Epi& E) {
    const int tid = threadIdx.x, wid = __builtin_amdgcn_readfirstlane(tid >> 6), lane = tid & 63, wr = wid >> 2, wc = wid & 3, fr = lane & 15, fq = lane >> 4;
    const int K = g.K;
    unsigned voffA[2], voffB[2];
#pragma unroll
    for (int i = 0; i < 2; ++i) { int R, C; stage_rc(tid * 16 + i * 8192, R, C); const int Rb = Epi::PERM ? ((R & ~31) + perm32(R & 31)) : R;
        voffA[i] = (unsigned)(R * K + C) * 2u; voffB[i] = (unsigned)(Rb * K + C) * 2u; }
    const size_t kstep = (size_t)(BK * 2);
    const size_t hstep = (size_t)HALF * K * 2;
    const size_t tstep = 2 * hstep;
    const unsigned ldsw = (unsigned)wid * 1024u;
    const int aoff = lds_byte(wr * 64 + fr, fq * 8), boff = lds_byte(wc * 32 + fr, fq * 8);
#define PG8_SA(b, h) (((b) * 2 + (h)) * HTB)
#define PG8_SB(b, h) ((4 + (b) * 2 + (h)) * HTB)
#define PG8_STAGE(bufoff, gbase, voff) do { _Pragma("unroll") for (int _i = 0; _i < 2; ++_i) \
        __builtin_amdgcn_global_load_lds((const unsigned*)((const char*)(gbase) + (voff)[_i]), (LAS unsigned*)(lds + (bufoff) + ldsw + _i * 8192), 16, 0, 0); } while (0)
#define PG8_LDA(dst, b, h) do { _Pragma("unroll") for (int m = 0; m < 4; ++m) _Pragma("unroll") for (int k = 0; k < 2; ++k) dst[m][k] = *(const LAS bf16x8*)(lds + PG8_SA(b, h) + aoff + m * 2048 + k * 1024); } while (0)
#define PG8_LDB(dst, b, h) do { _Pragma("unroll") for (int n = 0; n < 2; ++n) _Pragma("unroll") for (int k = 0; k < 2; ++k) dst[n][k] = *(const LAS bf16x8*)(lds + PG8_SB(b, h) + boff + n * 2048 + k * 1024); } while (0)
#define PG8_MMA(ai, bj, At, Bt) do { __builtin_amdgcn_s_setprio(1); _Pragma("unroll") for (int m = 0; m < 4; ++m) _Pragma("unroll") for (int n = 0; n < 2; ++n) _Pragma("unroll") for (int k = 0; k < 2; ++k) \
        acc[ai][bj][m][n] = __builtin_amdgcn_mfma_f32_16x16x32_bf16(Bt[n][k], At[m][k], acc[ai][bj][m][n], 0, 0, 0); __builtin_amdgcn_s_setprio(0); } while (0)
#define PG8_WAIT_V(n) asm volatile("s_waitcnt vmcnt(" #n ")" ::: "memory")
#define PG8_WAIT_L(n) asm volatile("s_waitcnt lgkmcnt(" #n ")" ::: "memory")
#define PG8_BAR __builtin_amdgcn_s_barrier()
#define PG8_SCHED __builtin_amdgcn_sched_barrier(0)
    Unit cur, nxt; int ui = 0;
    if (!S.next(0, cur)) return;
    f32x4 acc[2][2][4][2];
#pragma unroll
    for (int a = 0; a < 2; ++a)
#pragma unroll
        for (int b = 0; b < 2; ++b)
#pragma unroll
            for (int m = 0; m < 4; ++m)
#pragma unroll
                for (int n = 0; n < 2; ++n) acc[a][b][m][n] = (f32x4){0.f, 0.f, 0.f, 0.f};
    bf16x8 At[4][2], B0[2][2], B1[2][2];
    const char* cA = (const char*)g.A + (size_t)cur.pm * tstep + (size_t)(cur.kn & 0xffff) * kstep; const char* cB = (const char*)g.Bt + (size_t)cur.pn * tstep + (size_t)(cur.kn & 0xffff) * kstep;
    S.a_ready(cur);
    if constexpr (SP2) {
        PG8_STAGE(PG8_SB(0, 0), cB, voffB); PG8_STAGE(PG8_SB(0, 1), cB + hstep, voffB); PG8_STAGE(PG8_SA(0, 0), cA, voffA); PG8_STAGE(PG8_SA(0, 1), cA + hstep, voffA);
        if (wr == 1) PG8_BAR;
        PG8_WAIT_V(2); PG8_BAR;
        PG8_STAGE(PG8_SB(1, 0), cB + kstep, voffB); PG8_STAGE(PG8_SA(1, 0), cA + kstep, voffA); PG8_STAGE(PG8_SB(1, 1), cB + hstep + kstep, voffB);
        PG8_WAIT_V(6); PG8_BAR;
    } else {
        PG8_STAGE(PG8_SB(0, 0), cB, voffB); PG8_STAGE(PG8_SA(0, 0), cA, voffA); PG8_STAGE(PG8_SB(0, 1), cB + hstep, voffB); PG8_STAGE(PG8_SA(0, 1), cA + hstep, voffA);
        if (wr == 1) PG8_BAR;
        PG8_WAIT_V(4); PG8_BAR;
        PG8_STAGE(PG8_SB(1, 0), cB + kstep, voffB); PG8_STAGE(PG8_SA(1, 0), cA + kstep, voffA); PG8_STAGE(PG8_SB(1, 1), cB + hstep + kstep, voffB);
        PG8_WAIT_V(6); PG8_BAR;
    }
    for (;;) {
        const bool has_next = S.next(ui + 1, nxt);
        const char* nA = has_next ? (const char*)g.A + (size_t)nxt.pm * tstep + (size_t)(nxt.kn & 0xffff) * kstep : cA; const char* nB = has_next ? (const char*)g.Bt + (size_t)nxt.pn * tstep + (size_t)(nxt.kn & 0xffff) * kstep : cB;
        const int nt = cur.kn >> 16;
        for (int t = 0; t < nt; t += 2) {
            const bool last = (t == nt - 2);
            const char* a1 = cA + (size_t)(t + 1) * kstep;
            const char* a2 = last ? nA : cA + (size_t)(t + 2) * kstep; const char* b2 = last ? nB : cB + (size_t)(t + 2) * kstep;
            const char* a3 = a2 + kstep; const char* b3 = b2 + kstep;
            if (last && has_next) S.a_ready(nxt);
            if constexpr (SP2) {
            PG8_LDB(B0, 0, 0); PG8_LDB(B1, 0, 1); PG8_SCHED; PG8_LDA(At, 0, 0); PG8_STAGE(PG8_SA(1, 1), a1 + hstep, voffA);
            PG8_WAIT_V(8); PG8_WAIT_L(0); PG8_BAR; PG8_MMA(0, 0, At, B0); PG8_MMA(0, 1, At, B1); PG8_BAR; PG8_SCHED;
            PG8_LDA(At, 0, 1); PG8_STAGE(PG8_SB(0, 0), b2, voffB); PG8_STAGE(PG8_SB(0, 1), b2 + hstep, voffB); PG8_STAGE(PG8_SA(0, 0), a2, voffA);
            PG8_WAIT_V(8); PG8_WAIT_L(0); PG8_BAR; PG8_MMA(1, 0, At, B0); PG8_MMA(1, 1, At, B1); PG8_BAR; PG8_SCHED;
            PG8_LDB(B0, 1, 0); PG8_LDB(B1, 1, 1); PG8_SCHED; PG8_LDA(At, 1, 0); PG8_STAGE(PG8_SA(0, 1), a2 + hstep, voffA);
            PG8_WAIT_V(8); PG8_WAIT_L(0); PG8_BAR; PG8_MMA(0, 0, At, B0); PG8_MMA(0, 1, At, B1); PG8_BAR; PG8_SCHED;
            PG8_LDA(At, 1, 1); PG8_STAGE(PG8_SB(1, 0), b3, voffB); PG8_STAGE(PG8_SB(1, 1), b3 + hstep, voffB); PG8_STAGE(PG8_SA(1, 0), a3, voffA);
            PG8_WAIT_V(8); PG8_WAIT_L(0); PG8_BAR; PG8_MMA(1, 0, At, B0); PG8_MMA(1, 1, At, B1); PG8_BAR; PG8_SCHED;
            } else {
            PG8_LDB(B0, 0, 0); PG8_SCHED; PG8_LDA(At, 0, 0); PG8_STAGE(PG8_SA(1, 1), a1 + hstep, voffA);
            PG8_WAIT_L(8); PG8_BAR; PG8_WAIT_L(0); PG8_MMA(0, 0, At, B0); PG8_BAR; PG8_SCHED;
            PG8_LDB(B1, 0, 1); PG8_STAGE(PG8_SB(0, 0), b2, voffB);
            PG8_BAR; PG8_WAIT_L(0); PG8_MMA(0, 1, At, B1); PG8_BAR;
            PG8_LDA(At, 0, 1); PG8_STAGE(PG8_SA(0, 0), a2, voffA);
            PG8_BAR; PG8_WAIT_L(0); PG8_MMA(1, 0, At, B0); PG8_BAR; PG8_SCHED;
            PG8_STAGE(PG8_SB(0, 1), b2 + hstep, voffB);
            PG8_WAIT_V(6); PG8_BAR; PG8_MMA(1, 1, At, B1); PG8_BAR;
            PG8_LDB(B0, 1, 0); PG8_SCHED; PG8_LDA(At, 1, 0); PG8_STAGE(PG8_SA(0, 1), a2 + hstep, voffA);
            PG8_WAIT_L(8); PG8_BAR; PG8_WAIT_L(0); PG8_MMA(0, 0, At, B0); PG8_BAR; PG8_SCHED;
            PG8_LDB(B1, 1, 1); PG8_STAGE(PG8_SB(1, 0), b3, voffB);
            PG8_BAR; PG8_WAIT_L(0); PG8_MMA(0, 1, At, B1); PG8_BAR;
            PG8_LDA(At, 1, 1); PG8_STAGE(PG8_SA(1, 0), a3, voffA);
            PG8_BAR; PG8_WAIT_L(0); PG8_MMA(1, 0, At, B0); PG8_BAR; PG8_SCHED;
            PG8_STAGE(PG8_SB(1, 1), b3 + hstep, voffB);
            PG8_WAIT_V(6); PG8_BAR; PG8_MMA(1, 1, At, B1); PG8_BAR;
            }
        }
        if constexpr (ALIGN_EPI) { if (wr == 0) PG8_BAR; }
        if constexpr (!Epi::AFTER_DRAIN) { E(acc, cur, wr, wc, fr, fq); S.done(cur); }
        if (!has_next) break;
#pragma unroll
        for (int a = 0; a < 2; ++a)
#pragma unroll
            for (int b = 0; b < 2; ++b)
#pragma unroll
                for (int m = 0; m < 4; ++m)
#pragma unroll
                    for (int n = 0; n < 2; ++n) acc[a][b][m][n] = (f32x4){0.f, 0.f, 0.f, 0.f};
        cur = nxt; cA = nA; cB = nB; ++ui;
        if constexpr (ALIGN_EPI) { if (wr == 1) PG8_BAR; }
    }
    PG8_WAIT_V(0);
    if constexpr (!ALIGN_EPI) { if (wr == 0) PG8_BAR; }
    PG8_BAR;
#undef PG8_SA
#undef PG8_SB
#undef PG8_STAGE
#undef PG8_LDA
#undef PG8_LDB
#undef PG8_MMA
#undef PG8_WAIT_V
#undef PG8_WAIT_L
#undef PG8_BAR
#undef PG8_SCHED
}
}

namespace att {
constexpr int D = 128, NW = 8, QBLK = 32, KVBLK = 64;
constexpr float SCALE = 0.088388347648318440f;
constexpr float THR = 8.f;
constexpr int LDQ = NQKV, LDK = NQKV, LDO = DM;
constexpr size_t SHM_V = KVBLK * D * 2, SHM_K = KVBLK * D * 2, SHM_ATTN = 2 * SHM_V + 2 * SHM_K + NW * 64 * 4;
#define KSWZ(row, colB) ((row) * 256 + ((colB) ^ (((row) & 7) << 4)))
#define SBAR() __builtin_amdgcn_sched_barrier(0)
__device__ __forceinline__ int crow(int r, int hi) { return (r & 3) + 8 * (r >> 2) + 4 * hi; }
__device__ __forceinline__ unsigned cvtpk(float lo, float hi) { unsigned r; asm volatile("v_cvt_pk_bf16_f32 %0, %1, %2" : "=v"(r) : "v"(lo), "v"(hi)); return r; }
__device__ __forceinline__ bf16x8 ld8(const bf16_t* p) { return *reinterpret_cast<const bf16x8*>(p); }

__device__ __forceinline__ void partialSM(f32x16& p0, f32x16& p1, float& m_reg, float& mn, float& alpha) {
  constexpr float C = SCALE * 1.4426950408889634f;
  float pmax = p0[0];
#pragma unroll
  for (int r = 1; r < 16; ++r) pmax = fmaxf(pmax, p0[r]);
#pragma unroll
  for (int r = 0; r < 16; ++r) pmax = fmaxf(pmax, p1[r]);
  { auto rr = __builtin_amdgcn_permlane32_swap(__float_as_uint(pmax), __float_as_uint(pmax), false, false);
    pmax = fmaxf(__uint_as_float(rr[0]), __uint_as_float(rr[1])); }
  if (__builtin_expect(__all(pmax - m_reg <= THR / SCALE), 1)) { mn = m_reg; alpha = 1.f; }
  else { mn = fmaxf(m_reg, pmax); alpha = __builtin_amdgcn_exp2f((m_reg - mn) * C); m_reg = mn; }
  float mnC = -mn * C;
#pragma unroll
  for (int r = 0; r < 16; ++r) p0[r] = fmaf(p0[r], C, mnC);
#pragma unroll
  for (int r = 0; r < 16; ++r) p1[r] = fmaf(p1[r], C, mnC);
#pragma unroll
  for (int r = 0; r < 16; ++r) p0[r] = __builtin_amdgcn_exp2f(p0[r]);
}
__device__ __forceinline__ void finishSM(f32x16& p0, f32x16& p1, float alpha, float& l_reg, bf16x8& pa0, bf16x8& pa1, bf16x8& pa2, bf16x8& pa3) {
#pragma unroll
  for (int r = 0; r < 16; ++r) p1[r] = __builtin_amdgcn_exp2f(p1[r]);
  float ps = 0;
#pragma unroll
  for (int r = 0; r < 16; ++r) ps += p0[r];
#pragma unroll
  for (int r = 0; r < 16; ++r) ps += p1[r];
  { auto rr = __builtin_amdgcn_permlane32_swap(__float_as_uint(ps), __float_as_uint(ps), false, false);
    ps = __uint_as_float(rr[0]) + __uint_as_float(rr[1]); }
  l_reg = l_reg * alpha + ps;
#define PK4(P, BASE, OUT) do { unsigned a0 = cvtpk(P[BASE + 0], P[BASE + 1]), a1 = cvtpk(P[BASE + 2], P[BASE + 3]);   \
    unsigned b0 = cvtpk(P[BASE + 4], P[BASE + 5]), b1 = cvtpk(P[BASE + 6], P[BASE + 7]);                              \
    auto r0 = __builtin_amdgcn_permlane32_swap(a0, b0, false, false); auto r1 = __builtin_amdgcn_permlane32_swap(a1, b1, false, false); \
    u32x4 w = {r0[0], r1[0], r0[1], r1[1]}; OUT = *reinterpret_cast<bf16x8*>(&w); } while (0)
  PK4(p0, 0, pa0); PK4(p0, 8, pa1); PK4(p1, 0, pa2); PK4(p1, 8, pa3);
#undef PK4
}
__device__ __forceinline__ void qkt(f32x16& p0, f32x16& p1, const bf16_t* Ks, const bf16x8* qr, int r32, int hi) {
  p0 = f32x16{}; p1 = f32x16{};
#pragma unroll
  for (int d0 = 0; d0 < 8; ++d0) { int cb = (d0 * 16 + hi * 8) * 2;
    bf16x8 b0 = *reinterpret_cast<const bf16x8*>((const char*)Ks + KSWZ(r32, cb));
    bf16x8 b1 = *reinterpret_cast<const bf16x8*>((const char*)Ks + KSWZ(32 + r32, cb));
    p0 = __builtin_amdgcn_mfma_f32_32x32x16_bf16(b0, qr[d0], p0, 0, 0, 0);
    p1 = __builtin_amdgcn_mfma_f32_32x32x16_bf16(b1, qr[d0], p1, 0, 0, 0); }
}
__device__ __forceinline__ int v_st(int k, int c) { const int kk = (k & ~0xC) | ((k & 4) << 1) | ((k & 8) >> 1); return ((kk >> 3) * 4 + (c >> 5)) * 512 + ((kk & 7) * 32 + (c & 31)) * 2; }
__device__ __forceinline__ int v_rd_base(int lane) { return ((lane & 3) << 3) | (((lane >> 2) & 3) << 6) | (((lane >> 4) & 1) << 5) | (((lane >> 5) & 1) << 8); }
constexpr int v_rd_off(int d0, int ks, int half) { return d0 * 512 + ks * 4096 + half * 2048; }
template <int OFF> __device__ __forceinline__ s16x4 tr_read(int vb) {
  s16x4 r; asm volatile("ds_read_b64_tr_b16 %0, %1 offset:%2" : "=&v"(r) : "v"(vb), "i"(OFF) : "memory"); return r;
}
template <int D0> __device__ __forceinline__ void pv_one(f32x16& od, int vb, bf16x8 pa0, bf16x8 pa1, bf16x8 pa2, bf16x8 pa3) {
  const s16x4 l0 = tr_read<v_rd_off(D0, 0, 0)>(vb), h0 = tr_read<v_rd_off(D0, 0, 1)>(vb), l1 = tr_read<v_rd_off(D0, 1, 0)>(vb), h1 = tr_read<v_rd_off(D0, 1, 1)>(vb);
  const s16x4 l2 = tr_read<v_rd_off(D0, 2, 0)>(vb), h2 = tr_read<v_rd_off(D0, 2, 1)>(vb), l3 = tr_read<v_rd_off(D0, 3, 0)>(vb), h3 = tr_read<v_rd_off(D0, 3, 1)>(vb);
  asm volatile("s_waitcnt lgkmcnt(0)" ::: "memory"); SBAR();
#define PK(L, H) (bf16x8){L[0], L[1], L[2], L[3], H[0], H[1], H[2], H[3]}
  od = __builtin_amdgcn_mfma_f32_32x32x16_bf16(pa0, PK(l0, h0), od, 0, 0, 0);
  od = __builtin_amdgcn_mfma_f32_32x32x16_bf16(pa1, PK(l1, h1), od, 0, 0, 0);
  od = __builtin_amdgcn_mfma_f32_32x32x16_bf16(pa2, PK(l2, h2), od, 0, 0, 0);
  od = __builtin_amdgcn_mfma_f32_32x32x16_bf16(pa3, PK(l3, h3), od, 0, 0, 0);
#undef PK
}
__device__ __forceinline__ void pv_d0(f32x16* o, int vb, bf16x8 pa0, bf16x8 pa1, bf16x8 pa2, bf16x8 pa3) {
  pv_one<0>(o[0], vb, pa0, pa1, pa2, pa3); pv_one<1>(o[1], vb, pa0, pa1, pa2, pa3); pv_one<2>(o[2], vb, pa0, pa1, pa2, pa3); pv_one<3>(o[3], vb, pa0, pa1, pa2, pa3);
}

__device__ __forceinline__ void attn_dense_body(const bf16_t* __restrict__ Qb, const bf16_t* __restrict__ Kh, const bf16_t* __restrict__ Vh,
                                                bf16_t* __restrict__ Ob, int seq, char* lds) {
  const int tid = threadIdx.x, wid = tid >> 6, lane = tid & 63, r32 = lane & 31, hi = lane >> 5;
  bf16_t* V_lds = (bf16_t*)lds; bf16_t* K_lds = (bf16_t*)(lds + 2 * SHM_V);
  float* ws = (float*)(lds + 2 * SHM_V + 2 * SHM_K) + wid * 64; float* li_l = ws; float* al_l = ws + 32;
  float m_reg = -1e30f, l_reg = 0; f32x16 o[4] = {}; bf16x8 qr[8];
  const bf16_t* Qw = Qb + (long)(wid * QBLK + r32) * LDQ + hi * 8;
#pragma unroll
  for (int d0 = 0; d0 < 8; ++d0) qr[d0] = ld8(Qw + d0 * 16);
  const int sr = tid >> 4, sc = (tid & 15) * 8, vst0 = v_st(sr, sc), vst1 = v_st(32 + sr, sc);
  const int vb0 = (int)(uintptr_t)V_lds + v_rd_base(lane);
  struct { bf16x8 vs0, vs1, ks0, ks1; } sr_[2];
#define SLOAD(i, k0) do { sr_[i].vs0 = ld8(&Vh[(long)((k0) + sr) * LDK + sc]); sr_[i].vs1 = ld8(&Vh[(long)((k0) + 32 + sr) * LDK + sc]); \
    sr_[i].ks0 = ld8(&Kh[(long)((k0) + sr) * LDK + sc]); sr_[i].ks1 = ld8(&Kh[(long)((k0) + 32 + sr) * LDK + sc]); } while (0)
#define SWRITE(b, i) do { *(bf16x8*)((char*)V_lds + (b) * SHM_V + vst0) = sr_[i].vs0;          \
    *(bf16x8*)((char*)V_lds + (b) * SHM_V + vst1) = sr_[i].vs1; int kc = sc * 2;               \
    *(bf16x8*)((char*)K_lds + (b) * SHM_K + KSWZ(sr, kc)) = sr_[i].ks0;                       \
    *(bf16x8*)((char*)K_lds + (b) * SHM_K + KSWZ(32 + sr, kc)) = sr_[i].ks1; } while (0)
#define SWAIT() do { asm volatile("s_waitcnt vmcnt(4)" ::: "memory"); } while (0)
#define RESC(a) do { if (__any((a) < 1.f)) { if (hi == 0) al_l[r32] = (a); asm volatile("s_waitcnt lgkmcnt(0)" ::: "memory"); \
    _Pragma("unroll") for (int d = 0; d < 4; ++d) _Pragma("unroll") for (int r = 0; r < 16; ++r) o[d][r] *= al_l[crow(r, hi)]; } } while (0)
  f32x16 pA0, pA1, pB0, pB1; float mnA, mnB, alA, alB; bf16x8 pa0, pa1, pa2, pa3; const int NT = seq / KVBLK;
  constexpr int SE = 0, SO = 1;
  SLOAD(SE, 0); asm volatile("s_waitcnt vmcnt(0)" ::: "memory"); SWRITE(0, SE); __syncthreads();
  qkt(pA0, pA1, K_lds, qr, r32, hi); partialSM(pA0, pA1, m_reg, mnA, alA);
  SLOAD(SO, KVBLK); if (2 < NT) SLOAD(SE, 2 * KVBLK);
  SWAIT(); SWRITE(1, SO); __syncthreads();
  for (int j = 1; j + 1 < NT; j += 2) {
    SBAR(); qkt(pB0, pB1, (bf16_t*)((char*)K_lds + SHM_K), qr, r32, hi);
    finishSM(pA0, pA1, alA, l_reg, pa0, pa1, pa2, pa3); SBAR();
    SLOAD(SO, (j + 2) * KVBLK); SBAR();
    pv_d0(o, vb0, pa0, pa1, pa2, pa3); partialSM(pB0, pB1, m_reg, mnB, alB);
    __syncthreads(); SWAIT(); SWRITE(0, SE);
    RESC(alB); __syncthreads();
    SBAR(); qkt(pA0, pA1, K_lds, qr, r32, hi);
    finishSM(pB0, pB1, alB, l_reg, pa0, pa1, pa2, pa3); SBAR();
    if (j + 3 < NT) SLOAD(SE, (j + 3) * KVBLK); SBAR();
    pv_d0(o, vb0 + (int)SHM_V, pa0, pa1, pa2, pa3); partialSM(pA0, pA1, m_reg, mnA, alA);
    __syncthreads(); SWAIT(); SWRITE(1, SO);
    RESC(alA); __syncthreads();
  }
  SBAR(); qkt(pB0, pB1, (bf16_t*)((char*)K_lds + SHM_K), qr, r32, hi);
  finishSM(pA0, pA1, alA, l_reg, pa0, pa1, pa2, pa3); SBAR();
  pv_d0(o, vb0, pa0, pa1, pa2, pa3); partialSM(pB0, pB1, m_reg, mnB, alB);
  __syncthreads(); RESC(alB);
  finishSM(pB0, pB1, alB, l_reg, pa0, pa1, pa2, pa3); SBAR();
  pv_d0(o, vb0 + (int)SHM_V, pa0, pa1, pa2, pa3);
  if (hi == 0) li_l[r32] = l_reg; asm volatile("s_waitcnt lgkmcnt(0)" ::: "memory");
  float rli[16];
#pragma unroll
  for (int r = 0; r < 16; ++r) rli[r] = __builtin_amdgcn_rcpf(li_l[crow(r, hi)]);
  bf16_t* Ow = Ob + (long)(wid * QBLK) * LDO;
#pragma unroll
  for (int r = 0; r < 16; ++r) { int orow = crow(r, hi);
#pragma unroll
    for (int d0 = 0; d0 < 4; ++d0) Ow[(long)orow * LDO + d0 * 32 + r32] = (bf16_t)f2bf(o[d0][r] * rli[r]); }
  __syncthreads();
#undef SLOAD
#undef SWRITE
#undef SWAIT
#undef RESC
}
}

__device__ __forceinline__ void transpose_item(const float* W, int K, int N, bf16_t* WT, LAS float* scr, int item, int lane, bool ffn_remap = false) {
    const int nblk = N / 32, kb = item / nblk, nb = item % nblk, k0 = 64 * kb, n0 = 32 * nb;
    int n0o = n0; if (ffn_remap) { const int half = n0 >= DFF ? 1 : 0, f = n0 - half * DFF; n0o = (f >> 7) * 256 + half * 128 + (f & 127); }
#pragma unroll 8
    for (int i = 0; i < 32; ++i) { const int kk = 2 * i + (lane >> 5); scr[kk * 33 + (lane & 31)] = __builtin_nontemporal_load(W + (size_t)(k0 + kk) * N + n0 + (lane & 31)); }
    asm volatile("s_waitcnt lgkmcnt(0)" ::: "memory");
    const int c = lane & 7;
#pragma unroll
    for (int j = 0; j < 4; ++j) { const int n = (lane >> 3) + 8 * j; const LAS float* s = scr + (8 * c) * 33 + n;
        u32x4 o; o.x = pk2(s[0 * 33], s[1 * 33]); o.y = pk2(s[2 * 33], s[3 * 33]); o.z = pk2(s[4 * 33], s[5 * 33]); o.w = pk2(s[6 * 33], s[7 * 33]);
        *(u32x4*)(WT + (size_t)(n0o + n) * K + k0 + 8 * c) = o; }
    asm volatile("s_waitcnt lgkmcnt(0)" ::: "memory");
}

__device__ __forceinline__ void ada_phase(const float* c, const float* c_ctx, const float* ada_w, const float* ada_b, float* mod, LAS unsigned char* lds, int wg, int G, int tid) {
    LAS float* sv = (LAS float*)lds;
    LAS float* part = sv + 3 * 2048;
    for (int i = tid; i < 3 * 2048; i += 512) { const int s = i >> 11, k = i & 2047; const float v = (s == 0) ? c_ctx[k] : c[(s - 1) * 2048 + k]; sv[i] = siluf(v); }
    __syncthreads();
    const int wave = tid >> 6, lane = tid & 63;
    for (int item = wg; item < 192; item += G) {
        const int L = item / 96, n0 = (item % 96) * 128;
        const float* W = ada_w + (size_t)L * 2048 * 12288 + n0 + lane * 2;
        float a0x = 0, a0y = 0, a1x = 0, a1y = 0, a2x = 0, a2y = 0;
        const int k0 = wave * 256;
#pragma unroll 8
        for (int k = 0; k < 256; ++k) {
            const f32x2 w = __builtin_nontemporal_load((const f32x2*)(W + (size_t)(k0 + k) * 12288));
            const float s0 = sv[k0 + k], s1 = sv[2048 + k0 + k], s2 = sv[4096 + k0 + k];
            a0x += s0 * w.x; a0y += s0 * w.y; a1x += s1 * w.x; a1y += s1 * w.y; a2x += s2 * w.x; a2y += s2 * w.y;
        }
        part[(wave * 3 + 0) * 128 + lane * 2] = a0x; part[(wave * 3 + 0) * 128 + lane * 2 + 1] = a0y;
        part[(wave * 3 + 1) * 128 + lane * 2] = a1x; part[(wave * 3 + 1) * 128 + lane * 2 + 1] = a1y;
        part[(wave * 3 + 2) * 128 + lane * 2] = a2x; part[(wave * 3 + 2) * 128 + lane * 2 + 1] = a2y;
        __syncthreads();
        if (tid < 384) { const int s = tid >> 7, n = tid & 127; float acc = ada_b[L * 12288 + n0 + n];
#pragma unroll
            for (int w = 0; w < 8; ++w) acc += part[(w * 3 + s) * 128 + n];
            mod[(size_t)(L * 3 + s) * 12288 + n0 + n] = acc; }
        __syncthreads();
    }
}

template <bool XIN_BF, bool XOUT_BF>
__device__ __forceinline__ void row_phase_ctx(const float* xin_lat, const float* xin_ctx, float* xout_lat, float* xout_ctx, bf16_t* XR,
                                          const bf16_t* Y, const float* g_post, const float* g_pre, const float* modL, int jgate, int jshift, int jscale,
                                          bf16_t* H, bool has_y, bool make_h, bool lat_only, int gw, int NGW, int lane, const float* YS = nullptr, int nsplit = 0) {
    for (int cr = gw; cr < NB * CTX; cr += NGW) {
        const int b = cr / CTX, p = cr - b * CTX, r = b * SB + p; int s; const float* xi; float* xo; const bool ctxrow = p < CTX;
        size_t xrow;
        if (ctxrow) { if (lat_only) continue; s = 0; xrow = (size_t)(b * CTX + p) * DM; xi = xin_ctx + xrow; xo = xout_ctx + xrow; }
        else { s = 1 + b; xrow = (size_t)(b * SEQ + p - CTX) * DM; xi = xin_lat + xrow; xo = xout_lat + xrow; }
        const float* ms = modL + (size_t)s * 12288;
        f32x4 x[8];
#pragma unroll
        for (int j = 0; j < 8; ++j) {
            if (XIN_BF && !ctxrow) { const u32x2 xb = __builtin_nontemporal_load((const u32x2*)(XR + xrow + (j * 64 + lane) * 4)); x[j] = (f32x4){bflo(xb.x), bfhi(xb.x), bflo(xb.y), bfhi(xb.y)}; }
            else x[j] = XIN_BF ? *(const f32x4*)(xi + (j * 64 + lane) * 4) : __builtin_nontemporal_load((const f32x4*)(xi + (j * 64 + lane) * 4));
        }
        if (has_y) {
            f32x4 y[8]; float ss = 0.f;
#pragma unroll
            for (int j = 0; j < 8; ++j) {
                if (ctxrow && nsplit > 0) { f32x4 t = {0.f, 0.f, 0.f, 0.f};
                    for (int sp = 0; sp < nsplit; ++sp) t += *(const f32x4*)(YS + ((size_t)sp * 512 + b * CTX + p) * DM + (j * 64 + lane) * 4);
                    y[j] = t; }
                else { const u32x2 yb = __builtin_nontemporal_load((const u32x2*)(Y + (size_t)r * DM + (j * 64 + lane) * 4)); y[j] = (f32x4){bflo(yb.x), bfhi(yb.x), bflo(yb.y), bfhi(yb.y)}; }
                ss += (y[j].x * y[j].x + y[j].y * y[j].y) + (y[j].z * y[j].z + y[j].w * y[j].w); }
            const float rs = rsqrtf(wave_sum(ss) * (1.f / DM) + EPS);
#pragma unroll
            for (int j = 0; j < 8; ++j) { const f32x4 gp = *(const f32x4*)(g_post + (j * 64 + lane) * 4); const f32x4 gt = *(const f32x4*)(ms + jgate * 2048 + (j * 64 + lane) * 4);
                x[j] = x[j] + gt * (y[j] * rs * gp);
                if (XOUT_BF && !ctxrow) { u32x2 w; w.x = cvt_pk_bf16(x[j].x, x[j].y); w.y = cvt_pk_bf16(x[j].z, x[j].w); *(u32x2*)(XR + xrow + (j * 64 + lane) * 4) = w;
                    x[j] = (f32x4){bflo(w.x), bfhi(w.x), bflo(w.y), bfhi(w.y)}; }
                else *(f32x4*)(xo + (j * 64 + lane) * 4) = x[j]; }
        }
        if (make_h) {
            float ss = 0.f;
#pragma unroll
            for (int j = 0; j < 8; ++j) ss += (x[j].x * x[j].x + x[j].y * x[j].y) + (x[j].z * x[j].z + x[j].w * x[j].w);
            const float rs = rsqrtf(wave_sum(ss) * (1.f / DM) + EPS);
#pragma unroll
            for (int j = 0; j < 8; ++j) { const f32x4 gp = *(const f32x4*)(g_pre + (j * 64 + lane) * 4); const f32x4 sh = *(const f32x4*)(ms + jshift * 2048 + (j * 64 + lane) * 4);
                const f32x4 sc = *(const f32x4*)(ms + jscale * 2048 + (j * 64 + lane) * 4);
                const f32x4 hv = (x[j] * rs * gp) * (sc + 1.f) + sh;
                u32x2 w; w.x = cvt_pk_bf16(hv.x, hv.y); w.y = cvt_pk_bf16(hv.z, hv.w);
                *(u32x2*)(H + (size_t)r * DM + (j * 64 + lane) * 4) = w; }
        }
    }
}

template <bool XIN_BF, bool XOUT_BF>
__device__ __forceinline__ void row_phase(const float* xin_lat, const float* xin_ctx, float* xout_lat, float* xout_ctx, bf16_t* XR,
                                          const bf16_t* Y, const float* g_post, const float* g_pre, const float* modL, int jgate, int jshift, int jscale,
                                          bf16_t* H, bool has_y, bool make_h, bool lat_only, int gw, int NGW, int lane, const float* YS = nullptr, int nsplit = 0) {
    for (int q = gw; q < NB * SEQ / 2; q += NGW) {
        const int b = q / (SEQ / 2), t0 = 2 * (q - b * (SEQ / 2));
        const size_t r0 = (size_t)b * SB + CTX + t0, xrow = (size_t)(b * SEQ + t0) * DM;
        const float* ms = modL + (size_t)(1 + b) * 12288;
        f32x4 x[2][8], y[2][8];
#pragma unroll
        for (int rr = 0; rr < 2; ++rr)
#pragma unroll
            for (int j = 0; j < 8; ++j) {
                if (XIN_BF) { const u32x2 xb = __builtin_nontemporal_load((const u32x2*)(XR + xrow + rr * DM + (j * 64 + lane) * 4)); x[rr][j] = (f32x4){bflo(xb.x), bfhi(xb.x), bflo(xb.y), bfhi(xb.y)}; }
                else x[rr][j] = __builtin_nontemporal_load((const f32x4*)(xin_lat + xrow + rr * DM + (j * 64 + lane) * 4));
                if (has_y) { const u32x2 yb = __builtin_nontemporal_load((const u32x2*)(Y + (r0 + rr) * DM + (j * 64 + lane) * 4)); y[rr][j] = (f32x4){bflo(yb.x), bfhi(yb.x), bflo(yb.y), bfhi(yb.y)}; }
            }
        if (has_y) {
            float ss0 = 0.f, ss1 = 0.f;
#pragma unroll
            for (int j = 0; j < 8; ++j) { ss0 += (y[0][j].x * y[0][j].x + y[0][j].y * y[0][j].y) + (y[0][j].z * y[0][j].z + y[0][j].w * y[0][j].w);
                                          ss1 += (y[1][j].x * y[1][j].x + y[1][j].y * y[1][j].y) + (y[1][j].z * y[1][j].z + y[1][j].w * y[1][j].w); }
            const float rs0 = rsqrtf(wave_sum(ss0) * (1.f / DM) + EPS), rs1 = rsqrtf(wave_sum(ss1) * (1.f / DM) + EPS);
#pragma unroll
            for (int j = 0; j < 8; ++j) { const f32x4 gp = *(const f32x4*)(g_post + (j * 64 + lane) * 4); const f32x4 gt = *(const f32x4*)(ms + jgate * 2048 + (j * 64 + lane) * 4);
                const f32x4 gg = gt * gp;
#pragma unroll
                for (int rr = 0; rr < 2; ++rr) {
                    x[rr][j] = x[rr][j] + gt * (y[rr][j] * (rr ? rs1 : rs0) * gp);
                    if (XOUT_BF) { u32x2 w; w.x = cvt_pk_bf16(x[rr][j].x, x[rr][j].y); w.y = cvt_pk_bf16(x[rr][j].z, x[rr][j].w); *(u32x2*)(XR + xrow + rr * DM + (j * 64 + lane) * 4) = w;
                        x[rr][j] = (f32x4){bflo(w.x), bfhi(w.x), bflo(w.y), bfhi(w.y)}; }
                    else *(f32x4*)(xout_lat + xrow + rr * DM + (j * 64 + lane) * 4) = x[rr][j];
                }
                (void)gg; }
        }
        if (make_h) {
            float ss0 = 0.f, ss1 = 0.f;
#pragma unroll
            for (int j = 0; j < 8; ++j) { ss0 += (x[0][j].x * x[0][j].x + x[0][j].y * x[0][j].y) + (x[0][j].z * x[0][j].z + x[0][j].w * x[0][j].w);
                                          ss1 += (x[1][j].x * x[1][j].x + x[1][j].y * x[1][j].y) + (x[1][j].z * x[1][j].z + x[1][j].w * x[1][j].w); }
            const float rs0 = rsqrtf(wave_sum(ss0) * (1.f / DM) + EPS), rs1 = rsqrtf(wave_sum(ss1) * (1.f / DM) + EPS);
#pragma unroll
            for (int j = 0; j < 8; ++j) { const f32x4 gp = *(const f32x4*)(g_pre + (j * 64 + lane) * 4); const f32x4 sh = *(const f32x4*)(ms + jshift * 2048 + (j * 64 + lane) * 4);
                const f32x4 sc = *(const f32x4*)(ms + jscale * 2048 + (j * 64 + lane) * 4);
                const f32x4 gs = gp * (sc + 1.f);
#pragma unroll
                for (int rr = 0; rr < 2; ++rr) { const f32x4 hv = (x[rr][j] * (rr ? rs1 : rs0)) * gs + sh;
                    u32x2 w; w.x = cvt_pk_bf16(hv.x, hv.y); w.y = cvt_pk_bf16(hv.z, hv.w);
                    *(u32x2*)(H + (r0 + rr) * DM + (j * 64 + lane) * 4) = w; } }
        }
    }
    if (!lat_only) row_phase_ctx<XIN_BF, XOUT_BF>(xin_lat, xin_ctx, xout_lat, xout_ctx, XR, Y, g_post, g_pre, modL, jgate, jshift, jscale, H, has_y, make_h, false, gw, NGW, lane, YS, nsplit);
}

__device__ __forceinline__ void gla_prep_phase(bf16_t* P, bf16_t* QB, float* EB, const float* __restrict__ lbl, LAS unsigned char* lds, int wg, int G, int tid) {
    const int lane = tid & 63, w = __builtin_amdgcn_readfirstlane(tid >> 6);
    constexpr float L2E = 1.4426950408889634f;
    int par = 0;
    unsigned nq[8], nf[8], nb[8];
    if (wg < NB * NH * 132) { const int rb0 = wg % 132, bh0 = wg / 132; const size_t r0 = (size_t)(bh0 >> 4) * SB + rb0 * 64 + 8 * w; const int c0 = (bh0 & 15) * 128 + 2 * lane;
#pragma unroll
        for (int i = 0; i < 8; ++i) { const size_t ro = (r0 + i) * NHG + c0; nq[i] = __builtin_nontemporal_load((const unsigned*)(P + ro)); nf[i] = __builtin_nontemporal_load((const unsigned*)(P + ro + 2048)); nb[i] = __builtin_nontemporal_load((const unsigned*)(P + ro + 4096)); } }
    for (int item = wg; item < NB * NH * 132; item += G, par ^= 1) {
        LAS float* TOT = (LAS float*)lds + par * 2048;
        const int rb = item % 132, bh = item / 132, h = bh & 15, b = bh >> 4;
        float lb[2][2], oml[2][2];
#pragma unroll
        for (int d = 0; d < 2; ++d)
#pragma unroll
            for (int e = 0; e < 2; ++e) { const int ch = h * 128 + 2 * lane + e; const float l0 = lbl[(d * 2 + 0) * 2048 + ch], l1 = lbl[(d * 2 + 1) * 2048 + ch];
                lb[d][e] = __builtin_amdgcn_rcpf(1.f + __builtin_amdgcn_exp2f((l1 - l0) * L2E)); oml[d][e] = 1.f - lb[d][e]; }
        const size_t row0 = (size_t)b * SB + rb * 64 + 8 * w;
        const int col = h * 128 + 2 * lane;
        unsigned q2[8], ff[8], fb[8];
#pragma unroll
        for (int i = 0; i < 8; ++i) { q2[i] = nq[i]; ff[i] = nf[i]; fb[i] = nb[i]; }
        if (item + G < NB * NH * 132) {
            const int it2 = item + G, rb2 = it2 % 132, bh2 = it2 / 132;
            const size_t r2 = (size_t)(bh2 >> 4) * SB + rb2 * 64 + 8 * w; const int c2 = (bh2 & 15) * 128 + 2 * lane;
#pragma unroll
            for (int i = 0; i < 8; ++i) { const size_t ro = (r2 + i) * NHG + c2; nq[i] = __builtin_nontemporal_load((const unsigned*)(P + ro)); nf[i] = __builtin_nontemporal_load((const unsigned*)(P + ro + 2048)); nb[i] = __builtin_nontemporal_load((const unsigned*)(P + ro + 4096)); }
        }
        float blf[8][2], blb[8][2], kkf[8][2], kkb[8][2];
        { float r0 = 0.f, r1 = 0.f;
#pragma unroll
          for (int i = 0; i < 8; ++i) {
              { const float sg = __builtin_amdgcn_rcpf(1.f + __builtin_amdgcn_exp2f(bflo(ff[i]) * -L2E)); r0 += __builtin_amdgcn_logf(lb[0][0] + oml[0][0] * sg); blf[i][0] = r0; kkf[i][0] = oml[0][0] - oml[0][0] * sg; }
              { const float sg = __builtin_amdgcn_rcpf(1.f + __builtin_amdgcn_exp2f(bfhi(ff[i]) * -L2E)); r1 += __builtin_amdgcn_logf(lb[0][1] + oml[0][1] * sg); blf[i][1] = r1; kkf[i][1] = oml[0][1] - oml[0][1] * sg; }
          }
          *(LAS f32x2*)(TOT + w * 128 + 2 * lane) = (f32x2){r0, r1}; }
        { float r0 = 0.f, r1 = 0.f;
#pragma unroll
          for (int i = 7; i >= 0; --i) {
              { const float sg = __builtin_amdgcn_rcpf(1.f + __builtin_amdgcn_exp2f(bflo(fb[i]) * -L2E)); r0 += __builtin_amdgcn_logf(lb[1][0] + oml[1][0] * sg); blb[i][0] = r0; kkb[i][0] = oml[1][0] - oml[1][0] * sg; }
              { const float sg = __builtin_amdgcn_rcpf(1.f + __builtin_amdgcn_exp2f(bfhi(fb[i]) * -L2E)); r1 += __builtin_amdgcn_logf(lb[1][1] + oml[1][1] * sg); blb[i][1] = r1; kkb[i][1] = oml[1][1] - oml[1][1] * sg; }
          }
          *(LAS f32x2*)(TOT + 1024 + w * 128 + 2 * lane) = (f32x2){r0, r1}; }
        LBAR();
        float pf0 = 0.f, pf1 = 0.f, tf0 = 0.f, tf1 = 0.f, pb0 = 0.f, pb1 = 0.f, tb0 = 0.f, tb1 = 0.f;
#pragma unroll
        for (int g = 0; g < 8; ++g) { const f32x2 x = *(const LAS f32x2*)(TOT + g * 128 + 2 * lane), y = *(const LAS f32x2*)(TOT + 1024 + g * 128 + 2 * lane);
            tf0 += x.x; tf1 += x.y; tb0 += y.x; tb1 += y.y; if (g < w) { pf0 += x.x; pf1 += x.y; } if (g > w) { pb0 += y.x; pb1 += y.y; } }
#pragma unroll
        for (int i = 0; i < 8; ++i) {
            const float qs0 = bflo(q2[i]), qs1 = bfhi(q2[i]);
            const float s0 = qs0 * 0.08838834764831845f * __builtin_amdgcn_rcpf(1.f + __builtin_amdgcn_exp2f(qs0 * -L2E));
            const float s1 = qs1 * 0.08838834764831845f * __builtin_amdgcn_rcpf(1.f + __builtin_amdgcn_exp2f(qs1 * -L2E));
            const float df0 = pf0 + blf[i][0] - tf0, df1 = pf1 + blf[i][1] - tf1, db0 = pb0 + blb[i][0] - tb0, db1 = pb1 + blb[i][1] - tb1;
            const size_t ro = (row0 + i) * NHG + col;
            *(unsigned*)(P + ro) = cvt_pk_bf16(s0 * __builtin_amdgcn_exp2f(df0), s1 * __builtin_amdgcn_exp2f(df1));
            *(unsigned*)(P + ro + 2048) = cvt_pk_bf16(kkf[i][0] * __builtin_amdgcn_exp2f(-df0), kkf[i][1] * __builtin_amdgcn_exp2f(-df1));
            *(unsigned*)(P + ro + 4096) = cvt_pk_bf16(kkb[i][0] * __builtin_amdgcn_exp2f(-db0), kkb[i][1] * __builtin_amdgcn_exp2f(-db1));
            *(unsigned*)(QB + (row0 + i) * DM + col) = cvt_pk_bf16(s0 * __builtin_amdgcn_exp2f(db0), s1 * __builtin_amdgcn_exp2f(db1));
        }
        if (w == 0) {
            const int cb = rb < 4 ? 3 - rb : 135 - rb;
            *(f32x2*)(EB + ((size_t)((b * 16 + h) * 2 + 0) * 132 + rb) * 128 + 2 * lane) = (f32x2){__builtin_amdgcn_exp2f(tf0), __builtin_amdgcn_exp2f(tf1)};
            *(f32x2*)(EB + ((size_t)((b * 16 + h) * 2 + 1) * 132 + cb) * 128 + 2 * lane) = (f32x2){__builtin_amdgcn_exp2f(tb0), __builtin_amdgcn_exp2f(tb1)};
        }
    }
    __syncthreads();
}

__device__ __forceinline__ void gla_item(const bf16_t* __restrict__ P, const bf16_t* __restrict__ QS, int ldq, const float* __restrict__ EB, bf16_t* __restrict__ Od, LAS unsigned char* lds, int b, int h, int dir, int vs, int tid) {
    const int lane = tid & 63, w = __builtin_amdgcn_readfirstlane(tid >> 6), fr = lane & 15, fq = lane >> 4;
    constexpr int SETB = 66560;
    f32x4 S0 = {0.f, 0.f, 0.f, 0.f}, S1 = {0.f, 0.f, 0.f, 0.f};
    const int qrow = tid >> 4, colq = h * 128 + (tid & 15) * 8;
    const int kq = tid & 31, tg = tid >> 5, colf = 2048 * (1 + dir) + h * 128 + 4 * kq;
    const int colv = 3 * 2048 + h * 128 + vs * 32 + (tid & 7) * 4;
    const int tv = tid >> 3, base = b * SB, rofs = dir ? 63 : 0, rsign = dir ? -1 : 1;
    const float* ebp = EB + (size_t)((b * 16 + h) * 2 + dir) * 132 * 128 + 16 * w + 4 * fq;
    u32x4 q4[2][2]; u32x2 k2[2][4]; u32x2 vv[2]; f32x4 eb[2];
#define GLA_R0(c) (dir ? ((c) < 4 ? base + 192 - 64 * (c) : base + 8640 - 64 * (c)) : base + 64 * (c))
#define GLA_LOAD(u, c) do { const int R0n = GLA_R0(c); \
        _Pragma("unroll") for (int i = 0; i < 2; ++i) q4[u][i] = *(const u32x4*)(QS + (size_t)(R0n + rofs + rsign * (qrow + 32 * i)) * ldq + colq); \
        _Pragma("unroll") for (int i = 0; i < 4; ++i) k2[u][i] = *(const u32x2*)(P + (size_t)(R0n + rofs + rsign * (4 * tg + i)) * NHG + colf); \
        vv[u] = *(const u32x2*)(P + (size_t)(R0n + rofs + rsign * tv) * NHG + colv); eb[u] = *(const f32x4*)(ebp + (size_t)(c) * 128); __builtin_amdgcn_sched_barrier(0); } while (0)
    GLA_LOAD(0, 0); __builtin_amdgcn_sched_barrier(0); GLA_LOAD(1, 1); __builtin_amdgcn_sched_barrier(0);
    const int ti = w >> 1, vi = w & 1;
    for (int c0 = 0; c0 < 132; c0 += 2) {
#pragma unroll
      for (int u = 0; u < 2; ++u) {
        const int c = c0 + u;
        const int R0 = GLA_R0(c);
        LAS unsigned char* QD = lds + (u & 1) * SETB; LAS unsigned char* KD = QD + 17408; LAS unsigned char* KDT = QD + 34816; LAS unsigned char* VT = QD + 53248; LAS unsigned char* SDT = QD + 57856;
#pragma unroll
        for (int i = 0; i < 2; ++i) *(LAS u32x4*)(QD + (qrow + 32 * i) * 272 + (tid & 15) * 16) = q4[u][i];
#pragma unroll
        for (int i = 0; i < 4; ++i) *(LAS u32x2*)(KD + (4 * tg + i) * 272 + kq * 8) = k2[u][i];
        { const u32x2 r0 = k2[u][0], r1 = k2[u][1], r2 = k2[u][2], r3 = k2[u][3];
          *(LAS u32x2*)(KDT + (4 * kq + 0) * 144 + tg * 8) = (u32x2){(r0.x & 0xffffu) | (r1.x << 16), (r2.x & 0xffffu) | (r3.x << 16)};
          *(LAS u32x2*)(KDT + (4 * kq + 1) * 144 + tg * 8) = (u32x2){(r0.x >> 16) | (r1.x & 0xffff0000u), (r2.x >> 16) | (r3.x & 0xffff0000u)};
          *(LAS u32x2*)(KDT + (4 * kq + 2) * 144 + tg * 8) = (u32x2){(r0.y & 0xffffu) | (r1.y << 16), (r2.y & 0xffffu) | (r3.y << 16)};
          *(LAS u32x2*)(KDT + (4 * kq + 3) * 144 + tg * 8) = (u32x2){(r0.y >> 16) | (r1.y & 0xffff0000u), (r2.y >> 16) | (r3.y & 0xffff0000u)}; }
        { LAS bf16_t* vt = (LAS bf16_t*)VT; const int v4 = (tid & 7) * 4;
          vt[(v4 + 0) * 72 + tv] = (bf16_t)(vv[u].x & 0xffffu); vt[(v4 + 1) * 72 + tv] = (bf16_t)(vv[u].x >> 16);
          vt[(v4 + 2) * 72 + tv] = (bf16_t)(vv[u].y & 0xffffu); vt[(v4 + 3) * 72 + tv] = (bf16_t)(vv[u].y >> 16); }
        S0 *= eb[u]; S1 *= eb[u];
        *(LAS u32x2*)(SDT + fr * 272 + (16 * w + 4 * fq) * 2) = (u32x2){cvt_pk_bf16(S0.x, S0.y), cvt_pk_bf16(S0.z, S0.w)};
        *(LAS u32x2*)(SDT + (16 + fr) * 272 + (16 * w + 4 * fq) * 2) = (u32x2){cvt_pk_bf16(S1.x, S1.y), cvt_pk_bf16(S1.z, S1.w)};
        { const int cn = (c + 2 < 132) ? c + 2 : 131; GLA_LOAD(u, cn); }
        LBAR();
        { bf16x8 bq[4], ak[4][4], as_[4], kt[2], vb0[2], vb1[2]; s16x4 av[4];
#pragma unroll
          for (int ks = 0; ks < 4; ++ks) bq[ks] = *(const LAS bf16x8*)(QD + (16 * ti + fr) * 272 + (ks * 32 + fq * 8) * 2);
#pragma unroll
          for (int si = 0; si < 4; ++si) if (si <= ti) {
#pragma unroll
              for (int ks = 0; ks < 4; ++ks) ak[si][ks] = *(const LAS bf16x8*)(KD + (16 * si + fr) * 272 + (ks * 32 + fq * 8) * 2);
              av[si] = *(const LAS s16x4*)(VT + (16 * vi + fr) * 144 + (16 * si + 4 * fq) * 2); }
#pragma unroll
          for (int ks = 0; ks < 4; ++ks) as_[ks] = *(const LAS bf16x8*)(SDT + (16 * vi + fr) * 272 + (ks * 32 + fq * 8) * 2);
#pragma unroll
          for (int ks = 0; ks < 2; ++ks) { kt[ks] = *(const LAS bf16x8*)(KDT + (16 * w + fr) * 144 + (ks * 32 + fq * 8) * 2);
              vb0[ks] = *(const LAS bf16x8*)(VT + fr * 144 + (ks * 32 + fq * 8) * 2); vb1[ks] = *(const LAS bf16x8*)(VT + (16 + fr) * 144 + (ks * 32 + fq * 8) * 2); }
          f32x4 o = {0.f, 0.f, 0.f, 0.f};
#pragma unroll
          for (int ks = 0; ks < 4; ++ks) o = __builtin_amdgcn_mfma_f32_16x16x32_bf16(as_[ks], bq[ks], o, 0, 0, 0);
#pragma unroll
          for (int si = 0; si < 4; ++si) if (si <= ti) {
              f32x4 acc = {0.f, 0.f, 0.f, 0.f};
#pragma unroll
              for (int ks = 0; ks < 4; ++ks) acc = __builtin_amdgcn_mfma_f32_16x16x32_bf16(ak[si][ks], bq[ks], acc, 0, 0, 0);
              if (si == ti) {
#pragma unroll
                  for (int j = 0; j < 4; ++j) if (4 * fq + j > fr) acc[j] = 0.f;
              }
              const u32x2 pk = {cvt_pk_bf16(acc.x, acc.y), cvt_pk_bf16(acc.z, acc.w)};
              o = __builtin_amdgcn_mfma_f32_16x16x16bf16_1k(av[si], __builtin_bit_cast(s16x4, pk), o, 0, 0, 0);
          }
#pragma unroll
          for (int ks = 0; ks < 2; ++ks) { S0 = __builtin_amdgcn_mfma_f32_16x16x32_bf16(kt[ks], vb0[ks], S0, 0, 0, 0); S1 = __builtin_amdgcn_mfma_f32_16x16x32_bf16(kt[ks], vb1[ks], S1, 0, 0, 0); }
          const size_t ro = (size_t)(R0 + rofs + rsign * (16 * ti + fr)) * DM;
          *(u32x2*)(Od + ro + h * 128 + vs * 32 + 16 * vi + 4 * fq) = (u32x2){cvt_pk_bf16(o.x, o.y), cvt_pk_bf16(o.z, o.w)}; }
      }
    }
#undef GLA_LOAD
#undef GLA_R0
    __syncthreads();
}

__device__ __forceinline__ void readout_phase(const bf16_t* Ofw, const bf16_t* Obw, const bf16_t* P, const float* o_gain, bf16_t* R, int gw, int NGW, int lane) {
    const int cl = (8 * lane) & 127;
    const f32x4 g0 = *(const f32x4*)(o_gain + cl), g1 = *(const f32x4*)(o_gain + cl + 4);
    const float gn[8] = {g0.x, g0.y, g0.z, g0.w, g1.x, g1.y, g1.z, g1.w};
    for (int it0 = gw * 4; it0 < MR * 4; it0 += NGW * 4) {
        u32x4 a[4], bq[4], g[4];
#pragma unroll
        for (int u = 0; u < 4; ++u) { const int it = it0 + u, r = it >> 2, c0 = (it & 3) * 512 + 8 * lane;
            a[u] = __builtin_nontemporal_load((const u32x4*)(Ofw + (size_t)r * DM + c0)); bq[u] = __builtin_nontemporal_load((const u32x4*)(Obw + (size_t)r * DM + c0)); g[u] = __builtin_nontemporal_load((const u32x4*)(P + (size_t)r * NHG + 4 * DM + c0)); }
#pragma unroll
        for (int u = 0; u < 4; ++u) { const int it = it0 + u, r = it >> 2, c0 = (it & 3) * 512 + 8 * lane;
            float o[8];
            o[0] = bflo(a[u].x) + bflo(bq[u].x); o[1] = bfhi(a[u].x) + bfhi(bq[u].x); o[2] = bflo(a[u].y) + bflo(bq[u].y); o[3] = bfhi(a[u].y) + bfhi(bq[u].y);
            o[4] = bflo(a[u].z) + bflo(bq[u].z); o[5] = bfhi(a[u].z) + bfhi(bq[u].z); o[6] = bflo(a[u].w) + bflo(bq[u].w); o[7] = bfhi(a[u].w) + bfhi(bq[u].w);
            float ss = 0.f;
#pragma unroll
            for (int e = 0; e < 8; ++e) ss += o[e] * o[e];
            ss += __shfl_xor(ss, 1); ss += __shfl_xor(ss, 2); ss += __shfl_xor(ss, 4); ss += __shfl_xor(ss, 8);
            const float rs = rsqrtf(ss * (1.f / 128.f) + EPS);
            const float gv[8] = {bflo(g[u].x), bfhi(g[u].x), bflo(g[u].y), bfhi(g[u].y), bflo(g[u].z), bfhi(g[u].z), bflo(g[u].w), bfhi(g[u].w)};
            float v[8];
#pragma unroll
            for (int e = 0; e < 8; ++e) v[e] = o[e] * rs * gn[e] * siluf(gv[e]);
            u32x4 wv; wv.x = cvt_pk_bf16(v[0], v[1]); wv.y = cvt_pk_bf16(v[2], v[3]); wv.z = cvt_pk_bf16(v[4], v[5]); wv.w = cvt_pk_bf16(v[6], v[7]);
            *(u32x4*)(R + (size_t)r * DM + c0) = wv; }
    }
}

__device__ __forceinline__ void conv_fix_phase(const float* BND, const float* cw, const float* cbias, bf16_t* ACT, bool lat_only, int gw, int NGW, int lane) {
    constexpr float L2E = 1.4426950408889634f;
    for (int it = gw; it < 66 * 2 * 11; it += NGW) {
        const int cbk = it % 11, rest = it / 11, which = rest & 1, pm = rest >> 1;
        if (lat_only && (pm == 0 || pm == 33)) continue;
        const int c0 = cbk * 512 + 8 * lane;
        const float* bn = BND + (size_t)pm * 6 * DFF + c0;
        f32x4 pv[2], cv[2], nv[2], uv[2]; size_t row;
        if (which == 0) {
            const bool seq_start = (pm == 0 || pm == 1 || pm == 33 || pm == 34);
#pragma unroll
            for (int hh = 0; hh < 2; ++hh) { pv[hh] = seq_start ? (f32x4){0.f, 0.f, 0.f, 0.f} : *(const f32x4*)(bn - 6 * DFF + 3 * DFF + 4 * hh);
                cv[hh] = *(const f32x4*)(bn + 4 * hh); nv[hh] = *(const f32x4*)(bn + DFF + 4 * hh); uv[hh] = *(const f32x4*)(bn + 4 * DFF + 4 * hh); }
            row = (size_t)pm * 256;
        } else {
            const bool seq_end = (pm == 0 || pm == 32 || pm == 33 || pm == 65);
#pragma unroll
            for (int hh = 0; hh < 2; ++hh) { pv[hh] = *(const f32x4*)(bn + 2 * DFF + 4 * hh); cv[hh] = *(const f32x4*)(bn + 3 * DFF + 4 * hh);
                nv[hh] = seq_end ? (f32x4){0.f, 0.f, 0.f, 0.f} : *(const f32x4*)(bn + 6 * DFF + 4 * hh); uv[hh] = *(const f32x4*)(bn + 5 * DFF + 4 * hh); }
            row = (size_t)pm * 256 + 255;
        }
        float v[8];
#pragma unroll
        for (int hh = 0; hh < 2; ++hh) {
            const f32x4 w0 = *(const f32x4*)(cw + c0 + 4 * hh), w1 = *(const f32x4*)(cw + DFF + c0 + 4 * hh), w2 = *(const f32x4*)(cw + 2 * DFF + c0 + 4 * hh), cb = *(const f32x4*)(cbias + c0 + 4 * hh);
#pragma unroll
            for (int j = 0; j < 4; ++j) { const float y = w0[j] * pv[hh][j] + w1[j] * cv[hh][j] + w2[j] * nv[hh][j] + cb[j];
                v[4 * hh + j] = y * __builtin_amdgcn_rcpf(1.f + __builtin_amdgcn_exp2f(y * -L2E)) * uv[hh][j]; }
        }
        u32x4 wv; wv.x = cvt_pk_bf16(v[0], v[1]); wv.y = cvt_pk_bf16(v[2], v[3]); wv.z = cvt_pk_bf16(v[4], v[5]); wv.w = cvt_pk_bf16(v[6], v[7]);
        *(u32x4*)(ACT + row * DFF + c0) = wv;
    }
}

__device__ __forceinline__ void qknorm_phase(bf16_t* QKV, const float* q_gain, const float* k_gain, int gw, int NGW, int lane) {
    const int cl = (8 * lane) & 127;
    for (int it = gw; it < MR * 5; it += NGW) {
        const int r = it / 5, grp = it - r * 5, p = r % SB;
        const bool lat = p >= CTX;
        if (!lat && grp < 4) continue;
        bf16_t* ptr = QKV + (size_t)r * NQKV + grp * 512 + 8 * lane;
        const float* gn = (grp < 4) ? q_gain : k_gain;
        const u32x4 a = *(const u32x4*)ptr;
        float x[8] = {bflo(a.x), bfhi(a.x), bflo(a.y), bfhi(a.y), bflo(a.z), bfhi(a.z), bflo(a.w), bfhi(a.w)};
        float ss = 0.f;
#pragma unroll
        for (int e = 0; e < 8; ++e) ss += x[e] * x[e];
        ss += __shfl_xor(ss, 1); ss += __shfl_xor(ss, 2); ss += __shfl_xor(ss, 4); ss += __shfl_xor(ss, 8);
        const float rs = rsqrtf(ss * (1.f / 128.f) + EPS);
#pragma unroll
        for (int e = 0; e < 8; ++e) x[e] = x[e] * rs * gn[cl + e];
        if (lat) {
            const int t = p - CTX; const float prow = (float)(t >> 6), pcol = (float)(t & 63);
#pragma unroll
            for (int e2 = 0; e2 < 4; ++e2) {
                const int i = (cl >> 1) + e2; const int fi = i & 31;
                const float invf = exp2f(-(float)fi * (13.287712379549449f / 32.f));
                const float ang = ((i >= 32) ? pcol : prow) * invf;
                float sn, cs; sincosf(ang, &sn, &cs);
                const float x1 = x[2 * e2], x2 = x[2 * e2 + 1];
                x[2 * e2] = x1 * cs - x2 * sn; x[2 * e2 + 1] = x1 * sn + x2 * cs;
            }
        }
        u32x4 wv; wv.x = cvt_pk_bf16(x[0], x[1]); wv.y = cvt_pk_bf16(x[2], x[3]); wv.z = cvt_pk_bf16(x[4], x[5]); wv.w = cvt_pk_bf16(x[6], x[7]);
        *(u32x4*)ptr = wv;
    }
}


#define XB_TMO      128
#define XB_XCNT(j)  (256  + 64 * (j))
#define XB_XSUB(j)  (1280 + 64 * (j))
#define XB_XGEN(j)  (2304 + 64 * (j))
#define XB_TOP      3328
#define XB_TOPGEN   3392
#define XCD_BAR_WORDS 3456
#define XB_SPIN_CAP (1u << 20)
__device__ __forceinline__ unsigned xb_ld(unsigned* p)              { return __hip_atomic_load(p, __ATOMIC_RELAXED, __HIP_MEMORY_SCOPE_AGENT); }
__device__ __forceinline__ unsigned xb_add(unsigned* p, unsigned v) { return __hip_atomic_fetch_add(p, v, __ATOMIC_RELAXED, __HIP_MEMORY_SCOPE_AGENT); }
__device__ __forceinline__ unsigned xb_xcc_id() { return (unsigned)__builtin_amdgcn_s_getreg((3 << 11) | 20) & 0xFu; }
#define XB_SPIN(cond, bar) do { unsigned _sp = 0; while (cond) { __builtin_amdgcn_s_sleep(1); \
    if ((++_sp & 255u) == 0u) { if (xb_ld(&(bar)[XB_TMO])) break; if (_sp > XB_SPIN_CAP) { atomicAdd(&(bar)[XB_TMO], 1u); break; } } } } while (0)
struct XcdBarrier { unsigned* bar; unsigned x; volatile LAS unsigned* st; };
__device__ __forceinline__ XcdBarrier xcd_barrier_post(unsigned* bar, volatile LAS unsigned* st) {
    XcdBarrier b; b.bar = bar; b.x = xb_xcc_id(); b.st = st;
    if (threadIdx.x == 0) (void)xb_add(&bar[XB_XCNT(b.x)], 1u);
    return b;
}
__device__ __forceinline__ void xcd_barrier_complete(unsigned* bar, unsigned x, unsigned& nloc, unsigned& nx) {
    const unsigned G = gridDim.x * gridDim.y * gridDim.z;
    unsigned sum, cnt, mine, sp = 0u;
    for (;;) {
        sum = 0u; cnt = 0u; mine = 0u;
#pragma unroll
        for (unsigned j = 0; j < 16; ++j) { const unsigned c = xb_ld(&bar[XB_XCNT(j)]); sum += c; cnt += (c > 0u) ? 1u : 0u; mine = (j == x) ? c : mine; }
        if (sum == G) break;
        __builtin_amdgcn_s_sleep(1);
        if ((++sp & 255u) == 0u) { if (xb_ld(&bar[XB_TMO])) break; if (sp > XB_SPIN_CAP) { atomicAdd(&bar[XB_TMO], 1u); break; } }
    }
    nloc = mine > 0u ? mine : 1u; nx = cnt > 0u ? cnt : 1u;
}
__device__ __forceinline__ void xcd_barrier(const XcdBarrier& b) {
    asm volatile("s_waitcnt vmcnt(0)" ::: "memory");
    __syncthreads();
    if (threadIdx.x == 0) {
        unsigned* bar = b.bar;
        __builtin_amdgcn_s_waitcnt(0);
        unsigned nloc = b.st[0], nx = b.st[1];
        if (nloc == 0u) { xcd_barrier_complete(bar, b.x, nloc, nx); b.st[0] = nloc; b.st[1] = nx; }
        const unsigned old = xb_add(&bar[XB_XSUB(b.x)], 1u);
        const unsigned gen = old / nloc;
        if (old + 1u == (gen + 1u) * nloc) {
            __builtin_amdgcn_fence(__ATOMIC_RELEASE, "agent");
            asm volatile("s_waitcnt vmcnt(0)" ::: "memory");
            const unsigned og = xb_add(&bar[XB_TOP], 1u);
            const unsigned tg = og / nx;
            if (og + 1u == (tg + 1u) * nx) xb_add(&bar[XB_TOPGEN], 1u);
            else XB_SPIN(xb_ld(&bar[XB_TOPGEN]) == tg, bar);
            __builtin_amdgcn_fence(__ATOMIC_ACQUIRE, "agent");
            xb_add(&bar[XB_XGEN(b.x)], 1u);
            asm volatile("s_waitcnt vmcnt(0)" ::: "memory");
        } else {
            XB_SPIN(xb_ld(&bar[XB_XGEN(b.x)]) == gen, bar);
            __builtin_amdgcn_fence(__ATOMIC_ACQUIRE, "agent");
            asm volatile("s_waitcnt vmcnt(0)" ::: "memory");
        }
    }
    __syncthreads();
}

struct KArgs { const float* in[22]; float* out; unsigned char* ws; int ph_lo, ph_hi; };
enum { I_X = 0, I_C, I_CTX, I_CCTX, I_ADAW, I_ADAB, I_NMPRE, I_NMPOST, I_NFPRE, I_NFPOST, I_HWIN, I_HLB, I_HONORM, I_HWOUT, I_AQKV, I_AQN, I_AKN, I_AWOUT, I_FWIN, I_FCW, I_FCB, I_FWOUT };
constexpr int N_PHASES = 20;

__global__ void __launch_bounds__(512, 2) mega_fwd(KArgs a) {
    extern __shared__ __attribute__((aligned(16))) unsigned char lds_raw[];
    LAS unsigned char* lds = (LAS unsigned char*)lds_raw;
    cg::grid_group grid = cg::this_grid();
    const int tid = threadIdx.x, lane = tid & 63, wave = __builtin_amdgcn_readfirstlane(tid >> 6);
    const int G = gridDim.x, wg = blockIdx.x;
    const int gw = wg * 8 + wave, NGW = G * 8;
    unsigned char* ws = a.ws;
    float* mod = (float*)(ws + WS_MOD);
    float* xctx = (float*)(ws + WS_XCTX);
    bf16_t* H = (bf16_t*)(ws + WS_H);
    bf16_t* BIG = (bf16_t*)(ws + WS_BIG);
    bf16_t* Y = (bf16_t*)(ws + WS_BIG);
    bf16_t* XR = (bf16_t*)(ws + WS_BIG + 256 * MiB);
    float* BND = (float*)(ws + WS_BIG + 200 * MiB);
    float* YS = (float*)(ws + WS_BIG + 132 * MiB);
    bf16_t* ACT = (bf16_t*)(ws + WS_ACT);
    bf16_t* OFW = ACT; bf16_t* OBW = ACT + (size_t)MR * DM;
    const int lo = a.ph_lo, hi = a.ph_hi;
#ifndef MK_REPMASK
#define MK_REPMASK 0u
#endif
#define PH(k) if (lo <= (k) && (k) < hi) for (int rep_ = 0; rep_ <= (int)((MK_REPMASK >> (k)) & 1u); ++rep_)
#define SEAM(k) do { if ((k) + 1 < hi) { if ((k) == 0) { asm volatile("s_waitcnt vmcnt(0) lgkmcnt(0)" ::: "memory"); grid.sync(); } else xcd_barrier(bar); } } while (0)
    LAS float* scr = (LAS float*)(lds + wave * 16384);
    volatile LAS unsigned* MISC = (volatile LAS unsigned*)(lds + LDS_BYTES - 256);
    if (tid < 16) MISC[tid] = 0u;
    __syncthreads();
    XcdBarrier bar = xcd_barrier_post((unsigned*)ws, MISC);

    PH(0) {
        ada_phase(a.in[I_C], a.in[I_CCTX], a.in[I_ADAW], a.in[I_ADAB], mod, lds, wg, G, tid);
        constexpr int I0 = 32 * (NHG / 32), I1 = 32 * (DM / 32), I2 = 32 * (2 * DFF / 32), I3 = (DFF / 64) * (DM / 32);
        for (int it = gw; it < I0 + I1 + I2 + I3; it += NGW) {
            int r = it;
            if (r < I0) { transpose_item(a.in[I_HWIN], DM, NHG, (bf16_t*)(ws + W_HIN), scr, r, lane); continue; } r -= I0;
            if (r < I1) { transpose_item(a.in[I_HWOUT], DM, DM, (bf16_t*)(ws + W_HOUT), scr, r, lane); continue; } r -= I1;
            if (r < I2) { transpose_item(a.in[I_FWIN], DM, 2 * DFF, (bf16_t*)(ws + W_FIN), scr, r, lane, true); continue; } r -= I2;
            transpose_item(a.in[I_FWOUT], DFF, DM, (bf16_t*)(ws + W_FOUT), scr, r, lane);
        }
        SEAM(0);
    }
    PH(1) {
        row_phase<false, false>(a.in[I_X], a.in[I_CTX], nullptr, nullptr, XR, nullptr, nullptr, a.in[I_NMPRE], mod, 0, 0, 1, H, false, true, false, gw, NGW, lane);
        SEAM(1);
    }
    PH(2) {
        pg8::Gemm g{H, (const bf16_t*)(ws + W_HIN), MR, NHG, DM}; pg8::Order S; S.init(MR / 256, NHG, DM, G, wg, 0, 0);
        pg8::EpiBf16 E{BIG, NHG};
        pg8::gemm_phase<pg8::EpiBf16, pg8::Order, true, true>(lds, g, S, E);
        SEAM(2);
    }
    PH(3) {
        float* EB = (float*)(ACT + (size_t)2 * MR * DM);
        if (rep_ == 0) gla_prep_phase(BIG, H, EB, a.in[I_HLB], lds, wg, G, tid);
        xcd_barrier(bar);
        for (int item = wg; item < 256; item += G) {
            const int xq = item & 7, yq = item >> 3, vs = yq & 3, sq = xq + 8 * (yq >> 2);
            const int dir = sq & 1, h = (sq >> 1) & 15, b = sq >> 5;
            gla_item(BIG, dir ? H : BIG, dir ? DM : NHG, EB, dir ? OBW : OFW, lds, b, h, dir, vs, tid);
        }
        SEAM(3);
    }
    PH(4) {
        readout_phase(OFW, OBW, BIG, a.in[I_HONORM], H, gw, NGW, lane);
        SEAM(4);
    }
    PH(5) {
        pg8::Gemm g{H, (const bf16_t*)(ws + W_HOUT), MR, DM, DM}; pg8::Order S; S.init(64, DM, DM, G, wg, 1, 16);
        pg8::EpiF32 E{Y, DM, YS, DM / 64};
        pg8::gemm_phase<pg8::EpiF32, pg8::Order, true, true>(lds, g, S, E);
        SEAM(5);
    }
    PH(6) {
        row_phase<false, true>(a.in[I_X], a.in[I_CTX], a.out, xctx, XR, Y, a.in[I_NMPOST], a.in[I_NFPRE], mod, 2, 3, 4, H, true, true, false, gw, NGW, lane, YS, 16);
        SEAM(6);
    }
    PH(7) {
        pg8::Gemm g{H, (const bf16_t*)(ws + W_FIN), MR, 2 * DFF, DM}; pg8::Order S; S.init(MR / 256, 2 * DFF, DM, G, wg, 0, 0);
        pg8::EpiConv E{ACT, a.in[I_FCW], a.in[I_FCB], BND, (LAS float*)(lds + 131072)};
        pg8::gemm_phase<pg8::EpiConv, pg8::Order, true, true>(lds, g, S, E);
        SEAM(7);
    }
    PH(8) {
        conv_fix_phase(BND, a.in[I_FCW], a.in[I_FCB], ACT, false, gw, NGW, lane);
        SEAM(8);
    }
    PH(9) {
        pg8::Gemm g{ACT, (const bf16_t*)(ws + W_FOUT), MR, DM, DFF}; pg8::Order S; S.init(64, DM, DFF, G, wg, 1, 11);
        pg8::EpiF32 E{Y, DM, YS, DFF / 64};
        pg8::gemm_phase<pg8::EpiF32, pg8::Order, true, true>(lds, g, S, E);
        SEAM(9);
    }
    PH(10) {
        row_phase<true, true>(a.out, xctx, a.out, xctx, XR, Y, a.in[I_NFPOST], a.in[I_NMPRE] + DM, mod, 5, 6 * 3 + 0, 6 * 3 + 1, H, true, true, false, gw, NGW, lane, YS, 11);
        __syncthreads();
        constexpr int I0 = 32 * (NQKV / 32), I1 = 32 * (DM / 32), I2 = 32 * (2 * DFF / 32), I3 = (DFF / 64) * (DM / 32);
        for (int it = gw; it < I0 + I1 + I2 + I3; it += NGW) {
            int r = it;
            if (r < I0) { transpose_item(a.in[I_AQKV], DM, NQKV, (bf16_t*)(ws + W_QKV), scr, r, lane); continue; } r -= I0;
            if (r < I1) { transpose_item(a.in[I_AWOUT], DM, DM, (bf16_t*)(ws + W_AOUT), scr, r, lane); continue; } r -= I1;
            if (r < I2) { transpose_item(a.in[I_FWIN] + (size_t)DM * 2 * DFF, DM, 2 * DFF, (bf16_t*)(ws + W_FIN), scr, r, lane, true); continue; } r -= I2;
            transpose_item(a.in[I_FWOUT] + (size_t)DFF * DM, DFF, DM, (bf16_t*)(ws + W_FOUT), scr, r, lane);
        }
        SEAM(10);
    }
    PH(11) {
        pg8::Gemm g{H, (const bf16_t*)(ws + W_QKV), MR, NQKV, DM}; pg8::Order S; S.init(MR / 256, NQKV, DM, G, wg, 0, 0);
        pg8::EpiBf16 E{BIG, NQKV};
        pg8::gemm_phase<pg8::EpiBf16, pg8::Order, true, true>(lds, g, S, E);
        SEAM(11);
    }
    PH(12) {
        qknorm_phase(BIG, a.in[I_AQN], a.in[I_AKN], gw, NGW, lane);
        SEAM(12);
    }
    PH(13) {
        for (int u = wg; u < 1024; u += G) {
            const int x = u & 7, rest = u >> 3, j = rest & 31, i = rest >> 5;
            const int b = x >> 2, kvh = x & 3, h = kvh * 4 + i;
            const size_t qrow = (size_t)b * SB + CTX + (size_t)j * 256;
            att::attn_dense_body(BIG + qrow * NQKV + h * 128, BIG + (size_t)b * SB * NQKV + 2048 + kvh * 128, BIG + (size_t)b * SB * NQKV + 2560 + kvh * 128,
                                 ACT + qrow * DM + h * 128, SB, (char*)lds_raw);
        }
        SEAM(13);
    }
    PH(14) {
        pg8::Gemm g{ACT, (const bf16_t*)(ws + W_AOUT), MR, DM, DM}; pg8::Order S; S.init(64, DM, DM, G, wg, 1, 0);
        pg8::EpiF32 E{Y, DM, nullptr, 0};
        pg8::gemm_phase<pg8::EpiF32, pg8::Order, true, true>(lds, g, S, E);
        SEAM(14);
    }
    PH(15) {
        row_phase<true, true>(a.out, xctx, a.out, xctx, XR, Y, a.in[I_NMPOST] + DM, a.in[I_NFPRE] + DM, mod + 3 * 12288, 2, 3, 4, H, true, true, true, gw, NGW, lane);
        SEAM(15);
    }
    PH(16) {
        pg8::Gemm g{H, (const bf16_t*)(ws + W_FIN), MR, 2 * DFF, DM}; pg8::Order S; S.init(64, 2 * DFF, DM, G, wg, 1, 0);
        pg8::EpiConv E{ACT, a.in[I_FCW] + 3 * DFF, a.in[I_FCB] + DFF, BND, (LAS float*)(lds + 131072)};
        pg8::gemm_phase<pg8::EpiConv, pg8::Order, true, true>(lds, g, S, E);
        SEAM(16);
    }
    PH(17) {
        conv_fix_phase(BND, a.in[I_FCW] + 3 * DFF, a.in[I_FCB] + DFF, ACT, true, gw, NGW, lane);
        SEAM(17);
    }
    PH(18) {
        pg8::Gemm g{ACT, (const bf16_t*)(ws + W_FOUT), MR, DM, DFF}; pg8::Order S; S.init(64, DM, DFF, G, wg, 1, 0);
        pg8::EpiF32 E{Y, DM, nullptr, 0};
        pg8::gemm_phase<pg8::EpiF32, pg8::Order, true, true>(lds, g, S, E);
        SEAM(18);
    }
    PH(19) {
        row_phase<true, false>(a.out, xctx, a.out, xctx, XR, Y, a.in[I_NFPOST] + DM, nullptr, mod + 3 * 12288, 5, 0, 0, H, true, false, true, gw, NGW, lane);
    }
#undef PH
#undef SEAM
}


extern "C" void kernel_launch(void* const* d_in, const int* in_sizes, int n_in, void* d_out, int out_size, void* d_ws, size_t ws_size, hipStream_t stream) {
    static int grid = 0;
    if (grid == 0) {
        if (n_in != 22 || ws_size < WS_END || out_size != NB * SEQ * DM) { fprintf(stderr, "kernel_launch: unexpected shapes n_in %d ws %zu out %d\n", n_in, ws_size, out_size); grid = -1; return; }
        int dev = 0, cus = 0, per_cu = 0;
        if (hipGetDevice(&dev) != hipSuccess || hipDeviceGetAttribute(&cus, hipDeviceAttributeMultiprocessorCount, dev) != hipSuccess) { grid = -1; return; }
        if (hipFuncSetAttribute((const void*)mega_fwd, hipFuncAttributeMaxDynamicSharedMemorySize, LDS_BYTES) != hipSuccess) { fprintf(stderr, "kernel_launch: hipFuncSetAttribute failed\n"); grid = -1; return; }
        if (hipOccupancyMaxActiveBlocksPerMultiprocessor(&per_cu, (const void*)mega_fwd, 512, LDS_BYTES) != hipSuccess || per_cu < 1) { fprintf(stderr, "kernel_launch: occupancy query says %d\n", per_cu); per_cu = 1; }
        (void)hipGetLastError();
        grid = cus * 1;
    }
    if (grid < 0) return;
    KArgs a{};
    for (int i = 0; i < 22; ++i) a.in[i] = (const float*)d_in[i];
    a.out = (float*)d_out; a.ws = (unsigned char*)d_ws;
    a.ph_lo = 0; a.ph_hi = N_PHASES;
    if (hipMemsetAsync(d_ws, 0, 16384, stream) != hipSuccess) { fprintf(stderr, "kernel_launch: memset failed\n"); return; }
    void* args[] = {&a};
    hipError_t e = hipLaunchCooperativeKernel((const void*)mega_fwd, dim3(grid), dim3(512), args, LDS_BYTES, stream);
    if (e != hipSuccess) fprintf(stderr, "cooperative launch failed: %s (grid %d)\n", hipGetErrorString(e), grid);
}
```

```cpp
#include <hip/hip_runtime.h>
#include <hip/hip_cooperative_groups.h>
#include <cstdio>
#include <cstdint>
namespace cg = cooperative_groups;

#define LAS __attribute__((address_space(3)))
typedef unsigned short bf16_t;
typedef short bf16x8 __attribute__((ext_vector_type(8)));
typedef float f32x4 __attribute__((ext_vector_type(4)));
typedef float f32x2 __attribute__((ext_vector_type(2)));
typedef float f32x16 __attribute__((ext_vector_type(16)));
typedef unsigned u32x4 __attribute__((ext_vector_type(4)));
typedef unsigned u32x2 __attribute__((ext_vector_type(2)));
typedef short s16x4 __attribute__((ext_vector_type(4)));

constexpr int DM = 2048, NB = 2, SEQ = 8192, CTX = 256, SB = SEQ + CTX, MR = NB * SB;
constexpr int NH = 16, HD = 128, NKV = 4, DFF = 5632, NQKV = 3072, NHG = 5 * DM;
constexpr float EPS = 1e-6f;

constexpr size_t MiB = 1u << 20;
constexpr size_t WS_MOD = 64 * 1024;
constexpr size_t WS_XCTX = 2 * MiB;
constexpr size_t WS_W = 6 * MiB;
constexpr size_t W_HIN = WS_W, W_HOUT = WS_W + 40 * MiB, W_FIN = WS_W + 48 * MiB, W_FOUT = WS_W + 92 * MiB;
constexpr size_t W_QKV = WS_W, W_AOUT = WS_W + 12 * MiB;
constexpr size_t WS_H = 120 * MiB;
constexpr size_t WS_BIG = 186 * MiB;
constexpr size_t WS_ACT = 549 * MiB;
constexpr size_t WS_END = WS_ACT + (size_t)MR * DFF * 2;
static_assert(WS_END <= 768 * MiB, "ws");

constexpr int LDS_BYTES = 147456;

typedef __bf16 bf16x2_t __attribute__((ext_vector_type(2)));
__device__ __forceinline__ unsigned cvt_pk_bf16(float lo, float hi) { f32x2 v = {lo, hi}; bf16x2_t b = __builtin_convertvector(v, bf16x2_t); return __builtin_bit_cast(unsigned, b); }
__device__ __forceinline__ unsigned f2bf(float f) { unsigned u = __builtin_bit_cast(unsigned, f); return (u + 0x7fffu + ((u >> 16) & 1u)) >> 16; }
__device__ __forceinline__ unsigned pk2(float lo, float hi) { return f2bf(lo) | (f2bf(hi) << 16); }
__device__ __forceinline__ float bflo(unsigned u) { return __builtin_bit_cast(float, u << 16); }
__device__ __forceinline__ float bfhi(unsigned u) { return __builtin_bit_cast(float, u & 0xffff0000u); }
__device__ __forceinline__ float wave_sum(float v) {
#pragma unroll
    for (int o = 1; o < 64; o <<= 1) v += __shfl_xor(v, o);
    return v;
}
__device__ __forceinline__ float siluf(float v) { return v / (1.f + __expf(-v)); }
#define LBAR() do { asm volatile("s_waitcnt lgkmcnt(0)" ::: "memory"); __builtin_amdgcn_s_barrier(); asm volatile("" ::: "memory"); } while (0)

namespace pg8 {
constexpr int BM = 256, BK = 64, HALF = 128, HTB = HALF * BK * 2, STAGE_BYTES = 8 * HTB, NXCD = 8, WGM = 4;
__host__ __device__ __forceinline__ int lds_byte(int r, int c) { const int st = (r >> 4) * 2 + (c >> 5), rr = r & 15, cc = c & 31, ob = rr * 64 + cc * 2; return st * 1024 + (ob ^ (((ob >> 9) & 1) << 5)); }
__host__ __device__ __forceinline__ void stage_rc(int b, int& R, int& C) { const int st = b / 1024, sb = b % 1024, swz = sb ^ (((sb >> 9) & 1) << 5); R = (st >> 1) * 16 + swz / 64; C = (st & 1) * 32 + (swz % 64) / 2; }
__host__ __device__ __forceinline__ int perm32(int rho) { const int n = rho >> 4, i = rho & 15; return 8 * (i >> 2) + 4 * n + (i & 3); }

struct Unit { int pm, pn, kn; };
struct Gemm { const bf16_t* A; const bf16_t* Bt; int M, N, K; };

struct Order {
    int nM, nN, nwg, G, c, skip, ntf, nsplit;
    __device__ void init(int nM_, int N, int K, int G_, int c_, int skip_, int nsplit_) { nM = nM_; nN = N / BM; nwg = nM * nN; G = G_; c = c_; skip = skip_; ntf = K / BK; nsplit = nsplit_; }
    __device__ bool next(int i, Unit& u) const {
        const long L = (long)i * G + c;
        if (L >= nwg) {
            const int j = (int)(L - nwg); if (j >= 2 * nN * nsplit) return false;
            const int sidx = j % nsplit, cu = j / nsplit, cr = cu / nN;
            const int ntu = ntf / nsplit; u.pm = cr ? 33 : 0; u.pn = cu % nN; u.kn = (sidx * ntu) | (ntu << 16); return true;
        }
        int wgid = (int)L; { const int q = nwg / NXCD, r = nwg % NXCD, xcd = wgid % NXCD, off = wgid / NXCD; wgid = (xcd < r ? xcd * (q + 1) : r * (q + 1) + (xcd - r) * q) + off; }
        const int nig = WGM * nN, gid = wgid / nig, fm = gid * WGM, gsz = (nM - fm) < WGM ? (nM - fm) : WGM;
        int pm = fm + ((wgid % nig) % gsz); u.pn = (wgid % nig) / gsz;
        if (skip) pm = pm + 1 + (pm >= 32 ? 1 : 0);
        u.pm = pm; u.kn = ntf << 16; return true;
    }
    __device__ __forceinline__ void a_ready(const Unit&) const {}
    __device__ __forceinline__ void done(const Unit&) const {}
};

struct EpiBf16 {
    static constexpr bool PERM = true, AFTER_DRAIN = false;
    bf16_t* O; int ldc;
    __device__ __forceinline__ void operator()(const f32x4 (&acc)[2][2][4][2], const Unit& u, int wr, int wc, int fr, int fq) const {
        const int row0 = u.pm * BM + wr * 64 + fr; const int col0 = u.pn * BM + wc * 32 + 8 * fq;
#pragma unroll
        for (int ai = 0; ai < 2; ++ai)
#pragma unroll
            for (int m = 0; m < 4; ++m) { bf16_t* rowp = O + (size_t)(row0 + ai * HALF + m * 16) * ldc + col0;
#pragma unroll
                for (int bj = 0; bj < 2; ++bj) { const f32x4 v0 = acc[ai][bj][m][0], v1 = acc[ai][bj][m][1];
                    u32x4 w; w.x = cvt_pk_bf16(v0[0], v0[1]); w.y = cvt_pk_bf16(v0[2], v0[3]); w.z = cvt_pk_bf16(v1[0], v1[1]); w.w = cvt_pk_bf16(v1[2], v1[3]);
                    *(u32x4*)(rowp + bj * HALF) = w; } }
    }
};
struct EpiF32 {
    static constexpr bool PERM = true, AFTER_DRAIN = false;
    bf16_t* O; int ldc; float* SL; int ntf;
    __device__ __forceinline__ void operator()(const f32x4 (&acc)[2][2][4][2], const Unit& u, int wr, int wc, int fr, int fq) const {
        const int ntu = u.kn >> 16, kt0 = u.kn & 0xffff;
        const int row0 = wr * 64 + fr; const int col0 = u.pn * BM + wc * 32 + 8 * fq;
        if (ntu < ntf) {
            float* basep = SL + ((size_t)(kt0 / ntu) * 512 + (u.pm == 33 ? 256 : 0)) * ldc;
#pragma unroll
            for (int ai = 0; ai < 2; ++ai)
#pragma unroll
                for (int m = 0; m < 4; ++m) { float* rowp = basep + (size_t)(row0 + ai * HALF + m * 16) * ldc + col0;
#pragma unroll
                    for (int bj = 0; bj < 2; ++bj) { *(f32x4*)(rowp + bj * HALF) = acc[ai][bj][m][0]; *(f32x4*)(rowp + bj * HALF + 4) = acc[ai][bj][m][1]; } }
        } else {
            bf16_t* basep = O + (size_t)u.pm * BM * ldc;
#pragma unroll
            for (int ai = 0; ai < 2; ++ai)
#pragma unroll
                for (int m = 0; m < 4; ++m) { bf16_t* rowp = basep + (size_t)(row0 + ai * HALF + m * 16) * ldc + col0;
#pragma unroll
                    for (int bj = 0; bj < 2; ++bj) { const f32x4 v0 = acc[ai][bj][m][0], v1 = acc[ai][bj][m][1];
                        u32x4 w; w.x = cvt_pk_bf16(v0[0], v0[1]); w.y = cvt_pk_bf16(v0[2], v0[3]); w.z = cvt_pk_bf16(v1[0], v1[1]); w.w = cvt_pk_bf16(v1[2], v1[3]);
                        *(u32x4*)(rowp + bj * HALF) = w; } }
        }
    }
};

template <int CTRL> __device__ __forceinline__ float dpp_upd(float oldv, float src) {
    return __builtin_bit_cast(float, __builtin_amdgcn_update_dpp(__builtin_bit_cast(int, oldv), __builtin_bit_cast(int, src), CTRL, 0xf, 0xf, false)); }
template <int M> __device__ __forceinline__ float conv_elem(float gp, float gc, float gn, float up, float hp, float hn, float w0, float w1, float w2, float cb) {
    const float X = (M == 0) ? hp : dpp_upd<0x121>(0.f, gp);
    const float prev = dpp_upd<0x111>(X, gc);
    const float Yv = (M == 3) ? hn : dpp_upd<0x12F>(0.f, gn);
    const float next = dpp_upd<0x101>(Yv, gc);
    const float y = w0 * prev + w1 * gc + w2 * next + cb;
    return y * __builtin_amdgcn_rcpf(1.f + __builtin_amdgcn_exp2f(y * -1.4426950408889634f)) * up;
}
template <int M> __device__ __forceinline__ f32x4 conv_group(const f32x4 GP, const f32x4 GC, const f32x4 GN, const f32x4 up, const f32x4 hp, const f32x4 hn, const f32x4 w0, const f32x4 w1, const f32x4 w2, const f32x4 cb) {
    f32x4 r;
    r.x = conv_elem<M>(GP.x, GC.x, GN.x, up.x, hp.x, hn.x, w0.x, w1.x, w2.x, cb.x);
    r.y = conv_elem<M>(GP.y, GC.y, GN.y, up.y, hp.y, hn.y, w0.y, w1.y, w2.y, cb.y);
    r.z = conv_elem<M>(GP.z, GC.z, GN.z, up.z, hp.z, hn.z, w0.z, w1.z, w2.z, cb.z);
    r.w = conv_elem<M>(GP.w, GC.w, GN.w, up.w, hp.w, hn.w, w0.w, w1.w, w2.w, cb.w);
    return r;
}
struct EpiConv {
    static constexpr bool PERM = true, AFTER_DRAIN = false;
    bf16_t* ACT; const float* cw; const float* cbias; float* BND; LAS float* xch;
    __device__ __forceinline__ void operator()(const f32x4 (&acc)[2][2][4][2], const Unit& u, int wr_, int wc_, int fr_, int fq_) const {
        int wr = wr_, wc = wc_, fr = fr_, fq = fq_;
        asm volatile("" : "+v"(fr), "+v"(fq), "+s"(wr), "+s"(wc));
        const int cl = wc * 32 + 8 * fq, f0 = u.pn * 128 + cl;
#pragma unroll
        for (int ai = 0; ai < 2; ++ai) { const int blk = 2 * ai + wr;
            if (fr == 0) { *(LAS f32x4*)(xch + (blk * 2 + 0) * 128 + cl) = acc[ai][0][0][0]; *(LAS f32x4*)(xch + (blk * 2 + 0) * 128 + cl + 4) = acc[ai][0][0][1]; }
            if (fr == 15) { *(LAS f32x4*)(xch + (blk * 2 + 1) * 128 + cl) = acc[ai][0][3][0]; *(LAS f32x4*)(xch + (blk * 2 + 1) * 128 + cl + 4) = acc[ai][0][3][1]; } }
        { float* bnd = BND + (size_t)u.pm * 6 * DFF + f0;
          if (wr == 0 && fr < 2) { *(f32x4*)(bnd + fr * DFF) = acc[0][0][0][0]; *(f32x4*)(bnd + fr * DFF + 4) = acc[0][0][0][1]; }
          asm volatile("" ::: "memory");
          if (wr == 0 && fr == 0) { *(f32x4*)(bnd + 4 * DFF) = acc[0][1][0][0]; *(f32x4*)(bnd + 4 * DFF + 4) = acc[0][1][0][1]; }
          asm volatile("" ::: "memory");
          if (wr == 1 && fr >= 14) { *(f32x4*)(bnd + (fr - 12) * DFF) = acc[1][0][3][0]; *(f32x4*)(bnd + (fr - 12) * DFF + 4) = acc[1][0][3][1]; }
          asm volatile("" ::: "memory");
          if (wr == 1 && fr == 15) { *(f32x4*)(bnd + 5 * DFF) = acc[1][1][3][0]; *(f32x4*)(bnd + 5 * DFF + 4) = acc[1][1][3][1]; }
        }
        LBAR(); __builtin_amdgcn_sched_barrier(0);
        const f32x4 w00 = *(const f32x4*)(cw + f0), w01 = *(const f32x4*)(cw + f0 + 4), w10 = *(const f32x4*)(cw + DFF + f0), w11 = *(const f32x4*)(cw + DFF + f0 + 4);
        const f32x4 w20 = *(const f32x4*)(cw + 2 * DFF + f0), w21 = *(const f32x4*)(cw + 2 * DFF + f0 + 4), cb0 = *(const f32x4*)(cbias + f0), cb1 = *(const f32x4*)(cbias + f0 + 4);
#pragma unroll
        for (int ai = 0; ai < 2; ++ai) { const int blk = 2 * ai + wr;
            f32x4 hp0 = {0.f, 0.f, 0.f, 0.f}, hp1 = hp0, hn0 = hp0, hn1 = hp0;
            if (blk > 0) { hp0 = *(const LAS f32x4*)(xch + ((blk - 1) * 2 + 1) * 128 + cl); hp1 = *(const LAS f32x4*)(xch + ((blk - 1) * 2 + 1) * 128 + cl + 4); }
            if (blk < 3) { hn0 = *(const LAS f32x4*)(xch + ((blk + 1) * 2 + 0) * 128 + cl); hn1 = *(const LAS f32x4*)(xch + ((blk + 1) * 2 + 0) * 128 + cl + 4); }
#define CONV_ROW(M, MP, MN) do { __builtin_amdgcn_sched_barrier(0); \
            const f32x4 v0 = conv_group<M>(acc[ai][0][MP][0], acc[ai][0][M][0], acc[ai][0][MN][0], acc[ai][1][M][0], hp0, hn0, w00, w10, w20, cb0); \
            const f32x4 v1 = conv_group<M>(acc[ai][0][MP][1], acc[ai][0][M][1], acc[ai][0][MN][1], acc[ai][1][M][1], hp1, hn1, w01, w11, w21, cb1); \
            const int rl = ai * HALF + wr * 64 + M * 16 + fr; \
            if (rl != 0 && rl != 255) { u32x4 w; w.x = cvt_pk_bf16(v0[0], v0[1]); w.y = cvt_pk_bf16(v0[2], v0[3]); w.z = cvt_pk_bf16(v1[0], v1[1]); w.w = cvt_pk_bf16(v1[2], v1[3]); \
                *(u32x4*)(ACT + (size_t)(u.pm * BM + rl) * DFF + f0) = w; } } while (0)
            CONV_ROW(0, 0, 1); CONV_ROW(1, 0, 2); CONV_ROW(2, 1, 3); CONV_ROW(3, 2, 3);
#undef CONV_ROW
            __builtin_amdgcn_sched_barrier(0);
        }
    }
};

template <class Epi, class Sched, bool ALIGN_EPI = false, bool SP2 = false>
__device__ __forceinline__ void gemm_phase(LAS unsigned char* lds, const Gemm g, const Sched& S, const Epi& E) {
    const int tid = threadIdx.x, wid = __builtin_amdgcn_readfirstlane(tid >> 6), lane = tid & 63, wr = wid >> 2, wc = wid & 3, fr = lane & 15, fq = lane >> 4;
    const int K = g.K;
    unsigned voffA[2], voffB[2];
#pragma unroll
    for (int i = 0; i < 2; ++i) { int R, C; stage_rc(tid * 16 + i * 8192, R, C); const int Rb = Epi::PERM ? ((R & ~31) + perm32(R & 31)) : R;
        voffA[i] = (unsigned)(R * K + C) * 2u; voffB[i] = (unsigned)(Rb * K + C) * 2u; }
    const size_t kstep = (size_t)(BK * 2);
    const size_t hstep = (size_t)HALF * K * 2;
    const size_t tstep = 2 * hstep;
    const unsigned ldsw = (unsigned)wid * 1024u;
    const int aoff = lds_byte(wr * 64 + fr, fq * 8), boff = lds_byte(wc * 32 + fr, fq * 8);
#define PG8_SA(b, h) (((b) * 2 + (h)) * HTB)
#define PG8_SB(b, h) ((4 + (b) * 2 + (h)) * HTB)
#define PG8_STAGE(bufoff, gbase, voff) do { _Pragma("unroll") for (int _i = 0; _i < 2; ++_i) \
        __builtin_amdgcn_global_load_lds((const unsigned*)((const char*)(gbase) + (voff)[_i]), (LAS unsigned*)(lds + (bufoff) + ldsw + _i * 8192), 16, 0, 0); } while (0)
#define PG8_LDA(dst, b, h) do { _Pragma("unroll") for (int m = 0; m < 4; ++m) _Pragma("unroll") for (int k = 0; k < 2; ++k) dst[m][k] = *(const LAS bf16x8*)(lds + PG8_SA(b, h) + aoff + m * 2048 + k * 1024); } while (0)
#define PG8_LDB(dst, b, h) do { _Pragma("unroll") for (int n = 0; n < 2; ++n) _Pragma("unroll") for (int k = 0; k < 2; ++k) dst[n][k] = *(const LAS bf16x8*)(lds + PG8_SB(b, h) + boff + n * 2048 + k * 1024); } while (0)
#define PG8_MMA(ai, bj, At, Bt) do { __builtin_amdgcn_s_setprio(1); _Pragma("unroll") for (int m = 0; m < 4; ++m) _Pragma("unroll") for (int n = 0; n < 2; ++n) _Pragma("unroll") for (int k = 0; k < 2; ++k) \
        acc[ai][bj][m][n] = __builtin_amdgcn_mfma_f32_16x16x32_bf16(Bt[n][k], At[m][k], acc[ai][bj][m][n], 0, 0, 0); __builtin_amdgcn_s_setprio(0); } while (0)
#define PG8_WAIT_V(n) asm volatile("s_waitcnt vmcnt(" #n ")" ::: "memory")
#define PG8_WAIT_L(n) asm volatile("s_waitcnt lgkmcnt(" #n ")" ::: "memory")
#define PG8_BAR __builtin_amdgcn_s_barrier()
#define PG8_SCHED __builtin_amdgcn_sched_barrier(0)
    Unit cur, nxt; int ui = 0;
    if (!S.next(0, cur)) return;
    f32x4 acc[2][2][4][2];
#pragma unroll
    for (int a = 0; a < 2; ++a)
#pragma unroll
        for (int b = 0; b < 2; ++b)
#pragma unroll
            for (int m = 0; m < 4; ++m)
#pragma unroll
                for (int n = 0; n < 2; ++n) acc[a][b][m][n] = (f32x4){0.f, 0.f, 0.f, 0.f};
    bf16x8 At[4][2], B0[2][2], B1[2][2];
    const char* cA = (const char*)g.A + (size_t)cur.pm * tstep + (size_t)(cur.kn & 0xffff) * kstep; const char* cB = (const char*)g.Bt + (size_t)cur.pn * tstep + (size_t)(cur.kn & 0xffff) * kstep;
    S.a_ready(cur);
    if constexpr (SP2) {
        PG8_STAGE(PG8_SB(0, 0), cB, voffB); PG8_STAGE(PG8_SB(0, 1), cB + hstep, voffB); PG8_STAGE(PG8_SA(0, 0), cA, voffA); PG8_STAGE(PG8_SA(0, 1), cA + hstep, voffA);
        if (wr == 1) PG8_BAR;
        PG8_WAIT_V(2); PG8_BAR;
        PG8_STAGE(PG8_SB(1, 0), cB + kstep, voffB); PG8_STAGE(PG8_SA(1, 0), cA + kstep, voffA); PG8_STAGE(PG8_SB(1, 1), cB + hstep + kstep, voffB);
        PG8_WAIT_V(6); PG8_BAR;
    } else {
        PG8_STAGE(PG8_SB(0, 0), cB, voffB); PG8_STAGE(PG8_SA(0, 0), cA, voffA); PG8_STAGE(PG8_SB(0, 1), cB + hstep, voffB); PG8_STAGE(PG8_SA(0, 1), cA + hstep, voffA);
        if (wr == 1) PG8_BAR;
        PG8_WAIT_V(4); PG8_BAR;
        PG8_STAGE(PG8_SB(1, 0), cB + kstep, voffB); PG8_STAGE(PG8_SA(1, 0), cA + kstep, voffA); PG8_STAGE(PG8_SB(1, 1), cB + hstep + kstep, voffB);
        PG8_WAIT_V(6); PG8_BAR;
    }
    for (;;) {
        const bool has_next = S.next(ui + 1, nxt);
        const char* nA = has_next ? (const char*)g.A + (size_t)nxt.pm * tstep + (size_t)(nxt.kn & 0xffff) * kstep : cA; const char* nB = has_next ? (const char*)g.Bt + (size_t)nxt.pn * tstep + (size_t)(nxt.kn & 0xffff) * kstep : cB;
        const int nt = cur.kn >> 16;
        for (int t = 0; t < nt; t += 2) {
            const bool last = (t == nt - 2);
            const char* a1 = cA + (size_t)(t + 1) * kstep;
            const char* a2 = last ? nA : cA + (size_t)(t + 2) * kstep; const char* b2 = last ? nB : cB + (size_t)(t + 2) * kstep;
            const char* a3 = a2 + kstep; const char* b3 = b2 + kstep;
            if (last && has_next) S.a_ready(nxt);
            if constexpr (SP2) {
            PG8_LDB(B0, 0, 0); PG8_LDB(B1, 0, 1); PG8_SCHED; PG8_LDA(At, 0, 0); PG8_STAGE(PG8_SA(1, 1), a1 + hstep, voffA);
            PG8_WAIT_V(8); PG8_WAIT_L(0); PG8_BAR; PG8_MMA(0, 0, At, B0); PG8_MMA(0, 1, At, B1); PG8_BAR; PG8_SCHED;
            PG8_LDA(At, 0, 1); PG8_STAGE(PG8_SB(0, 0), b2, voffB); PG8_STAGE(PG8_SB(0, 1), b2 + hstep, voffB); PG8_STAGE(PG8_SA(0, 0), a2, voffA);
            PG8_WAIT_V(8); PG8_WAIT_L(0); PG8_BAR; PG8_MMA(1, 0, At, B0); PG8_MMA(1, 1, At, B1); PG8_BAR; PG8_SCHED;
            PG8_LDB(B0, 1, 0); PG8_LDB(B1, 1, 1); PG8_SCHED; PG8_LDA(At, 1, 0); PG8_STAGE(PG8_SA(0, 1), a2 + hstep, voffA);
            PG8_WAIT_V(8); PG8_WAIT_L(0); PG8_BAR; PG8_MMA(0, 0, At, B0); PG8_MMA(0, 1, At, B1); PG8_BAR; PG8_SCHED;
            PG8_LDA(At, 1, 1); PG8_STAGE(PG8_SB(1, 0), b3, voffB); PG8_STAGE(PG8_SB(1, 1), b3 + hstep, voffB); PG8_STAGE(PG8_SA(1, 0), a3, voffA);
            PG8_WAIT_V(8); PG8_WAIT_L(0); PG8_BAR; PG8_MMA(1, 0, At, B0); PG8_MMA(1, 1, At, B1); PG8_BAR; PG8_SCHED;
            } else {
            PG8_LDB(B0, 0, 0); PG8_SCHED; PG8_LDA(At, 0, 0); PG8_STAGE(PG8_SA(1, 1), a1 + hstep, voffA);
            PG8_WAIT_L(8); PG8_BAR; PG8_WAIT_L(0); PG8_MMA(0, 0, At, B0); PG8_BAR; PG8_SCHED;
            PG8_LDB(B1, 0, 1); PG8_STAGE(PG8_SB(0, 0), b2, voffB);
            PG8_BAR; PG8_WAIT_L(0); PG8_MMA(0, 1, At, B1); PG8_BAR;
            PG8_LDA(At, 0, 1); PG8_STAGE(PG8_SA(0, 0), a2, voffA);
            PG8_BAR; PG8_WAIT_L(0); PG8_MMA(1, 0, At, B0); PG8_BAR; PG8_SCHED;
            PG8_STAGE(PG8_SB(0, 1), b2 + hstep, voffB);
            PG8_WAIT_V(6); PG8_BAR; PG8_MMA(1, 1, At, B1); PG8_BAR;
            PG8_LDB(B0, 1, 0); PG8_SCHED; PG8_LDA(At, 1, 0); PG8_STAGE(PG8_SA(0, 1), a2 + hstep, voffA);
            PG8_WAIT_L(8); PG8_BAR; PG8_WAIT_L(0); PG8_MMA(0, 0, At, B0); PG8_BAR; PG8_SCHED;
            PG8_LDB(B1, 1, 1); PG8_STAGE(PG8_SB(1, 0), b3, voffB);
            PG8_BAR; PG8_WAIT_L(0); PG8_MMA(0, 1, At, B1); PG8_BAR;
            PG8_LDA(At, 1, 1); PG8_STAGE(PG8_SA(1, 0), a3, voffA);
            PG8_BAR; PG8_WAIT_L(0); PG8_MMA(1, 0, At, B0); PG8_BAR; PG8_SCHED;
            PG8_STAGE(PG8_SB(1, 1), b3 + hstep, voffB);
            PG8_WAIT_V(6); PG8_BAR; PG8_MMA(1, 1, At, B1); PG8_BAR;
            }
        }
        if constexpr (ALIGN_EPI) { if (wr == 0) PG8_BAR; }
        if constexpr (!Epi::AFTER_DRAIN) { E(acc, cur, wr, wc, fr, fq); S.done(cur); }
        if (!has_next) break;
#pragma unroll
        for (int a = 0; a < 2; ++a)
#pragma unroll
            for (int b = 0; b < 2; ++b)
#pragma unroll
                for (int m = 0; m < 4; ++m)
#pragma unroll
                    for (int n = 0; n < 2; ++n) acc[a][b][m][n] = (f32x4){0.f, 0.f, 0.f, 0.f};
        cur = nxt; cA = nA; cB = nB; ++ui;
        if constexpr (ALIGN_EPI) { if (wr == 1) PG8_BAR; }
    }
    PG8_WAIT_V(0);
    if constexpr (!ALIGN_EPI) { if (wr == 0) PG8_BAR; }
    PG8_BAR;
#undef PG8_SA
#undef PG8_SB
#undef PG8_STAGE
#undef PG8_LDA
#undef PG8_LDB
#undef PG8_MMA
#undef PG8_WAIT_V
#undef PG8_WAIT_L
#undef PG8_BAR
#undef PG8_SCHED
}
}

namespace att {
constexpr int D = 128, NW = 8, QBLK = 32, KVBLK = 64;
constexpr float SCALE = 0.088388347648318440f;
constexpr float THR = 8.f;
constexpr int LDQ = NQKV, LDK = NQKV, LDO = DM;
constexpr size_t SHM_V = KVBLK * D * 2, SHM_K = KVBLK * D * 2, SHM_ATTN = 2 * SHM_V + 2 * SHM_K + NW * 64 * 4;
#define KSWZ(row, colB) ((row) * 256 + ((colB) ^ (((row) & 7) << 4)))
#define SBAR() __builtin_amdgcn_sched_barrier(0)
__device__ __forceinline__ int crow(int r, int hi) { return (r & 3) + 8 * (r >> 2) + 4 * hi; }
__device__ __forceinline__ unsigned cvtpk(float lo, float hi) { unsigned r; asm volatile("v_cvt_pk_bf16_f32 %0, %1, %2" : "=v"(r) : "v"(lo), "v"(hi)); return r; }
__device__ __forceinline__ bf16x8 ld8(const bf16_t* p) { return *reinterpret_cast<const bf16x8*>(p); }

__device__ __forceinline__ void partialSM(f32x16& p0, f32x16& p1, float& m_reg, float& mn, float& alpha) {
  constexpr float C = SCALE * 1.4426950408889634f;
  float pmax = p0[0];
#pragma unroll
  for (int r = 1; r < 16; ++r) pmax = fmaxf(pmax, p0[r]);
#pragma unroll
  for (int r = 0; r < 16; ++r) pmax = fmaxf(pmax, p1[r]);
  { auto rr = __builtin_amdgcn_permlane32_swap(__float_as_uint(pmax), __float_as_uint(pmax), false, false);
    pmax = fmaxf(__uint_as_float(rr[0]), __uint_as_float(rr[1])); }
  if (__builtin_expect(__all(pmax - m_reg <= THR / SCALE), 1)) { mn = m_reg; alpha = 1.f; }
  else { mn = fmaxf(m_reg, pmax); alpha = __builtin_amdgcn_exp2f((m_reg - mn) * C); m_reg = mn; }
  float mnC = -mn * C;
#pragma unroll
  for (int r = 0; r < 16; ++r) p0[r] = fmaf(p0[r], C, mnC);
#pragma unroll
  for (int r = 0; r < 16; ++r) p1[r] = fmaf(p1[r], C, mnC);
#pragma unroll
  for (int r = 0; r < 16; ++r) p0[r] = __builtin_amdgcn_exp2f(p0[r]);
}
__device__ __forceinline__ void finishSM(f32x16& p0, f32x16& p1, float alpha, float& l_reg, bf16x8& pa0, bf16x8& pa1, bf16x8& pa2, bf16x8& pa3) {
#pragma unroll
  for (int r = 0; r < 16; ++r) p1[r] = __builtin_amdgcn_exp2f(p1[r]);
  float ps = 0;
#pragma unroll
  for (int r = 0; r < 16; ++r) ps += p0[r];
#pragma unroll
  for (int r = 0; r < 16; ++r) ps += p1[r];
  { auto rr = __builtin_amdgcn_permlane32_swap(__float_as_uint(ps), __float_as_uint(ps), false, false);
    ps = __uint_as_float(rr[0]) + __uint_as_float(rr[1]); }
  l_reg = l_reg * alpha + ps;
#define PK4(P, BASE, OUT) do { unsigned a0 = cvtpk(P[BASE + 0], P[BASE + 1]), a1 = cvtpk(P[BASE + 2], P[BASE + 3]);   \
    unsigned b0 = cvtpk(P[BASE + 4], P[BASE + 5]), b1 = cvtpk(P[BASE + 6], P[BASE + 7]);                              \
    auto r0 = __builtin_amdgcn_permlane32_swap(a0, b0, false, false); auto r1 = __builtin_amdgcn_permlane32_swap(a1, b1, false, false); \
    u32x4 w = {r0[0], r1[0], r0[1], r1[1]}; OUT = *reinterpret_cast<bf16x8*>(&w); } while (0)
  PK4(p0, 0, pa0); PK4(p0, 8, pa1); PK4(p1, 0, pa2); PK4(p1, 8, pa3);
#undef PK4
}
__device__ __forceinline__ void qkt(f32x16& p0, f32x16& p1, const bf16_t* Ks, const bf16x8* qr, int r32, int hi) {
  p0 = f32x16{}; p1 = f32x16{};
#pragma unroll
  for (int d0 = 0; d0 < 8; ++d0) { int cb = (d0 * 16 + hi * 8) * 2;
    bf16x8 b0 = *reinterpret_cast<const bf16x8*>((const char*)Ks + KSWZ(r32, cb));
    bf16x8 b1 = *reinterpret_cast<const bf16x8*>((const char*)Ks + KSWZ(32 + r32, cb));
    p0 = __builtin_amdgcn_mfma_f32_32x32x16_bf16(b0, qr[d0], p0, 0, 0, 0);
    p1 = __builtin_amdgcn_mfma_f32_32x32x16_bf16(b1, qr[d0], p1, 0, 0, 0); }
}
__device__ __forceinline__ int v_st(int k, int c) { const int kk = (k & ~0xC) | ((k & 4) << 1) | ((k & 8) >> 1); return ((kk >> 3) * 4 + (c >> 5)) * 512 + ((kk & 7) * 32 + (c & 31)) * 2; }
__device__ __forceinline__ int v_rd_base(int lane) { return ((lane & 3) << 3) | (((lane >> 2) & 3) << 6) | (((lane >> 4) & 1) << 5) | (((lane >> 5) & 1) << 8); }
constexpr int v_rd_off(int d0, int ks, int half) { return d0 * 512 + ks * 4096 + half * 2048; }
template <int OFF> __device__ __forceinline__ s16x4 tr_read(int vb) {
  s16x4 r; asm volatile("ds_read_b64_tr_b16 %0, %1 offset:%2" : "=&v"(r) : "v"(vb), "i"(OFF) : "memory"); return r;
}
template <int D0> __device__ __forceinline__ void pv_one(f32x16& od, int vb, bf16x8 pa0, bf16x8 pa1, bf16x8 pa2, bf16x8 pa3) {
  const s16x4 l0 = tr_read<v_rd_off(D0, 0, 0)>(vb), h0 = tr_read<v_rd_off(D0, 0, 1)>(vb), l1 = tr_read<v_rd_off(D0, 1, 0)>(vb), h1 = tr_read<v_rd_off(D0, 1, 1)>(vb);
  const s16x4 l2 = tr_read<v_rd_off(D0, 2, 0)>(vb), h2 = tr_read<v_rd_off(D0, 2, 1)>(vb), l3 = tr_read<v_rd_off(D0, 3, 0)>(vb), h3 = tr_read<v_rd_off(D0, 3, 1)>(vb);
  asm volatile("s_waitcnt lgkmcnt(0)" ::: "memory"); SBAR();
#define PK(L, H) (bf16x8){L[0], L[1], L[2], L[3], H[0], H[1], H[2], H[3]}
  od = __builtin_amdgcn_mfma_f32_32x32x16_bf16(pa0, PK(l0, h0), od, 0, 0, 0);
  od = __builtin_amdgcn_mfma_f32_32x32x16_bf16(pa1, PK(l1, h1), od, 0, 0, 0);
  od = __builtin_amdgcn_mfma_f32_32x32x16_bf16(pa2, PK(l2, h2), od, 0, 0, 0);
  od = __builtin_amdgcn_mfma_f32_32x32x16_bf16(pa3, PK(l3, h3), od, 0, 0, 0);
#undef PK
}
__device__ __forceinline__ void pv_d0(f32x16* o, int vb, bf16x8 pa0, bf16x8 pa1, bf16x8 pa2, bf16x8 pa3) {
  pv_one<0>(o[0], vb, pa0, pa1, pa2, pa3); pv_one<1>(o[1], vb, pa0, pa1, pa2, pa3); pv_one<2>(o[2], vb, pa0, pa1, pa2, pa3); pv_one<3>(o[3], vb, pa0, pa1, pa2, pa3);
}

__device__ __forceinline__ void attn_dense_body(const bf16_t* __restrict__ Qb, const bf16_t* __restrict__ Kh, const bf16_t* __restrict__ Vh,
                                                bf16_t* __restrict__ Ob, int seq, char* lds) {
  const int tid = threadIdx.x, wid = tid >> 6, lane = tid & 63, r32 = lane & 31, hi = lane >> 5;
  bf16_t* V_lds = (bf16_t*)lds; bf16_t* K_lds = (bf16_t*)(lds + 2 * SHM_V);
  float* ws = (float*)(lds + 2 * SHM_V + 2 * SHM_K) + wid * 64; float* li_l = ws; float* al_l = ws + 32;
  float m_reg = -1e30f, l_reg = 0; f32x16 o[4] = {}; bf16x8 qr[8];
  const bf16_t* Qw = Qb + (long)(wid * QBLK + r32) * LDQ + hi * 8;
#pragma unroll
  for (int d0 = 0; d0 < 8; ++d0) qr[d0] = ld8(Qw + d0 * 16);
  const int sr = tid >> 4, sc = (tid & 15) * 8, vst0 = v_st(sr, sc), vst1 = v_st(32 + sr, sc);
  const int vb0 = (int)(uintptr_t)V_lds + v_rd_base(lane);
  struct { bf16x8 vs0, vs1, ks0, ks1; } sr_[2];
#define SLOAD(i, k0) do { sr_[i].vs0 = ld8(&Vh[(long)((k0) + sr) * LDK + sc]); sr_[i].vs1 = ld8(&Vh[(long)((k0) + 32 + sr) * LDK + sc]); \
    sr_[i].ks0 = ld8(&Kh[(long)((k0) + sr) * LDK + sc]); sr_[i].ks1 = ld8(&Kh[(long)((k0) + 32 + sr) * LDK + sc]); } while (0)
#define SWRITE(b, i) do { *(bf16x8*)((char*)V_lds + (b) * SHM_V + vst0) = sr_[i].vs0;          \
    *(bf16x8*)((char*)V_lds + (b) * SHM_V + vst1) = sr_[i].vs1; int kc = sc * 2;               \
    *(bf16x8*)((char*)K_lds + (b) * SHM_K + KSWZ(sr, kc)) = sr_[i].ks0;                       \
    *(bf16x8*)((char*)K_lds + (b) * SHM_K + KSWZ(32 + sr, kc)) = sr_[i].ks1; } while (0)
#define SWAIT() do { asm volatile("s_waitcnt vmcnt(4)" ::: "memory"); } while (0)
#define RESC(a) do { if (__any((a) < 1.f)) { if (hi == 0) al_l[r32] = (a); asm volatile("s_waitcnt lgkmcnt(0)" ::: "memory"); \
    _Pragma("unroll") for (int d = 0; d < 4; ++d) _Pragma("unroll") for (int r = 0; r < 16; ++r) o[d][r] *= al_l[crow(r, hi)]; } } while (0)
  f32x16 pA0, pA1, pB0, pB1; float mnA, mnB, alA, alB; bf16x8 pa0, pa1, pa2, pa3; const int NT = seq / KVBLK;
  constexpr int SE = 0, SO = 1;
  SLOAD(SE, 0); asm volatile("s_waitcnt vmcnt(0)" ::: "memory"); SWRITE(0, SE); __syncthreads();
  qkt(pA0, pA1, K_lds, qr, r32, hi); partialSM(pA0, pA1, m_reg, mnA, alA);
  SLOAD(SO, KVBLK); if (2 < NT) SLOAD(SE, 2 * KVBLK);
  SWAIT(); SWRITE(1, SO); __syncthreads();
  for (int j = 1; j + 1 < NT; j += 2) {
    SBAR(); qkt(pB0, pB1, (bf16_t*)((char*)K_lds + SHM_K), qr, r32, hi);
    finishSM(pA0, pA1, alA, l_reg, pa0, pa1, pa2, pa3); SBAR();
    SLOAD(SO, (j + 2) * KVBLK); SBAR();
    pv_d0(o, vb0, pa0, pa1, pa2, pa3); partialSM(pB0, pB1, m_reg, mnB, alB);
    __syncthreads(); SWAIT(); SWRITE(0, SE);
    RESC(alB); __syncthreads();
    SBAR(); qkt(pA0, pA1, K_lds, qr, r32, hi);
    finishSM(pB0, pB1, alB, l_reg, pa0, pa1, pa2, pa3); SBAR();
    if (j + 3 < NT) SLOAD(SE, (j + 3) * KVBLK); SBAR();
    pv_d0(o, vb0 + (int)SHM_V, pa0, pa1, pa2, pa3); partialSM(pA0, pA1, m_reg, mnA, alA);
    __syncthreads(); SWAIT(); SWRITE(1, SO);
    RESC(alA); __syncthreads();
  }
  SBAR(); qkt(pB0, pB1, (bf16_t*)((char*)K_lds + SHM_K), qr, r32, hi);
  finishSM(pA0, pA1, alA, l_reg, pa0, pa1, pa2, pa3); SBAR();
  pv_d0(o, vb0, pa0, pa1, pa2, pa3); partialSM(pB0, pB1, m_reg, mnB, alB);
  __syncthreads(); RESC(alB);
  finishSM(pB0, pB1, alB, l_reg, pa0, pa1, pa2, pa3); SBAR();
  pv_d0(o, vb0 + (int)SHM_V, pa0, pa1, pa2, pa3);
  if (hi == 0) li_l[r32] = l_reg; asm volatile("s_waitcnt lgkmcnt(0)" ::: "memory");
  float rli[16];
#pragma unroll
  for (int r = 0; r < 16; ++r) rli[r] = __builtin_amdgcn_rcpf(li_l[crow(r, hi)]);
  bf16_t* Ow = Ob + (long)(wid * QBLK) * LDO;
#pragma unroll
  for (int r = 0; r < 16; ++r) { int orow = crow(r, hi);
#pragma unroll
    for (int d0 = 0; d0 < 4; ++d0) Ow[(long)orow * LDO + d0 * 32 + r32] = (bf16_t)f2bf(o[d0][r] * rli[r]); }
  __syncthreads();
#undef SLOAD
#undef SWRITE
#undef SWAIT
#undef RESC
}
}

__device__ __forceinline__ void transpose_item(const float* W, int K, int N, bf16_t* WT, LAS float* scr, int item, int lane, bool ffn_remap = false) {
    const int nblk = N / 32, kb = item / nblk, nb = item % nblk, k0 = 64 * kb, n0 = 32 * nb;
    int n0o = n0; if (ffn_remap) { const int half = n0 >= DFF ? 1 : 0, f = n0 - half * DFF; n0o = (f >> 7) * 256 + half * 128 + (f & 127); }
#pragma unroll 8
    for (int i = 0; i < 32; ++i) { const int kk = 2 * i + (lane >> 5); scr[kk * 33 + (lane & 31)] = __builtin_nontemporal_load(W + (size_t)(k0 + kk) * N + n0 + (lane & 31)); }
    asm volatile("s_waitcnt lgkmcnt(0)" ::: "memory");
    const int c = lane & 7;
#pragma unroll
    for (int j = 0; j < 4; ++j) { const int n = (lane >> 3) + 8 * j; const LAS float* s = scr + (8 * c) * 33 + n;
        u32x4 o; o.x = pk2(s[0 * 33], s[1 * 33]); o.y = pk2(s[2 * 33], s[3 * 33]); o.z = pk2(s[4 * 33], s[5 * 33]); o.w = pk2(s[6 * 33], s[7 * 33]);
        *(u32x4*)(WT + (size_t)(n0o + n) * K + k0 + 8 * c) = o; }
    asm volatile("s_waitcnt lgkmcnt(0)" ::: "memory");
}

__device__ __forceinline__ void ada_phase(const float* c, const float* c_ctx, const float* ada_w, const float* ada_b, float* mod, LAS unsigned char* lds, int wg, int G, int tid) {
    LAS float* sv = (LAS float*)lds;
    LAS float* part = sv + 3 * 2048;
    for (int i = tid; i < 3 * 2048; i += 512) { const int s = i >> 11, k = i & 2047; const float v = (s == 0) ? c_ctx[k] : c[(s - 1) * 2048 + k]; sv[i] = siluf(v); }
    __syncthreads();
    const int wave = tid >> 6, lane = tid & 63;
    for (int item = wg; item < 192; item += G) {
        const int L = item / 96, n0 = (item % 96) * 128;
        const float* W = ada_w + (size_t)L * 2048 * 12288 + n0 + lane * 2;
        float a0x = 0, a0y = 0, a1x = 0, a1y = 0, a2x = 0, a2y = 0;
        const int k0 = wave * 256;
#pragma unroll 8
        for (int k = 0; k < 256; ++k) {
            const f32x2 w = __builtin_nontemporal_load((const f32x2*)(W + (size_t)(k0 + k) * 12288));
            const float s0 = sv[k0 + k], s1 = sv[2048 + k0 + k], s2 = sv[4096 + k0 + k];
            a0x += s0 * w.x; a0y += s0 * w.y; a1x += s1 * w.x; a1y += s1 * w.y; a2x += s2 * w.x; a2y += s2 * w.y;
        }
        part[(wave * 3 + 0) * 128 + lane * 2] = a0x; part[(wave * 3 + 0) * 128 + lane * 2 + 1] = a0y;
        part[(wave * 3 + 1) * 128 + lane * 2] = a1x; part[(wave * 3 + 1) * 128 + lane * 2 + 1] = a1y;
        part[(wave * 3 + 2) * 128 + lane * 2] = a2x; part[(wave * 3 + 2) * 128 + lane * 2 + 1] = a2y;
        __syncthreads();
        if (tid < 384) { const int s = tid >> 7, n = tid & 127; float acc = ada_b[L * 12288 + n0 + n];
#pragma unroll
            for (int w = 0; w < 8; ++w) acc += part[(w * 3 + s) * 128 + n];
            mod[(size_t)(L * 3 + s) * 12288 + n0 + n] = acc; }
        __syncthreads();
    }
}

template <bool XIN_BF, bool XOUT_BF>
__device__ __forceinline__ void row_phase_ctx(const float* xin_lat, const float* xin_ctx, float* xout_lat, float* xout_ctx, bf16_t* XR,
                                          const bf16_t* Y, const float* g_post, const float* g_pre, const float* modL, int jgate, int jshift, int jscale,
                                          bf16_t* H, bool has_y, bool make_h, bool lat_only, int gw, int NGW, int lane, const float* YS = nullptr, int nsplit = 0) {
    for (int cr = gw; cr < NB * CTX; cr += NGW) {
        const int b = cr / CTX, p = cr - b * CTX, r = b * SB + p; int s; const float* xi; float* xo; const bool ctxrow = p < CTX;
        size_t xrow;
        if (ctxrow) { if (lat_only) continue; s = 0; xrow = (size_t)(b * CTX + p) * DM; xi = xin_ctx + xrow; xo = xout_ctx + xrow; }
        else { s = 1 + b; xrow = (size_t)(b * SEQ + p - CTX) * DM; xi = xin_lat + xrow; xo = xout_lat + xrow; }
        const float* ms = modL + (size_t)s * 12288;
        f32x4 x[8];
#pragma unroll
        for (int j = 0; j < 8; ++j) {
            if (XIN_BF && !ctxrow) { const u32x2 xb = __builtin_nontemporal_load((const u32x2*)(XR + xrow + (j * 64 + lane) * 4)); x[j] = (f32x4){bflo(xb.x), bfhi(xb.x), bflo(xb.y), bfhi(xb.y)}; }
            else x[j] = XIN_BF ? *(const f32x4*)(xi + (j * 64 + lane) * 4) : __builtin_nontemporal_load((const f32x4*)(xi + (j * 64 + lane) * 4));
        }
        if (has_y) {
            f32x4 y[8]; float ss = 0.f;
#pragma unroll
            for (int j = 0; j < 8; ++j) {
                if (ctxrow && nsplit > 0) { f32x4 t = {0.f, 0.f, 0.f, 0.f};
                    for (int sp = 0; sp < nsplit; ++sp) t += *(const f32x4*)(YS + ((size_t)sp * 512 + b * CTX + p) * DM + (j * 64 + lane) * 4);
                    y[j] = t; }
                else { const u32x2 yb = __builtin_nontemporal_load((const u32x2*)(Y + (size_t)r * DM + (j * 64 + lane) * 4)); y[j] = (f32x4){bflo(yb.x), bfhi(yb.x), bflo(yb.y), bfhi(yb.y)}; }
                ss += (y[j].x * y[j].x + y[j].y * y[j].y) + (y[j].z * y[j].z + y[j].w * y[j].w); }
            const float rs = rsqrtf(wave_sum(ss) * (1.f / DM) + EPS);
#pragma unroll
            for (int j = 0; j < 8; ++j) { const f32x4 gp = *(const f32x4*)(g_post + (j * 64 + lane) * 4); const f32x4 gt = *(const f32x4*)(ms + jgate * 2048 + (j * 64 + lane) * 4);
                x[j] = x[j] + gt * (y[j] * rs * gp);
                if (XOUT_BF && !ctxrow) { u32x2 w; w.x = cvt_pk_bf16(x[j].x, x[j].y); w.y = cvt_pk_bf16(x[j].z, x[j].w); *(u32x2*)(XR + xrow + (j * 64 + lane) * 4) = w;
                    x[j] = (f32x4){bflo(w.x), bfhi(w.x), bflo(w.y), bfhi(w.y)}; }
                else *(f32x4*)(xo + (j * 64 + lane) * 4) = x[j]; }
        }
        if (make_h) {
            float ss = 0.f;
#pragma unroll
            for (int j = 0; j < 8; ++j) ss += (x[j].x * x[j].x + x[j].y * x[j].y) + (x[j].z * x[j].z + x[j].w * x[j].w);
            const float rs = rsqrtf(wave_sum(ss) * (1.f / DM) + EPS);
#pragma unroll
            for (int j = 0; j < 8; ++j) { const f32x4 gp = *(const f32x4*)(g_pre + (j * 64 + lane) * 4); const f32x4 sh = *(const f32x4*)(ms + jshift * 2048 + (j * 64 + lane) * 4);
                const f32x4 sc = *(const f32x4*)(ms + jscale * 2048 + (j * 64 + lane) * 4);
                const f32x4 hv = (x[j] * rs * gp) * (sc + 1.f) + sh;
                u32x2 w; w.x = cvt_pk_bf16(hv.x, hv.y); w.y = cvt_pk_bf16(hv.z, hv.w);
                *(u32x2*)(H + (size_t)r * DM + (j * 64 + lane) * 4) = w; }
        }
    }
}

template <bool XIN_BF, bool XOUT_BF>
__device__ __forceinline__ void row_phase(const float* xin_lat, const float* xin_ctx, float* xout_lat, float* xout_ctx, bf16_t* XR,
                                          const bf16_t* Y, const float* g_post, const float* g_pre, const float* modL, int jgate, int jshift, int jscale,
                                          bf16_t* H, bool has_y, bool make_h, bool lat_only, int gw, int NGW, int lane, const float* YS = nullptr, int nsplit = 0) {
    extern __shared__ __attribute__((aligned(16))) unsigned char lds_raw[];
    LAS float* pl = (LAS float*)lds_raw;
    for (int i = threadIdx.x; i < 2 * 2048; i += 512) { const int bb = i >> 11, c = i & 2047; const float* msf = modL + (size_t)(1 + bb) * 12288;
        if (has_y) pl[(0 * 2 + bb) * 2048 + c] = msf[jgate * 2048 + c] * g_post[c];
        if (make_h) pl[(1 * 2 + bb) * 2048 + c] = g_pre[c] * (1.f + msf[jscale * 2048 + c]); }
    __syncthreads();
    for (int q = gw; q < NB * SEQ / 2; q += NGW) {
        const int b = q / (SEQ / 2), t0 = 2 * (q - b * (SEQ / 2));
        const size_t r0 = (size_t)b * SB + CTX + t0, xrow = (size_t)(b * SEQ + t0) * DM;
        const float* ms = modL + (size_t)(1 + b) * 12288;
        f32x4 x[2][8], y[2][8];
#pragma unroll
        for (int rr = 0; rr < 2; ++rr)
#pragma unroll
            for (int j = 0; j < 8; ++j) {
                if (XIN_BF) { const u32x2 xb = __builtin_nontemporal_load((const u32x2*)(XR + xrow + rr * DM + (j * 64 + lane) * 4)); x[rr][j] = (f32x4){bflo(xb.x), bfhi(xb.x), bflo(xb.y), bfhi(xb.y)}; }
                else x[rr][j] = __builtin_nontemporal_load((const f32x4*)(xin_lat + xrow + rr * DM + (j * 64 + lane) * 4));
                if (has_y) { const u32x2 yb = __builtin_nontemporal_load((const u32x2*)(Y + (r0 + rr) * DM + (j * 64 + lane) * 4)); y[rr][j] = (f32x4){bflo(yb.x), bfhi(yb.x), bflo(yb.y), bfhi(yb.y)}; }
            }
        if (has_y) {
            float ss0 = 0.f, ss1 = 0.f;
#pragma unroll
            for (int j = 0; j < 8; ++j) { ss0 += (y[0][j].x * y[0][j].x + y[0][j].y * y[0][j].y) + (y[0][j].z * y[0][j].z + y[0][j].w * y[0][j].w);
                                          ss1 += (y[1][j].x * y[1][j].x + y[1][j].y * y[1][j].y) + (y[1][j].z * y[1][j].z + y[1][j].w * y[1][j].w); }
            const float rs0 = rsqrtf(wave_sum(ss0) * (1.f / DM) + EPS), rs1 = rsqrtf(wave_sum(ss1) * (1.f / DM) + EPS);
#pragma unroll
            for (int j = 0; j < 8; ++j) { const f32x4 gg = *(const LAS f32x4*)(pl + (0 * 2 + b) * 2048 + (j * 64 + lane) * 4);
#pragma unroll
                for (int rr = 0; rr < 2; ++rr) {
                    x[rr][j] = x[rr][j] + gg * (y[rr][j] * (rr ? rs1 : rs0));
                    if (XOUT_BF) { u32x2 w; w.x = cvt_pk_bf16(x[rr][j].x, x[rr][j].y); w.y = cvt_pk_bf16(x[rr][j].z, x[rr][j].w); *(u32x2*)(XR + xrow + rr * DM + (j * 64 + lane) * 4) = w;
                        x[rr][j] = (f32x4){bflo(w.x), bfhi(w.x), bflo(w.y), bfhi(w.y)}; }
                    else *(f32x4*)(xout_lat + xrow + rr * DM + (j * 64 + lane) * 4) = x[rr][j];
                }
                }
        }
        if (make_h) {
            float ss0 = 0.f, ss1 = 0.f;
#pragma unroll
            for (int j = 0; j < 8; ++j) { ss0 += (x[0][j].x * x[0][j].x + x[0][j].y * x[0][j].y) + (x[0][j].z * x[0][j].z + x[0][j].w * x[0][j].w);
                                          ss1 += (x[1][j].x * x[1][j].x + x[1][j].y * x[1][j].y) + (x[1][j].z * x[1][j].z + x[1][j].w * x[1][j].w); }
            const float rs0 = rsqrtf(wave_sum(ss0) * (1.f / DM) + EPS), rs1 = rsqrtf(wave_sum(ss1) * (1.f / DM) + EPS);
#pragma unroll
            for (int j = 0; j < 8; ++j) { const f32x4 sh = *(const f32x4*)(ms + jshift * 2048 + (j * 64 + lane) * 4);
                const f32x4 gs = *(const LAS f32x4*)(pl + (1 * 2 + b) * 2048 + (j * 64 + lane) * 4);
#pragma unroll
                for (int rr = 0; rr < 2; ++rr) { const f32x4 hv = (x[rr][j] * (rr ? rs1 : rs0)) * gs + sh;
                    u32x2 w; w.x = cvt_pk_bf16(hv.x, hv.y); w.y = cvt_pk_bf16(hv.z, hv.w);
                    *(u32x2*)(H + (r0 + rr) * DM + (j * 64 + lane) * 4) = w; } }
        }
    }
    if (!lat_only) row_phase_ctx<XIN_BF, XOUT_BF>(xin_lat, xin_ctx, xout_lat, xout_ctx, XR, Y, g_post, g_pre, modL, jgate, jshift, jscale, H, has_y, make_h, false, gw, NGW, lane, YS, nsplit);
}

__device__ __forceinline__ void gla_prep_phase(bf16_t* P, bf16_t* QB, float* EB, const float* __restrict__ lbl, LAS unsigned char* lds, int wg, int G, int tid) {
    const int lane = tid & 63, w = __builtin_amdgcn_readfirstlane(tid >> 6);
    constexpr float L2E = 1.4426950408889634f;
    int par = 0;
    unsigned nq[8], nf[8], nb[8];
    if (wg < NB * NH * 132) { const int rb0 = wg % 132, bh0 = wg / 132; const size_t r0 = (size_t)(bh0 >> 4) * SB + rb0 * 64 + 8 * w; const int c0 = (bh0 & 15) * 128 + 2 * lane;
#pragma unroll
        for (int i = 0; i < 8; ++i) { const size_t ro = (r0 + i) * NHG + c0; nq[i] = __builtin_nontemporal_load((const unsigned*)(P + ro)); nf[i] = __builtin_nontemporal_load((const unsigned*)(P + ro + 2048)); nb[i] = __builtin_nontemporal_load((const unsigned*)(P + ro + 4096)); } }
    for (int item = wg; item < NB * NH * 132; item += G, par ^= 1) {
        LAS float* TOT = (LAS float*)lds + par * 2048;
        const int rb = item % 132, bh = item / 132, h = bh & 15, b = bh >> 4;
        float lb[2][2], oml[2][2];
#pragma unroll
        for (int d = 0; d < 2; ++d)
#pragma unroll
            for (int e = 0; e < 2; ++e) { const int ch = h * 128 + 2 * lane + e; const float l0 = lbl[(d * 2 + 0) * 2048 + ch], l1 = lbl[(d * 2 + 1) * 2048 + ch];
                lb[d][e] = __builtin_amdgcn_rcpf(1.f + __builtin_amdgcn_exp2f((l1 - l0) * L2E)); oml[d][e] = 1.f - lb[d][e]; }
        const size_t row0 = (size_t)b * SB + rb * 64 + 8 * w;
        const int col = h * 128 + 2 * lane;
        unsigned q2[8], ff[8], fb[8];
#pragma unroll
        for (int i = 0; i < 8; ++i) { q2[i] = nq[i]; ff[i] = nf[i]; fb[i] = nb[i]; }
        if (item + G < NB * NH * 132) {
            const int it2 = item + G, rb2 = it2 % 132, bh2 = it2 / 132;
            const size_t r2 = (size_t)(bh2 >> 4) * SB + rb2 * 64 + 8 * w; const int c2 = (bh2 & 15) * 128 + 2 * lane;
#pragma unroll
            for (int i = 0; i < 8; ++i) { const size_t ro = (r2 + i) * NHG + c2; nq[i] = __builtin_nontemporal_load((const unsigned*)(P + ro)); nf[i] = __builtin_nontemporal_load((const unsigned*)(P + ro + 2048)); nb[i] = __builtin_nontemporal_load((const unsigned*)(P + ro + 4096)); }
        }
        float blf[8][2], blb[8][2], kkf[8][2], kkb[8][2];
        { float r0 = 0.f, r1 = 0.f;
#pragma unroll
          for (int i = 0; i < 8; ++i) {
              { const float sg = __builtin_amdgcn_rcpf(1.f + __builtin_amdgcn_exp2f(bflo(ff[i]) * -L2E)); r0 += __builtin_amdgcn_logf(lb[0][0] + oml[0][0] * sg); blf[i][0] = r0; kkf[i][0] = oml[0][0] - oml[0][0] * sg; }
              { const float sg = __builtin_amdgcn_rcpf(1.f + __builtin_amdgcn_exp2f(bfhi(ff[i]) * -L2E)); r1 += __builtin_amdgcn_logf(lb[0][1] + oml[0][1] * sg); blf[i][1] = r1; kkf[i][1] = oml[0][1] - oml[0][1] * sg; }
          }
          *(LAS f32x2*)(TOT + w * 128 + 2 * lane) = (f32x2){r0, r1}; }
        { float r0 = 0.f, r1 = 0.f;
#pragma unroll
          for (int i = 7; i >= 0; --i) {
              { const float sg = __builtin_amdgcn_rcpf(1.f + __builtin_amdgcn_exp2f(bflo(fb[i]) * -L2E)); r0 += __builtin_amdgcn_logf(lb[1][0] + oml[1][0] * sg); blb[i][0] = r0; kkb[i][0] = oml[1][0] - oml[1][0] * sg; }
              { const float sg = __builtin_amdgcn_rcpf(1.f + __builtin_amdgcn_exp2f(bfhi(fb[i]) * -L2E)); r1 += __builtin_amdgcn_logf(lb[1][1] + oml[1][1] * sg); blb[i][1] = r1; kkb[i][1] = oml[1][1] - oml[1][1] * sg; }
          }
          *(LAS f32x2*)(TOT + 1024 + w * 128 + 2 * lane) = (f32x2){r0, r1}; }
        LBAR();
        float pf0 = 0.f, pf1 = 0.f, tf0 = 0.f, tf1 = 0.f, pb0 = 0.f, pb1 = 0.f, tb0 = 0.f, tb1 = 0.f;
#pragma unroll
        for (int g = 0; g < 8; ++g) { const f32x2 x = *(const LAS f32x2*)(TOT + g * 128 + 2 * lane), y = *(const LAS f32x2*)(TOT + 1024 + g * 128 + 2 * lane);
            tf0 += x.x; tf1 += x.y; tb0 += y.x; tb1 += y.y; if (g < w) { pf0 += x.x; pf1 += x.y; } if (g > w) { pb0 += y.x; pb1 += y.y; } }
#pragma unroll
        for (int i = 0; i < 8; ++i) {
            const float qs0 = bflo(q2[i]), qs1 = bfhi(q2[i]);
            const float s0 = qs0 * 0.08838834764831845f * __builtin_amdgcn_rcpf(1.f + __builtin_amdgcn_exp2f(qs0 * -L2E));
            const float s1 = qs1 * 0.08838834764831845f * __builtin_amdgcn_rcpf(1.f + __builtin_amdgcn_exp2f(qs1 * -L2E));
            const float df0 = pf0 + blf[i][0] - tf0, df1 = pf1 + blf[i][1] - tf1, db0 = pb0 + blb[i][0] - tb0, db1 = pb1 + blb[i][1] - tb1;
            const size_t ro = (row0 + i) * NHG + col;
            *(unsigned*)(P + ro) = cvt_pk_bf16(s0 * __builtin_amdgcn_exp2f(df0), s1 * __builtin_amdgcn_exp2f(df1));
            *(unsigned*)(P + ro + 2048) = cvt_pk_bf16(kkf[i][0] * __builtin_amdgcn_exp2f(-df0), kkf[i][1] * __builtin_amdgcn_exp2f(-df1));
            *(unsigned*)(P + ro + 4096) = cvt_pk_bf16(kkb[i][0] * __builtin_amdgcn_exp2f(-db0), kkb[i][1] * __builtin_amdgcn_exp2f(-db1));
            *(unsigned*)(QB + (row0 + i) * DM + col) = cvt_pk_bf16(s0 * __builtin_amdgcn_exp2f(db0), s1 * __builtin_amdgcn_exp2f(db1));
        }
        if (w == 0) {
            const int cb = rb < 4 ? 3 - rb : 135 - rb;
            *(f32x2*)(EB + ((size_t)((b * 16 + h) * 2 + 0) * 132 + rb) * 128 + 2 * lane) = (f32x2){__builtin_amdgcn_exp2f(tf0), __builtin_amdgcn_exp2f(tf1)};
            *(f32x2*)(EB + ((size_t)((b * 16 + h) * 2 + 1) * 132 + cb) * 128 + 2 * lane) = (f32x2){__builtin_amdgcn_exp2f(tb0), __builtin_amdgcn_exp2f(tb1)};
        }
    }
    __syncthreads();
}

__device__ __forceinline__ void gla_item(const bf16_t* __restrict__ P, const bf16_t* __restrict__ QS, int ldq, const float* __restrict__ EB, bf16_t* __restrict__ Od, LAS unsigned char* lds, int b, int h, int dir, int vs, int tid) {
    const int lane = tid & 63, w = __builtin_amdgcn_readfirstlane(tid >> 6), fr = lane & 15, fq = lane >> 4;
    constexpr int SETB = 66560;
    f32x4 S0 = {0.f, 0.f, 0.f, 0.f}, S1 = {0.f, 0.f, 0.f, 0.f};
    const int qrow = tid >> 4, colq = h * 128 + (tid & 15) * 8;
    const int kq = tid & 31, tg = tid >> 5, colf = 2048 * (1 + dir) + h * 128 + 4 * kq;
    const int colv = 3 * 2048 + h * 128 + vs * 32 + (tid & 7) * 4;
    const int tv = tid >> 3, base = b * SB, rofs = dir ? 63 : 0, rsign = dir ? -1 : 1;
    const float* ebp = EB + (size_t)((b * 16 + h) * 2 + dir) * 132 * 128 + 16 * w + 4 * fq;
    u32x4 q4[2][2]; u32x2 k2[2][4]; u32x2 vv[2]; f32x4 eb[2];
#define GLA_R0(c) (dir ? ((c) < 4 ? base + 192 - 64 * (c) : base + 8640 - 64 * (c)) : base + 64 * (c))
#define GLA_LOAD(u, c) do { const int R0n = GLA_R0(c); \
        _Pragma("unroll") for (int i = 0; i < 2; ++i) q4[u][i] = *(const u32x4*)(QS + (size_t)(R0n + rofs + rsign * (qrow + 32 * i)) * ldq + colq); \
        _Pragma("unroll") for (int i = 0; i < 4; ++i) k2[u][i] = *(const u32x2*)(P + (size_t)(R0n + rofs + rsign * (4 * tg + i)) * NHG + colf); \
        vv[u] = *(const u32x2*)(P + (size_t)(R0n + rofs + rsign * tv) * NHG + colv); eb[u] = *(const f32x4*)(ebp + (size_t)(c) * 128); __builtin_amdgcn_sched_barrier(0); } while (0)
    GLA_LOAD(0, 0); __builtin_amdgcn_sched_barrier(0); GLA_LOAD(1, 1); __builtin_amdgcn_sched_barrier(0);
    const int ti = w >> 1, vi = w & 1;
    for (int c0 = 0; c0 < 132; c0 += 2) {
#pragma unroll
      for (int u = 0; u < 2; ++u) {
        const int c = c0 + u;
        const int R0 = GLA_R0(c);
        LAS unsigned char* QD = lds + (u & 1) * SETB; LAS unsigned char* KD = QD + 17408; LAS unsigned char* KDT = QD + 34816; LAS unsigned char* VT = QD + 53248; LAS unsigned char* SDT = QD + 57856;
#pragma unroll
        for (int i = 0; i < 2; ++i) *(LAS u32x4*)(QD + (qrow + 32 * i) * 272 + (tid & 15) * 16) = q4[u][i];
#pragma unroll
        for (int i = 0; i < 4; ++i) *(LAS u32x2*)(KD + (4 * tg + i) * 272 + kq * 8) = k2[u][i];
        { const u32x2 r0 = k2[u][0], r1 = k2[u][1], r2 = k2[u][2], r3 = k2[u][3];
          *(LAS u32x2*)(KDT + (4 * kq + 0) * 144 + tg * 8) = (u32x2){(r0.x & 0xffffu) | (r1.x << 16), (r2.x & 0xffffu) | (r3.x << 16)};
          *(LAS u32x2*)(KDT + (4 * kq + 1) * 144 + tg * 8) = (u32x2){(r0.x >> 16) | (r1.x & 0xffff0000u), (r2.x >> 16) | (r3.x & 0xffff0000u)};
          *(LAS u32x2*)(KDT + (4 * kq + 2) * 144 + tg * 8) = (u32x2){(r0.y & 0xffffu) | (r1.y << 16), (r2.y & 0xffffu) | (r3.y << 16)};
          *(LAS u32x2*)(KDT + (4 * kq + 3) * 144 + tg * 8) = (u32x2){(r0.y >> 16) | (r1.y & 0xffff0000u), (r2.y >> 16) | (r3.y & 0xffff0000u)}; }
        { LAS bf16_t* vt = (LAS bf16_t*)VT; const int v4 = (tid & 7) * 4;
          vt[(v4 + 0) * 72 + tv] = (bf16_t)(vv[u].x & 0xffffu); vt[(v4 + 1) * 72 + tv] = (bf16_t)(vv[u].x >> 16);
          vt[(v4 + 2) * 72 + tv] = (bf16_t)(vv[u].y & 0xffffu); vt[(v4 + 3) * 72 + tv] = (bf16_t)(vv[u].y >> 16); }
        S0 *= eb[u]; S1 *= eb[u];
        *(LAS u32x2*)(SDT + fr * 272 + (16 * w + 4 * fq) * 2) = (u32x2){cvt_pk_bf16(S0.x, S0.y), cvt_pk_bf16(S0.z, S0.w)};
        *(LAS u32x2*)(SDT + (16 + fr) * 272 + (16 * w + 4 * fq) * 2) = (u32x2){cvt_pk_bf16(S1.x, S1.y), cvt_pk_bf16(S1.z, S1.w)};
        { const int cn = (c + 2 < 132) ? c + 2 : 131; GLA_LOAD(u, cn); }
        LBAR();
        { bf16x8 bq[4], ak[4][4], as_[4], kt[2], vb0[2], vb1[2]; s16x4 av[4];
#pragma unroll
          for (int ks = 0; ks < 4; ++ks) bq[ks] = *(const LAS bf16x8*)(QD + (16 * ti + fr) * 272 + (ks * 32 + fq * 8) * 2);
#pragma unroll
          for (int si = 0; si < 4; ++si) if (si <= ti) {
#pragma unroll
              for (int ks = 0; ks < 4; ++ks) ak[si][ks] = *(const LAS bf16x8*)(KD + (16 * si + fr) * 272 + (ks * 32 + fq * 8) * 2);
              av[si] = *(const LAS s16x4*)(VT + (16 * vi + fr) * 144 + (16 * si + 4 * fq) * 2); }
#pragma unroll
          for (int ks = 0; ks < 4; ++ks) as_[ks] = *(const LAS bf16x8*)(SDT + (16 * vi + fr) * 272 + (ks * 32 + fq * 8) * 2);
#pragma unroll
          for (int ks = 0; ks < 2; ++ks) { kt[ks] = *(const LAS bf16x8*)(KDT + (16 * w + fr) * 144 + (ks * 32 + fq * 8) * 2);
              vb0[ks] = *(const LAS bf16x8*)(VT + fr * 144 + (ks * 32 + fq * 8) * 2); vb1[ks] = *(const LAS bf16x8*)(VT + (16 + fr) * 144 + (ks * 32 + fq * 8) * 2); }
          f32x4 o = {0.f, 0.f, 0.f, 0.f};
#pragma unroll
          for (int ks = 0; ks < 4; ++ks) o = __builtin_amdgcn_mfma_f32_16x16x32_bf16(as_[ks], bq[ks], o, 0, 0, 0);
#pragma unroll
          for (int si = 0; si < 4; ++si) if (si <= ti) {
              f32x4 acc = {0.f, 0.f, 0.f, 0.f};
#pragma unroll
              for (int ks = 0; ks < 4; ++ks) acc = __builtin_amdgcn_mfma_f32_16x16x32_bf16(ak[si][ks], bq[ks], acc, 0, 0, 0);
              if (si == ti) {
#pragma unroll
                  for (int j = 0; j < 4; ++j) if (4 * fq + j > fr) acc[j] = 0.f;
              }
              const u32x2 pk = {cvt_pk_bf16(acc.x, acc.y), cvt_pk_bf16(acc.z, acc.w)};
              o = __builtin_amdgcn_mfma_f32_16x16x16bf16_1k(av[si], __builtin_bit_cast(s16x4, pk), o, 0, 0, 0);
          }
#pragma unroll
          for (int ks = 0; ks < 2; ++ks) { S0 = __builtin_amdgcn_mfma_f32_16x16x32_bf16(kt[ks], vb0[ks], S0, 0, 0, 0); S1 = __builtin_amdgcn_mfma_f32_16x16x32_bf16(kt[ks], vb1[ks], S1, 0, 0, 0); }
          const size_t ro = (size_t)(R0 + rofs + rsign * (16 * ti + fr)) * DM;
          *(u32x2*)(Od + ro + h * 128 + vs * 32 + 16 * vi + 4 * fq) = (u32x2){cvt_pk_bf16(o.x, o.y), cvt_pk_bf16(o.z, o.w)}; }
      }
    }
#undef GLA_LOAD
#undef GLA_R0
    __syncthreads();
}

__device__ __forceinline__ void readout_phase(const bf16_t* Ofw, const bf16_t* Obw, const bf16_t* P, const float* o_gain, bf16_t* R, int gw, int NGW, int lane) {
    const int cl = (8 * lane) & 127;
    const f32x4 g0 = *(const f32x4*)(o_gain + cl), g1 = *(const f32x4*)(o_gain + cl + 4);
    const float gn[8] = {g0.x, g0.y, g0.z, g0.w, g1.x, g1.y, g1.z, g1.w};
    for (int it0 = gw * 4; it0 < MR * 4; it0 += NGW * 4) {
        u32x4 a[4], bq[4], g[4];
#pragma unroll
        for (int u = 0; u < 4; ++u) { const int it = it0 + u, r = it >> 2, c0 = (it & 3) * 512 + 8 * lane;
            a[u] = __builtin_nontemporal_load((const u32x4*)(Ofw + (size_t)r * DM + c0)); bq[u] = __builtin_nontemporal_load((const u32x4*)(Obw + (size_t)r * DM + c0)); g[u] = __builtin_nontemporal_load((const u32x4*)(P + (size_t)r * NHG + 4 * DM + c0)); }
#pragma unroll
        for (int u = 0; u < 4; ++u) { const int it = it0 + u, r = it >> 2, c0 = (it & 3) * 512 + 8 * lane;
            float o[8];
            o[0] = bflo(a[u].x) + bflo(bq[u].x); o[1] = bfhi(a[u].x) + bfhi(bq[u].x); o[2] = bflo(a[u].y) + bflo(bq[u].y); o[3] = bfhi(a[u].y) + bfhi(bq[u].y);
            o[4] = bflo(a[u].z) + bflo(bq[u].z); o[5] = bfhi(a[u].z) + bfhi(bq[u].z); o[6] = bflo(a[u].w) + bflo(bq[u].w); o[7] = bfhi(a[u].w) + bfhi(bq[u].w);
            float ss = 0.f;
#pragma unroll
            for (int e = 0; e < 8; ++e) ss += o[e] * o[e];
            ss += __shfl_xor(ss, 1); ss += __shfl_xor(ss, 2); ss += __shfl_xor(ss, 4); ss += __shfl_xor(ss, 8);
            const float rs = rsqrtf(ss * (1.f / 128.f) + EPS);
            const float gv[8] = {bflo(g[u].x), bfhi(g[u].x), bflo(g[u].y), bfhi(g[u].y), bflo(g[u].z), bfhi(g[u].z), bflo(g[u].w), bfhi(g[u].w)};
            float v[8];
#pragma unroll
            for (int e = 0; e < 8; ++e) v[e] = o[e] * rs * gn[e] * siluf(gv[e]);
            u32x4 wv; wv.x = cvt_pk_bf16(v[0], v[1]); wv.y = cvt_pk_bf16(v[2], v[3]); wv.z = cvt_pk_bf16(v[4], v[5]); wv.w = cvt_pk_bf16(v[6], v[7]);
            *(u32x4*)(R + (size_t)r * DM + c0) = wv; }
    }
}

__device__ __forceinline__ void conv_fix_phase(const float* BND, const float* cw, const float* cbias, bf16_t* ACT, bool lat_only, int gw, int NGW, int lane) {
    constexpr float L2E = 1.4426950408889634f;
    for (int it = gw; it < 66 * 2 * 11; it += NGW) {
        const int cbk = it % 11, rest = it / 11, which = rest & 1, pm = rest >> 1;
        if (lat_only && (pm == 0 || pm == 33)) continue;
        const int c0 = cbk * 512 + 8 * lane;
        const float* bn = BND + (size_t)pm * 6 * DFF + c0;
        f32x4 pv[2], cv[2], nv[2], uv[2]; size_t row;
        if (which == 0) {
            const bool seq_start = (pm == 0 || pm == 1 || pm == 33 || pm == 34);
#pragma unroll
            for (int hh = 0; hh < 2; ++hh) { pv[hh] = seq_start ? (f32x4){0.f, 0.f, 0.f, 0.f} : *(const f32x4*)(bn - 6 * DFF + 3 * DFF + 4 * hh);
                cv[hh] = *(const f32x4*)(bn + 4 * hh); nv[hh] = *(const f32x4*)(bn + DFF + 4 * hh); uv[hh] = *(const f32x4*)(bn + 4 * DFF + 4 * hh); }
            row = (size_t)pm * 256;
        } else {
            const bool seq_end = (pm == 0 || pm == 32 || pm == 33 || pm == 65);
#pragma unroll
            for (int hh = 0; hh < 2; ++hh) { pv[hh] = *(const f32x4*)(bn + 2 * DFF + 4 * hh); cv[hh] = *(const f32x4*)(bn + 3 * DFF + 4 * hh);
                nv[hh] = seq_end ? (f32x4){0.f, 0.f, 0.f, 0.f} : *(const f32x4*)(bn + 6 * DFF + 4 * hh); uv[hh] = *(const f32x4*)(bn + 5 * DFF + 4 * hh); }
            row = (size_t)pm * 256 + 255;
        }
        float v[8];
#pragma unroll
        for (int hh = 0; hh < 2; ++hh) {
            const f32x4 w0 = *(const f32x4*)(cw + c0 + 4 * hh), w1 = *(const f32x4*)(cw + DFF + c0 + 4 * hh), w2 = *(const f32x4*)(cw + 2 * DFF + c0 + 4 * hh), cb = *(const f32x4*)(cbias + c0 + 4 * hh);
#pragma unroll
            for (int j = 0; j < 4; ++j) { const float y = w0[j] * pv[hh][j] + w1[j] * cv[hh][j] + w2[j] * nv[hh][j] + cb[j];
                v[4 * hh + j] = y * __builtin_amdgcn_rcpf(1.f + __builtin_amdgcn_exp2f(y * -L2E)) * uv[hh][j]; }
        }
        u32x4 wv; wv.x = cvt_pk_bf16(v[0], v[1]); wv.y = cvt_pk_bf16(v[2], v[3]); wv.z = cvt_pk_bf16(v[4], v[5]); wv.w = cvt_pk_bf16(v[6], v[7]);
        *(u32x4*)(ACT + row * DFF + c0) = wv;
    }
}

__device__ __forceinline__ void qknorm_phase(bf16_t* QKV, const float* q_gain, const float* k_gain, int gw, int NGW, int lane) {
    const int cl = (8 * lane) & 127;
    for (int it = gw; it < MR * 5; it += NGW) {
        const int r = it / 5, grp = it - r * 5, p = r % SB;
        const bool lat = p >= CTX;
        if (!lat && grp < 4) continue;
        bf16_t* ptr = QKV + (size_t)r * NQKV + grp * 512 + 8 * lane;
        const float* gn = (grp < 4) ? q_gain : k_gain;
        const u32x4 a = *(const u32x4*)ptr;
        float x[8] = {bflo(a.x), bfhi(a.x), bflo(a.y), bfhi(a.y), bflo(a.z), bfhi(a.z), bflo(a.w), bfhi(a.w)};
        float ss = 0.f;
#pragma unroll
        for (int e = 0; e < 8; ++e) ss += x[e] * x[e];
        ss += __shfl_xor(ss, 1); ss += __shfl_xor(ss, 2); ss += __shfl_xor(ss, 4); ss += __shfl_xor(ss, 8);
        const float rs = rsqrtf(ss * (1.f / 128.f) + EPS);
#pragma unroll
        for (int e = 0; e < 8; ++e) x[e] = x[e] * rs * gn[cl + e];
        if (lat) {
            const int t = p - CTX; const float prow = (float)(t >> 6), pcol = (float)(t & 63);
#pragma unroll
            for (int e2 = 0; e2 < 4; ++e2) {
                const int i = (cl >> 1) + e2; const int fi = i & 31;
                const float invf = exp2f(-(float)fi * (13.287712379549449f / 32.f));
                const float ang = ((i >= 32) ? pcol : prow) * invf;
                float sn, cs; sincosf(ang, &sn, &cs);
                const float x1 = x[2 * e2], x2 = x[2 * e2 + 1];
                x[2 * e2] = x1 * cs - x2 * sn; x[2 * e2 + 1] = x1 * sn + x2 * cs;
            }
        }
        u32x4 wv; wv.x = cvt_pk_bf16(x[0], x[1]); wv.y = cvt_pk_bf16(x[2], x[3]); wv.z = cvt_pk_bf16(x[4], x[5]); wv.w = cvt_pk_bf16(x[6], x[7]);
        *(u32x4*)ptr = wv;
    }
}


#define XB_TMO      128
#define XB_XCNT(j)  (256  + 64 * (j))
#define XB_XSUB(j)  (1280 + 64 * (j))
#define XB_XGEN(j)  (2304 + 64 * (j))
#define XB_TOP      3328
#define XB_TOPGEN   3392
#define XCD_BAR_WORDS 3456
#define XB_SPIN_CAP (1u << 20)
__device__ __forceinline__ unsigned xb_ld(unsigned* p)              { return __hip_atomic_load(p, __ATOMIC_RELAXED, __HIP_MEMORY_SCOPE_AGENT); }
__device__ __forceinline__ unsigned xb_add(unsigned* p, unsigned v) { return __hip_atomic_fetch_add(p, v, __ATOMIC_RELAXED, __HIP_MEMORY_SCOPE_AGENT); }
__device__ __forceinline__ unsigned xb_xcc_id() { return (unsigned)__builtin_amdgcn_s_getreg((3 << 11) | 20) & 0xFu; }
#define XB_SPIN(cond, bar) do { unsigned _sp = 0; while (cond) { __builtin_amdgcn_s_sleep(1); \
    if ((++_sp & 255u) == 0u) { if (xb_ld(&(bar)[XB_TMO])) break; if (_sp > XB_SPIN_CAP) { atomicAdd(&(bar)[XB_TMO], 1u); break; } } } } while (0)
struct XcdBarrier { unsigned* bar; unsigned x; volatile LAS unsigned* st; };
__device__ __forceinline__ XcdBarrier xcd_barrier_post(unsigned* bar, volatile LAS unsigned* st) {
    XcdBarrier b; b.bar = bar; b.x = xb_xcc_id(); b.st = st;
    if (threadIdx.x == 0) (void)xb_add(&bar[XB_XCNT(b.x)], 1u);
    return b;
}
__device__ __forceinline__ void xcd_barrier_complete(unsigned* bar, unsigned x, unsigned& nloc, unsigned& nx) {
    const unsigned G = gridDim.x * gridDim.y * gridDim.z;
    unsigned sum, cnt, mine, sp = 0u;
    for (;;) {
        sum = 0u; cnt = 0u; mine = 0u;
#pragma unroll
        for (unsigned j = 0; j < 16; ++j) { const unsigned c = xb_ld(&bar[XB_XCNT(j)]); sum += c; cnt += (c > 0u) ? 1u : 0u; mine = (j == x) ? c : mine; }
        if (sum == G) break;
        __builtin_amdgcn_s_sleep(1);
        if ((++sp & 255u) == 0u) { if (xb_ld(&bar[XB_TMO])) break; if (sp > XB_SPIN_CAP) { atomicAdd(&bar[XB_TMO], 1u); break; } }
    }
    nloc = mine > 0u ? mine : 1u; nx = cnt > 0u ? cnt : 1u;
}
__device__ __forceinline__ void xcd_barrier(const XcdBarrier& b) {
    asm volatile("s_waitcnt vmcnt(0)" ::: "memory");
    __syncthreads();
    if (threadIdx.x == 0) {
        unsigned* bar = b.bar;
        __builtin_amdgcn_s_waitcnt(0);
        unsigned nloc = b.st[0], nx = b.st[1];
        if (nloc == 0u) { xcd_barrier_complete(bar, b.x, nloc, nx); b.st[0] = nloc; b.st[1] = nx; }
        const unsigned old = xb_add(&bar[XB_XSUB(b.x)], 1u);
        const unsigned gen = old / nloc;
        if (old + 1u == (gen + 1u) * nloc) {
            __builtin_amdgcn_fence(__ATOMIC_RELEASE, "agent");
            asm volatile("s_waitcnt vmcnt(0)" ::: "memory");
            const unsigned og = xb_add(&bar[XB_TOP], 1u);
            const unsigned tg = og / nx;
            if (og + 1u == (tg + 1u) * nx) xb_add(&bar[XB_TOPGEN], 1u);
            else XB_SPIN(xb_ld(&bar[XB_TOPGEN]) == tg, bar);
            __builtin_amdgcn_fence(__ATOMIC_ACQUIRE, "agent");
            xb_add(&bar[XB_XGEN(b.x)], 1u);
            asm volatile("s_waitcnt vmcnt(0)" ::: "memory");
        } else {
            XB_SPIN(xb_ld(&bar[XB_XGEN(b.x)]) == gen, bar);
            __builtin_amdgcn_fence(__ATOMIC_ACQUIRE, "agent");
            asm volatile("s_waitcnt vmcnt(0)" ::: "memory");
        }
    }
    __syncthreads();
}

struct KArgs { const float* in[22]; float* out; unsigned char* ws; int ph_lo, ph_hi; };
enum { I_X = 0, I_C, I_CTX, I_CCTX, I_ADAW, I_ADAB, I_NMPRE, I_NMPOST, I_NFPRE, I_NFPOST, I_HWIN, I_HLB, I_HONORM, I_HWOUT, I_AQKV, I_AQN, I_AKN, I_AWOUT, I_FWIN, I_FCW, I_FCB, I_FWOUT };
constexpr int N_PHASES = 20;

__global__ void __launch_bounds__(512, 2) mega_fwd(KArgs a) {
    extern __shared__ __attribute__((aligned(16))) unsigned char lds_raw[];
    LAS unsigned char* lds = (LAS unsigned char*)lds_raw;
    cg::grid_group grid = cg::this_grid();
    const int tid = threadIdx.x, lane = tid & 63, wave = __builtin_amdgcn_readfirstlane(tid >> 6);
    const int G = gridDim.x, wg = blockIdx.x;
    const int gw = wg * 8 + wave, NGW = G * 8;
    unsigned char* ws = a.ws;
    float* mod = (float*)(ws + WS_MOD);
    float* xctx = (float*)(ws + WS_XCTX);
    bf16_t* H = (bf16_t*)(ws + WS_H);
    bf16_t* BIG = (bf16_t*)(ws + WS_BIG);
    bf16_t* Y = (bf16_t*)(ws + WS_BIG);
    bf16_t* XR = (bf16_t*)(ws + WS_BIG + 256 * MiB);
    float* BND = (float*)(ws + WS_BIG + 200 * MiB);
    float* YS = (float*)(ws + WS_BIG + 132 * MiB);
    bf16_t* ACT = (bf16_t*)(ws + WS_ACT);
    bf16_t* OFW = ACT; bf16_t* OBW = ACT + (size_t)MR * DM;
    const int lo = a.ph_lo, hi = a.ph_hi;
#ifndef MK_REPMASK
#define MK_REPMASK 0u
#endif
#define PH(k) if (lo <= (k) && (k) < hi) for (int rep_ = 0; rep_ <= (int)((MK_REPMASK >> (k)) & 1u); ++rep_)
#define SEAM(k) do { if ((k) + 1 < hi) { if ((k) == 0) { asm volatile("s_waitcnt vmcnt(0) lgkmcnt(0)" ::: "memory"); grid.sync(); } else xcd_barrier(bar); } } while (0)
    LAS float* scr = (LAS float*)(lds + wave * 16384);
    volatile LAS unsigned* MISC = (volatile LAS unsigned*)(lds + LDS_BYTES - 256);
    if (tid < 16) MISC[tid] = 0u;
    __syncthreads();
    XcdBarrier bar = xcd_barrier_post((unsigned*)ws, MISC);

    PH(0) {
        ada_phase(a.in[I_C], a.in[I_CCTX], a.in[I_ADAW], a.in[I_ADAB], mod, lds, wg, G, tid);
        constexpr int I0 = 32 * (NHG / 32), I1 = 32 * (DM / 32), I2 = 32 * (2 * DFF / 32), I3 = (DFF / 64) * (DM / 32);
        for (int it = gw; it < I0 + I1 + I2 + I3; it += NGW) {
            int r = it;
            if (r < I0) { transpose_item(a.in[I_HWIN], DM, NHG, (bf16_t*)(ws + W_HIN), scr, r, lane); continue; } r -= I0;
            if (r < I1) { transpose_item(a.in[I_HWOUT], DM, DM, (bf16_t*)(ws + W_HOUT), scr, r, lane); continue; } r -= I1;
            if (r < I2) { transpose_item(a.in[I_FWIN], DM, 2 * DFF, (bf16_t*)(ws + W_FIN), scr, r, lane, true); continue; } r -= I2;
            transpose_item(a.in[I_FWOUT], DFF, DM, (bf16_t*)(ws + W_FOUT), scr, r, lane);
        }
        SEAM(0);
    }
    PH(1) {
        row_phase<false, false>(a.in[I_X], a.in[I_CTX], nullptr, nullptr, XR, nullptr, nullptr, a.in[I_NMPRE], mod, 0, 0, 1, H, false, true, false, gw, NGW, lane);
        SEAM(1);
    }
    PH(2) {
        pg8::Gemm g{H, (const bf16_t*)(ws + W_HIN), MR, NHG, DM}; pg8::Order S; S.init(MR / 256, NHG, DM, G, wg, 0, 0);
        pg8::EpiBf16 E{BIG, NHG};
        pg8::gemm_phase<pg8::EpiBf16, pg8::Order, true, true>(lds, g, S, E);
        SEAM(2);
    }
    PH(3) {
        float* EB = (float*)(ACT + (size_t)2 * MR * DM);
        if (rep_ == 0) gla_prep_phase(BIG, H, EB, a.in[I_HLB], lds, wg, G, tid);
        xcd_barrier(bar);
        for (int item = wg; item < 256; item += G) {
            const int xq = item & 7, yq = item >> 3, vs = yq & 3, sq = xq + 8 * (yq >> 2);
            const int dir = sq & 1, h = (sq >> 1) & 15, b = sq >> 5;
            gla_item(BIG, dir ? H : BIG, dir ? DM : NHG, EB, dir ? OBW : OFW, lds, b, h, dir, vs, tid);
        }
        SEAM(3);
    }
    PH(4) {
        readout_phase(OFW, OBW, BIG, a.in[I_HONORM], H, gw, NGW, lane);
        SEAM(4);
    }
    PH(5) {
        pg8::Gemm g{H, (const bf16_t*)(ws + W_HOUT), MR, DM, DM}; pg8::Order S; S.init(64, DM, DM, G, wg, 1, 16);
        pg8::EpiF32 E{Y, DM, YS, DM / 64};
        pg8::gemm_phase<pg8::EpiF32, pg8::Order, true, true>(lds, g, S, E);
        SEAM(5);
    }
    PH(6) {
        row_phase<false, true>(a.in[I_X], a.in[I_CTX], a.out, xctx, XR, Y, a.in[I_NMPOST], a.in[I_NFPRE], mod, 2, 3, 4, H, true, true, false, gw, NGW, lane, YS, 16);
        SEAM(6);
    }
    PH(7) {
        pg8::Gemm g{H, (const bf16_t*)(ws + W_FIN), MR, 2 * DFF, DM}; pg8::Order S; S.init(MR / 256, 2 * DFF, DM, G, wg, 0, 0);
        pg8::EpiConv E{ACT, a.in[I_FCW], a.in[I_FCB], BND, (LAS float*)(lds + 131072)};
        pg8::gemm_phase<pg8::EpiConv, pg8::Order, true, true>(lds, g, S, E);
        SEAM(7);
    }
    PH(8) {
        conv_fix_phase(BND, a.in[I_FCW], a.in[I_FCB], ACT, false, gw, NGW, lane);
        SEAM(8);
    }
    PH(9) {
        pg8::Gemm g{ACT, (const bf16_t*)(ws + W_FOUT), MR, DM, DFF}; pg8::Order S; S.init(64, DM, DFF, G, wg, 1, 11);
        pg8::EpiF32 E{Y, DM, YS, DFF / 64};
        pg8::gemm_phase<pg8::EpiF32, pg8::Order, true, true>(lds, g, S, E);
        SEAM(9);
    }
    PH(10) {
        row_phase<true, true>(a.out, xctx, a.out, xctx, XR, Y, a.in[I_NFPOST], a.in[I_NMPRE] + DM, mod, 5, 6 * 3 + 0, 6 * 3 + 1, H, true, true, false, gw, NGW, lane, YS, 11);
        __syncthreads();
        constexpr int I0 = 32 * (NQKV / 32), I1 = 32 * (DM / 32), I2 = 32 * (2 * DFF / 32), I3 = (DFF / 64) * (DM / 32);
        for (int it = gw; it < I0 + I1 + I2 + I3; it += NGW) {
            int r = it;
            if (r < I0) { transpose_item(a.in[I_AQKV], DM, NQKV, (bf16_t*)(ws + W_QKV), scr, r, lane); continue; } r -= I0;
            if (r < I1) { transpose_item(a.in[I_AWOUT], DM, DM, (bf16_t*)(ws + W_AOUT), scr, r, lane); continue; } r -= I1;
            if (r < I2) { transpose_item(a.in[I_FWIN] + (size_t)DM * 2 * DFF, DM, 2 * DFF, (bf16_t*)(ws + W_FIN), scr, r, lane, true); continue; } r -= I2;
            transpose_item(a.in[I_FWOUT] + (size_t)DFF * DM, DFF, DM, (bf16_t*)(ws + W_FOUT), scr, r, lane);
        }
        SEAM(10);
    }
    PH(11) {
        pg8::Gemm g{H, (const bf16_t*)(ws + W_QKV), MR, NQKV, DM}; pg8::Order S; S.init(MR / 256, NQKV, DM, G, wg, 0, 0);
        pg8::EpiBf16 E{BIG, NQKV};
        pg8::gemm_phase<pg8::EpiBf16, pg8::Order, true, true>(lds, g, S, E);
        SEAM(11);
    }
    PH(12) {
        qknorm_phase(BIG, a.in[I_AQN], a.in[I_AKN], gw, NGW, lane);
        SEAM(12);
    }
    PH(13) {
        for (int u = wg; u < 1024; u += G) {
            const int x = u & 7, rest = u >> 3, j = rest & 31, i = rest >> 5;
            const int b = x >> 2, kvh = x & 3, h = kvh * 4 + i;
            const size_t qrow = (size_t)b * SB + CTX + (size_t)j * 256;
            att::attn_dense_body(BIG + qrow * NQKV + h * 128, BIG + (size_t)b * SB * NQKV + 2048 + kvh * 128, BIG + (size_t)b * SB * NQKV + 2560 + kvh * 128,
                                 ACT + qrow * DM + h * 128, SB, (char*)lds_raw);
        }
        SEAM(13);
    }
    PH(14) {
        pg8::Gemm g{ACT, (const bf16_t*)(ws + W_AOUT), MR, DM, DM}; pg8::Order S; S.init(64, DM, DM, G, wg, 1, 0);
        pg8::EpiF32 E{Y, DM, nullptr, 0};
        pg8::gemm_phase<pg8::EpiF32, pg8::Order, true, true>(lds, g, S, E);
        SEAM(14);
    }
    PH(15) {
        row_phase<true, true>(a.out, xctx, a.out, xctx, XR, Y, a.in[I_NMPOST] + DM, a.in[I_NFPRE] + DM, mod + 3 * 12288, 2, 3, 4, H, true, true, true, gw, NGW, lane);
        SEAM(15);
    }
    PH(16) {
        pg8::Gemm g{H, (const bf16_t*)(ws + W_FIN), MR, 2 * DFF, DM}; pg8::Order S; S.init(64, 2 * DFF, DM, G, wg, 1, 0);
        pg8::EpiConv E{ACT, a.in[I_FCW] + 3 * DFF, a.in[I_FCB] + DFF, BND, (LAS float*)(lds + 131072)};
        pg8::gemm_phase<pg8::EpiConv, pg8::Order, true, true>(lds, g, S, E);
        SEAM(16);
    }
    PH(17) {
        conv_fix_phase(BND, a.in[I_FCW] + 3 * DFF, a.in[I_FCB] + DFF, ACT, true, gw, NGW, lane);
        SEAM(17);
    }
    PH(18) {
        pg8::Gemm g{ACT, (const bf16_t*)(ws + W_FOUT), MR, DM, DFF}; pg8::Order S; S.init(64, DM, DFF, G, wg, 1, 0);
        pg8::EpiF32 E{Y, DM, nullptr, 0};
        pg8::gemm_phase<pg8::EpiF32, pg8::Order, true, true>(lds, g, S, E);
        SEAM(18);
    }
    PH(19) {
        row_phase<true, false>(a.out, xctx, a.out, xctx, XR, Y, a.in[I_NFPOST] + DM, nullptr, mod + 3 * 12288, 5, 0, 0, H, true, false, true, gw, NGW, lane);
    }
#undef PH
#undef SEAM
}


extern "C" void kernel_launch(void* const* d_in, const int* in_sizes, int n_in, void* d_out, int out_size, void* d_ws, size_t ws_size, hipStream_t stream) {
    static int grid = 0;
    if (grid == 0) {
        if (n_in != 22 || ws_size < WS_END || out_size != NB * SEQ * DM) { fprintf(stderr, "kernel_launch: unexpected shapes n_in %d ws %zu out %d\n", n_in, ws_size, out_size); grid = -1; return; }
        int dev = 0, cus = 0, per_cu = 0;
        if (hipGetDevice(&dev) != hipSuccess || hipDeviceGetAttribute(&cus, hipDeviceAttributeMultiprocessorCount, dev) != hipSuccess) { grid = -1; return; }
        if (hipFuncSetAttribute((const void*)mega_fwd, hipFuncAttributeMaxDynamicSharedMemorySize, LDS_BYTES) != hipSuccess) { fprintf(stderr, "kernel_launch: hipFuncSetAttribute failed\n"); grid = -1; return; }
        if (hipOccupancyMaxActiveBlocksPerMultiprocessor(&per_cu, (const void*)mega_fwd, 512, LDS_BYTES) != hipSuccess || per_cu < 1) { fprintf(stderr, "kernel_launch: occupancy query says %d\n", per_cu); per_cu = 1; }
        (void)hipGetLastError();
        grid = cus * 1;
    }
    if (grid < 0) return;
    KArgs a{};
    for (int i = 0; i < 22; ++i) a.in[i] = (const float*)d_in[i];
    a.out = (float*)d_out; a.ws = (unsigned char*)d_ws;
    a.ph_lo = 0; a.ph_hi = N_PHASES;
    if (hipMemsetAsync(d_ws, 0, 16384, stream) != hipSuccess) { fprintf(stderr, "kernel_launch: memset failed\n"); return; }
    void* args[] = {&a};
    hipError_t e = hipLaunchCooperativeKernel((const void*)mega_fwd, dim3(grid), dim3(512), args, LDS_BYTES, stream);
    if (e != hipSuccess) fprintf(stderr, "cooperative launch failed: %s (grid %d)\n", hipGetErrorString(e), grid);
}
```

```cpp
#include <hip/hip_runtime.h>
#include <hip/hip_cooperative_groups.h>
#include <cstdio>
#include <cstdint>
namespace cg = cooperative_groups;

#define LAS __attribute__((address_space(3)))
typedef unsigned short bf16_t;
typedef short bf16x8 __attribute__((ext_vector_type(8)));
typedef float f32x4 __attribute__((ext_vector_type(4)));
typedef float f32x2 __attribute__((ext_vector_type(2)));
typedef float f32x16 __attribute__((ext_vector_type(16)));
typedef unsigned u32x4 __attribute__((ext_vector_type(4)));
typedef unsigned u32x2 __attribute__((ext_vector_type(2)));
typedef short s16x4 __attribute__((ext_vector_type(4)));

constexpr int DM = 2048, NB = 2, SEQ = 8192, CTX = 256, SB = SEQ + CTX, MR = NB * SB;
constexpr int NH = 16, HD = 128, NKV = 4, DFF = 5632, NQKV = 3072, NHG = 5 * DM;
constexpr float EPS = 1e-6f;

constexpr size_t MiB = 1u << 20;
constexpr size_t WS_MOD = 64 * 1024;
constexpr size_t WS_XCTX = 2 * MiB;
constexpr size_t WS_W = 6 * MiB;
constexpr size_t W_HIN = WS_W, W_HOUT = WS_W + 40 * MiB, W_FIN = WS_W + 48 * MiB, W_FOUT = WS_W + 92 * MiB;
constexpr size_t W_QKV = WS_W, W_AOUT = WS_W + 12 * MiB;
constexpr size_t WS_H = 120 * MiB;
constexpr size_t WS_BIG = 186 * MiB;
constexpr size_t WS_ACT = 549 * MiB;
constexpr size_t WS_END = WS_ACT + (size_t)MR * DFF * 2;
static_assert(WS_END <= 768 * MiB, "ws");

constexpr int LDS_BYTES = 147456;

typedef __bf16 bf16x2_t __attribute__((ext_vector_type(2)));
__device__ __forceinline__ unsigned cvt_pk_bf16(float lo, float hi) { f32x2 v = {lo, hi}; bf16x2_t b = __builtin_convertvector(v, bf16x2_t); return __builtin_bit_cast(unsigned, b); }
__device__ __forceinline__ unsigned f2bf(float f) { unsigned u = __builtin_bit_cast(unsigned, f); return (u + 0x7fffu + ((u >> 16) & 1u)) >> 16; }
__device__ __forceinline__ unsigned pk2(float lo, float hi) { return f2bf(lo) | (f2bf(hi) << 16); }
__device__ __forceinline__ float bflo(unsigned u) { return __builtin_bit_cast(float, u << 16); }
__device__ __forceinline__ float bfhi(unsigned u) { return __builtin_bit_cast(float, u & 0xffff0000u); }
__device__ __forceinline__ float wave_sum(float v) {
#pragma unroll
    for (int o = 1; o < 64; o <<= 1) v += __shfl_xor(v, o);
    return v;
}
__device__ __forceinline__ float siluf(float v) { return v / (1.f + __expf(-v)); }
#define LBAR() do { asm volatile("s_waitcnt lgkmcnt(0)" ::: "memory"); __builtin_amdgcn_s_barrier(); asm volatile("" ::: "memory"); } while (0)

namespace pg8 {
constexpr int BM = 256, BK = 64, HALF = 128, HTB = HALF * BK * 2, STAGE_BYTES = 8 * HTB, NXCD = 8, WGM = 4;
__host__ __device__ __forceinline__ int lds_byte(int r, int c) { const int st = (r >> 4) * 2 + (c >> 5), rr = r & 15, cc = c & 31, ob = rr * 64 + cc * 2; return st * 1024 + (ob ^ (((ob >> 9) & 1) << 5)); }
__host__ __device__ __forceinline__ void stage_rc(int b, int& R, int& C) { const int st = b / 1024, sb = b % 1024, swz = sb ^ (((sb >> 9) & 1) << 5); R = (st >> 1) * 16 + swz / 64; C = (st & 1) * 32 + (swz % 64) / 2; }
__host__ __device__ __forceinline__ int perm32(int rho) { const int n = rho >> 4, i = rho & 15; return 8 * (i >> 2) + 4 * n + (i & 3); }

struct Unit { int pm, pn, kn; };
struct Gemm { const bf16_t* A; const bf16_t* Bt; int M, N, K; };

struct Order {
    int nM, nN, nwg, G, c, skip, ntf, nsplit;
    __device__ void init(int nM_, int N, int K, int G_, int c_, int skip_, int nsplit_) { nM = nM_; nN = N / BM; nwg = nM * nN; G = G_; c = c_; skip = skip_; ntf = K / BK; nsplit = nsplit_; }
    __device__ bool next(int i, Unit& u) const {
        const long L = (long)i * G + c;
        if (L >= nwg) {
            const int j = (int)(L - nwg); if (j >= 2 * nN * nsplit) return false;
            const int sidx = j % nsplit, cu = j / nsplit, cr = cu / nN;
            const int ntu = ntf / nsplit; u.pm = cr ? 33 : 0; u.pn = cu % nN; u.kn = (sidx * ntu) | (ntu << 16); return true;
        }
        int wgid = (int)L; { const int q = nwg / NXCD, r = nwg % NXCD, xcd = wgid % NXCD, off = wgid / NXCD; wgid = (xcd < r ? xcd * (q + 1) : r * (q + 1) + (xcd - r) * q) + off; }
        const int nig = WGM * nN, gid = wgid / nig, fm = gid * WGM, gsz = (nM - fm) < WGM ? (nM - fm) : WGM;
        int pm = fm + ((wgid % nig) % gsz); u.pn = (wgid % nig) / gsz;
        if (skip) pm = pm + 1 + (pm >= 32 ? 1 : 0);
        u.pm = pm; u.kn = ntf << 16; return true;
    }
    __device__ __forceinline__ void a_ready(const Unit&) const {}
    __device__ __forceinline__ void done(const Unit&) const {}
};

struct EpiBf16 {
    static constexpr bool PERM = true, AFTER_DRAIN = false;
    bf16_t* O; int ldc;
    __device__ __forceinline__ void operator()(const f32x4 (&acc)[2][2][4][2], const Unit& u, int wr, int wc, int fr, int fq) const {
        const int row0 = u.pm * BM + wr * 64 + fr; const int col0 = u.pn * BM + wc * 32 + 8 * fq;
#pragma unroll
        for (int ai = 0; ai < 2; ++ai)
#pragma unroll
            for (int m = 0; m < 4; ++m) { bf16_t* rowp = O + (size_t)(row0 + ai * HALF + m * 16) * ldc + col0;
#pragma unroll
                for (int bj = 0; bj < 2; ++bj) { const f32x4 v0 = acc[ai][bj][m][0], v1 = acc[ai][bj][m][1];
                    u32x4 w; w.x = cvt_pk_bf16(v0[0], v0[1]); w.y = cvt_pk_bf16(v0[2], v0[3]); w.z = cvt_pk_bf16(v1[0], v1[1]); w.w = cvt_pk_bf16(v1[2], v1[3]);
                    *(u32x4*)(rowp + bj * HALF) = w; } }
    }
};
struct EpiF32 {
    static constexpr bool PERM = true, AFTER_DRAIN = false;
    bf16_t* O; int ldc; float* SL; int ntf;
    __device__ __forceinline__ void operator()(const f32x4 (&acc)[2][2][4][2], const Unit& u, int wr, int wc, int fr, int fq) const {
        const int ntu = u.kn >> 16, kt0 = u.kn & 0xffff;
        const int row0 = wr * 64 + fr; const int col0 = u.pn * BM + wc * 32 + 8 * fq;
        if (ntu < ntf) {
            float* basep = SL + ((size_t)(kt0 / ntu) * 512 + (u.pm == 33 ? 256 : 0)) * ldc;
#pragma unroll
            for (int ai = 0; ai < 2; ++ai)
#pragma unroll
                for (int m = 0; m < 4; ++m) { float* rowp = basep + (size_t)(row0 + ai * HALF + m * 16) * ldc + col0;
#pragma unroll
                    for (int bj = 0; bj < 2; ++bj) { *(f32x4*)(rowp + bj * HALF) = acc[ai][bj][m][0]; *(f32x4*)(rowp + bj * HALF + 4) = acc[ai][bj][m][1]; } }
        } else {
            bf16_t* basep = O + (size_t)u.pm * BM * ldc;
#pragma unroll
            for (int ai = 0; ai < 2; ++ai)
#pragma unroll
                for (int m = 0; m < 4; ++m) { bf16_t* rowp = basep + (size_t)(row0 + ai * HALF + m * 16) * ldc + col0;
#pragma unroll
                    for (int bj = 0; bj < 2; ++bj) { const f32x4 v0 = acc[ai][bj][m][0], v1 = acc[ai][bj][m][1];
                        u32x4 w; w.x = cvt_pk_bf16(v0[0], v0[1]); w.y = cvt_pk_bf16(v0[2], v0[3]); w.z = cvt_pk_bf16(v1[0], v1[1]); w.w = cvt_pk_bf16(v1[2], v1[3]);
                        *(u32x4*)(rowp + bj * HALF) = w; } }
        }
    }
};

template <int CTRL> __device__ __forceinline__ float dpp_upd(float oldv, float src) {
    return __builtin_bit_cast(float, __builtin_amdgcn_update_dpp(__builtin_bit_cast(int, oldv), __builtin_bit_cast(int, src), CTRL, 0xf, 0xf, false)); }
template <int M> __device__ __forceinline__ float conv_elem(float gp, float gc, float gn, float up, float hp, float hn, float w0, float w1, float w2, float cb) {
    const float X = (M == 0) ? hp : dpp_upd<0x121>(0.f, gp);
    const float prev = dpp_upd<0x111>(X, gc);
    const float Yv = (M == 3) ? hn : dpp_upd<0x12F>(0.f, gn);
    const float next = dpp_upd<0x101>(Yv, gc);
    const float y = w0 * prev + w1 * gc + w2 * next + cb;
    return y * __builtin_amdgcn_rcpf(1.f + __builtin_amdgcn_exp2f(y * -1.4426950408889634f)) * up;
}
template <int M> __device__ __forceinline__ f32x4 conv_group(const f32x4 GP, const f32x4 GC, const f32x4 GN, const f32x4 up, const f32x4 hp, const f32x4 hn, const f32x4 w0, const f32x4 w1, const f32x4 w2, const f32x4 cb) {
    f32x4 r;
    r.x = conv_elem<M>(GP.x, GC.x, GN.x, up.x, hp.x, hn.x, w0.x, w1.x, w2.x, cb.x);
    r.y = conv_elem<M>(GP.y, GC.y, GN.y, up.y, hp.y, hn.y, w0.y, w1.y, w2.y, cb.y);
    r.z = conv_elem<M>(GP.z, GC.z, GN.z, up.z, hp.z, hn.z, w0.z, w1.z, w2.z, cb.z);
    r.w = conv_elem<M>(GP.w, GC.w, GN.w, up.w, hp.w, hn.w, w0.w, w1.w, w2.w, cb.w);
    return r;
}
struct EpiConv {
    static constexpr bool PERM = true, AFTER_DRAIN = false;
    bf16_t* ACT; const float* cw; const float* cbias; float* BND; LAS float* xch;
    __device__ __forceinline__ void operator()(const f32x4 (&acc)[2][2][4][2], const Unit& u, int wr_, int wc_, int fr_, int fq_) const {
        int wr = wr_, wc = wc_, fr = fr_, fq = fq_;
        asm volatile("" : "+v"(fr), "+v"(fq), "+s"(wr), "+s"(wc));
        const int cl = wc * 32 + 8 * fq, f0 = u.pn * 128 + cl;
#pragma unroll
        for (int ai = 0; ai < 2; ++ai) { const int blk = 2 * ai + wr;
            if (fr == 0) { *(LAS f32x4*)(xch + (blk * 2 + 0) * 128 + cl) = acc[ai][0][0][0]; *(LAS f32x4*)(xch + (blk * 2 + 0) * 128 + cl + 4) = acc[ai][0][0][1]; }
            if (fr == 15) { *(LAS f32x4*)(xch + (blk * 2 + 1) * 128 + cl) = acc[ai][0][3][0]; *(LAS f32x4*)(xch + (blk * 2 + 1) * 128 + cl + 4) = acc[ai][0][3][1]; } }
        { float* bnd = BND + (size_t)u.pm * 6 * DFF + f0;
          if (wr == 0 && fr < 2) { *(f32x4*)(bnd + fr * DFF) = acc[0][0][0][0]; *(f32x4*)(bnd + fr * DFF + 4) = acc[0][0][0][1]; }
          asm volatile("" ::: "memory");
          if (wr == 0 && fr == 0) { *(f32x4*)(bnd + 4 * DFF) = acc[0][1][0][0]; *(f32x4*)(bnd + 4 * DFF + 4) = acc[0][1][0][1]; }
          asm volatile("" ::: "memory");
          if (wr == 1 && fr >= 14) { *(f32x4*)(bnd + (fr - 12) * DFF) = acc[1][0][3][0]; *(f32x4*)(bnd + (fr - 12) * DFF + 4) = acc[1][0][3][1]; }
          asm volatile("" ::: "memory");
          if (wr == 1 && fr == 15) { *(f32x4*)(bnd + 5 * DFF) = acc[1][1][3][0]; *(f32x4*)(bnd + 5 * DFF + 4) = acc[1][1][3][1]; }
        }
        LBAR(); __builtin_amdgcn_sched_barrier(0);
        const f32x4 w00 = *(const f32x4*)(cw + f0), w01 = *(const f32x4*)(cw + f0 + 4), w10 = *(const f32x4*)(cw + DFF + f0), w11 = *(const f32x4*)(cw + DFF + f0 + 4);
        const f32x4 w20 = *(const f32x4*)(cw + 2 * DFF + f0), w21 = *(const f32x4*)(cw + 2 * DFF + f0 + 4), cb0 = *(const f32x4*)(cbias + f0), cb1 = *(const f32x4*)(cbias + f0 + 4);
#pragma unroll
        for (int ai = 0; ai < 2; ++ai) { const int blk = 2 * ai + wr;
            f32x4 hp0 = {0.f, 0.f, 0.f, 0.f}, hp1 = hp0, hn0 = hp0, hn1 = hp0;
            if (blk > 0) { hp0 = *(const LAS f32x4*)(xch + ((blk - 1) * 2 + 1) * 128 + cl); hp1 = *(const LAS f32x4*)(xch + ((blk - 1) * 2 + 1) * 128 + cl + 4); }
            if (blk < 3) { hn0 = *(const LAS f32x4*)(xch + ((blk + 1) * 2 + 0) * 128 + cl); hn1 = *(const LAS f32x4*)(xch + ((blk + 1) * 2 + 0) * 128 + cl + 4); }
#define CONV_ROW(M, MP, MN) do { __builtin_amdgcn_sched_barrier(0); \
            const f32x4 v0 = conv_group<M>(acc[ai][0][MP][0], acc[ai][0][M][0], acc[ai][0][MN][0], acc[ai][1][M][0], hp0, hn0, w00, w10, w20, cb0); \
            const f32x4 v1 = conv_group<M>(acc[ai][0][MP][1], acc[ai][0][M][1], acc[ai][0][MN][1], acc[ai][1][M][1], hp1, hn1, w01, w11, w21, cb1); \
            const int rl = ai * HALF + wr * 64 + M * 16 + fr; \
            if (rl != 0 && rl != 255) { u32x4 w; w.x = cvt_pk_bf16(v0[0], v0[1]); w.y = cvt_pk_bf16(v0[2], v0[3]); w.z = cvt_pk_bf16(v1[0], v1[1]); w.w = cvt_pk_bf16(v1[2], v1[3]); \
                *(u32x4*)(ACT + (size_t)(u.pm * BM + rl) * DFF + f0) = w; } } while (0)
            CONV_ROW(0, 0, 1); CONV_ROW(1, 0, 2); CONV_ROW(2, 1, 3); CONV_ROW(3, 2, 3);
#undef CONV_ROW
            __builtin_amdgcn_sched_barrier(0);
        }
    }
};

template <class Epi, class Sched, bool ALIGN_EPI = false, bool SP2 = false>
__device__ __forceinline__ void gemm_phase(LAS unsigned char* lds, const Gemm g, const Sched& S, const Epi& E) {
    const int tid = threadIdx.x, wid = __builtin_amdgcn_readfirstlane(tid >> 6), lane = tid & 63, wr = wid >> 2, wc = wid & 3, fr = lane & 15, fq = lane >> 4;
    const int K = g.K;
    unsigned voffA[2], voffB[2];
#pragma unroll
    for (int i = 0; i < 2; ++i) { int R, C; stage_rc(tid * 16 + i * 8192, R, C); const int Rb = Epi::PERM ? ((R & ~31) + perm32(R & 31)) : R;
        voffA[i] = (unsigned)(R * K + C) * 2u; voffB[i] = (unsigned)(Rb * K + C) * 2u; }
    const size_t kstep = (size_t)(BK * 2);
    const size_t hstep = (size_t)HALF * K * 2;
    const size_t tstep = 2 * hstep;
    const unsigned ldsw = (unsigned)wid * 1024u;
    const int aoff = lds_byte(wr * 64 + fr, fq * 8), boff = lds_byte(wc * 32 + fr, fq * 8);
#define PG8_SA(b, h) (((b) * 2 + (h)) * HTB)
#define PG8_SB(b, h) ((4 + (b) * 2 + (h)) * HTB)
#define PG8_STAGE(bufoff, gbase, voff) do { _Pragma("unroll") for (int _i = 0; _i < 2; ++_i) \
        __builtin_amdgcn_global_load_lds((const unsigned*)((const char*)(gbase) + (voff)[_i]), (LAS unsigned*)(lds + (bufoff) + ldsw + _i * 8192), 16, 0, 0); } while (0)
#define PG8_LDA(dst, b, h) do { _Pragma("unroll") for (int m = 0; m < 4; ++m) _Pragma("unroll") for (int k = 0; k < 2; ++k) dst[m][k] = *(const LAS bf16x8*)(lds + PG8_SA(b, h) + aoff + m * 2048 + k * 1024); } while (0)
#define PG8_LDB(dst, b, h) do { _Pragma("unroll") for (int n = 0; n < 2; ++n) _Pragma("unroll") for (int k = 0; k < 2; ++k) dst[n][k] = *(const LAS bf16x8*)(lds + PG8_SB(b, h) + boff + n * 2048 + k * 1024); } while (0)
#define PG8_MMA(ai, bj, At, Bt) do { __builtin_amdgcn_s_setprio(1); _Pragma("unroll") for (int m = 0; m < 4; ++m) _Pragma("unroll") for (int n = 0; n < 2; ++n) _Pragma("unroll") for (int k = 0; k < 2; ++k) \
        acc[ai][bj][m][n] = __builtin_amdgcn_mfma_f32_16x16x32_bf16(Bt[n][k], At[m][k], acc[ai][bj][m][n], 0, 0, 0); __builtin_amdgcn_s_setprio(0); } while (0)
#define PG8_WAIT_V(n) asm volatile("s_waitcnt vmcnt(" #n ")" ::: "memory")
#define PG8_WAIT_L(n) asm volatile("s_waitcnt lgkmcnt(" #n ")" ::: "memory")
#define PG8_BAR __builtin_amdgcn_s_barrier()
#define PG8_SCHED __builtin_amdgcn_sched_barrier(0)
    Unit cur, nxt; int ui = 0;
    if (!S.next(0, cur)) return;
    f32x4 acc[2][2][4][2];
#pragma unroll
    for (int a = 0; a < 2; ++a)
#pragma unroll
        for (int b = 0; b < 2; ++b)
#pragma unroll
            for (int m = 0; m < 4; ++m)
#pragma unroll
                for (int n = 0; n < 2; ++n) acc[a][b][m][n] = (f32x4){0.f, 0.f, 0.f, 0.f};
    bf16x8 At[4][2], B0[2][2], B1[2][2];
    const char* cA = (const char*)g.A + (size_t)cur.pm * tstep + (size_t)(cur.kn & 0xffff) * kstep; const char* cB = (const char*)g.Bt + (size_t)cur.pn * tstep + (size_t)(cur.kn & 0xffff) * kstep;
    S.a_ready(cur);
    if constexpr (SP2) {
        PG8_STAGE(PG8_SB(0, 0), cB, voffB); PG8_STAGE(PG8_SB(0, 1), cB + hstep, voffB); PG8_STAGE(PG8_SA(0, 0), cA, voffA); PG8_STAGE(PG8_SA(0, 1), cA + hstep, voffA);
        if (wr == 1) PG8_BAR;
        PG8_WAIT_V(2); PG8_BAR;
        PG8_STAGE(PG8_SB(1, 0), cB + kstep, voffB); PG8_STAGE(PG8_SA(1, 0), cA + kstep, voffA); PG8_STAGE(PG8_SB(1, 1), cB + hstep + kstep, voffB);
        PG8_WAIT_V(6); PG8_BAR;
    } else {
        PG8_STAGE(PG8_SB(0, 0), cB, voffB); PG8_STAGE(PG8_SA(0, 0), cA, voffA); PG8_STAGE(PG8_SB(0, 1), cB + hstep, voffB); PG8_STAGE(PG8_SA(0, 1), cA + hstep, voffA);
        if (wr == 1) PG8_BAR;
        PG8_WAIT_V(4); PG8_BAR;
        PG8_STAGE(PG8_SB(1, 0), cB + kstep, voffB); PG8_STAGE(PG8_SA(1, 0), cA + kstep, voffA); PG8_STAGE(PG8_SB(1, 1), cB + hstep + kstep, voffB);
        PG8_WAIT_V(6); PG8_BAR;
    }
    for (;;) {
        const bool has_next = S.next(ui + 1, nxt);
        const char* nA = has_next ? (const char*)g.A + (size_t)nxt.pm * tstep + (size_t)(nxt.kn & 0xffff) * kstep : cA; const char* nB = has_next ? (const char*)g.Bt + (size_t)nxt.pn * tstep + (size_t)(nxt.kn & 0xffff) * kstep : cB;
        const int nt = cur.kn >> 16;
        for (int t = 0; t < nt; t += 2) {
            const bool last = (t == nt - 2);
            const char* a1 = cA + (size_t)(t + 1) * kstep;
            const char* a2 = last ? nA : cA + (size_t)(t + 2) * kstep; const char* b2 = last ? nB : cB + (size_t)(t + 2) * kstep;
            const char* a3 = a2 + kstep; const char* b3 = b2 + kstep;
            if (last && has_next) S.a_ready(nxt);
            if constexpr (SP2) {
            PG8_LDB(B0, 0, 0); PG8_LDB(B1, 0, 1); PG8_SCHED; PG8_LDA(At, 0, 0); PG8_STAGE(PG8_SA(1, 1), a1 + hstep, voffA);
            PG8_WAIT_V(8); PG8_WAIT_L(0); PG8_BAR; PG8_MMA(0, 0, At, B0); PG8_MMA(0, 1, At, B1); PG8_BAR; PG8_SCHED;
            PG8_LDA(At, 0, 1); PG8_STAGE(PG8_SB(0, 0), b2, voffB); PG8_STAGE(PG8_SB(0, 1), b2 + hstep, voffB); PG8_STAGE(PG8_SA(0, 0), a2, voffA);
            PG8_WAIT_V(8); PG8_WAIT_L(0); PG8_BAR; PG8_MMA(1, 0, At, B0); PG8_MMA(1, 1, At, B1); PG8_BAR; PG8_SCHED;
            PG8_LDB(B0, 1, 0); PG8_LDB(B1, 1, 1); PG8_SCHED; PG8_LDA(At, 1, 0); PG8_STAGE(PG8_SA(0, 1), a2 + hstep, voffA);
            PG8_WAIT_V(8); PG8_WAIT_L(0); PG8_BAR; PG8_MMA(0, 0, At, B0); PG8_MMA(0, 1, At, B1); PG8_BAR; PG8_SCHED;
            PG8_LDA(At, 1, 1); PG8_STAGE(PG8_SB(1, 0), b3, voffB); PG8_STAGE(PG8_SB(1, 1), b3 + hstep, voffB); PG8_STAGE(PG8_SA(1, 0), a3, voffA);
            PG8_WAIT_V(8); PG8_WAIT_L(0); PG8_BAR; PG8_MMA(1, 0, At, B0); PG8_MMA(1, 1, At, B1); PG8_BAR; PG8_SCHED;
            } else {
            PG8_LDB(B0, 0, 0); PG8_SCHED; PG8_LDA(At, 0, 0); PG8_STAGE(PG8_SA(1, 1), a1 + hstep, voffA);
            PG8_WAIT_L(8); PG8_BAR; PG8_WAIT_L(0); PG8_MMA(0, 0, At, B0); PG8_BAR; PG8_SCHED;
            PG8_LDB(B1, 0, 1); PG8_STAGE(PG8_SB(0, 0), b2, voffB);
            PG8_BAR; PG8_WAIT_L(0); PG8_MMA(0, 1, At, B1); PG8_BAR;
            PG8_LDA(At, 0, 1); PG8_STAGE(PG8_SA(0, 0), a2, voffA);
            PG8_BAR; PG8_WAIT_L(0); PG8_MMA(1, 0, At, B0); PG8_BAR; PG8_SCHED;
            PG8_STAGE(PG8_SB(0, 1), b2 + hstep, voffB);
            PG8_WAIT_V(6); PG8_BAR; PG8_MMA(1, 1, At, B1); PG8_BAR;
            PG8_LDB(B0, 1, 0); PG8_SCHED; PG8_LDA(At, 1, 0); PG8_STAGE(PG8_SA(0, 1), a2 + hstep, voffA);
            PG8_WAIT_L(8); PG8_BAR; PG8_WAIT_L(0); PG8_MMA(0, 0, At, B0); PG8_BAR; PG8_SCHED;
            PG8_LDB(B1, 1, 1); PG8_STAGE(PG8_SB(1, 0), b3, voffB);
            PG8_BAR; PG8_WAIT_L(0); PG8_MMA(0, 1, At, B1); PG8_BAR;
            PG8_LDA(At, 1, 1); PG8_STAGE(PG8_SA(1, 0), a3, voffA);
            PG8_BAR; PG8_WAIT_L(0); PG8_MMA(1, 0, At, B0); PG8_BAR; PG8_SCHED;
            PG8_STAGE(PG8_SB(1, 1), b3 + hstep, voffB);
            PG8_WAIT_V(6); PG8_BAR; PG8_MMA(1, 1, At, B1); PG8_BAR;
            }
        }
        if constexpr (ALIGN_EPI) { if (wr == 0) PG8_BAR; }
        if constexpr (!Epi::AFTER_DRAIN) { E(acc, cur, wr, wc, fr, fq); S.done(cur); }
        if (!has_next) break;
#pragma unroll
        for (int a = 0; a < 2; ++a)
#pragma unroll
            for (int b = 0; b < 2; ++b)
#pragma unroll
                for (int m = 0; m < 4; ++m)
#pragma unroll
                    for (int n = 0; n < 2; ++n) acc[a][b][m][n] = (f32x4){0.f, 0.f, 0.f, 0.f};
        cur = nxt; cA = nA; cB = nB; ++ui;
        if constexpr (ALIGN_EPI) { if (wr == 1) PG8_BAR; }
    }
    PG8_WAIT_V(0);
    if constexpr (!ALIGN_EPI) { if (wr == 0) PG8_BAR; }
    PG8_BAR;
#undef PG8_SA
#undef PG8_SB
#undef PG8_STAGE
#undef PG8_LDA
#undef PG8_LDB
#undef PG8_MMA
#undef PG8_WAIT_V
#undef PG8_WAIT_L
#undef PG8_BAR
#undef PG8_SCHED
}
}

namespace att {
constexpr int D = 128, NW = 8, QBLK = 32, KVBLK = 64;
constexpr float SCALE = 0.088388347648318440f;
constexpr float THR = 8.f;
constexpr int LDQ = NQKV, LDK = NQKV, LDO = DM;
constexpr size_t SHM_V = KVBLK * D * 2, SHM_K = KVBLK * D * 2, SHM_ATTN = 2 * SHM_V + 2 * SHM_K + NW * 64 * 4;
#define KSWZ(row, colB) ((row) * 256 + ((colB) ^ (((row) & 7) << 4)))
#define SBAR() __builtin_amdgcn_sched_barrier(0)
__device__ __forceinline__ int crow(int r, int hi) { return (r & 3) + 8 * (r >> 2) + 4 * hi; }
__device__ __forceinline__ unsigned cvtpk(float lo, float hi) { unsigned r; asm volatile("v_cvt_pk_bf16_f32 %0, %1, %2" : "=v"(r) : "v"(lo), "v"(hi)); return r; }
__device__ __forceinline__ bf16x8 ld8(const bf16_t* p) { return *reinterpret_cast<const bf16x8*>(p); }

__device__ __forceinline__ void partialSM(f32x16& p0, f32x16& p1, float& m_reg, float& mn, float& alpha) {
  constexpr float C = SCALE * 1.4426950408889634f;
  float pmax = p0[0];
#pragma unroll
  for (int r = 1; r < 16; ++r) pmax = fmaxf(pmax, p0[r]);
#pragma unroll
  for (int r = 0; r < 16; ++r) pmax = fmaxf(pmax, p1[r]);
  { auto rr = __builtin_amdgcn_permlane32_swap(__float_as_uint(pmax), __float_as_uint(pmax), false, false);
    pmax = fmaxf(__uint_as_float(rr[0]), __uint_as_float(rr[1])); }
  if (__builtin_expect(__all(pmax - m_reg <= THR / SCALE), 1)) { mn = m_reg; alpha = 1.f; }
  else { mn = fmaxf(m_reg, pmax); alpha = __builtin_amdgcn_exp2f((m_reg - mn) * C); m_reg = mn; }
  float mnC = -mn * C;
#pragma unroll
  for (int r = 0; r < 16; ++r) p0[r] = fmaf(p0[r], C, mnC);
#pragma unroll
  for (int r = 0; r < 16; ++r) p1[r] = fmaf(p1[r], C, mnC);
#pragma unroll
  for (int r = 0; r < 16; ++r) p0[r] = __builtin_amdgcn_exp2f(p0[r]);
}
__device__ __forceinline__ void finishSM(f32x16& p0, f32x16& p1, float alpha, float& l_reg, bf16x8& pa0, bf16x8& pa1, bf16x8& pa2, bf16x8& pa3) {
#pragma unroll
  for (int r = 0; r < 16; ++r) p1[r] = __builtin_amdgcn_exp2f(p1[r]);
  float ps = 0;
#pragma unroll
  for (int r = 0; r < 16; ++r) ps += p0[r];
#pragma unroll
  for (int r = 0; r < 16; ++r) ps += p1[r];
  { auto rr = __builtin_amdgcn_permlane32_swap(__float_as_uint(ps), __float_as_uint(ps), false, false);
    ps = __uint_as_float(rr[0]) + __uint_as_float(rr[1]); }
  l_reg = l_reg * alpha + ps;
#define PK4(P, BASE, OUT) do { unsigned a0 = cvtpk(P[BASE + 0], P[BASE + 1]), a1 = cvtpk(P[BASE + 2], P[BASE + 3]);   \
    unsigned b0 = cvtpk(P[BASE + 4], P[BASE + 5]), b1 = cvtpk(P[BASE + 6], P[BASE + 7]);                              \
    auto r0 = __builtin_amdgcn_permlane32_swap(a0, b0, false, false); auto r1 = __builtin_amdgcn_permlane32_swap(a1, b1, false, false); \
    u32x4 w = {r0[0], r1[0], r0[1], r1[1]}; OUT = *reinterpret_cast<bf16x8*>(&w); } while (0)
  PK4(p0, 0, pa0); PK4(p0, 8, pa1); PK4(p1, 0, pa2); PK4(p1, 8, pa3);
#undef PK4
}
__device__ __forceinline__ void qkt(f32x16& p0, f32x16& p1, const bf16_t* Ks, const bf16x8* qr, int r32, int hi) {
  p0 = f32x16{}; p1 = f32x16{};
#pragma unroll
  for (int d0 = 0; d0 < 8; ++d0) { int cb = (d0 * 16 + hi * 8) * 2;
    bf16x8 b0 = *reinterpret_cast<const bf16x8*>((const char*)Ks + KSWZ(r32, cb));
    bf16x8 b1 = *reinterpret_cast<const bf16x8*>((const char*)Ks + KSWZ(32 + r32, cb));
    p0 = __builtin_amdgcn_mfma_f32_32x32x16_bf16(b0, qr[d0], p0, 0, 0, 0);
    p1 = __builtin_amdgcn_mfma_f32_32x32x16_bf16(b1, qr[d0], p1, 0, 0, 0); }
}
__device__ __forceinline__ int v_st(int k, int c) { const int kk = (k & ~0xC) | ((k & 4) << 1) | ((k & 8) >> 1); return ((kk >> 3) * 4 + (c >> 5)) * 512 + ((kk & 7) * 32 + (c & 31)) * 2; }
__device__ __forceinline__ int v_rd_base(int lane) { return ((lane & 3) << 3) | (((lane >> 2) & 3) << 6) | (((lane >> 4) & 1) << 5) | (((lane >> 5) & 1) << 8); }
constexpr int v_rd_off(int d0, int ks, int half) { return d0 * 512 + ks * 4096 + half * 2048; }
template <int OFF> __device__ __forceinline__ s16x4 tr_read(int vb) {
  s16x4 r; asm volatile("ds_read_b64_tr_b16 %0, %1 offset:%2" : "=&v"(r) : "v"(vb), "i"(OFF) : "memory"); return r;
}
template <int D0> __device__ __forceinline__ void pv_one(f32x16& od, int vb, bf16x8 pa0, bf16x8 pa1, bf16x8 pa2, bf16x8 pa3) {
  const s16x4 l0 = tr_read<v_rd_off(D0, 0, 0)>(vb), h0 = tr_read<v_rd_off(D0, 0, 1)>(vb), l1 = tr_read<v_rd_off(D0, 1, 0)>(vb), h1 = tr_read<v_rd_off(D0, 1, 1)>(vb);
  const s16x4 l2 = tr_read<v_rd_off(D0, 2, 0)>(vb), h2 = tr_read<v_rd_off(D0, 2, 1)>(vb), l3 = tr_read<v_rd_off(D0, 3, 0)>(vb), h3 = tr_read<v_rd_off(D0, 3, 1)>(vb);
  asm volatile("s_waitcnt lgkmcnt(0)" ::: "memory"); SBAR();
#define PK(L, H) (bf16x8){L[0], L[1], L[2], L[3], H[0], H[1], H[2], H[3]}
  od = __builtin_amdgcn_mfma_f32_32x32x16_bf16(pa0, PK(l0, h0), od, 0, 0, 0);
  od = __builtin_amdgcn_mfma_f32_32x32x16_bf16(pa1, PK(l1, h1), od, 0, 0, 0);
  od = __builtin_amdgcn_mfma_f32_32x32x16_bf16(pa2, PK(l2, h2), od, 0, 0, 0);
  od = __builtin_amdgcn_mfma_f32_32x32x16_bf16(pa3, PK(l3, h3), od, 0, 0, 0);
#undef PK
}
__device__ __forceinline__ void pv_d0(f32x16* o, int vb, bf16x8 pa0, bf16x8 pa1, bf16x8 pa2, bf16x8 pa3) {
  pv_one<0>(o[0], vb, pa0, pa1, pa2, pa3); pv_one<1>(o[1], vb, pa0, pa1, pa2, pa3); pv_one<2>(o[2], vb, pa0, pa1, pa2, pa3); pv_one<3>(o[3], vb, pa0, pa1, pa2, pa3);
}

__device__ __forceinline__ void attn_dense_body(const bf16_t* __restrict__ Qb, const bf16_t* __restrict__ Kh, const bf16_t* __restrict__ Vh,
                                                bf16_t* __restrict__ Ob, int seq, char* lds) {
  const int tid = threadIdx.x, wid = tid >> 6, lane = tid & 63, r32 = lane & 31, hi = lane >> 5;
  bf16_t* V_lds = (bf16_t*)lds; bf16_t* K_lds = (bf16_t*)(lds + 2 * SHM_V);
  float* ws = (float*)(lds + 2 * SHM_V + 2 * SHM_K) + wid * 64; float* li_l = ws; float* al_l = ws + 32;
  float m_reg = -1e30f, l_reg = 0; f32x16 o[4] = {}; bf16x8 qr[8];
  const bf16_t* Qw = Qb + (long)(wid * QBLK + r32) * LDQ + hi * 8;
#pragma unroll
  for (int d0 = 0; d0 < 8; ++d0) qr[d0] = ld8(Qw + d0 * 16);
  const int sr = tid >> 4, sc = (tid & 15) * 8, vst0 = v_st(sr, sc), vst1 = v_st(32 + sr, sc);
  const int vb0 = (int)(uintptr_t)V_lds + v_rd_base(lane);
  struct { bf16x8 vs0, vs1, ks0, ks1; } sr_[2];
#define SLOAD(i, k0) do { sr_[i].vs0 = ld8(&Vh[(long)((k0) + sr) * LDK + sc]); sr_[i].vs1 = ld8(&Vh[(long)((k0) + 32 + sr) * LDK + sc]); \
    sr_[i].ks0 = ld8(&Kh[(long)((k0) + sr) * LDK + sc]); sr_[i].ks1 = ld8(&Kh[(long)((k0) + 32 + sr) * LDK + sc]); } while (0)
#define SWRITE(b, i) do { *(bf16x8*)((char*)V_lds + (b) * SHM_V + vst0) = sr_[i].vs0;          \
    *(bf16x8*)((char*)V_lds + (b) * SHM_V + vst1) = sr_[i].vs1; int kc = sc * 2;               \
    *(bf16x8*)((char*)K_lds + (b) * SHM_K + KSWZ(sr, kc)) = sr_[i].ks0;                       \
    *(bf16x8*)((char*)K_lds + (b) * SHM_K + KSWZ(32 + sr, kc)) = sr_[i].ks1; } while (0)
#define SWAIT() do { asm volatile("s_waitcnt vmcnt(4)" ::: "memory"); } while (0)
#define RESC(a) do { if (__any((a) < 1.f)) { if (hi == 0) al_l[r32] = (a); asm volatile("s_waitcnt lgkmcnt(0)" ::: "memory"); \
    _Pragma("unroll") for (int d = 0; d < 4; ++d) _Pragma("unroll") for (int r = 0; r < 16; ++r) o[d][r] *= al_l[crow(r, hi)]; } } while (0)
  f32x16 pA0, pA1, pB0, pB1; float mnA, mnB, alA, alB; bf16x8 pa0, pa1, pa2, pa3; const int NT = seq / KVBLK;
  constexpr int SE = 0, SO = 1;
  SLOAD(SE, 0); asm volatile("s_waitcnt vmcnt(0)" ::: "memory"); SWRITE(0, SE); __syncthreads();
  qkt(pA0, pA1, K_lds, qr, r32, hi); partialSM(pA0, pA1, m_reg, mnA, alA);
  SLOAD(SO, KVBLK); if (2 < NT) SLOAD(SE, 2 * KVBLK);
  SWAIT(); SWRITE(1, SO); __syncthreads();
  for (int j = 1; j + 1 < NT; j += 2) {
    SBAR(); qkt(pB0, pB1, (bf16_t*)((char*)K_lds + SHM_K), qr, r32, hi);
    finishSM(pA0, pA1, alA, l_reg, pa0, pa1, pa2, pa3); SBAR();
    SLOAD(SO, (j + 2) * KVBLK); SBAR();
    pv_d0(o, vb0, pa0, pa1, pa2, pa3); partialSM(pB0, pB1, m_reg, mnB, alB);
    __syncthreads(); SWAIT(); SWRITE(0, SE);
    RESC(alB); __syncthreads();
    SBAR(); qkt(pA0, pA1, K_lds, qr, r32, hi);
    finishSM(pB0, pB1, alB, l_reg, pa0, pa1, pa2, pa3); SBAR();
    if (j + 3 < NT) SLOAD(SE, (j + 3) * KVBLK); SBAR();
    pv_d0(o, vb0 + (int)SHM_V, pa0, pa1, pa2, pa3); partialSM(pA0, pA1, m_reg, mnA, alA);
    __syncthreads(); SWAIT(); SWRITE(1, SO);
    RESC(alA); __syncthreads();
  }
  SBAR(); qkt(pB0, pB1, (bf16_t*)((char*)K_lds + SHM_K), qr, r32, hi);
  finishSM(pA0, pA1, alA, l_reg, pa0, pa1, pa2, pa3); SBAR();
  pv_d0(o, vb0, pa0, pa1, pa2, pa3); partialSM(pB0, pB1, m_reg, mnB, alB);
  __syncthreads(); RESC(alB);
  finishSM(pB0, pB1, alB, l_reg, pa0, pa1, pa2, pa3); SBAR();
  pv_d0(o, vb0 + (int)SHM_V, pa0, pa1, pa2, pa3);
  if (hi == 0) li_l[r32] = l_reg; asm volatile("s_waitcnt lgkmcnt(0)" ::: "memory");
  float rli[16];
#pragma unroll
  for (int r = 0; r < 16; ++r) rli[r] = __builtin_amdgcn_rcpf(li_l[crow(r, hi)]);
  bf16_t* Ow = Ob + (long)(wid * QBLK) * LDO;
#pragma unroll
  for (int r = 0; r < 16; ++r) { int orow = crow(r, hi);
#pragma unroll
    for (int d0 = 0; d0 < 4; ++d0) Ow[(long)orow * LDO + d0 * 32 + r32] = (bf16_t)f2bf(o[d0][r] * rli[r]); }
  __syncthreads();
#undef SLOAD
#undef SWRITE
#undef SWAIT
#undef RESC
}
}

__device__ __forceinline__ void transpose_item(const float* W, int K, int N, bf16_t* WT, LAS float* scr, int item, int lane, bool ffn_remap = false) {
    const int nblk = N / 32, kb = item / nblk, nb = item % nblk, k0 = 64 * kb, n0 = 32 * nb;
    int n0o = n0; if (ffn_remap) { const int half = n0 >= DFF ? 1 : 0, f = n0 - half * DFF; n0o = (f >> 7) * 256 + half * 128 + (f & 127); }
#pragma unroll 8
    for (int i = 0; i < 32; ++i) { const int kk = 2 * i + (lane >> 5); scr[kk * 33 + (lane & 31)] = __builtin_nontemporal_load(W + (size_t)(k0 + kk) * N + n0 + (lane & 31)); }
    asm volatile("s_waitcnt lgkmcnt(0)" ::: "memory");
    const int c = lane & 7;
#pragma unroll
    for (int j = 0; j < 4; ++j) { const int n = (lane >> 3) + 8 * j; const LAS float* s = scr + (8 * c) * 33 + n;
        u32x4 o; o.x = pk2(s[0 * 33], s[1 * 33]); o.y = pk2(s[2 * 33], s[3 * 33]); o.z = pk2(s[4 * 33], s[5 * 33]); o.w = pk2(s[6 * 33], s[7 * 33]);
        *(u32x4*)(WT + (size_t)(n0o + n) * K + k0 + 8 * c) = o; }
    asm volatile("s_waitcnt lgkmcnt(0)" ::: "memory");
}

__device__ __forceinline__ void ada_phase(const float* c, const float* c_ctx, const float* ada_w, const float* ada_b, float* mod, LAS unsigned char* lds, int wg, int G, int tid) {
    LAS float* sv = (LAS float*)lds;
    LAS float* part = sv + 3 * 2048;
    for (int i = tid; i < 3 * 2048; i += 512) { const int s = i >> 11, k = i & 2047; const float v = (s == 0) ? c_ctx[k] : c[(s - 1) * 2048 + k]; sv[i] = siluf(v); }
    __syncthreads();
    const int wave = tid >> 6, lane = tid & 63;
    for (int item = wg; item < 192; item += G) {
        const int L = item / 96, n0 = (item % 96) * 128;
        const float* W = ada_w + (size_t)L * 2048 * 12288 + n0 + lane * 2;
        float a0x = 0, a0y = 0, a1x = 0, a1y = 0, a2x = 0, a2y = 0;
        const int k0 = wave * 256;
#pragma unroll 8
        for (int k = 0; k < 256; ++k) {
            const f32x2 w = __builtin_nontemporal_load((const f32x2*)(W + (size_t)(k0 + k) * 12288));
            const float s0 = sv[k0 + k], s1 = sv[2048 + k0 + k], s2 = sv[4096 + k0 + k];
            a0x += s0 * w.x; a0y += s0 * w.y; a1x += s1 * w.x; a1y += s1 * w.y; a2x += s2 * w.x; a2y += s2 * w.y;
        }
        part[(wave * 3 + 0) * 128 + lane * 2] = a0x; part[(wave * 3 + 0) * 128 + lane * 2 + 1] = a0y;
        part[(wave * 3 + 1) * 128 + lane * 2] = a1x; part[(wave * 3 + 1) * 128 + lane * 2 + 1] = a1y;
        part[(wave * 3 + 2) * 128 + lane * 2] = a2x; part[(wave * 3 + 2) * 128 + lane * 2 + 1] = a2y;
        __syncthreads();
        if (tid < 384) { const int s = tid >> 7, n = tid & 127; float acc = ada_b[L * 12288 + n0 + n];
#pragma unroll
            for (int w = 0; w < 8; ++w) acc += part[(w * 3 + s) * 128 + n];
            mod[(size_t)(L * 3 + s) * 12288 + n0 + n] = acc; }
        __syncthreads();
    }
}

template <bool XIN_BF, bool XOUT_BF>
__device__ __forceinline__ void row_phase_ctx(const float* xin_lat, const float* xin_ctx, float* xout_lat, float* xout_ctx, bf16_t* XR,
                                          const bf16_t* Y, const float* g_post, const float* g_pre, const float* modL, int jgate, int jshift, int jscale,
                                          bf16_t* H, bool has_y, bool make_h, bool lat_only, int gw, int NGW, int lane, const float* YS = nullptr, int nsplit = 0) {
    for (int cr = gw; cr < NB * CTX; cr += NGW) {
        const int b = cr / CTX, p = cr - b * CTX, r = b * SB + p; int s; const float* xi; float* xo; const bool ctxrow = p < CTX;
        size_t xrow;
        if (ctxrow) { if (lat_only) continue; s = 0; xrow = (size_t)(b * CTX + p) * DM; xi = xin_ctx + xrow; xo = xout_ctx + xrow; }
        else { s = 1 + b; xrow = (size_t)(b * SEQ + p - CTX) * DM; xi = xin_lat + xrow; xo = xout_lat + xrow; }
        const float* ms = modL + (size_t)s * 12288;
        f32x4 x[8];
#pragma unroll
        for (int j = 0; j < 8; ++j) {
            if (XIN_BF && !ctxrow) { const u32x2 xb = __builtin_nontemporal_load((const u32x2*)(XR + xrow + (j * 64 + lane) * 4)); x[j] = (f32x4){bflo(xb.x), bfhi(xb.x), bflo(xb.y), bfhi(xb.y)}; }
            else x[j] = XIN_BF ? *(const f32x4*)(xi + (j * 64 + lane) * 4) : __builtin_nontemporal_load((const f32x4*)(xi + (j * 64 + lane) * 4));
        }
        if (has_y) {
            f32x4 y[8]; float ss = 0.f;
#pragma unroll
            for (int j = 0; j < 8; ++j) {
                if (ctxrow && nsplit > 0) { f32x4 t = {0.f, 0.f, 0.f, 0.f};
                    for (int sp = 0; sp < nsplit; ++sp) t += *(const f32x4*)(YS + ((size_t)sp * 512 + b * CTX + p) * DM + (j * 64 + lane) * 4);
                    y[j] = t; }
                else { const u32x2 yb = __builtin_nontemporal_load((const u32x2*)(Y + (size_t)r * DM + (j * 64 + lane) * 4)); y[j] = (f32x4){bflo(yb.x), bfhi(yb.x), bflo(yb.y), bfhi(yb.y)}; }
                ss += (y[j].x * y[j].x + y[j].y * y[j].y) + (y[j].z * y[j].z + y[j].w * y[j].w); }
            const float rs = rsqrtf(wave_sum(ss) * (1.f / DM) + EPS);
#pragma unroll
            for (int j = 0; j < 8; ++j) { const f32x4 gp = *(const f32x4*)(g_post + (j * 64 + lane) * 4); const f32x4 gt = *(const f32x4*)(ms + jgate * 2048 + (j * 64 + lane) * 4);
                x[j] = x[j] + gt * (y[j] * rs * gp);
                if (XOUT_BF && !ctxrow) { u32x2 w; w.x = cvt_pk_bf16(x[j].x, x[j].y); w.y = cvt_pk_bf16(x[j].z, x[j].w); *(u32x2*)(XR + xrow + (j * 64 + lane) * 4) = w;
                    x[j] = (f32x4){bflo(w.x), bfhi(w.x), bflo(w.y), bfhi(w.y)}; }
                else *(f32x4*)(xo + (j * 64 + lane) * 4) = x[j]; }
        }
        if (make_h) {
            float ss = 0.f;
#pragma unroll
            for (int j = 0; j < 8; ++j) ss += (x[j].x * x[j].x + x[j].y * x[j].y) + (x[j].z * x[j].z + x[j].w * x[j].w);
            const float rs = rsqrtf(wave_sum(ss) * (1.f / DM) + EPS);
#pragma unroll
            for (int j = 0; j < 8; ++j) { const f32x4 gp = *(const f32x4*)(g_pre + (j * 64 + lane) * 4); const f32x4 sh = *(const f32x4*)(ms + jshift * 2048 + (j * 64 + lane) * 4);
                const f32x4 sc = *(const f32x4*)(ms + jscale * 2048 + (j * 64 + lane) * 4);
                const f32x4 hv = (x[j] * rs * gp) * (sc + 1.f) + sh;
                u32x2 w; w.x = cvt_pk_bf16(hv.x, hv.y); w.y = cvt_pk_bf16(hv.z, hv.w);
                *(u32x2*)(H + (size_t)r * DM + (j * 64 + lane) * 4) = w; }
        }
    }
}

template <bool XIN_BF, bool XOUT_BF>
__device__ __forceinline__ void row_phase(const float* xin_lat, const float* xin_ctx, float* xout_lat, float* xout_ctx, bf16_t* XR,
                                          const bf16_t* Y, const float* g_post, const float* g_pre, const float* modL, int jgate, int jshift, int jscale,
                                          bf16_t* H, bool has_y, bool make_h, bool lat_only, int gw, int NGW, int lane, const float* YS = nullptr, int nsplit = 0) {
    extern __shared__ __attribute__((aligned(16))) unsigned char lds_raw[];
    LAS float* pl = (LAS float*)lds_raw;
    for (int i = threadIdx.x; i < 2 * 2048; i += 512) { const int bb = i >> 11, c = i & 2047; const float* msf = modL + (size_t)(1 + bb) * 12288;
        if (has_y) pl[(0 * 2 + bb) * 2048 + c] = msf[jgate * 2048 + c] * g_post[c];
        if (make_h) pl[(1 * 2 + bb) * 2048 + c] = g_pre[c] * (1.f + msf[jscale * 2048 + c]); }
    __syncthreads();
    for (int q = gw; q < NB * SEQ / 2; q += NGW) {
        const int b = q / (SEQ / 2), t0 = 2 * (q - b * (SEQ / 2));
        const size_t r0 = (size_t)b * SB + CTX + t0, xrow = (size_t)(b * SEQ + t0) * DM;
        const float* ms = modL + (size_t)(1 + b) * 12288;
        f32x4 x[2][8], y[2][8];
#pragma unroll
        for (int rr = 0; rr < 2; ++rr)
#pragma unroll
            for (int j = 0; j < 8; ++j) {
                if (XIN_BF) { const u32x2 xb = __builtin_nontemporal_load((const u32x2*)(XR + xrow + rr * DM + (j * 64 + lane) * 4)); x[rr][j] = (f32x4){bflo(xb.x), bfhi(xb.x), bflo(xb.y), bfhi(xb.y)}; }
                else x[rr][j] = __builtin_nontemporal_load((const f32x4*)(xin_lat + xrow + rr * DM + (j * 64 + lane) * 4));
                if (has_y) { const u32x2 yb = __builtin_nontemporal_load((const u32x2*)(Y + (r0 + rr) * DM + (j * 64 + lane) * 4)); y[rr][j] = (f32x4){bflo(yb.x), bfhi(yb.x), bflo(yb.y), bfhi(yb.y)}; }
            }
        if (has_y) {
            float ss0 = 0.f, ss1 = 0.f;
#pragma unroll
            for (int j = 0; j < 8; ++j) { ss0 += (y[0][j].x * y[0][j].x + y[0][j].y * y[0][j].y) + (y[0][j].z * y[0][j].z + y[0][j].w * y[0][j].w);
                                          ss1 += (y[1][j].x * y[1][j].x + y[1][j].y * y[1][j].y) + (y[1][j].z * y[1][j].z + y[1][j].w * y[1][j].w); }
            const float rs0 = rsqrtf(wave_sum(ss0) * (1.f / DM) + EPS), rs1 = rsqrtf(wave_sum(ss1) * (1.f / DM) + EPS);
#pragma unroll
            for (int j = 0; j < 8; ++j) { const f32x4 gg = *(const LAS f32x4*)(pl + (0 * 2 + b) * 2048 + (j * 64 + lane) * 4);
#pragma unroll
                for (int rr = 0; rr < 2; ++rr) {
                    x[rr][j] = x[rr][j] + gg * (y[rr][j] * (rr ? rs1 : rs0));
                    if (XOUT_BF) { u32x2 w; w.x = cvt_pk_bf16(x[rr][j].x, x[rr][j].y); w.y = cvt_pk_bf16(x[rr][j].z, x[rr][j].w); *(u32x2*)(XR + xrow + rr * DM + (j * 64 + lane) * 4) = w;
                        x[rr][j] = (f32x4){bflo(w.x), bfhi(w.x), bflo(w.y), bfhi(w.y)}; }
                    else *(f32x4*)(xout_lat + xrow + rr * DM + (j * 64 + lane) * 4) = x[rr][j];
                }
                }
        }
        if (make_h) {
            float ss0 = 0.f, ss1 = 0.f;
#pragma unroll
            for (int j = 0; j < 8; ++j) { ss0 += (x[0][j].x * x[0][j].x + x[0][j].y * x[0][j].y) + (x[0][j].z * x[0][j].z + x[0][j].w * x[0][j].w);
                                          ss1 += (x[1][j].x * x[1][j].x + x[1][j].y * x[1][j].y) + (x[1][j].z * x[1][j].z + x[1][j].w * x[1][j].w); }
            const float rs0 = rsqrtf(wave_sum(ss0) * (1.f / DM) + EPS), rs1 = rsqrtf(wave_sum(ss1) * (1.f / DM) + EPS);
#pragma unroll
            for (int j = 0; j < 8; ++j) { const f32x4 sh = *(const f32x4*)(ms + jshift * 2048 + (j * 64 + lane) * 4);
                const f32x4 gs = *(const LAS f32x4*)(pl + (1 * 2 + b) * 2048 + (j * 64 + lane) * 4);
#pragma unroll
                for (int rr = 0; rr < 2; ++rr) { const f32x4 hv = (x[rr][j] * (rr ? rs1 : rs0)) * gs + sh;
                    u32x2 w; w.x = cvt_pk_bf16(hv.x, hv.y); w.y = cvt_pk_bf16(hv.z, hv.w);
                    *(u32x2*)(H + (r0 + rr) * DM + (j * 64 + lane) * 4) = w; } }
        }
    }
    if (!lat_only) row_phase_ctx<XIN_BF, XOUT_BF>(xin_lat, xin_ctx, xout_lat, xout_ctx, XR, Y, g_post, g_pre, modL, jgate, jshift, jscale, H, has_y, make_h, false, gw, NGW, lane, YS, nsplit);
}

__device__ __forceinline__ void gla_prep_phase(bf16_t* P, bf16_t* QB, float* EB, const float* __restrict__ lbl, LAS unsigned char* lds, int wg, int G, int tid) {
    const int lane = tid & 63, w = __builtin_amdgcn_readfirstlane(tid >> 6);
    constexpr float L2E = 1.4426950408889634f;
    int par = 0;
    unsigned nq[8], nf[8], nb[8];
    if (wg < NB * NH * 132) { const int rb0 = wg % 132, bh0 = wg / 132; const size_t r0 = (size_t)(bh0 >> 4) * SB + rb0 * 64 + 8 * w; const int c0 = (bh0 & 15) * 128 + 2 * lane;
#pragma unroll
        for (int i = 0; i < 8; ++i) { const size_t ro = (r0 + i) * NHG + c0; nq[i] = __builtin_nontemporal_load((const unsigned*)(P + ro)); nf[i] = __builtin_nontemporal_load((const unsigned*)(P + ro + 2048)); nb[i] = __builtin_nontemporal_load((const unsigned*)(P + ro + 4096)); } }
    for (int item = wg; item < NB * NH * 132; item += G, par ^= 1) {
        LAS float* TOT = (LAS float*)lds + par * 2048;
        const int rb = item % 132, bh = item / 132, h = bh & 15, b = bh >> 4;
        float lb[2][2], oml[2][2];
#pragma unroll
        for (int d = 0; d < 2; ++d)
#pragma unroll
            for (int e = 0; e < 2; ++e) { const int ch = h * 128 + 2 * lane + e; const float l0 = lbl[(d * 2 + 0) * 2048 + ch], l1 = lbl[(d * 2 + 1) * 2048 + ch];
                lb[d][e] = __builtin_amdgcn_rcpf(1.f + __builtin_amdgcn_exp2f((l1 - l0) * L2E)); oml[d][e] = 1.f - lb[d][e]; }
        const size_t row0 = (size_t)b * SB + rb * 64 + 8 * w;
        const int col = h * 128 + 2 * lane;
        unsigned q2[8], ff[8], fb[8];
#pragma unroll
        for (int i = 0; i < 8; ++i) { q2[i] = nq[i]; ff[i] = nf[i]; fb[i] = nb[i]; }
        if (item + G < NB * NH * 132) {
            const int it2 = item + G, rb2 = it2 % 132, bh2 = it2 / 132;
            const size_t r2 = (size_t)(bh2 >> 4) * SB + rb2 * 64 + 8 * w; const int c2 = (bh2 & 15) * 128 + 2 * lane;
#pragma unroll
            for (int i = 0; i < 8; ++i) { const size_t ro = (r2 + i) * NHG + c2; nq[i] = __builtin_nontemporal_load((const unsigned*)(P + ro)); nf[i] = __builtin_nontemporal_load((const unsigned*)(P + ro + 2048)); nb[i] = __builtin_nontemporal_load((const unsigned*)(P + ro + 4096)); }
        }
        float blf[8][2], blb[8][2], kkf[8][2], kkb[8][2];
        { float r0 = 0.f, r1 = 0.f;
#pragma unroll
          for (int i = 0; i < 8; ++i) {
              { const float sg = __builtin_amdgcn_rcpf(1.f + __builtin_amdgcn_exp2f(bflo(ff[i]) * -L2E)); r0 += __builtin_amdgcn_logf(lb[0][0] + oml[0][0] * sg); blf[i][0] = r0; kkf[i][0] = oml[0][0] - oml[0][0] * sg; }
              { const float sg = __builtin_amdgcn_rcpf(1.f + __builtin_amdgcn_exp2f(bfhi(ff[i]) * -L2E)); r1 += __builtin_amdgcn_logf(lb[0][1] + oml[0][1] * sg); blf[i][1] = r1; kkf[i][1] = oml[0][1] - oml[0][1] * sg; }
          }
          *(LAS f32x2*)(TOT + w * 128 + 2 * lane) = (f32x2){r0, r1}; }
        { float r0 = 0.f, r1 = 0.f;
#pragma unroll
          for (int i = 7; i >= 0; --i) {
              { const float sg = __builtin_amdgcn_rcpf(1.f + __builtin_amdgcn_exp2f(bflo(fb[i]) * -L2E)); r0 += __builtin_amdgcn_logf(lb[1][0] + oml[1][0] * sg); blb[i][0] = r0; kkb[i][0] = oml[1][0] - oml[1][0] * sg; }
              { const float sg = __builtin_amdgcn_rcpf(1.f + __builtin_amdgcn_exp2f(bfhi(fb[i]) * -L2E)); r1 += __builtin_amdgcn_logf(lb[1][1] + oml[1][1] * sg); blb[i][1] = r1; kkb[i][1] = oml[1][1] - oml[1][1] * sg; }
          }
          *(LAS f32x2*)(TOT + 1024 + w * 128 + 2 * lane) = (f32x2){r0, r1}; }
        LBAR();
        float pf0 = 0.f, pf1 = 0.f, tf0 = 0.f, tf1 = 0.f, pb0 = 0.f, pb1 = 0.f, tb0 = 0.f, tb1 = 0.f;
#pragma unroll
        for (int g = 0; g < 8; ++g) { const f32x2 x = *(const LAS f32x2*)(TOT + g * 128 + 2 * lane), y = *(const LAS f32x2*)(TOT + 1024 + g * 128 + 2 * lane);
            tf0 += x.x; tf1 += x.y; tb0 += y.x; tb1 += y.y; if (g < w) { pf0 += x.x; pf1 += x.y; } if (g > w) { pb0 += y.x; pb1 += y.y; } }
#pragma unroll
        for (int i = 0; i < 8; ++i) {
            const float qs0 = bflo(q2[i]), qs1 = bfhi(q2[i]);
            const float s0 = qs0 * 0.08838834764831845f * __builtin_amdgcn_rcpf(1.f + __builtin_amdgcn_exp2f(qs0 * -L2E));
            const float s1 = qs1 * 0.08838834764831845f * __builtin_amdgcn_rcpf(1.f + __builtin_amdgcn_exp2f(qs1 * -L2E));
            const float df0 = pf0 + blf[i][0] - tf0, df1 = pf1 + blf[i][1] - tf1, db0 = pb0 + blb[i][0] - tb0, db1 = pb1 + blb[i][1] - tb1;
            const size_t ro = (row0 + i) * NHG + col;
            *(unsigned*)(P + ro) = cvt_pk_bf16(s0 * __builtin_amdgcn_exp2f(df0), s1 * __builtin_amdgcn_exp2f(df1));
            *(unsigned*)(P + ro + 2048) = cvt_pk_bf16(kkf[i][0] * __builtin_amdgcn_exp2f(-df0), kkf[i][1] * __builtin_amdgcn_exp2f(-df1));
            *(unsigned*)(P + ro + 4096) = cvt_pk_bf16(kkb[i][0] * __builtin_amdgcn_exp2f(-db0), kkb[i][1] * __builtin_amdgcn_exp2f(-db1));
            *(unsigned*)(QB + (row0 + i) * DM + col) = cvt_pk_bf16(s0 * __builtin_amdgcn_exp2f(db0), s1 * __builtin_amdgcn_exp2f(db1));
        }
        if (w == 0) {
            const int cb = rb < 4 ? 3 - rb : 135 - rb;
            *(f32x2*)(EB + ((size_t)((b * 16 + h) * 2 + 0) * 132 + rb) * 128 + 2 * lane) = (f32x2){__builtin_amdgcn_exp2f(tf0), __builtin_amdgcn_exp2f(tf1)};
            *(f32x2*)(EB + ((size_t)((b * 16 + h) * 2 + 1) * 132 + cb) * 128 + 2 * lane) = (f32x2){__builtin_amdgcn_exp2f(tb0), __builtin_amdgcn_exp2f(tb1)};
        }
    }
    __syncthreads();
}

__device__ __forceinline__ void gla_item(const bf16_t* __restrict__ P, const bf16_t* __restrict__ QS, int ldq, const float* __restrict__ EB, bf16_t* __restrict__ Od, LAS unsigned char* lds, int b, int h, int dir, int vs, int tid) {
    const int lane = tid & 63, w = __builtin_amdgcn_readfirstlane(tid >> 6), fr = lane & 15, fq = lane >> 4;
    constexpr int SETB = 66560;
    f32x4 S0 = {0.f, 0.f, 0.f, 0.f}, S1 = {0.f, 0.f, 0.f, 0.f};
    const int qrow = tid >> 4, colq = h * 128 + (tid & 15) * 8;
    const int kq = tid & 31, tg = tid >> 5, colf = 2048 * (1 + dir) + h * 128 + 4 * kq;
    const int colv = 3 * 2048 + h * 128 + vs * 32 + (tid & 7) * 4;
    const int tv = tid >> 3, base = b * SB, rofs = dir ? 63 : 0, rsign = dir ? -1 : 1;
    const float* ebp = EB + (size_t)((b * 16 + h) * 2 + dir) * 132 * 128 + 16 * w + 4 * fq;
    u32x4 q4[2][2]; u32x2 k2[2][4]; u32x2 vv[2]; f32x4 eb[2];
#define GLA_R0(c) (dir ? ((c) < 4 ? base + 192 - 64 * (c) : base + 8640 - 64 * (c)) : base + 64 * (c))
#define GLA_LOAD(u, c) do { const int R0n = GLA_R0(c); \
        _Pragma("unroll") for (int i = 0; i < 2; ++i) q4[u][i] = *(const u32x4*)(QS + (size_t)(R0n + rofs + rsign * (qrow + 32 * i)) * ldq + colq); \
        _Pragma("unroll") for (int i = 0; i < 4; ++i) k2[u][i] = *(const u32x2*)(P + (size_t)(R0n + rofs + rsign * (4 * tg + i)) * NHG + colf); \
        vv[u] = *(const u32x2*)(P + (size_t)(R0n + rofs + rsign * tv) * NHG + colv); eb[u] = *(const f32x4*)(ebp + (size_t)(c) * 128); __builtin_amdgcn_sched_barrier(0); } while (0)
    GLA_LOAD(0, 0); __builtin_amdgcn_sched_barrier(0); GLA_LOAD(1, 1); __builtin_amdgcn_sched_barrier(0);
    const int ti = w >> 1, vi = w & 1;
    for (int c0 = 0; c0 < 132; c0 += 2) {
#pragma unroll
      for (int u = 0; u < 2; ++u) {
        const int c = c0 + u;
        const int R0 = GLA_R0(c);
        LAS unsigned char* QD = lds + (u & 1) * SETB; LAS unsigned char* KD = QD + 17408; LAS unsigned char* KDT = QD + 34816; LAS unsigned char* VT = QD + 53248; LAS unsigned char* SDT = QD + 57856;
#pragma unroll
        for (int i = 0; i < 2; ++i) *(LAS u32x4*)(QD + (qrow + 32 * i) * 272 + (tid & 15) * 16) = q4[u][i];
#pragma unroll
        for (int i = 0; i < 4; ++i) *(LAS u32x2*)(KD + (4 * tg + i) * 272 + kq * 8) = k2[u][i];
        { const u32x2 r0 = k2[u][0], r1 = k2[u][1], r2 = k2[u][2], r3 = k2[u][3];
          *(LAS u32x2*)(KDT + (4 * kq + 0) * 144 + tg * 8) = (u32x2){(r0.x & 0xffffu) | (r1.x << 16), (r2.x & 0xffffu) | (r3.x << 16)};
          *(LAS u32x2*)(KDT + (4 * kq + 1) * 144 + tg * 8) = (u32x2){(r0.x >> 16) | (r1.x & 0xffff0000u), (r2.x >> 16) | (r3.x & 0xffff0000u)};
          *(LAS u32x2*)(KDT + (4 * kq + 2) * 144 + tg * 8) = (u32x2){(r0.y & 0xffffu) | (r1.y << 16), (r2.y & 0xffffu) | (r3.y << 16)};
          *(LAS u32x2*)(KDT + (4 * kq + 3) * 144 + tg * 8) = (u32x2){(r0.y >> 16) | (r1.y & 0xffff0000u), (r2.y >> 16) | (r3.y & 0xffff0000u)}; }
        { LAS bf16_t* vt = (LAS bf16_t*)VT; const int v4 = (tid & 7) * 4;
          vt[(v4 + 0) * 72 + tv] = (bf16_t)(vv[u].x & 0xffffu); vt[(v4 + 1) * 72 + tv] = (bf16_t)(vv[u].x >> 16);
          vt[(v4 + 2) * 72 + tv] = (bf16_t)(vv[u].y & 0xffffu); vt[(v4 + 3) * 72 + tv] = (bf16_t)(vv[u].y >> 16); }
        S0 *= eb[u]; S1 *= eb[u];
        *(LAS u32x2*)(SDT + fr * 272 + (16 * w + 4 * fq) * 2) = (u32x2){cvt_pk_bf16(S0.x, S0.y), cvt_pk_bf16(S0.z, S0.w)};
        *(LAS u32x2*)(SDT + (16 + fr) * 272 + (16 * w + 4 * fq) * 2) = (u32x2){cvt_pk_bf16(S1.x, S1.y), cvt_pk_bf16(S1.z, S1.w)};
        { const int cn = (c + 2 < 132) ? c + 2 : 131; GLA_LOAD(u, cn); }
        LBAR();
        { bf16x8 bq[4], ak[4][4], as_[4], kt[2], vb0[2], vb1[2]; s16x4 av[4];
#pragma unroll
          for (int ks = 0; ks < 4; ++ks) bq[ks] = *(const LAS bf16x8*)(QD + (16 * ti + fr) * 272 + (ks * 32 + fq * 8) * 2);
#pragma unroll
          for (int si = 0; si < 4; ++si) if (si <= ti) {
#pragma unroll
              for (int ks = 0; ks < 4; ++ks) ak[si][ks] = *(const LAS bf16x8*)(KD + (16 * si + fr) * 272 + (ks * 32 + fq * 8) * 2);
              av[si] = *(const LAS s16x4*)(VT + (16 * vi + fr) * 144 + (16 * si + 4 * fq) * 2); }
#pragma unroll
          for (int ks = 0; ks < 4; ++ks) as_[ks] = *(const LAS bf16x8*)(SDT + (16 * vi + fr) * 272 + (ks * 32 + fq * 8) * 2);
#pragma unroll
          for (int ks = 0; ks < 2; ++ks) { kt[ks] = *(const LAS bf16x8*)(KDT + (16 * w + fr) * 144 + (ks * 32 + fq * 8) * 2);
              vb0[ks] = *(const LAS bf16x8*)(VT + fr * 144 + (ks * 32 + fq * 8) * 2); vb1[ks] = *(const LAS bf16x8*)(VT + (16 + fr) * 144 + (ks * 32 + fq * 8) * 2); }
          f32x4 o = {0.f, 0.f, 0.f, 0.f};
#pragma unroll
          for (int ks = 0; ks < 4; ++ks) o = __builtin_amdgcn_mfma_f32_16x16x32_bf16(as_[ks], bq[ks], o, 0, 0, 0);
#pragma unroll
          for (int si = 0; si < 4; ++si) if (si <= ti) {
              f32x4 acc = {0.f, 0.f, 0.f, 0.f};
#pragma unroll
              for (int ks = 0; ks < 4; ++ks) acc = __builtin_amdgcn_mfma_f32_16x16x32_bf16(ak[si][ks], bq[ks], acc, 0, 0, 0);
              if (si == ti) {
#pragma unroll
                  for (int j = 0; j < 4; ++j) if (4 * fq + j > fr) acc[j] = 0.f;
              }
              const u32x2 pk = {cvt_pk_bf16(acc.x, acc.y), cvt_pk_bf16(acc.z, acc.w)};
              o = __builtin_amdgcn_mfma_f32_16x16x16bf16_1k(av[si], __builtin_bit_cast(s16x4, pk), o, 0, 0, 0);
          }
#pragma unroll
          for (int ks = 0; ks < 2; ++ks) { S0 = __builtin_amdgcn_mfma_f32_16x16x32_bf16(kt[ks], vb0[ks], S0, 0, 0, 0); S1 = __builtin_amdgcn_mfma_f32_16x16x32_bf16(kt[ks], vb1[ks], S1, 0, 0, 0); }
          const size_t ro = (size_t)(R0 + rofs + rsign * (16 * ti + fr)) * DM;
          *(u32x2*)(Od + ro + h * 128 + vs * 32 + 16 * vi + 4 * fq) = (u32x2){cvt_pk_bf16(o.x, o.y), cvt_pk_bf16(o.z, o.w)}; }
      }
    }
#undef GLA_LOAD
#undef GLA_R0
    __syncthreads();
}

__device__ __forceinline__ void readout_phase(const bf16_t* Ofw, const bf16_t* Obw, const bf16_t* P, const float* o_gain, bf16_t* R, int gw, int NGW, int lane) {
    const int cl = (8 * lane) & 127;
    const f32x4 g0 = *(const f32x4*)(o_gain + cl), g1 = *(const f32x4*)(o_gain + cl + 4);
    const float gn[8] = {g0.x, g0.y, g0.z, g0.w, g1.x, g1.y, g1.z, g1.w};
    for (int it0 = gw * 4; it0 < MR * 4; it0 += NGW * 4) {
        u32x4 a[4], bq[4], g[4];
#pragma unroll
        for (int u = 0; u < 4; ++u) { const int it = it0 + u, r = it >> 2, c0 = (it & 3) * 512 + 8 * lane;
            a[u] = __builtin_nontemporal_load((const u32x4*)(Ofw + (size_t)r * DM + c0)); bq[u] = __builtin_nontemporal_load((const u32x4*)(Obw + (size_t)r * DM + c0)); g[u] = __builtin_nontemporal_load((const u32x4*)(P + (size_t)r * NHG + 4 * DM + c0)); }
#pragma unroll
        for (int u = 0; u < 4; ++u) { const int it = it0 + u, r = it >> 2, c0 = (it & 3) * 512 + 8 * lane;
            float o[8];
            o[0] = bflo(a[u].x) + bflo(bq[u].x); o[1] = bfhi(a[u].x) + bfhi(bq[u].x); o[2] = bflo(a[u].y) + bflo(bq[u].y); o[3] = bfhi(a[u].y) + bfhi(bq[u].y);
            o[4] = bflo(a[u].z) + bflo(bq[u].z); o[5] = bfhi(a[u].z) + bfhi(bq[u].z); o[6] = bflo(a[u].w) + bflo(bq[u].w); o[7] = bfhi(a[u].w) + bfhi(bq[u].w);
            float ss = 0.f;
#pragma unroll
            for (int e = 0; e < 8; ++e) ss += o[e] * o[e];
            ss += __shfl_xor(ss, 1); ss += __shfl_xor(ss, 2); ss += __shfl_xor(ss, 4); ss += __shfl_xor(ss, 8);
            const float rs = rsqrtf(ss * (1.f / 128.f) + EPS);
            const float gv[8] = {bflo(g[u].x), bfhi(g[u].x), bflo(g[u].y), bfhi(g[u].y), bflo(g[u].z), bfhi(g[u].z), bflo(g[u].w), bfhi(g[u].w)};
            float v[8];
#pragma unroll
            for (int e = 0; e < 8; ++e) v[e] = o[e] * rs * gn[e] * siluf(gv[e]);
            u32x4 wv; wv.x = cvt_pk_bf16(v[0], v[1]); wv.y = cvt_pk_bf16(v[2], v[3]); wv.z = cvt_pk_bf16(v[4], v[5]); wv.w = cvt_pk_bf16(v[6], v[7]);
            *(u32x4*)(R + (size_t)r * DM + c0) = wv; }
    }
}

__device__ __forceinline__ void conv_fix_phase(const float* BND, const float* cw, const float* cbias, bf16_t* ACT, bool lat_only, int gw, int NGW, int lane) {
    constexpr float L2E = 1.4426950408889634f;
    for (int it = gw; it < 66 * 2 * 11; it += NGW) {
        const int cbk = it % 11, rest = it / 11, which = rest & 1, pm = rest >> 1;
        if (lat_only && (pm == 0 || pm == 33)) continue;
        const int c0 = cbk * 512 + 8 * lane;
        const float* bn = BND + (size_t)pm * 6 * DFF + c0;
        f32x4 pv[2], cv[2], nv[2], uv[2]; size_t row;
        if (which == 0) {
            const bool seq_start = (pm == 0 || pm == 1 || pm == 33 || pm == 34);
#pragma unroll
            for (int hh = 0; hh < 2; ++hh) { pv[hh] = seq_start ? (f32x4){0.f, 0.f, 0.f, 0.f} : *(const f32x4*)(bn - 6 * DFF + 3 * DFF + 4 * hh);
                cv[hh] = *(const f32x4*)(bn + 4 * hh); nv[hh] = *(const f32x4*)(bn + DFF + 4 * hh); uv[hh] = *(const f32x4*)(bn + 4 * DFF + 4 * hh); }
            row = (size_t)pm * 256;
        } else {
            const bool seq_end = (pm == 0 || pm == 32 || pm == 33 || pm == 65);
#pragma unroll
            for (int hh = 0; hh < 2; ++hh) { pv[hh] = *(const f32x4*)(bn + 2 * DFF + 4 * hh); cv[hh] = *(const f32x4*)(bn + 3 * DFF + 4 * hh);
                nv[hh] = seq_end ? (f32x4){0.f, 0.f, 0.f, 0.f} : *(const f32x4*)(bn + 6 * DFF + 4 * hh); uv[hh] = *(const f32x4*)(bn + 5 * DFF + 4 * hh); }
            row = (size_t)pm * 256 + 255;
        }
        float v[8];
#pragma unroll
        for (int hh = 0; hh < 2; ++hh) {
            const f32x4 w0 = *(const f32x4*)(cw + c0 + 4 * hh), w1 = *(const f32x4*)(cw + DFF + c0 + 4 * hh), w2 = *(const f32x4*)(cw + 2 * DFF + c0 + 4 * hh), cb = *(const f32x4*)(cbias + c0 + 4 * hh);
#pragma unroll
            for (int j = 0; j < 4; ++j) { const float y = w0[j] * pv[hh][j] + w1[j] * cv[hh][j] + w2[j] * nv[hh][j] + cb[j];
                v[4 * hh + j] = y * __builtin_amdgcn_rcpf(1.f + __builtin_amdgcn_exp2f(y * -L2E)) * uv[hh][j]; }
        }
        u32x4 wv; wv.x = cvt_pk_bf16(v[0], v[1]); wv.y = cvt_pk_bf16(v[2], v[3]); wv.z = cvt_pk_bf16(v[4], v[5]); wv.w = cvt_pk_bf16(v[6], v[7]);
        *(u32x4*)(ACT + row * DFF + c0) = wv;
    }
}

__device__ __forceinline__ void qknorm_phase(bf16_t* QKV, const float* q_gain, const float* k_gain, int gw, int NGW, int lane) {
    const int cl = (8 * lane) & 127;
    float gq[8], gk[8], invf4[4];
#pragma unroll
    for (int e = 0; e < 8; ++e) { gq[e] = q_gain[cl + e]; gk[e] = k_gain[cl + e]; }
#pragma unroll
    for (int e2 = 0; e2 < 4; ++e2) { const int fi = ((cl >> 1) + e2) & 31; invf4[e2] = exp2f(-(float)fi * (13.287712379549449f / 32.f)); }
    for (int it = gw; it < MR * 5; it += NGW) {
        const int r = it / 5, grp = it - r * 5, p = r % SB;
        const bool lat = p >= CTX;
        if (!lat && grp < 4) continue;
        bf16_t* ptr = QKV + (size_t)r * NQKV + grp * 512 + 8 * lane;
        const u32x4 a = *(const u32x4*)ptr;
        float x[8] = {bflo(a.x), bfhi(a.x), bflo(a.y), bfhi(a.y), bflo(a.z), bfhi(a.z), bflo(a.w), bfhi(a.w)};
        float ss = 0.f;
#pragma unroll
        for (int e = 0; e < 8; ++e) ss += x[e] * x[e];
        ss += __shfl_xor(ss, 1); ss += __shfl_xor(ss, 2); ss += __shfl_xor(ss, 4); ss += __shfl_xor(ss, 8);
        const float rs = rsqrtf(ss * (1.f / 128.f) + EPS);
#pragma unroll
        for (int e = 0; e < 8; ++e) x[e] = x[e] * rs * (grp < 4 ? gq[e] : gk[e]);
        if (lat) {
            const int t = p - CTX; const float prow = (float)(t >> 6), pcol = (float)(t & 63);
#pragma unroll
            for (int e2 = 0; e2 < 4; ++e2) {
                const int i = (cl >> 1) + e2;
                const float ang = ((i >= 32) ? pcol : prow) * invf4[e2];
                float sn, cs; sincosf(ang, &sn, &cs);
                const float x1 = x[2 * e2], x2 = x[2 * e2 + 1];
                x[2 * e2] = x1 * cs - x2 * sn; x[2 * e2 + 1] = x1 * sn + x2 * cs;
            }
        }
        u32x4 wv; wv.x = cvt_pk_bf16(x[0], x[1]); wv.y = cvt_pk_bf16(x[2], x[3]); wv.z = cvt_pk_bf16(x[4], x[5]); wv.w = cvt_pk_bf16(x[6], x[7]);
        *(u32x4*)ptr = wv;
    }
}


#define XB_TMO      128
#define XB_XCNT(j)  (256  + 64 * (j))
#define XB_XSUB(j)  (1280 + 64 * (j))
#define XB_XGEN(j)  (2304 + 64 * (j))
#define XB_TOP      3328
#define XB_TOPGEN   3392
#define XCD_BAR_WORDS 3456
#define XB_SPIN_CAP (1u << 20)
__device__ __forceinline__ unsigned xb_ld(unsigned* p)              { return __hip_atomic_load(p, __ATOMIC_RELAXED, __HIP_MEMORY_SCOPE_AGENT); }
__device__ __forceinline__ unsigned xb_add(unsigned* p, unsigned v) { return __hip_atomic_fetch_add(p, v, __ATOMIC_RELAXED, __HIP_MEMORY_SCOPE_AGENT); }
__device__ __forceinline__ unsigned xb_xcc_id() { return (unsigned)__builtin_amdgcn_s_getreg((3 << 11) | 20) & 0xFu; }
#define XB_SPIN(cond, bar) do { unsigned _sp = 0; while (cond) { __builtin_amdgcn_s_sleep(1); \
    if ((++_sp & 255u) == 0u) { if (xb_ld(&(bar)[XB_TMO])) break; if (_sp > XB_SPIN_CAP) { atomicAdd(&(bar)[XB_TMO], 1u); break; } } } } while (0)
struct XcdBarrier { unsigned* bar; unsigned x; volatile LAS unsigned* st; };
__device__ __forceinline__ XcdBarrier xcd_barrier_post(unsigned* bar, volatile LAS unsigned* st) {
    XcdBarrier b; b.bar = bar; b.x = xb_xcc_id(); b.st = st;
    if (threadIdx.x == 0) (void)xb_add(&bar[XB_XCNT(b.x)], 1u);
    return b;
}
__device__ __forceinline__ void xcd_barrier_complete(unsigned* bar, unsigned x, unsigned& nloc, unsigned& nx) {
    const unsigned G = gridDim.x * gridDim.y * gridDim.z;
    unsigned sum, cnt, mine, sp = 0u;
    for (;;) {
        sum = 0u; cnt = 0u; mine = 0u;
#pragma unroll
        for (unsigned j = 0; j < 16; ++j) { const unsigned c = xb_ld(&bar[XB_XCNT(j)]); sum += c; cnt += (c > 0u) ? 1u : 0u; mine = (j == x) ? c : mine; }
        if (sum == G) break;
        __builtin_amdgcn_s_sleep(1);
        if ((++sp & 255u) == 0u) { if (xb_ld(&bar[XB_TMO])) break; if (sp > XB_SPIN_CAP) { atomicAdd(&bar[XB_TMO], 1u); break; } }
    }
    nloc = mine > 0u ? mine : 1u; nx = cnt > 0u ? cnt : 1u;
}
__device__ __forceinline__ void xcd_barrier(const XcdBarrier& b) {
    asm volatile("s_waitcnt vmcnt(0)" ::: "memory");
    __syncthreads();
    if (threadIdx.x == 0) {
        unsigned* bar = b.bar;
        __builtin_amdgcn_s_waitcnt(0);
        unsigned nloc = b.st[0], nx = b.st[1];
        if (nloc == 0u) { xcd_barrier_complete(bar, b.x, nloc, nx); b.st[0] = nloc; b.st[1] = nx; }
        const unsigned old = xb_add(&bar[XB_XSUB(b.x)], 1u);
        const unsigned gen = old / nloc;
        if (old + 1u == (gen + 1u) * nloc) {
            __builtin_amdgcn_fence(__ATOMIC_RELEASE, "agent");
            asm volatile("s_waitcnt vmcnt(0)" ::: "memory");
            const unsigned og = xb_add(&bar[XB_TOP], 1u);
            const unsigned tg = og / nx;
            if (og + 1u == (tg + 1u) * nx) xb_add(&bar[XB_TOPGEN], 1u);
            else XB_SPIN(xb_ld(&bar[XB_TOPGEN]) == tg, bar);
            __builtin_amdgcn_fence(__ATOMIC_ACQUIRE, "agent");
            xb_add(&bar[XB_XGEN(b.x)], 1u);
            asm volatile("s_waitcnt vmcnt(0)" ::: "memory");
        } else {
            XB_SPIN(xb_ld(&bar[XB_XGEN(b.x)]) == gen, bar);
            __builtin_amdgcn_fence(__ATOMIC_ACQUIRE, "agent");
            asm volatile("s_waitcnt vmcnt(0)" ::: "memory");
        }
    }
    __syncthreads();
}

struct KArgs { const float* in[22]; float* out; unsigned char* ws; int ph_lo, ph_hi; };
enum { I_X = 0, I_C, I_CTX, I_CCTX, I_ADAW, I_ADAB, I_NMPRE, I_NMPOST, I_NFPRE, I_NFPOST, I_HWIN, I_HLB, I_HONORM, I_HWOUT, I_AQKV, I_AQN, I_AKN, I_AWOUT, I_FWIN, I_FCW, I_FCB, I_FWOUT };
constexpr int N_PHASES = 20;

__global__ void __launch_bounds__(512, 2) mega_fwd(KArgs a) {
    extern __shared__ __attribute__((aligned(16))) unsigned char lds_raw[];
    LAS unsigned char* lds = (LAS unsigned char*)lds_raw;
    cg::grid_group grid = cg::this_grid();
    const int tid = threadIdx.x, lane = tid & 63, wave = __builtin_amdgcn_readfirstlane(tid >> 6);
    const int G = gridDim.x, wg = blockIdx.x;
    const int gw = wg * 8 + wave, NGW = G * 8;
    unsigned char* ws = a.ws;
    float* mod = (float*)(ws + WS_MOD);
    float* xctx = (float*)(ws + WS_XCTX);
    bf16_t* H = (bf16_t*)(ws + WS_H);
    bf16_t* BIG = (bf16_t*)(ws + WS_BIG);
    bf16_t* Y = (bf16_t*)(ws + WS_BIG);
    bf16_t* XR = (bf16_t*)(ws + WS_BIG + 256 * MiB);
    float* BND = (float*)(ws + WS_BIG + 200 * MiB);
    float* YS = (float*)(ws + WS_BIG + 132 * MiB);
    bf16_t* ACT = (bf16_t*)(ws + WS_ACT);
    bf16_t* OFW = ACT; bf16_t* OBW = ACT + (size_t)MR * DM;
    const int lo = a.ph_lo, hi = a.ph_hi;
#ifndef MK_REPMASK
#define MK_REPMASK 0u
#endif
#define PH(k) if (lo <= (k) && (k) < hi) for (int rep_ = 0; rep_ <= (int)((MK_REPMASK >> (k)) & 1u); ++rep_)
#define SEAM(k) do { if ((k) + 1 < hi) { if ((k) == 0) { asm volatile("s_waitcnt vmcnt(0) lgkmcnt(0)" ::: "memory"); grid.sync(); } else xcd_barrier(bar); } } while (0)
    LAS float* scr = (LAS float*)(lds + wave * 16384);
    volatile LAS unsigned* MISC = (volatile LAS unsigned*)(lds + LDS_BYTES - 256);
    if (tid < 16) MISC[tid] = 0u;
    __syncthreads();
    XcdBarrier bar = xcd_barrier_post((unsigned*)ws, MISC);

    PH(0) {
        ada_phase(a.in[I_C], a.in[I_CCTX], a.in[I_ADAW], a.in[I_ADAB], mod, lds, wg, G, tid);
        constexpr int I0 = 32 * (NHG / 32), I1 = 32 * (DM / 32), I2 = 32 * (2 * DFF / 32), I3 = (DFF / 64) * (DM / 32);
        for (int it = gw; it < I0 + I1 + I2 + I3; it += NGW) {
            int r = it;
            if (r < I0) { transpose_item(a.in[I_HWIN], DM, NHG, (bf16_t*)(ws + W_HIN), scr, r, lane); continue; } r -= I0;
            if (r < I1) { transpose_item(a.in[I_HWOUT], DM, DM, (bf16_t*)(ws + W_HOUT), scr, r, lane); continue; } r -= I1;
            if (r < I2) { transpose_item(a.in[I_FWIN], DM, 2 * DFF, (bf16_t*)(ws + W_FIN), scr, r, lane, true); continue; } r -= I2;
            transpose_item(a.in[I_FWOUT], DFF, DM, (bf16_t*)(ws + W_FOUT), scr, r, lane);
        }
        SEAM(0);
    }
    PH(1) {
        row_phase<false, false>(a.in[I_X], a.in[I_CTX], nullptr, nullptr, XR, nullptr, nullptr, a.in[I_NMPRE], mod, 0, 0, 1, H, false, true, false, gw, NGW, lane);
        SEAM(1);
    }
    PH(2) {
        pg8::Gemm g{H, (const bf16_t*)(ws + W_HIN), MR, NHG, DM}; pg8::Order S; S.init(MR / 256, NHG, DM, G, wg, 0, 0);
        pg8::EpiBf16 E{BIG, NHG};
        pg8::gemm_phase<pg8::EpiBf16, pg8::Order, true, true>(lds, g, S, E);
        SEAM(2);
    }
    PH(3) {
        float* EB = (float*)(ACT + (size_t)2 * MR * DM);
        if (rep_ == 0) gla_prep_phase(BIG, H, EB, a.in[I_HLB], lds, wg, G, tid);
        xcd_barrier(bar);
        for (int item = wg; item < 256; item += G) {
            const int xq = item & 7, yq = item >> 3, vs = yq & 3, sq = xq + 8 * (yq >> 2);
            const int dir = sq & 1, h = (sq >> 1) & 15, b = sq >> 5;
            gla_item(BIG, dir ? H : BIG, dir ? DM : NHG, EB, dir ? OBW : OFW, lds, b, h, dir, vs, tid);
        }
        SEAM(3);
    }
    PH(4) {
        readout_phase(OFW, OBW, BIG, a.in[I_HONORM], H, gw, NGW, lane);
        SEAM(4);
    }
    PH(5) {
        pg8::Gemm g{H, (const bf16_t*)(ws + W_HOUT), MR, DM, DM}; pg8::Order S; S.init(64, DM, DM, G, wg, 1, 16);
        pg8::EpiF32 E{Y, DM, YS, DM / 64};
        pg8::gemm_phase<pg8::EpiF32, pg8::Order, true, true>(lds, g, S, E);
        SEAM(5);
    }
    PH(6) {
        row_phase<false, true>(a.in[I_X], a.in[I_CTX], a.out, xctx, XR, Y, a.in[I_NMPOST], a.in[I_NFPRE], mod, 2, 3, 4, H, true, true, false, gw, NGW, lane, YS, 16);
        SEAM(6);
    }
    PH(7) {
        pg8::Gemm g{H, (const bf16_t*)(ws + W_FIN), MR, 2 * DFF, DM}; pg8::Order S; S.init(MR / 256, 2 * DFF, DM, G, wg, 0, 0);
        pg8::EpiConv E{ACT, a.in[I_FCW], a.in[I_FCB], BND, (LAS float*)(lds + 131072)};
        pg8::gemm_phase<pg8::EpiConv, pg8::Order, true, true>(lds, g, S, E);
        SEAM(7);
    }
    PH(8) {
        conv_fix_phase(BND, a.in[I_FCW], a.in[I_FCB], ACT, false, gw, NGW, lane);
        SEAM(8);
    }
    PH(9) {
        pg8::Gemm g{ACT, (const bf16_t*)(ws + W_FOUT), MR, DM, DFF}; pg8::Order S; S.init(64, DM, DFF, G, wg, 1, 11);
        pg8::EpiF32 E{Y, DM, YS, DFF / 64};
        pg8::gemm_phase<pg8::EpiF32, pg8::Order, true, true>(lds, g, S, E);
        SEAM(9);
    }
    PH(10) {
        row_phase<true, true>(a.out, xctx, a.out, xctx, XR, Y, a.in[I_NFPOST], a.in[I_NMPRE] + DM, mod, 5, 6 * 3 + 0, 6 * 3 + 1, H, true, true, false, gw, NGW, lane, YS, 11);
        __syncthreads();
        constexpr int I0 = 32 * (NQKV / 32), I1 = 32 * (DM / 32), I2 = 32 * (2 * DFF / 32), I3 = (DFF / 64) * (DM / 32);
        for (int it = gw; it < I0 + I1 + I2 + I3; it += NGW) {
            int r = it;
            if (r < I0) { transpose_item(a.in[I_AQKV], DM, NQKV, (bf16_t*)(ws + W_QKV), scr, r, lane); continue; } r -= I0;
            if (r < I1) { transpose_item(a.in[I_AWOUT], DM, DM, (bf16_t*)(ws + W_AOUT), scr, r, lane); continue; } r -= I1;
            if (r < I2) { transpose_item(a.in[I_FWIN] + (size_t)DM * 2 * DFF, DM, 2 * DFF, (bf16_t*)(ws + W_FIN), scr, r, lane, true); continue; } r -= I2;
            transpose_item(a.in[I_FWOUT] + (size_t)DFF * DM, DFF, DM, (bf16_t*)(ws + W_FOUT), scr, r, lane);
        }
        SEAM(10);
    }
    PH(11) {
        pg8::Gemm g{H, (const bf16_t*)(ws + W_QKV), MR, NQKV, DM}; pg8::Order S; S.init(MR / 256, NQKV, DM, G, wg, 0, 0);
        pg8::EpiBf16 E{BIG, NQKV};
        pg8::gemm_phase<pg8::EpiBf16, pg8::Order, true, true>(lds, g, S, E);
        SEAM(11);
    }
    PH(12) {
        qknorm_phase(BIG, a.in[I_AQN], a.in[I_AKN], gw, NGW, lane);
        SEAM(12);
    }
    PH(13) {
        for (int u = wg; u < 1024; u += G) {
            const int x = u & 7, rest = u >> 3, j = rest & 31, i = rest >> 5;
            const int b = x >> 2, kvh = x & 3, h = kvh * 4 + i;
            const size_t qrow = (size_t)b * SB + CTX + (size_t)j * 256;
            att::attn_dense_body(BIG + qrow * NQKV + h * 128, BIG + (size_t)b * SB * NQKV + 2048 + kvh * 128, BIG + (size_t)b * SB * NQKV + 2560 + kvh * 128,
                                 ACT + qrow * DM + h * 128, SB, (char*)lds_raw);
        }
        SEAM(13);
    }
    PH(14) {
        pg8::Gemm g{ACT, (const bf16_t*)(ws + W_AOUT), MR, DM, DM}; pg8::Order S; S.init(64, DM, DM, G, wg, 1, 0);
        pg8::EpiF32 E{Y, DM, nullptr, 0};
        pg8::gemm_phase<pg8::EpiF32, pg8::Order, true, true>(lds, g, S, E);
        SEAM(14);
    }
    PH(15) {
        row_phase<true, true>(a.out, xctx, a.out, xctx, XR, Y, a.in[I_NMPOST] + DM, a.in[I_NFPRE] + DM, mod + 3 * 12288, 2, 3, 4, H, true, true, true, gw, NGW, lane);
        SEAM(15);
    }
    PH(16) {
        pg8::Gemm g{H, (const bf16_t*)(ws + W_FIN), MR, 2 * DFF, DM}; pg8::Order S; S.init(64, 2 * DFF, DM, G, wg, 1, 0);
        pg8::EpiConv E{ACT, a.in[I_FCW] + 3 * DFF, a.in[I_FCB] + DFF, BND, (LAS float*)(lds + 131072)};
        pg8::gemm_phase<pg8::EpiConv, pg8::Order, true, true>(lds, g, S, E);
        SEAM(16);
    }
    PH(17) {
        conv_fix_phase(BND, a.in[I_FCW] + 3 * DFF, a.in[I_FCB] + DFF, ACT, true, gw, NGW, lane);
        SEAM(17);
    }
    PH(18) {
        pg8::Gemm g{ACT, (const bf16_t*)(ws + W_FOUT), MR, DM, DFF}; pg8::Order S; S.init(64, DM, DFF, G, wg, 1, 0);
        pg8::EpiF32 E{Y, DM, nullptr, 0};
        pg8::gemm_phase<pg8::EpiF32, pg8::Order, true, true>(lds, g, S, E);
        SEAM(18);
    }
    PH(19) {
        row_phase<true, false>(a.out, xctx, a.out, xctx, XR, Y, a.in[I_NFPOST] + DM, nullptr, mod + 3 * 12288, 5, 0, 0, H, true, false, true, gw, NGW, lane);
    }
#undef PH
#undef SEAM
}


extern "C" void kernel_launch(void* const* d_in, const int* in_sizes, int n_in, void* d_out, int out_size, void* d_ws, size_t ws_size, hipStream_t stream) {
    static int grid = 0;
    if (grid == 0) {
        if (n_in != 22 || ws_size < WS_END || out_size != NB * SEQ * DM) { fprintf(stderr, "kernel_launch: unexpected shapes n_in %d ws %zu out %d\n", n_in, ws_size, out_size); grid = -1; return; }
        int dev = 0, cus = 0, per_cu = 0;
        if (hipGetDevice(&dev) != hipSuccess || hipDeviceGetAttribute(&cus, hipDeviceAttributeMultiprocessorCount, dev) != hipSuccess) { grid = -1; return; }
        if (hipFuncSetAttribute((const void*)mega_fwd, hipFuncAttributeMaxDynamicSharedMemorySize, LDS_BYTES) != hipSuccess) { fprintf(stderr, "kernel_launch: hipFuncSetAttribute failed\n"); grid = -1; return; }
        if (hipOccupancyMaxActiveBlocksPerMultiprocessor(&per_cu, (const void*)mega_fwd, 512, LDS_BYTES) != hipSuccess || per_cu < 1) { fprintf(stderr, "kernel_launch: occupancy query says %d\n", per_cu); per_cu = 1; }
        (void)hipGetLastError();
        grid = cus * 1;
    }
    if (grid < 0) return;
    KArgs a{};
    for (int i = 0; i < 22; ++i) a.in[i] = (const float*)d_in[i];
    a.out = (float*)d_out; a.ws = (unsigned char*)d_ws;
    a.ph_lo = 0; a.ph_hi = N_PHASES;
    if (hipMemsetAsync(d_ws, 0, 16384, stream) != hipSuccess) { fprintf(stderr, "kernel_launch: memset failed\n"); return; }
    void* args[] = {&a};
    hipError_t e = hipLaunchCooperativeKernel((const void*)mega_fwd, dim3(grid), dim3(512), args, LDS_BYTES, stream);
    if (e != hipSuccess) fprintf(stderr, "cooperative launch failed: %s (grid %d)\n", hipGetErrorString(e), grid);
}
```
